# Optimizing an MI355X kernel written in HIP

```python
import math
import numpy as np
import jax
import jax.numpy as jnp
from jax import lax

D_MODEL = 1024
BATCH = 4
SEQ = 4096
DEPTH = 4

HEAD_DIM = 64
QBLK = 128
SPARSE_QCHUNK = 32
NEG_INF = -1e30
EPS = 1e-6

NSA_HEADS = 4
CMP_BLOCK = 32
CMP_STRIDE = 16
CMP_HIDDEN = 256
SEL_BLOCK = 64
SEL_TOPK = 8
NSA_WINDOW = 512
FORCE_BONUS = 1e4
SWA_HEADS = 4
SWA_KV_HEADS = 2
SWA_WINDOW = 128
MOBA_HEADS = 4
MOBA_BLOCK = 256
MOBA_TOPK = 3
MLA_HEADS = 4
MLA_Q_RANK = 384
MLA_KV_RANK = 128
MLA_NOPE = 64
MLA_ROPE = 32
MLA_V = 64
ROPE_THETA = 10000.0
N_BRANCH = 4
BRANCH_WIDTH = 256
N_GROUPS = 4
EXPERTS_PER_GROUP = 8
N_EXPERTS = N_GROUPS * EXPERTS_PER_GROUP
TOPK_IN_GROUP = 2
D_EXPERT = 256
MOE_BLOCK = 128

QK_NSA_Q = 0
QK_NSA_KC = 1
QK_NSA_KS = 2
QK_NSA_KW = 3
QK_SWA_Q = 4
QK_SWA_K = 5
QK_MOBA_Q = 6
QK_MOBA_K = 7
QK_MLA_Q = 8
QK_MLA_K = 9
N_QK = 10

IN_SIZES = (
    NSA_HEADS * HEAD_DIM,
    HEAD_DIM, HEAD_DIM,
    HEAD_DIM, HEAD_DIM,
    HEAD_DIM, HEAD_DIM,
    3 * NSA_HEADS,
    SWA_HEADS * HEAD_DIM,
    SWA_KV_HEADS * HEAD_DIM,
    SWA_KV_HEADS * HEAD_DIM,
    MOBA_HEADS * HEAD_DIM,
    MOBA_HEADS * HEAD_DIM,
    MOBA_HEADS * HEAD_DIM,
    MLA_Q_RANK,
    MLA_KV_RANK,
    MLA_ROPE,
    N_BRANCH * D_MODEL,
)
D_IN = sum(IN_SIZES)

kernel_name = 'hybrid_nsa_swa_moba_mla_hmoe_trunk'


def rms_norm(x, g):
    xf = x.astype(jnp.float32)
    y = xf * lax.rsqrt(jnp.mean(xf * xf, axis=-1, keepdims=True) + EPS)
    return (y * g.astype(jnp.float32)).astype(x.dtype)


def alibi_slopes():
    n = NSA_HEADS + SWA_HEADS + MOBA_HEADS
    def pow2(m):
        start = 2.0 ** (-8.0 / m)
        return [start ** (i + 1) for i in range(m)]
    c = 2 ** int(math.floor(math.log2(n)))
    s = pow2(c) + (pow2(2 * c)[0::2][: n - c] if c < n else [])
    s = -np.sort(-np.asarray(s, np.float32))
    return s.reshape(NSA_HEADS, 3).T


def to_chunks(a, n_chunks):
    return jnp.moveaxis(a.reshape(a.shape[0], n_chunks, -1, *a.shape[2:]), 1, 0)


def from_chunks(a):
    return jnp.moveaxis(a, 0, 1).reshape(a.shape[1], -1, *a.shape[3:])


def apply_rope(x, pos):
    half = x.shape[-1] // 2
    inv = ROPE_THETA ** (-jnp.arange(half, dtype=jnp.float32) / half)
    ang = pos.astype(jnp.float32)[:, None] * inv[None, :]
    cos = jnp.cos(ang)[:, None, :]
    sin = jnp.sin(ang)[:, None, :]
    xf = x.astype(jnp.float32)
    x1, x2 = xf[..., :half], xf[..., half:]
    return jnp.concatenate([x1 * cos - x2 * sin, x1 * sin + x2 * cos], axis=-1).astype(x.dtype)


def banded_attention(q, k, v, window, slopes, sinks):
    B, S, H, dh = q.shape
    G = k.shape[2]
    R = H // G
    f32 = jnp.float32
    nq = S // QBLK
    span = window + QBLK
    pad = ((0, 0), (window, 0), (0, 0), (0, 0))
    idx = (jnp.arange(nq) * QBLK)[:, None] + jnp.arange(span)[None, :]
    kb = jnp.pad(k, pad)[:, idx]
    vb = jnp.pad(v, pad)[:, idx]
    qb = q.reshape(B, nq, QBLK, G, R, dh)
    s = jnp.einsum('bnqgrd,bnkgd->bngrqk', qb, kb, preferred_element_type=f32) * (dh ** -0.5)
    tq = (jnp.arange(nq) * QBLK)[:, None] + jnp.arange(QBLK)[None, :]
    kpos = idx - window
    dist = tq[:, :, None] - kpos[:, None, :]
    valid = (dist >= 0) & (dist < window) & (kpos[:, None, :] >= 0)
    sl = slopes.reshape(G, R)[None, None, :, :, None, None]
    s = s - sl * dist.astype(f32)[None, :, None, None]
    s = jnp.where(valid[None, :, None, None], s, NEG_INF)
    if sinks is None:
        p = jax.nn.softmax(s, axis=-1)
    else:
        sk = sinks.astype(f32).reshape(G, R)[None, None, :, :, None, None]
        m = jnp.maximum(jnp.max(s, axis=-1, keepdims=True), sk)
        e = jnp.exp(s - m)
        p = e / (jnp.sum(e, axis=-1, keepdims=True) + jnp.exp(sk - m))
    out = jnp.einsum('bngrqk,bnkgd->bnqgrd', p.astype(v.dtype), vb)
    return out.reshape(B, S, H, dh)


def compress_blocks(kv, pe, w1, w2):
    B, S, dk = kv.shape
    n_cmp = (S - CMP_BLOCK) // CMP_STRIDE + 1
    idx = (jnp.arange(n_cmp) * CMP_STRIDE)[:, None] + jnp.arange(CMP_BLOCK)[None, :]
    blk = (kv[:, idx] + pe).reshape(B, n_cmp, CMP_BLOCK * dk)
    return jax.nn.silu(blk @ w1) @ w2


def selected_block_attention(q, k, v, sel_idx, sel_ok, slopes):
    B, S, H, dk = q.shape
    n = sel_idx.shape[-1]
    f32 = jnp.float32
    nch = S // SPARSE_QCHUNK
    kblk = k.reshape(B, S // SEL_BLOCK, SEL_BLOCK, dk)
    vblk = v.reshape(B, S // SEL_BLOCK, SEL_BLOCK, dk)
    bi = jnp.arange(B)[:, None, None]
    off = jnp.arange(SEL_BLOCK)

    def chunk(args):
        qi, ii, oi, ci = args
        kg = kblk[bi, ii]
        vg = vblk[bi, ii]
        s = jnp.einsum('bchd,bcnld->bchnl', qi, kg, preferred_element_type=f32) * (dk ** -0.5)
        t = ci * SPARSE_QCHUNK + jnp.arange(SPARSE_QCHUNK)
        dist = t[None, :, None, None] - (ii[..., None] * SEL_BLOCK + off)
        valid = oi[..., None] & (dist >= 0)
        s = s - slopes[None, None, :, None, None] * dist[:, :, None].astype(f32)
        s = jnp.where(valid[:, :, None], s, NEG_INF).reshape(B, SPARSE_QCHUNK, H, n * SEL_BLOCK)
        p = jax.nn.softmax(s, axis=-1).astype(v.dtype)
        return jnp.einsum('bchk,bckd->bchd', p, vg.reshape(B, SPARSE_QCHUNK, n * SEL_BLOCK, dk))

    out = lax.map(chunk, (to_chunks(q, nch), to_chunks(sel_idx, nch), to_chunks(sel_ok, nch), jnp.arange(nch)))
    return from_chunks(out)


def nsa_attention(q, kc_raw, vc_raw, ks, vs, kw, vw, gate_logit, g_kc, pe, w1, w2, slopes):
    B, S, H, dk = q.shape
    f32 = jnp.float32
    t = jnp.arange(S)
    kc = rms_norm(compress_blocks(kc_raw, pe[0], w1[0], w2[0]), g_kc)
    vc = compress_blocks(vc_raw, pe[1], w1[1], w2[1])
    n_cmp = kc.shape[1]
    c_end = jnp.arange(n_cmp) * CMP_STRIDE + CMP_BLOCK - 1
    dist = t[:, None] - c_end[None, :]
    vis = dist >= 0
    s = jnp.einsum('bshd,bnd->bhsn', q, kc, preferred_element_type=f32) * (dk ** -0.5)
    s = s - slopes[None, :, None, None] * dist.astype(f32)
    s = jnp.where(vis, s, NEG_INF)
    e = jnp.exp(s - jnp.max(s, axis=-1, keepdims=True)) * vis
    p_cmp = e / jnp.maximum(jnp.sum(e, axis=-1, keepdims=True), 1e-30)
    o_cmp = jnp.einsum('bhsn,bnd->bshd', p_cmp.astype(vc.dtype), vc)
    n_sel = S // SEL_BLOCK
    starts = np.arange(n_cmp) * CMP_STRIDE
    jb = np.arange(n_sel) * SEL_BLOCK
    cover = ((starts[:, None] < jb[None, :] + SEL_BLOCK) & (starts[:, None] + CMP_BLOCK > jb[None, :])).astype(np.float32)
    p_slc = jnp.einsum('bhsn,nj->bsj', p_cmp, jnp.asarray(cover))
    cur = (t // SEL_BLOCK)[:, None]
    j = jnp.arange(n_sel)[None, :]
    forced = (j == 0) | (j == cur) | (j == cur - 1)
    score = jnp.where(j <= cur, p_slc + FORCE_BONUS * forced.astype(f32), NEG_INF)
    top_val, top_idx = lax.top_k(score, min(SEL_TOPK, n_sel))
    o_slc = selected_block_attention(q, ks, vs, top_idx, top_val > 0.5 * NEG_INF, slopes)
    o_win = banded_attention(q, kw[:, :, None], vw[:, :, None], NSA_WINDOW, slopes, None)
    g = jax.nn.sigmoid(gate_logit.astype(f32)).reshape(B, S, H, 3).astype(q.dtype)
    return g[..., 0:1] * o_cmp + g[..., 1:2] * o_slc + g[..., 2:3] * o_win


def moba_attention(q, k, v, slopes):
    B, S, H, dh = q.shape
    f32 = jnp.float32
    L = MOBA_BLOCK
    nb = -(-S // L)
    pad = ((0, 0), (0, nb * L - S), (0, 0), (0, 0))
    kp = jnp.pad(k, pad)
    vp = jnp.pad(v, pad)
    kblk = kp.reshape(B, nb, L, H, dh)
    kmean = jnp.mean(kblk.astype(f32), axis=2)
    t = jnp.arange(S)
    gs = jnp.einsum('bshd,bnhd->bshn', q.astype(f32), kmean)
    past = jnp.arange(nb)[None, :] < (t // L)[:, None]
    gs = jnp.where(past[None, :, None, :], gs, NEG_INF)
    kk = min(MOBA_TOPK, nb)
    top_val, top_idx = lax.top_k(gs, kk)
    top_ok = top_val > 0.5 * NEG_INF
    kbh = jnp.transpose(kblk, (0, 3, 1, 2, 4))
    vbh = jnp.transpose(vp.reshape(B, nb, L, H, dh), (0, 3, 1, 2, 4))
    bi = jnp.arange(B)[:, None, None, None]
    hi = jnp.arange(H)[None, None, :, None]
    off = jnp.arange(L)
    scale = dh ** -0.5
    C = SPARSE_QCHUNK
    nch = S // C

    def chunk(args):
        qi, ii, oi, ci = args
        tc = ci * C + jnp.arange(C)
        kg = kbh[bi, hi, ii]
        vg = vbh[bi, hi, ii]
        s_past = jnp.einsum('bchd,bchild->bchil', qi, kg, preferred_element_type=f32) * scale
        d_past = tc[None, :, None, None, None] - (ii[..., None] * L + off)
        s_past = s_past - slopes[None, None, :, None, None] * d_past.astype(f32)
        s_past = jnp.where(oi[..., None], s_past, NEG_INF).reshape(B, C, H, kk * L)
        start = (ci * C // L) * L
        ko = lax.dynamic_slice_in_dim(kp, start, L, axis=1)
        vo = lax.dynamic_slice_in_dim(vp, start, L, axis=1)
        s_own = jnp.einsum('bchd,blhd->bchl', qi, ko, preferred_element_type=f32) * scale
        d_own = tc[:, None] - (start + off)[None, :]
        s_own = s_own - slopes[None, None, :, None] * d_own.astype(f32)[None, :, None, :]
        s_own = jnp.where((d_own >= 0)[None, :, None, :], s_own, NEG_INF)
        p = jax.nn.softmax(jnp.concatenate([s_past, s_own], axis=-1), axis=-1).astype(v.dtype)
        o_past = jnp.einsum('bchk,bchkd->bchd', p[..., : kk * L], vg.reshape(B, C, H, kk * L, dh))
        o_own = jnp.einsum('bchl,blhd->bchd', p[..., kk * L:], vo)
        return o_past + o_own

    out = lax.map(chunk, (to_chunks(q, nch), to_chunks(top_idx, nch), to_chunks(top_ok, nch), jnp.arange(nch)))
    return from_chunks(out)


def causal_attention(q, k, v):
    B, S, H, dq = q.shape
    nq = S // QBLK
    kpos = jnp.arange(S)

    def block(args):
        qi, bidx = args
        s = jnp.einsum('bqhd,bkhd->bhqk', qi, k, preferred_element_type=jnp.float32) * (dq ** -0.5)
        tq = bidx * QBLK + jnp.arange(QBLK)
        s = jnp.where((kpos[None, :] <= tq[:, None])[None, None], s, NEG_INF)
        p = jax.nn.softmax(s, axis=-1).astype(v.dtype)
        return jnp.einsum('bhqk,bkhd->bqhd', p, v)

    out = lax.map(block, (to_chunks(q, nq), jnp.arange(nq)))
    return from_chunks(out)


def mla_attention(cq, ckv, k_rope, g_cq, g_ckv, w_uq, w_ukv, g_qn, g_kn, g_rope, pos):
    B, S, _ = cq.shape
    q = (rms_norm(cq, g_cq) @ w_uq).reshape(B, S, MLA_HEADS, MLA_NOPE + MLA_ROPE)
    kv = (rms_norm(ckv, g_ckv) @ w_ukv).reshape(B, S, MLA_HEADS, MLA_NOPE + MLA_V)
    q_nope = rms_norm(q[..., :MLA_NOPE], g_qn)
    q_rot = apply_rope(rms_norm(q[..., MLA_NOPE:], g_rope[0]), pos)
    k_nope = rms_norm(kv[..., :MLA_NOPE], g_kn)
    v = kv[..., MLA_NOPE:]
    k_rot = apply_rope(rms_norm(k_rope, g_rope[1])[:, :, None, :], pos)
    qf = jnp.concatenate([q_nope, q_rot], axis=-1)
    kf = jnp.concatenate([k_nope, jnp.broadcast_to(k_rot, (B, S, MLA_HEADS, MLA_ROPE))], axis=-1)
    return causal_attention(qf, kf, v)


def routed_experts(xf, eid, wts, w13, w2):
    N, D = xf.shape
    K = eid.shape[1]
    E = w13.shape[0]
    flat_e = eid.reshape(-1)
    order = jnp.argsort(flat_e)
    se = flat_e[order]
    counts = jnp.bincount(flat_e, length=E)
    padded = (counts + MOE_BLOCK - 1) // MOE_BLOCK * MOE_BLOCK
    pend = jnp.cumsum(padded)
    pstart = pend - padded
    start = jnp.cumsum(counts) - counts
    dest = pstart[se] + jnp.arange(N * K) - start[se]
    n_blocks = -(-(N * K) // MOE_BLOCK) + E
    R = n_blocks * MOE_BLOCK
    row_tok = jnp.full((R,), N, jnp.int32).at[dest].set((order // K).astype(jnp.int32))
    row_w = jnp.zeros((R,), xf.dtype).at[dest].set(wts.reshape(-1)[order])
    blk_e = jnp.minimum(jnp.searchsorted(pend, jnp.arange(n_blocks) * MOE_BLOCK, side='right'), E - 1)
    xpad = jnp.concatenate([xf, jnp.zeros((1, D), xf.dtype)], axis=0)
    xb = xpad[row_tok].reshape(n_blocks, MOE_BLOCK, D)

    def block(args):
        xi, e = args
        a, b = jnp.split(xi @ w13[e], 2, axis=-1)
        return (jax.nn.silu(a) * b) @ w2[e]

    yb = lax.map(block, (xb, blk_e)).reshape(R, D)
    y = jnp.zeros((N + 1, D), xf.dtype).at[row_tok].add(yb * row_w[:, None])
    return y[:N]


def hier_moe(h, w_coarse, b_coarse, w_fine, b_fine, w13, w2):
    B, S, D = h.shape
    N = B * S
    f32 = jnp.float32
    xf = h.reshape(N, D)
    lc = (xf @ w_coarse).astype(f32) + b_coarse.astype(f32)
    grp = jnp.argmax(lc, axis=-1)
    p_grp = jnp.take_along_axis(jax.nn.softmax(lc, axis=-1), grp[:, None], axis=-1)
    lf = ((xf @ w_fine).astype(f32) + b_fine.astype(f32)).reshape(N, N_GROUPS, EXPERTS_PER_GROUP)
    lf = jnp.take_along_axis(lf, grp[:, None, None], axis=1)[:, 0]
    top_p, top_e = lax.top_k(jax.nn.softmax(lf, axis=-1), TOPK_IN_GROUP)
    wts = p_grp * top_p / jnp.sum(top_p, axis=-1, keepdims=True)
    eid = (grp[:, None] * EXPERTS_PER_GROUP + top_e).astype(jnp.int32)
    return routed_experts(xf, eid, wts.astype(h.dtype), w13, w2).reshape(B, S, D)


def setup_inputs(seed: int = 0) -> dict:
    key = jax.random.key(seed)
    ks = jax.random.split(key, 24)
    f32 = jnp.float32
    L = DEPTH
    D = D_MODEL

    def nrm(k, shape, fan_in, s=1.0):
        return (s * fan_in ** -0.5) * jax.random.normal(k, shape, f32)

    def gain(k, shape):
        return 1.0 + 0.05 * jax.random.normal(k, shape, f32)

    return {
        'x': jax.random.normal(ks[0], (BATCH, SEQ, D), f32),
        'c': jax.random.normal(ks[1], (BATCH, D), f32),
        'w_ada': nrm(ks[2], (L, D, 6 * D), D, 0.5),
        'b_ada': 0.02 * jax.random.normal(ks[3], (L, 6 * D), f32),
        'norm_gain': gain(ks[4], (L, 2, D)),
        'w_in': nrm(ks[5], (L, D, D_IN), D),
        'qk_gain': gain(ks[6], (L, N_QK, HEAD_DIM)),
        'cmp_pe': 0.02 * jax.random.normal(ks[7], (L, 2, CMP_BLOCK, HEAD_DIM), f32),
        'cmp_w1': nrm(ks[8], (L, 2, CMP_BLOCK * HEAD_DIM, CMP_HIDDEN), CMP_BLOCK * HEAD_DIM),
        'cmp_w2': nrm(ks[9], (L, 2, CMP_HIDDEN, HEAD_DIM), CMP_HIDDEN),
        'swa_sinks': jax.random.normal(ks[10], (L, SWA_HEADS), f32),
        'lat_gain_q': gain(ks[11], (L, MLA_Q_RANK)),
        'lat_gain_kv': gain(ks[12], (L, MLA_KV_RANK)),
        'rope_gain': gain(ks[13], (L, 2, MLA_ROPE)),
        'w_uq': nrm(ks[14], (L, MLA_Q_RANK, MLA_HEADS * (MLA_NOPE + MLA_ROPE)), MLA_Q_RANK),
        'w_ukv': nrm(ks[15], (L, MLA_KV_RANK, MLA_HEADS * (MLA_NOPE + MLA_V)), MLA_KV_RANK),
        'w_branch': nrm(ks[16], (L, N_BRANCH, BRANCH_WIDTH, D), BRANCH_WIDTH),
        'w_out': nrm(ks[17], (L, D, D), D),
        'w_coarse': nrm(ks[18], (L, D, N_GROUPS), D),
        'b_coarse': 0.01 * jax.random.normal(ks[19], (L, N_GROUPS), f32),
        'w_fine': nrm(ks[20], (L, D, N_EXPERTS), D),
        'b_fine': 0.01 * jax.random.normal(ks[21], (L, N_EXPERTS), f32),
        'w13': nrm(ks[22], (L, N_EXPERTS, D, 2 * D_EXPERT), D),
        'w2': nrm(ks[23], (L, N_EXPERTS, D_EXPERT, D), D_EXPERT),
    }


def reference(x, c, w_ada, b_ada, norm_gain, w_in, qk_gain, cmp_pe, cmp_w1, cmp_w2, swa_sinks,
              lat_gain_q, lat_gain_kv, rope_gain, w_uq, w_ukv, w_branch, w_out,
              w_coarse, b_coarse, w_fine, b_fine, w13, w2):
    B, S, D = x.shape
    slopes = jnp.asarray(alibi_slopes())
    pos = jnp.arange(S)
    split_at = np.cumsum(IN_SIZES)[:-1].tolist()
    for l in range(DEPTH):
        mod = jax.nn.silu(c) @ w_ada[l] + b_ada[l]
        sh1, sc1, g1, sh2, sc2, g2 = jnp.split(mod[:, None, :], 6, axis=-1)
        h = rms_norm(x, norm_gain[l, 0]) * (1.0 + sc1) + sh1
        (q_a, kc_a, vc_a, ks_a, vs_a, kw_a, vw_a, gl_a,
         q_b, k_b, v_b, q_c, k_c, v_c, cq_d, ckv_d, kr_d, gate_in) = jnp.split(h @ w_in[l], split_at, axis=-1)
        gq = qk_gain[l]
        o_a = nsa_attention(rms_norm(q_a.reshape(B, S, NSA_HEADS, HEAD_DIM), gq[QK_NSA_Q]),
                            kc_a, vc_a, rms_norm(ks_a, gq[QK_NSA_KS]), vs_a,
                            rms_norm(kw_a, gq[QK_NSA_KW]), vw_a, gl_a, gq[QK_NSA_KC],
                            cmp_pe[l], cmp_w1[l], cmp_w2[l], slopes[0])
        o_b = banded_attention(rms_norm(q_b.reshape(B, S, SWA_HEADS, HEAD_DIM), gq[QK_SWA_Q]),
                               rms_norm(k_b.reshape(B, S, SWA_KV_HEADS, HEAD_DIM), gq[QK_SWA_K]),
                               v_b.reshape(B, S, SWA_KV_HEADS, HEAD_DIM), SWA_WINDOW, slopes[1], swa_sinks[l])
        o_c = moba_attention(rms_norm(q_c.reshape(B, S, MOBA_HEADS, HEAD_DIM), gq[QK_MOBA_Q]),
                             rms_norm(k_c.reshape(B, S, MOBA_HEADS, HEAD_DIM), gq[QK_MOBA_K]),
                             v_c.reshape(B, S, MOBA_HEADS, HEAD_DIM), slopes[2])
        o_d = mla_attention(cq_d, ckv_d, kr_d, lat_gain_q[l], lat_gain_kv[l], w_uq[l], w_ukv[l],
                            gq[QK_MLA_Q], gq[QK_MLA_K], rope_gain[l], pos)
        branches = jnp.stack([o_a.reshape(B, S, BRANCH_WIDTH), o_b.reshape(B, S, BRANCH_WIDTH),
                              o_c.reshape(B, S, BRANCH_WIDTH), o_d.reshape(B, S, BRANCH_WIDTH)], axis=2)
        proj = jnp.einsum('bsnw,nwd->bsnd', branches, w_branch[l])
        gates = jax.nn.sigmoid(gate_in.reshape(B, S, N_BRANCH, D))
        mixed = jnp.sum(gates * proj, axis=2) @ w_out[l]
        x = x + g1 * mixed
        h2 = rms_norm(x, norm_gain[l, 1]) * (1.0 + sc2) + sh2
        x = x + g2 * hier_moe(h2, w_coarse[l], b_coarse[l], w_fine[l], b_fine[l], w13[l], w2[l])
    return x
```

```cpp
#include <hip/hip_runtime.h>
#include <cstdio>
#include <cstdint>
#include <cmath>

#ifndef MK_ONE_LAUNCH
#define MK_ONE_LAUNCH 1
#endif

#define DEV __device__ __forceinline__
#define LAS __attribute__((address_space(3)))
typedef unsigned short bf16_t;
typedef short bf16x8 __attribute__((ext_vector_type(8)));
typedef float f32x4 __attribute__((ext_vector_type(4)));
typedef unsigned u32x4 __attribute__((ext_vector_type(4)));
typedef unsigned u32x2 __attribute__((ext_vector_type(2)));

constexpr int NBATCH = 4, SEQ = 4096, DM = 1024, NTOK = NBATCH * SEQ, NLAYER = 4;
constexpr int DIN = 6572, NSMALL = 2476, PSW = 2560, NPROJ = 6656, NGATE = 4096;
constexpr int I_QA = 0, I_KC = 256, I_VC = 320, I_KS = 384, I_VS = 448, I_KW = 512, I_VW = 576, I_GL = 640, I_QB = 652, I_KB = 908, I_VB = 1036,
              I_QC = 1164, I_KCC = 1420, I_VCC = 1676, I_CQ = 1932, I_CKV = 2316, I_KR = 2444;
constexpr int ACTW = 2560;
constexpr int A_QA = 0, A_KCR = 256, A_VCR = 320, A_KS = 384, A_VS = 448, A_KW = 512, A_VW = 576, A_QB = 640, A_KB = 896, A_VB = 1024,
              A_QC = 1152, A_KC = 1408, A_VC = 1664, A_CQ = 1920, A_CKV = 2304, A_KR = 2432;
constexpr int ACT2W = 896, A2_QF = 0, A2_KN = 384, A2_VD = 640;
constexpr int NCMP = 255, NEXP = 32, XS_ROWS = 40960;
constexpr float EPS = 1e-6f;
__device__ const float SLOPES[3][4] = {{0.70710678118654752f, 0.25f, 0.08838834764831845f, 0.015625f},
                                       {0.5f, 0.17677669529663689f, 0.0625f, 0.0078125f},
                                       {0.35355339059327379f, 0.125f, 0.03125f, 0.00390625f}};

constexpr size_t MiB = 1u << 20;
constexpr size_t WS_CTL = 0;
constexpr size_t WS_MOD = 1 * MiB;
constexpr size_t WS_ROPE = 2 * MiB;
constexpr size_t WS_MISC = 3 * MiB;
constexpr size_t WS_WIN = 8 * MiB;
constexpr size_t WS_W13 = WS_WIN + 56 * MiB;
constexpr size_t WS_W2 = WS_W13 + 128 * MiB;
constexpr size_t WS_WOUT = WS_W2 + 64 * MiB;
constexpr size_t WS_WBR = WS_WOUT + 8 * MiB;
constexpr size_t WS_CW1 = WS_WBR + 8 * MiB;
constexpr size_t WS_WU = WS_CW1 + 8 * MiB;
constexpr size_t WS_HBF = WS_WU + 4 * MiB;
constexpr size_t WS_BIG = WS_HBF + 32 * MiB;
constexpr size_t WS_GATES = WS_BIG + 160 * MiB;
constexpr size_t WS_ACT = WS_GATES + 128 * MiB;
constexpr size_t WS_ACT2 = WS_ACT + 80 * MiB;
constexpr size_t WS_MUR = WS_ACT2 + 28 * MiB;
constexpr size_t WS_CMPA = WS_MUR + 64 * MiB;
constexpr size_t WS_HID = WS_CMPA + 8 * MiB;
constexpr size_t WS_PB = WS_HID + 1 * MiB;
constexpr size_t WS_OCMP = WS_PB + 16 * MiB;
constexpr size_t WS_OWIN = WS_OCMP + 16 * MiB;
constexpr size_t WS_SMALL = WS_OWIN + 16 * MiB;
constexpr size_t WS_BR = WS_SMALL + 2 * MiB;
constexpr size_t WS_END = WS_BR + 32 * MiB;
static_assert(WS_END <= 1000 * MiB, "workspace map");
constexpr size_t BIG_PSM = 0, BIG_MIX = 0, BIG_MIXB = 64 * MiB, BIG_XS = 0, BIG_YP = 80 * MiB;
constexpr size_t MISC_KCMP = 0, MISC_VCMP = 256 * 1024, MISC_KMEAN = 512 * 1024, MISC_EID = 640 * 1024, MISC_WTS = 768 * 1024, MISC_PSLOT = 896 * 1024;
constexpr size_t SM_PL = 0, SM_SEL = 256 * 1024, SM_GA = 512 * 1024;
constexpr int CW_BAR = 4096;
constexpr int CW_CNT = 16384;
constexpr int CW_CUR = 16384 + 256;

constexpr int RING_BYTES = 131072, LDS_AUX = RING_BYTES, LDS_BYTES = 147456;

struct Params { const float* in[24]; float* out; unsigned char* ws; };

DEV float bf2f(unsigned v) { return __uint_as_float(v << 16); }
DEV float bflo(unsigned w) { return __uint_as_float(w << 16); }
DEV float bfhi(unsigned w) { return __uint_as_float(w & 0xffff0000u); }
DEV unsigned f2bf(float f) { unsigned u = __float_as_uint(f); return (u + 0x7fffu + ((u >> 16) & 1u)) >> 16; }
DEV unsigned pk2(float lo, float hi) { return f2bf(lo) | (f2bf(hi) << 16); }
template <int M> DEV float swz_xor(float v) { return __int_as_float(__builtin_amdgcn_ds_swizzle(__float_as_int(v), (M << 10) | 0x1f)); }
template <int M> DEV int swz_xor_i(int v) { return __builtin_amdgcn_ds_swizzle(v, (M << 10) | 0x1f); }
DEV float xhalf(float v, float& other) { auto rr = __builtin_amdgcn_permlane32_swap(__float_as_uint(v), __float_as_uint(v), false, false); other = __uint_as_float(rr[1]); return __uint_as_float(rr[0]); }
DEV float wave_sum(float v) {
    v += swz_xor<1>(v); v += swz_xor<2>(v); v += swz_xor<4>(v); v += swz_xor<8>(v); v += swz_xor<16>(v);
    float hi; const float lo = xhalf(v, hi); return lo + hi;
}
DEV float sigm(float x) { return 1.f / (1.f + __expf(-x)); }
DEV float silu_(float x) { return x / (1.f + __expf(-x)); }
#define LDS_WAIT() asm volatile("s_waitcnt lgkmcnt(0)" ::: "memory")

namespace pg8 {
constexpr int BM = 256, BK = 64, HALF = 128, HTB = HALF * BK * 2, STAGE_BYTES = 8 * HTB, NXCD = 8, WGM = 8;
__host__ __device__ __forceinline__ int lds_byte(int r, int c) { const int st = (r >> 4) * 2 + (c >> 5), rr = r & 15, cc = c & 31, ob = rr * 64 + cc * 2; return st * 1024 + (ob ^ (((ob >> 9) & 1) << 5)); }
__host__ __device__ __forceinline__ void stage_rc(int b, int& R, int& C) { const int st = b / 1024, sb = b % 1024, swz = sb ^ (((sb >> 9) & 1) << 5); R = (st >> 1) * 16 + swz / 64; C = (st & 1) * 32 + (swz % 64) / 2; }
__host__ __device__ __forceinline__ int perm32(int rho) { const int n = rho >> 4, i = rho & 15; return 8 * (i >> 2) + 4 * n + (i & 3); }
struct Unit { int pm, pn; };
struct Gemm { const bf16_t* A; const bf16_t* Bt; int lda, K; };
struct StaticOrder {
    int nM, nN, nwg, G, c;
    __device__ void init(int M, int N, int G_, int c_) { nM = M / BM; nN = N / BM; nwg = nM * nN; G = G_; c = c_; }
    __device__ bool next(int i, Unit& u) const {
        const long L = (long)i * G + c; if (L >= nwg) return false;
        int wgid = (int)L; { const int q = nwg / NXCD, r = nwg % NXCD, xcd = wgid % NXCD, off = wgid / NXCD; wgid = (xcd < r ? xcd * (q + 1) : r * (q + 1) + (xcd - r) * q) + off; }
        const int nig = WGM * nN, gid = wgid / nig, fm = gid * WGM, gsz = (nM - fm) < WGM ? (nM - fm) : WGM;
        u.pm = fm + ((wgid % nig) % gsz); u.pn = (wgid % nig) / gsz; return true;
    }
};
template <class F> struct Epi8 {
    F f;
    __device__ __forceinline__ void operator()(const f32x4 (&acc)[2][2][4][2], const Unit& u, int wr, int wc, int fr, int fq) const {
        const int row0 = u.pm * BM + wr * 64 + fr, col0 = u.pn * BM + wc * 32 + 8 * fq;
#pragma unroll
        for (int ai = 0; ai < 2; ++ai)
#pragma unroll
            for (int m = 0; m < 4; ++m)
#pragma unroll
                for (int bj = 0; bj < 2; ++bj) f(row0 + ai * HALF + m * 16, col0 + bj * HALF, acc[ai][bj][m][0], acc[ai][bj][m][1]);
    }
};
template <class Epi, class Sched, bool ALIGN_EPI>
__device__ __forceinline__ void gemm_phase(LAS unsigned char* lds, const Gemm g, const Sched& S, const Epi& E) {
    int tid_ = threadIdx.x; asm volatile("" : "+v"(tid_));
    const int tid = tid_, wid = __builtin_amdgcn_readfirstlane(tid >> 6), lane = tid & 63, wr = wid >> 2, wc = wid & 3, fr = lane & 15, fq = lane >> 4;
    const int K = g.K, nt = K / BK, lda = g.lda;
    unsigned voffA[2], voffB[2];
#pragma unroll
    for (int i = 0; i < 2; ++i) { int R, C; stage_rc(tid * 16 + i * 8192, R, C); const int Rb = (R & ~31) + perm32(R & 31);
        voffA[i] = (unsigned)(R * lda + C) * 2u; voffB[i] = (unsigned)(Rb * K + C) * 2u; }
    const size_t kstep = (size_t)(BK * 2);
    const size_t hstepA = (size_t)HALF * lda * 2, tstepA = 2 * hstepA;
    const size_t hstepB = (size_t)HALF * K * 2, tstepB = 2 * hstepB;
    const unsigned ldsw = (unsigned)wid * 1024u;
    const int aoff = lds_byte(wr * 64 + fr, fq * 8), boff = lds_byte(wc * 32 + fr, fq * 8);
#define PG8_SA(b, h) (((b) * 2 + (h)) * HTB)
#define PG8_SB(b, h) ((4 + (b) * 2 + (h)) * HTB)
#define PG8_STAGE(bufoff, gbase, voff) do { _Pragma("unroll") for (int _i = 0; _i < 2; ++_i) \
        __builtin_amdgcn_global_load_lds((const unsigned*)((const char*)(gbase) + (voff)[_i]), (LAS unsigned*)(lds + (bufoff) + ldsw + _i * 8192), 16, 0, 0); } while (0)
#define PG8_LDA(dst, b, h) do { _Pragma("unroll") for (int m = 0; m < 4; ++m) _Pragma("unroll") for (int k = 0; k < 2; ++k) dst[m][k] = *(const LAS bf16x8*)(lds + PG8_SA(b, h) + aoff + m * 2048 + k * 1024); } while (0)
#define PG8_LDB(dst, b, h) do { _Pragma("unroll") for (int n = 0; n < 2; ++n) _Pragma("unroll") for (int k = 0; k < 2; ++k) dst[n][k] = *(const LAS bf16x8*)(lds + PG8_SB(b, h) + boff + n * 2048 + k * 1024); } while (0)
#define PG8_MMA(ai, bj, At, Bt) do { __builtin_amdgcn_s_setprio(1); _Pragma("unroll") for (int m = 0; m < 4; ++m) _Pragma("unroll") for (int n = 0; n < 2; ++n) _Pragma("unroll") for (int k = 0; k < 2; ++k) \
        acc[ai][bj][m][n] = __builtin_amdgcn_mfma_f32_16x16x32_bf16(Bt[n][k], At[m][k], acc[ai][bj][m][n], 0, 0, 0); __builtin_amdgcn_s_setprio(0); } while (0)
#define PG8_WAIT_V(n) asm volatile("s_waitcnt vmcnt(" #n ")" ::: "memory")
#define PG8_WAIT_L(n) asm volatile("s_waitcnt lgkmcnt(" #n ")" ::: "memory")
#define PG8_BAR __builtin_amdgcn_s_barrier()
#define PG8_SCHED __builtin_amdgcn_sched_barrier(0)
    Unit cur, nxt; int ui = 0;
    if (!S.next(0, cur)) return;
    f32x4 acc[2][2][4][2];
#pragma unroll
    for (int a = 0; a < 2; ++a)
#pragma unroll
        for (int b = 0; b < 2; ++b)
#pragma unroll
            for (int m = 0; m < 4; ++m)
#pragma unroll
                for (int n = 0; n < 2; ++n) acc[a][b][m][n] = (f32x4){0.f, 0.f, 0.f, 0.f};
    bf16x8 At[4][2], B0[2][2], B1[2][2];
    const char* cA = (const char*)g.A + (size_t)cur.pm * tstepA; const char* cB = (const char*)g.Bt + (size_t)cur.pn * tstepB;
    PG8_STAGE(PG8_SB(0, 0), cB, voffB); PG8_STAGE(PG8_SB(0, 1), cB + hstepB, voffB); PG8_STAGE(PG8_SA(0, 0), cA, voffA); PG8_STAGE(PG8_SA(0, 1), cA + hstepA, voffA);
    if (wr == 1) PG8_BAR;
    PG8_WAIT_V(2); PG8_BAR;
    PG8_STAGE(PG8_SB(1, 0), cB + kstep, voffB); PG8_STAGE(PG8_SA(1, 0), cA + kstep, voffA); PG8_STAGE(PG8_SB(1, 1), cB + hstepB + kstep, voffB);
    PG8_WAIT_V(6); PG8_BAR;
    for (;;) {
        const bool has_next = S.next(ui + 1, nxt);
        const char* nA = has_next ? (const char*)g.A + (size_t)nxt.pm * tstepA : cA; const char* nB = has_next ? (const char*)g.Bt + (size_t)nxt.pn * tstepB : cB;
        for (int t = 0; t < nt; t += 2) {
            const bool last = (t == nt - 2);
            const char* a1 = cA + (size_t)(t + 1) * kstep;
            const char* a2 = last ? nA : cA + (size_t)(t + 2) * kstep; const char* b2 = last ? nB : cB + (size_t)(t + 2) * kstep;
            const char* a3 = a2 + kstep; const char* b3 = b2 + kstep;
            PG8_LDB(B0, 0, 0); PG8_LDB(B1, 0, 1); PG8_SCHED; PG8_LDA(At, 0, 0); PG8_STAGE(PG8_SA(1, 1), a1 + hstepA, voffA);
            PG8_WAIT_V(8); PG8_WAIT_L(0); PG8_BAR; PG8_MMA(0, 0, At, B0); PG8_MMA(0, 1, At, B1); PG8_BAR; PG8_SCHED;
            PG8_LDA(At, 0, 1); PG8_STAGE(PG8_SB(0, 0), b2, voffB); PG8_STAGE(PG8_SB(0, 1), b2 + hstepB, voffB); PG8_STAGE(PG8_SA(0, 0), a2, voffA);
            PG8_WAIT_V(8); PG8_WAIT_L(0); PG8_BAR; PG8_MMA(1, 0, At, B0); PG8_MMA(1, 1, At, B1); PG8_BAR; PG8_SCHED;
            PG8_LDB(B0, 1, 0); PG8_LDB(B1, 1, 1); PG8_SCHED; PG8_LDA(At, 1, 0); PG8_STAGE(PG8_SA(0, 1), a2 + hstepA, voffA);
            PG8_WAIT_V(8); PG8_WAIT_L(0); PG8_BAR; PG8_MMA(0, 0, At, B0); PG8_MMA(0, 1, At, B1); PG8_BAR; PG8_SCHED;
            PG8_LDA(At, 1, 1); PG8_STAGE(PG8_SB(1, 0), b3, voffB); PG8_STAGE(PG8_SB(1, 1), b3 + hstepB, voffB); PG8_STAGE(PG8_SA(1, 0), a3, voffA);
            PG8_WAIT_V(8); PG8_WAIT_L(0); PG8_BAR; PG8_MMA(1, 0, At, B0); PG8_MMA(1, 1, At, B1); PG8_BAR; PG8_SCHED;
        }
        if constexpr (ALIGN_EPI) { if (wr == 0) PG8_BAR; }
        E(acc, cur, wr, wc, fr, fq);
        if (!has_next) break;
#pragma unroll
        for (int a = 0; a < 2; ++a)
#pragma unroll
            for (int b = 0; b < 2; ++b)
#pragma unroll
                for (int m = 0; m < 4; ++m)
#pragma unroll
                    for (int n = 0; n < 2; ++n) acc[a][b][m][n] = (f32x4){0.f, 0.f, 0.f, 0.f};
        cur = nxt; cA = nA; cB = nB; ++ui;
        if constexpr (ALIGN_EPI) { if (wr == 1) PG8_BAR; }
    }
    PG8_WAIT_V(0);
    if constexpr (!ALIGN_EPI) { if (wr == 0) PG8_BAR; }
    PG8_BAR;
#undef PG8_SA
#undef PG8_SB
#undef PG8_STAGE
#undef PG8_LDA
#undef PG8_LDB
#undef PG8_MMA
#undef PG8_WAIT_V
#undef PG8_WAIT_L
#undef PG8_BAR
#undef PG8_SCHED
}
}

#define XB_TMO      128
#define XB_XCNT(j)  (256  + 64 * (j))
#define XB_XSUB(j)  (1280 + 64 * (j))
#define XB_XGEN(j)  (2304 + 64 * (j))
#define XB_TOP      3328
#define XB_TOPGEN   3392
#define XCD_BAR_WORDS 3456
#define XB_SPIN_CAP (1u << 22)
__device__ __forceinline__ unsigned xb_ld(unsigned* p)              { return __hip_atomic_load(p, __ATOMIC_RELAXED, __HIP_MEMORY_SCOPE_AGENT); }
__device__ __forceinline__ unsigned xb_add(unsigned* p, unsigned v) { return __hip_atomic_fetch_add(p, v, __ATOMIC_RELAXED, __HIP_MEMORY_SCOPE_AGENT); }
__device__ __forceinline__ unsigned xb_xcc_id() { return (unsigned)__builtin_amdgcn_s_getreg((3 << 11) | 20) & 0xFu; }
#define XB_SPIN(cond, bar) do { unsigned _sp = 0; while (cond) { __builtin_amdgcn_s_sleep(1); \
    if ((++_sp & 255u) == 0u) { if (xb_ld(&(bar)[XB_TMO])) break; if (_sp > XB_SPIN_CAP) { atomicAdd(&(bar)[XB_TMO], 1u); break; } } } } while (0)
struct XcdBarrier { unsigned* bar; unsigned x; volatile LAS unsigned* st; };
__device__ __forceinline__ XcdBarrier xcd_barrier_post(unsigned* bar, volatile LAS unsigned* st) {
    XcdBarrier b; b.bar = bar; b.x = xb_xcc_id(); b.st = st;
    if (threadIdx.x == 0) (void)xb_add(&bar[XB_XCNT(b.x)], 1u);
    return b;
}
__device__ __forceinline__ void xcd_barrier_complete(unsigned* bar, unsigned x, unsigned& nloc, unsigned& nx) {
    const unsigned G = gridDim.x * gridDim.y * gridDim.z;
    unsigned sum, cnt, mine, sp = 0u;
    for (;;) {
        sum = 0u; cnt = 0u; mine = 0u;
#pragma unroll
        for (unsigned j = 0; j < 16; ++j) { const unsigned c = xb_ld(&bar[XB_XCNT(j)]); sum += c; cnt += (c > 0u) ? 1u : 0u; mine = (j == x) ? c : mine; }
        if (sum == G) break;
        __builtin_amdgcn_s_sleep(1);
        if ((++sp & 255u) == 0u) { if (xb_ld(&bar[XB_TMO])) break; if (sp > XB_SPIN_CAP) { atomicAdd(&bar[XB_TMO], 1u); break; } }
    }
    nloc = mine > 0u ? mine : 1u; nx = cnt > 0u ? cnt : 1u;
}
__device__ __noinline__ void xcd_barrier_fn(unsigned* bar_, unsigned x_, volatile LAS unsigned* st_) {
    XcdBarrier b; b.bar = bar_; b.x = x_; b.st = st_;
    asm volatile("s_waitcnt vmcnt(0)" ::: "memory");
    __syncthreads();
    if (threadIdx.x == 0) {
        unsigned* bar = b.bar;
        __builtin_amdgcn_s_waitcnt(0);
        unsigned nloc = b.st[0], nx = b.st[1];
        if (nloc == 0u) { xcd_barrier_complete(bar, b.x, nloc, nx); b.st[0] = nloc; b.st[1] = nx; }
        const unsigned old = xb_add(&bar[XB_XSUB(b.x)], 1u);
        const unsigned gen = old / nloc;
        if (old + 1u == (gen + 1u) * nloc) {
            __builtin_amdgcn_fence(__ATOMIC_RELEASE, "agent");
            asm volatile("s_waitcnt vmcnt(0)" ::: "memory");
            const unsigned og = xb_add(&bar[XB_TOP], 1u);
            const unsigned tg = og / nx;
            if (og + 1u == (tg + 1u) * nx) xb_add(&bar[XB_TOPGEN], 1u);
            else XB_SPIN(xb_ld(&bar[XB_TOPGEN]) == tg, bar);
            __builtin_amdgcn_fence(__ATOMIC_ACQUIRE, "agent");
            xb_add(&bar[XB_XGEN(b.x)], 1u);
            asm volatile("s_waitcnt vmcnt(0)" ::: "memory");
        } else {
            XB_SPIN(xb_ld(&bar[XB_XGEN(b.x)]) == gen, bar);
            __builtin_amdgcn_fence(__ATOMIC_ACQUIRE, "agent");
            asm volatile("s_waitcnt vmcnt(0)" ::: "memory");
        }
    }
    __syncthreads();
}

struct Ctx {
    int tid, lane, wave, gw, NGW, bid, G;
    LAS unsigned char* lds;
};
DEV Ctx make_ctx(LAS unsigned char* lds) {
    Ctx c; int tid_ = threadIdx.x; asm volatile("" : "+v"(tid_));
    c.tid = tid_; c.lane = c.tid & 63; c.wave = __builtin_amdgcn_readfirstlane(c.tid >> 6); { int b_ = blockIdx.x, g_ = gridDim.x; asm volatile("" : "+s"(b_), "+s"(g_)); c.bid = b_; c.G = g_; }
    c.gw = c.bid * 8 + c.wave; c.NGW = c.G * 8; c.lds = lds; return c;
}
#define WSP(T, off) ((T*)(p.ws + (off)))

DEV void transpose_item(const float* W, const float* W2, int ldw, int K, bf16_t* WT, int nblk, int mode, int nvalid, int item, LAS float* scr, int lane) {
    const int kb = item / nblk, nb = item % nblk, k0 = 64 * kb, n0 = 32 * nb;
    const int n = n0 + (lane & 31);
    const float* src = W; int c = -1; int ld = ldw; int kofs = 0;
    if (mode == 0) { c = n < nvalid ? n : -1; }
    else if (mode == 1) { c = n < NSMALL ? n : (n < PSW ? -1 : n - (PSW - NSMALL)); }
    else if (mode == 2) { c = (n & 1) ? 256 + (n >> 1) : (n >> 1); }
    else { if (n < 384 && k0 < 384) { c = n; ld = 384; } else if (n >= 512 && k0 >= 384) { src = W2; c = n - 512; ld = 512; kofs = 384; } }
#pragma unroll 8
    for (int i = 0; i < 32; ++i) { const int kk = 2 * i + (lane >> 5); scr[kk * 33 + (lane & 31)] = (c >= 0) ? src[(size_t)(k0 - kofs + kk) * ld + c] : 0.f; }
    LDS_WAIT(); asm volatile("" ::: "memory");
    const int c8 = lane & 7;
#pragma unroll
    for (int j = 0; j < 4; ++j) { const int nn = (lane >> 3) + 8 * j; const LAS float* s = scr + (8 * c8) * 33 + nn;
        u32x4 o; o.x = pk2(s[0 * 33], s[1 * 33]); o.y = pk2(s[2 * 33], s[3 * 33]); o.z = pk2(s[4 * 33], s[5 * 33]); o.w = pk2(s[6 * 33], s[7 * 33]);
        *(u32x4*)(WT + (size_t)(n0 + nn) * K + k0 + 8 * c8) = o; }
    LDS_WAIT(); asm volatile("" ::: "memory");
}
constexpr int IT_WIN = 16 * 208, IT_W13 = 256 * 32, IT_W2 = 128 * 32, IT_CW1 = 256 * 2, IT_WBR = 128 * 4, IT_WOUT = 512, IT_WU = 8 * 32;
constexpr int IT_LAYER = IT_WIN + IT_W13 + IT_W2 + IT_CW1 + IT_WBR + IT_WOUT + IT_WU;
DEV void phase_prologue(const Params& p, const Ctx& c) {
    float* MOD = WSP(float, WS_MOD);
    if (c.bid < 48) {
        LAS float* sc = (LAS float*)(c.lds + 73728);
        for (int i = c.tid; i < 4096; i += 512) sc[i] = silu_(p.in[1][i]);
        __syncthreads();
        const int idx = c.bid * 512 + c.tid; const int l = idx / 6144, j = idx % 6144;
        const float* wa = p.in[2] + (size_t)l * 1024 * 6144 + j;
        float a0 = 0.f, a1 = 0.f, a2 = 0.f, a3 = 0.f;
        for (int k = 0; k < 1024; ++k) { const float w = wa[(size_t)k * 6144]; a0 += sc[k] * w; a1 += sc[1024 + k] * w; a2 += sc[2048 + k] * w; a3 += sc[3072 + k] * w; }
        const float bb = p.in[3][l * 6144 + j];
        MOD[(l * 4 + 0) * 6144 + j] = a0 + bb; MOD[(l * 4 + 1) * 6144 + j] = a1 + bb; MOD[(l * 4 + 2) * 6144 + j] = a2 + bb; MOD[(l * 4 + 3) * 6144 + j] = a3 + bb;
    }
    { float* RC = WSP(float, WS_ROPE); float* RS = RC + 4096 * 16;
      for (int i = c.bid * 512 + c.tid; i < 4096 * 16; i += c.G * 512) { const int pos = i >> 4, k = i & 15;
          const float inv = (float)pow(10000.0, -(double)k / 16.0); const float ang = (float)pos * inv;
          RC[i] = (float)cos((double)ang); RS[i] = (float)sin((double)ang); } }
    LAS float* scr = (LAS float*)(c.lds + c.wave * 8448);
    for (int it = c.gw; it < IT_LAYER * NLAYER; it += c.NGW) {
        const int l = it / IT_LAYER; int r = it % IT_LAYER;
        if (r < IT_WIN) { transpose_item(p.in[5] + (size_t)l * 1024 * DIN, nullptr, DIN, 1024, WSP(bf16_t, WS_WIN) + (size_t)l * NPROJ * 1024, NPROJ / 32, 1, 0, r, scr, c.lane); continue; } r -= IT_WIN;
        if (r < IT_W13) { const int e = r / 256; transpose_item(p.in[22] + (size_t)(l * 32 + e) * 1024 * 512, nullptr, 512, 1024, WSP(bf16_t, WS_W13) + (size_t)(l * 32 + e) * 512 * 1024, 16, 2, 0, r % 256, scr, c.lane); continue; } r -= IT_W13;
        if (r < IT_W2) { const int e = r / 128; transpose_item(p.in[23] + (size_t)(l * 32 + e) * 256 * 1024, nullptr, 1024, 256, WSP(bf16_t, WS_W2) + (size_t)(l * 32 + e) * 1024 * 256, 32, 0, 1024, r % 128, scr, c.lane); continue; } r -= IT_W2;
        if (r < IT_CW1) { const int kv = r / 256; transpose_item(p.in[8] + (size_t)(l * 2 + kv) * 2048 * 256, nullptr, 256, 2048, WSP(bf16_t, WS_CW1) + (size_t)(l * 2 + kv) * 256 * 2048, 8, 0, 256, r % 256, scr, c.lane); continue; } r -= IT_CW1;
        if (r < IT_WBR) { const int n = r / 128; transpose_item(p.in[16] + (size_t)(l * 4 + n) * 256 * 1024, nullptr, 1024, 256, WSP(bf16_t, WS_WBR) + (size_t)(l * 4 + n) * 1024 * 256, 32, 0, 1024, r % 128, scr, c.lane); continue; } r -= IT_WBR;
        if (r < IT_WOUT) { transpose_item(p.in[17] + (size_t)l * 1024 * 1024, nullptr, 1024, 1024, WSP(bf16_t, WS_WOUT) + (size_t)l * 1024 * 1024, 32, 0, 1024, r, scr, c.lane); continue; } r -= IT_WOUT;
        transpose_item(p.in[14] + (size_t)l * 384 * 384, p.in[15] + (size_t)l * 128 * 512, 0, 512, WSP(bf16_t, WS_WU) + (size_t)l * 1024 * 512, 32, 3, 0, r, scr, c.lane);
    }
}

template <bool NORM> DEV void phase_norm1(const Params& p, const Ctx& c, int l) {
    const float* MOD = WSP(float, WS_MOD);
    const bf16_t* YP = (const bf16_t*)(p.ws + WS_BIG + BIG_YP);
    const int* PSLOT = WSP(int, WS_MISC + MISC_PSLOT); const float* WTS = WSP(float, WS_MISC + MISC_WTS);
    bf16_t* HBF = WSP(bf16_t, WS_HBF);
    for (int row = c.gw; row < NTOK; row += c.NGW) {
        const int b = row / SEQ;
        f32x4 v[4];
        if (l == 0) {
#pragma unroll
            for (int j = 0; j < 4; ++j) v[j] = *(const f32x4*)(p.in[0] + (size_t)row * DM + j * 256 + c.lane * 4);
        } else {
            const float* g2 = MOD + ((l - 1) * 4 + b) * 6144 + 5120;
            const int s0 = PSLOT[row * 2], s1 = PSLOT[row * 2 + 1]; const float w0 = WTS[row * 2], w1 = WTS[row * 2 + 1];
#pragma unroll
            for (int j = 0; j < 4; ++j) { const int col = j * 256 + c.lane * 4;
                const f32x4 x = *(const f32x4*)(p.out + (size_t)row * DM + col); const f32x4 g = *(const f32x4*)(g2 + col);
                const u32x2 y0 = *(const u32x2*)(YP + (size_t)s0 * DM + col), y1 = *(const u32x2*)(YP + (size_t)s1 * DM + col);
                f32x4 y; y[0] = w0 * bflo(y0.x) + w1 * bflo(y1.x); y[1] = w0 * bfhi(y0.x) + w1 * bfhi(y1.x); y[2] = w0 * bflo(y0.y) + w1 * bflo(y1.y); y[3] = w0 * bfhi(y0.y) + w1 * bfhi(y1.y);
                v[j] = x + g * y; }
        }
#pragma unroll
        for (int j = 0; j < 4; ++j) *(f32x4*)(p.out + (size_t)row * DM + j * 256 + c.lane * 4) = v[j];
        if (NORM) {
            float ss = 0.f;
#pragma unroll
            for (int j = 0; j < 4; ++j) ss += (v[j][0] * v[j][0] + v[j][1] * v[j][1]) + (v[j][2] * v[j][2] + v[j][3] * v[j][3]);
            const float r = rsqrtf(wave_sum(ss) * (1.f / DM) + EPS);
            const float* gn = p.in[4] + (size_t)(l * 2 + 0) * DM; const float* sh = MOD + (l * 4 + b) * 6144; const float* sc = sh + 1024;
#pragma unroll
            for (int j = 0; j < 4; ++j) { const int col = j * 256 + c.lane * 4;
                const f32x4 g = *(const f32x4*)(gn + col), s1 = *(const f32x4*)(sc + col), s0 = *(const f32x4*)(sh + col);
                const f32x4 h = v[j] * r * g * (s1 + 1.f) + s0;
                u32x2 o; o.x = pk2(h[0], h[1]); o.y = pk2(h[2], h[3]); *(u32x2*)(HBF + (size_t)row * DM + col) = o; }
        }
    }
}

struct FInproj { float* PSM; bf16_t* GATES;
    DEV void operator()(int row, int col, const f32x4& v0, const f32x4& v1) const {
        if (col < PSW) { float* o = PSM + (size_t)row * PSW + col; *(f32x4*)o = v0; *(f32x4*)(o + 4) = v1; }
        else { u32x4 w; w.x = pk2(sigm(v0[0]), sigm(v0[1])); w.y = pk2(sigm(v0[2]), sigm(v0[3])); w.z = pk2(sigm(v1[0]), sigm(v1[1])); w.w = pk2(sigm(v1[2]), sigm(v1[3]));
               *(u32x4*)(GATES + (size_t)row * NGATE + (col - PSW)) = w; } } };
DEV void phase_inproj(const Params& p, const Ctx& c, int l) {
    pg8::Gemm g{WSP(bf16_t, WS_HBF), WSP(bf16_t, WS_WIN) + (size_t)l * NPROJ * 1024, 1024, 1024};
    pg8::StaticOrder S; S.init(NTOK, NPROJ, c.G, c.bid);
    pg8::Epi8<FInproj> E{{(float*)(p.ws + WS_BIG + BIG_PSM), WSP(bf16_t, WS_GATES)}};
    pg8::gemm_phase<pg8::Epi8<FInproj>, pg8::StaticOrder, true>(c.lds, g, S, E);
}

DEV float head_norm(float v, const float* gain, int lane) { const float ss = wave_sum(v * v); return v * rsqrtf(ss * (1.f / 64.f) + EPS) * gain[lane]; }
DEV void phase_post(const Params& p, const Ctx& c, int l) {
    const float* PSM = (const float*)(p.ws + WS_BIG + BIG_PSM); bf16_t* ACT = WSP(bf16_t, WS_ACT);
    float* GA = WSP(float, WS_SMALL + SM_GA);
    const float* gq = p.in[6] + (size_t)l * 10 * 64;
    const float* RC = WSP(float, WS_ROPE); const float* RS = RC + 4096 * 16;
    const int lane = c.lane;
    for (int row = c.gw; row < NTOK; row += c.NGW) {
        const float* P = PSM + (size_t)row * PSW; bf16_t* A = ACT + (size_t)row * ACTW; const int t = row % SEQ;
#pragma unroll
        for (int h = 0; h < 4; ++h) A[A_QA + h * 64 + lane] = (bf16_t)f2bf(head_norm(P[I_QA + h * 64 + lane], gq + 0 * 64, lane));
        A[A_KCR + lane] = (bf16_t)f2bf(P[I_KC + lane]); A[A_VCR + lane] = (bf16_t)f2bf(P[I_VC + lane]);
        A[A_KS + lane] = (bf16_t)f2bf(head_norm(P[I_KS + lane], gq + 2 * 64, lane)); A[A_VS + lane] = (bf16_t)f2bf(P[I_VS + lane]);
        A[A_KW + lane] = (bf16_t)f2bf(head_norm(P[I_KW + lane], gq + 3 * 64, lane)); A[A_VW + lane] = (bf16_t)f2bf(P[I_VW + lane]);
        if (lane < 12) GA[row * 12 + lane] = sigm(P[I_GL + lane]);
#pragma unroll
        for (int h = 0; h < 4; ++h) A[A_QB + h * 64 + lane] = (bf16_t)f2bf(head_norm(P[I_QB + h * 64 + lane], gq + 4 * 64, lane));
#pragma unroll
        for (int h = 0; h < 2; ++h) { A[A_KB + h * 64 + lane] = (bf16_t)f2bf(head_norm(P[I_KB + h * 64 + lane], gq + 5 * 64, lane)); A[A_VB + h * 64 + lane] = (bf16_t)f2bf(P[I_VB + h * 64 + lane]); }
#pragma unroll
        for (int h = 0; h < 4; ++h) { A[A_QC + h * 64 + lane] = (bf16_t)f2bf(head_norm(P[I_QC + h * 64 + lane], gq + 6 * 64, lane));
            A[A_KC + h * 64 + lane] = (bf16_t)f2bf(head_norm(P[I_KCC + h * 64 + lane], gq + 7 * 64, lane)); A[A_VC + h * 64 + lane] = (bf16_t)f2bf(P[I_VCC + h * 64 + lane]); }
        { float x[6]; float ss = 0.f;
#pragma unroll
          for (int j = 0; j < 6; ++j) { x[j] = P[I_CQ + j * 64 + lane]; ss += x[j] * x[j]; }
          const float r = rsqrtf(wave_sum(ss) * (1.f / 384.f) + EPS); const float* g = p.in[11] + l * 384;
#pragma unroll
          for (int j = 0; j < 6; ++j) A[A_CQ + j * 64 + lane] = (bf16_t)f2bf(x[j] * r * g[j * 64 + lane]); }
        { float x0 = P[I_CKV + lane], x1 = P[I_CKV + 64 + lane]; const float r = rsqrtf(wave_sum(x0 * x0 + x1 * x1) * (1.f / 128.f) + EPS); const float* g = p.in[12] + l * 128;
          A[A_CKV + lane] = (bf16_t)f2bf(x0 * r * g[lane]); A[A_CKV + 64 + lane] = (bf16_t)f2bf(x1 * r * g[64 + lane]); }
        { const float x = lane < 32 ? P[I_KR + lane] : 0.f; const float r = rsqrtf(wave_sum(x * x) * (1.f / 32.f) + EPS);
          const float y = x * r * p.in[13][(l * 2 + 1) * 32 + (lane & 31)];
          const float yo = swz_xor<16>(y); const int k = lane & 15; const float cs = RC[t * 16 + k], sn = RS[t * 16 + k];
          const float o = (lane & 16) ? (yo * sn + y * cs) : (y * cs - yo * sn);
          if (lane < 32) A[A_KR + lane] = (bf16_t)f2bf(o); }
    }
}

struct FStoreF32 { float* O; int ld;
    DEV void operator()(int row, int col, const f32x4& v0, const f32x4& v1) const { float* o = O + (size_t)row * ld + col; *(f32x4*)o = v0; *(f32x4*)(o + 4) = v1; } };
DEV void phase_mlaup(const Params& p, const Ctx& c, int l) {
    { pg8::Gemm g{WSP(bf16_t, WS_ACT) + A_CQ, WSP(bf16_t, WS_WU) + (size_t)l * 1024 * 512, ACTW, 512};
      pg8::StaticOrder S; S.init(NTOK, 1024, c.G, c.bid);
      pg8::Epi8<FStoreF32> E{{WSP(float, WS_MUR), 1024}};
      pg8::gemm_phase<pg8::Epi8<FStoreF32>, pg8::StaticOrder, true>(c.lds, g, S, E); }
    { const bf16_t* ACT = WSP(bf16_t, WS_ACT); bf16_t* CMPA = WSP(bf16_t, WS_CMPA); const float* pe = p.in[7] + (size_t)l * 2 * 32 * 64;
      for (int idx = c.bid * 512 + c.tid; idx < 2 * 1024 * 256; idx += c.G * 512) {
          const int c8 = idx & 255, r = (idx >> 8) & 1023, kv = idx >> 18; const int j = c8 >> 3, d = (c8 & 7) * 8;
          u32x4 o = (u32x4){0u, 0u, 0u, 0u};
          if (r < 1020) { const int b = r / 255, i = r % 255; const size_t tok = (size_t)b * SEQ + 16 * i + j;
              const u32x4 s = *(const u32x4*)(ACT + tok * ACTW + (kv ? A_VCR : A_KCR) + d); const float* pp = pe + (kv * 32 + j) * 64 + d;
              o.x = pk2(bflo(s.x) + pp[0], bfhi(s.x) + pp[1]); o.y = pk2(bflo(s.y) + pp[2], bfhi(s.y) + pp[3]); o.z = pk2(bflo(s.z) + pp[4], bfhi(s.z) + pp[5]); o.w = pk2(bflo(s.w) + pp[6], bfhi(s.w) + pp[7]); }
          *(u32x4*)(CMPA + ((size_t)kv * 1024 + r) * 2048 + c8 * 8) = o; } }
    { const bf16_t* ACT = WSP(bf16_t, WS_ACT); float* KM = WSP(float, WS_MISC + MISC_KMEAN);
      for (int idx = c.bid * 512 + c.tid; idx < 4 * 16 * 256; idx += c.G * 512) { const int hd = idx & 255, n = (idx >> 8) & 15, b = idx >> 12;
          const bf16_t* src = ACT + ((size_t)b * SEQ + n * 256) * ACTW + A_KC + hd; float s = 0.f;
          for (int i = 0; i < 256; ++i) s += bf2f(src[(size_t)i * ACTW]);
          KM[idx] = s * (1.f / 256.f); } }
}

struct CmpOrder { int G, c; DEV bool next(int i, pg8::Unit& u) const { const int L = i * G + c; if (L >= 8) return false; u.pm = L; u.pn = L >> 2; return true; } };
struct FCmpHid { bf16_t* HID;
    DEV void operator()(int row, int col, const f32x4& v0, const f32x4& v1) const { const int cc = col & 255;
        u32x4 w; w.x = pk2(silu_(v0[0]), silu_(v0[1])); w.y = pk2(silu_(v0[2]), silu_(v0[3])); w.z = pk2(silu_(v1[0]), silu_(v1[1])); w.w = pk2(silu_(v1[2]), silu_(v1[3]));
        *(u32x4*)(HID + (size_t)row * 256 + cc) = w; } };
DEV void phase_post2(const Params& p, const Ctx& c, int l) {
    { pg8::Gemm g{WSP(bf16_t, WS_CMPA), WSP(bf16_t, WS_CW1) + (size_t)l * 2 * 256 * 2048, 2048, 2048};
      CmpOrder S{c.G, c.bid}; pg8::Epi8<FCmpHid> E{{WSP(bf16_t, WS_HID)}};
      pg8::gemm_phase<pg8::Epi8<FCmpHid>, CmpOrder, true>(c.lds, g, S, E); }
    const float* MUR = WSP(float, WS_MUR); bf16_t* ACT2 = WSP(bf16_t, WS_ACT2);
    const float* gq = p.in[6] + (size_t)l * 10 * 64; const float* RC = WSP(float, WS_ROPE); const float* RS = RC + 4096 * 16;
    const int lane = c.lane;
    for (int row = c.gw; row < NTOK; row += c.NGW) {
        const float* R = MUR + (size_t)row * 1024; bf16_t* A = ACT2 + (size_t)row * ACT2W; const int t = row % SEQ;
#pragma unroll
        for (int h = 0; h < 4; ++h) {
            A[A2_QF + h * 96 + lane] = (bf16_t)f2bf(head_norm(R[h * 96 + lane], gq + 8 * 64, lane));
            { const float x = lane < 32 ? R[h * 96 + 64 + lane] : 0.f; const float r = rsqrtf(wave_sum(x * x) * (1.f / 32.f) + EPS);
              const float y = x * r * p.in[13][(l * 2 + 0) * 32 + (lane & 31)];
              const float yo = swz_xor<16>(y); const int k = lane & 15; const float cs = RC[t * 16 + k], sn = RS[t * 16 + k];
              const float o = (lane & 16) ? (yo * sn + y * cs) : (y * cs - yo * sn);
              if (lane < 32) A[A2_QF + h * 96 + 64 + lane] = (bf16_t)f2bf(o); }
            A[A2_KN + h * 64 + lane] = (bf16_t)f2bf(head_norm(R[512 + h * 128 + lane], gq + 9 * 64, lane));
            A[A2_VD + h * 64 + lane] = (bf16_t)f2bf(R[512 + h * 128 + 64 + lane]);
        }
    }
}

template <int D0, int D1, int DV>
DEV void att_step(const float (&q)[D0 + D1], float (&o)[DV], float& m, float& l, const bf16_t* k0, const bf16_t* k1, const bf16_t* v, float scale, float bias, bool valid) {
    float acc = 0.f;
#pragma unroll
    for (int i = 0; i < D0 / 8; ++i) { const u32x4 u = *(const u32x4*)(k0 + 8 * i);
        acc += q[8 * i] * bflo(u.x) + q[8 * i + 1] * bfhi(u.x) + q[8 * i + 2] * bflo(u.y) + q[8 * i + 3] * bfhi(u.y) + q[8 * i + 4] * bflo(u.z) + q[8 * i + 5] * bfhi(u.z) + q[8 * i + 6] * bflo(u.w) + q[8 * i + 7] * bfhi(u.w); }
    if (D1 > 0) {
#pragma unroll
        for (int i = 0; i < D1 / 8; ++i) { const u32x4 u = *(const u32x4*)(k1 + 8 * i); const int b = D0 + 8 * i;
            acc += q[b] * bflo(u.x) + q[b + 1] * bfhi(u.x) + q[b + 2] * bflo(u.y) + q[b + 3] * bfhi(u.y) + q[b + 4] * bflo(u.z) + q[b + 5] * bfhi(u.z) + q[b + 6] * bflo(u.w) + q[b + 7] * bfhi(u.w); }
    }
    const float s = acc * scale + bias;
    if (valid) {
        if (s > m) { const float a = __expf(m - s); l *= a;
#pragma unroll
            for (int d = 0; d < DV; ++d) o[d] *= a;
            m = s; }
        const float pr = __expf(s - m); l += pr;
#pragma unroll
        for (int i = 0; i < DV / 8; ++i) { const u32x4 u = *(const u32x4*)(v + 8 * i);
            o[8 * i] += pr * bflo(u.x); o[8 * i + 1] += pr * bfhi(u.x); o[8 * i + 2] += pr * bflo(u.y); o[8 * i + 3] += pr * bfhi(u.y);
            o[8 * i + 4] += pr * bflo(u.z); o[8 * i + 5] += pr * bfhi(u.z); o[8 * i + 6] += pr * bflo(u.w); o[8 * i + 7] += pr * bfhi(u.w); }
    }
}
template <int D> DEV void load_q(float (&q)[D], const bf16_t* src) {
#pragma unroll
    for (int i = 0; i < D / 8; ++i) { const u32x4 u = *(const u32x4*)(src + 8 * i);
        q[8 * i] = bflo(u.x); q[8 * i + 1] = bfhi(u.x); q[8 * i + 2] = bflo(u.y); q[8 * i + 3] = bfhi(u.y); q[8 * i + 4] = bflo(u.z); q[8 * i + 5] = bfhi(u.z); q[8 * i + 6] = bflo(u.w); q[8 * i + 7] = bfhi(u.w); }
}
template <int DV> DEV void store_o_bf16(bf16_t* dst, const float (&o)[DV], float inv) {
#pragma unroll
    for (int i = 0; i < DV / 8; ++i) { u32x4 w; w.x = pk2(o[8 * i] * inv, o[8 * i + 1] * inv); w.y = pk2(o[8 * i + 2] * inv, o[8 * i + 3] * inv); w.z = pk2(o[8 * i + 4] * inv, o[8 * i + 5] * inv); w.w = pk2(o[8 * i + 6] * inv, o[8 * i + 7] * inv);
        *(u32x4*)(dst + 8 * i) = w; }
}
DEV void item_bgh(int it, int& b, int& g, int& h) { const int r = it & 63, bh = it >> 6; g = (r & 1) ? 63 - (r >> 1) : (r >> 1); b = bh >> 2; h = bh & 3; }

DEV void phase_attn(const Params& p, const Ctx& c, int l) {
    const int lane = c.lane;
    { const bf16_t* HID = WSP(bf16_t, WS_HID); float* KC = WSP(float, WS_MISC + MISC_KCMP); float* VC = WSP(float, WS_MISC + MISC_VCMP);
      const float* gq = p.in[6] + (size_t)l * 10 * 64;
      for (int it = c.gw; it < 2 * 1020; it += c.NGW) { const int kv = it / 1020, r = it % 1020;
          const float* w2 = p.in[9] + (size_t)(l * 2 + kv) * 256 * 64; const bf16_t* hrow = HID + ((size_t)kv * 1024 + r) * 256;
          float a = 0.f;
          for (int k = 0; k < 256; ++k) a += bf2f(hrow[k]) * w2[k * 64 + lane];
          const int b = r / 255, i = r % 255;
          if (kv == 0) KC[(b * 256 + i) * 64 + lane] = head_norm(a, gq + 1 * 64, lane); else VC[(b * 256 + i) * 64 + lane] = a; } }
    const bf16_t* ACT = WSP(bf16_t, WS_ACT); const bf16_t* ACT2 = WSP(bf16_t, WS_ACT2); bf16_t* BR = WSP(bf16_t, WS_BR);
    for (int it0 = c.gw; it0 < 2048; it0 += c.NGW) {
        if (it0 < 1024) {
            int b, g, h; item_bgh(it0, b, g, h); const int t = g * 64 + lane; const size_t tok = (size_t)b * SEQ + t;
            float q[96], o[64]; float m = -INFINITY, ls = 0.f;
            load_q<96>(q, ACT2 + tok * ACT2W + A2_QF + h * 96);
#pragma unroll
            for (int d = 0; d < 64; ++d) o[d] = 0.f;
            const float scale = 0.10206207261596575f;
            for (int s = g * 64 + 63; s >= 0; --s) { const size_t kt = (size_t)b * SEQ + s;
                att_step<64, 32, 64>(q, o, m, ls, ACT2 + kt * ACT2W + A2_KN + h * 64, ACT + kt * ACTW + A_KR, ACT2 + kt * ACT2W + A2_VD + h * 64, scale, 0.f, s <= t); }
            store_o_bf16<64>(BR + tok * 1024 + 768 + h * 64, o, 1.f / ls);
        } else {
            int b, g, h; item_bgh(it0 - 1024, b, g, h); const int t = g * 64 + lane; const size_t tok = (size_t)b * SEQ + t;
            const int nb = g >> 2; const float slope = SLOPES[2][h];
            float q[64], o[64]; float m = -INFINITY, ls = 0.f;
            load_q<64>(q, ACT + tok * ACTW + A_QC + h * 64);
#pragma unroll
            for (int d = 0; d < 64; ++d) o[d] = 0.f;
            const float* KM = WSP(float, WS_MISC + MISC_KMEAN) + (size_t)b * 16 * 256 + h * 64;
            float v1 = -INFINITY, v2 = -INFINITY, v3 = -INFINITY; int i1 = -1, i2 = -1, i3 = -1;
            for (int n = 0; n < nb; ++n) { const float* km = KM + n * 256; float dsum = 0.f;
#pragma unroll
                for (int d = 0; d < 64; ++d) dsum += q[d] * km[d];
                if (dsum > v1) { v3 = v2; i3 = i2; v2 = v1; i2 = i1; v1 = dsum; i1 = n; }
                else if (dsum > v2) { v3 = v2; i3 = i2; v2 = dsum; i2 = n; }
                else if (dsum > v3) { v3 = dsum; i3 = n; } }
            const int start = nb * 256;
            for (int s = g * 64 + 63; s >= start; --s) { const size_t kt = (size_t)b * SEQ + s;
                att_step<64, 0, 64>(q, o, m, ls, ACT + kt * ACTW + A_KC + h * 64, nullptr, ACT + kt * ACTW + A_VC + h * 64, 0.125f, -slope * (float)(t - s), s <= t); }
            for (int n = nb - 1; n >= 0; --n) { const bool sel = (n == i1) || (n == i2) || (n == i3);
                if (!__any(sel)) continue;
                for (int s = n * 256 + 255; s >= n * 256; --s) { const size_t kt = (size_t)b * SEQ + s;
                    att_step<64, 0, 64>(q, o, m, ls, ACT + kt * ACTW + A_KC + h * 64, nullptr, ACT + kt * ACTW + A_VC + h * 64, 0.125f, -slope * (float)(t - s), sel); } }
            store_o_bf16<64>(BR + tok * 1024 + 512 + h * 64, o, 1.f / ls);
        }
    }
    for (int it0 = c.gw; it0 < 2048; it0 += c.NGW) {
        const bool swa = it0 >= 1024;
        int b, g, h; item_bgh(swa ? it0 - 1024 : it0, b, g, h); const int t = g * 64 + lane; const size_t tok = (size_t)b * SEQ + t;
        const int W = swa ? 128 : 512; const float slope = SLOPES[swa ? 1 : 0][h];
        const int qoff = swa ? A_QB + h * 64 : A_QA + h * 64, koff = swa ? A_KB + (h >> 1) * 64 : A_KW, voff = swa ? A_VB + (h >> 1) * 64 : A_VW;
        float q[64], o[64]; float m = -INFINITY, ls = 0.f;
        load_q<64>(q, ACT + tok * ACTW + qoff);
#pragma unroll
        for (int d = 0; d < 64; ++d) o[d] = 0.f;
        int lo = g * 64 - (W - 1); if (lo < 0) lo = 0;
        for (int s = g * 64 + 63; s >= lo; --s) { const size_t kt = (size_t)b * SEQ + s; const int dist = t - s;
            att_step<64, 0, 64>(q, o, m, ls, ACT + kt * ACTW + koff, nullptr, ACT + kt * ACTW + voff, 0.125f, -slope * (float)dist, dist >= 0 && dist < W); }
        if (swa) { const float sk = p.in[10][l * 4 + h]; const float mf = fmaxf(m, sk); const float a = __expf(m - mf); const float den = ls * a + __expf(sk - mf);
            store_o_bf16<64>(BR + tok * 1024 + 256 + h * 64, o, a / den); }
        else { float* OW = WSP(float, WS_OWIN) + tok * 256 + h * 64; const float inv = 1.f / ls;
#pragma unroll
            for (int d = 0; d < 64; d += 4) *(f32x4*)(OW + d) = (f32x4){o[d] * inv, o[d + 1] * inv, o[d + 2] * inv, o[d + 3] * inv}; }
    }
}

DEV void phase_cmpattn(const Params& p, const Ctx& c, int l) {
    const bf16_t* ACT = WSP(bf16_t, WS_ACT); const float* KC = WSP(float, WS_MISC + MISC_KCMP); const float* VC = WSP(float, WS_MISC + MISC_VCMP);
    float* PB = WSP(float, WS_PB); float* PL = WSP(float, WS_SMALL + SM_PL); float* OC = WSP(float, WS_OCMP);
    const int lane = c.lane;
    for (int it = c.gw; it < 1024; it += c.NGW) {
        int b, g, h; item_bgh(it, b, g, h); const int t = g * 64 + lane; const size_t tok = (size_t)b * SEQ + t; const float slope = SLOPES[0][h];
        float q[64], o[64];
        load_q<64>(q, ACT + tok * ACTW + A_QA + h * 64);
#pragma unroll
        for (int d = 0; d < 64; ++d) o[d] = 0.f;
        const int nvis = t >= 31 ? ((t - 31) >> 4) + 1 : 0;
        const int tmaxw = g * 64 + 63; const int nmax = tmaxw >= 31 ? ((tmaxw - 31) >> 4) + 1 : 0;
        const float* kcb = KC + (size_t)b * 256 * 64; const float* vcb = VC + (size_t)b * 256 * 64;
        float m = -INFINITY;
        for (int n = 0; n < nmax; ++n) { const float* k = kcb + n * 64; float a = 0.f;
#pragma unroll
            for (int d = 0; d < 64; ++d) a += q[d] * k[d];
            const float s = a * 0.125f - slope * (float)(t - (16 * n + 31));
            if (n < nvis) m = fmaxf(m, s); }
        float ls = 0.f, carry = 0.f; float* pb = PB + (tok * 4 + h) * 64;
        for (int j = 0; j < 64; ++j) { float e4[4];
#pragma unroll
            for (int u = 0; u < 4; ++u) { const int n = 4 * j + u; float e = 0.f;
                if (n < nmax) { const float* k = kcb + n * 64; float a = 0.f;
#pragma unroll
                    for (int d = 0; d < 64; ++d) a += q[d] * k[d];
                    const float s = a * 0.125f - slope * (float)(t - (16 * n + 31));
                    if (n < nvis) { e = __expf(s - m); const float* v = vcb + n * 64;
#pragma unroll
                        for (int d = 0; d < 64; ++d) o[d] += e * v[d]; } }
                e4[u] = e; }
            pb[j] = carry + e4[0] + e4[1] + e4[2] + e4[3]; carry = e4[3]; ls += e4[0] + e4[1] + e4[2] + e4[3];
            if (4 * j + 4 >= nmax) { for (int jj = j + 1; jj < 64; ++jj) pb[jj] = (jj == j + 1) ? carry : 0.f; break; } }
        const float inv = 1.f / fmaxf(ls, 1e-30f);
        PL[tok * 4 + h] = inv;
        float* oc = OC + tok * 256 + h * 64;
#pragma unroll
        for (int d = 0; d < 64; d += 4) *(f32x4*)(oc + d) = (f32x4){o[d] * inv, o[d + 1] * inv, o[d + 2] * inv, o[d + 3] * inv};
    }
}

DEV void phase_topk(const Params& p, const Ctx& c) {
    const float* PB = WSP(float, WS_PB); const float* PL = WSP(float, WS_SMALL + SM_PL); unsigned long long* SEL = WSP(unsigned long long, WS_SMALL + SM_SEL);
    const int lane = c.lane;
    for (int tok = c.gw; tok < NTOK; tok += c.NGW) {
        const int t = tok % SEQ, cur = t >> 6;
        float ps = 0.f;
#pragma unroll
        for (int h = 0; h < 4; ++h) ps += PB[((size_t)tok * 4 + h) * 64 + lane] * PL[tok * 4 + h];
        const bool forced = (lane == 0) || (lane == cur) || (lane == cur - 1);
        float score = lane <= cur ? ps + (forced ? 1e4f : 0.f) : -1e30f;
        unsigned long long mask = 0ull;
        for (int r = 0; r < 8; ++r) {
            float bv = score; int bi = lane;
#define TK_STEP(M) { const float ov = swz_xor<M>(bv); const int oi = swz_xor_i<M>(bi); if (ov > bv || (ov == bv && oi < bi)) { bv = ov; bi = oi; } }
            TK_STEP(1) TK_STEP(2) TK_STEP(4) TK_STEP(8) TK_STEP(16)
#undef TK_STEP
            { auto rv = __builtin_amdgcn_permlane32_swap(__float_as_uint(bv), __float_as_uint(bv), false, false); auto ri = __builtin_amdgcn_permlane32_swap((unsigned)bi, (unsigned)bi, false, false);
              const float v0 = __uint_as_float(rv[0]), v1 = __uint_as_float(rv[1]); const int i0 = (int)ri[0], i1 = (int)ri[1];
              if (v1 > v0 || (v1 == v0 && i1 < i0)) { bv = v1; bi = i1; } else { bv = v0; bi = i0; } }
            if (bv > -5e29f) mask |= 1ull << bi;
            if (lane == bi) score = -INFINITY;
        }
        if (lane == 0) SEL[tok] = mask;
    }
}

DEV void phase_slc(const Params& p, const Ctx& c, int l) {
    const bf16_t* ACT = WSP(bf16_t, WS_ACT); bf16_t* BR = WSP(bf16_t, WS_BR); const unsigned long long* SEL = WSP(unsigned long long, WS_SMALL + SM_SEL);
    const float* OC = WSP(float, WS_OCMP); const float* OW = WSP(float, WS_OWIN); const float* GA = WSP(float, WS_SMALL + SM_GA);
    const int lane = c.lane;
    for (int it = c.gw; it < 1024; it += c.NGW) {
        int b, g, h; item_bgh(it, b, g, h); const int t = g * 64 + lane; const size_t tok = (size_t)b * SEQ + t; const float slope = SLOPES[0][h];
        float q[64], o[64]; float m = -INFINITY, ls = 0.f;
        load_q<64>(q, ACT + tok * ACTW + A_QA + h * 64);
#pragma unroll
        for (int d = 0; d < 64; ++d) o[d] = 0.f;
        const unsigned long long mask = SEL[tok];
        for (int j = g; j >= 0; --j) { const bool sel = (mask >> j) & 1ull;
            if (!__any(sel)) continue;
            for (int s = j * 64 + 63; s >= j * 64; --s) { const size_t kt = (size_t)b * SEQ + s;
                att_step<64, 0, 64>(q, o, m, ls, ACT + kt * ACTW + A_KS, nullptr, ACT + kt * ACTW + A_VS, 0.125f, -slope * (float)(t - s), sel && s <= t); } }
        const float inv = 1.f / ls; const float g0 = GA[tok * 12 + h * 3], g1 = GA[tok * 12 + h * 3 + 1], g2 = GA[tok * 12 + h * 3 + 2];
        const float* oc = OC + tok * 256 + h * 64; const float* ow = OW + tok * 256 + h * 64;
#pragma unroll
        for (int d = 0; d < 64; ++d) o[d] = g0 * oc[d] + g1 * o[d] * inv + g2 * ow[d];
        store_o_bf16<64>(BR + tok * 1024 + h * 64, o, 1.f);
    }
}

template <int NB> struct FMerge { const bf16_t* GATES; float* MIX; bf16_t* MIXB;
    DEV void operator()(int row, int col, const f32x4& v0, const f32x4& v1) const {
        const u32x4 gw = *(const u32x4*)(GATES + (size_t)row * NGATE + NB * 1024 + col);
        f32x4 a = (f32x4){bflo(gw.x), bfhi(gw.x), bflo(gw.y), bfhi(gw.y)} * v0, b = (f32x4){bflo(gw.z), bfhi(gw.z), bflo(gw.w), bfhi(gw.w)} * v1;
        float* mx = MIX + (size_t)row * 1024 + col;
        if (NB > 0) { a += *(const f32x4*)mx; b += *(const f32x4*)(mx + 4); }
        if (NB < 3) { *(f32x4*)mx = a; *(f32x4*)(mx + 4) = b; }
        else { u32x4 w; w.x = pk2(a[0], a[1]); w.y = pk2(a[2], a[3]); w.z = pk2(b[0], b[1]); w.w = pk2(b[2], b[3]); *(u32x4*)(MIXB + (size_t)row * 1024 + col) = w; } } };
template <int NB> DEV void phase_merge(const Params& p, const Ctx& c, int l) {
    pg8::Gemm g{WSP(bf16_t, WS_BR) + NB * 256, WSP(bf16_t, WS_WBR) + (size_t)(l * 4 + NB) * 1024 * 256, 1024, 256};
    pg8::StaticOrder S; S.init(NTOK, 1024, c.G, c.bid);
    pg8::Epi8<FMerge<NB>> E{{WSP(bf16_t, WS_GATES), (float*)(p.ws + WS_BIG + BIG_MIX), (bf16_t*)(p.ws + WS_BIG + BIG_MIXB)}};
    pg8::gemm_phase<pg8::Epi8<FMerge<NB>>, pg8::StaticOrder, true>(c.lds, g, S, E);
}
struct FOut { float* X; const float* g1;
    DEV void operator()(int row, int col, const f32x4& v0, const f32x4& v1) const { const float* gg = g1 + (row / SEQ) * 6144 + col; float* x = X + (size_t)row * DM + col;
        *(f32x4*)x = *(const f32x4*)x + *(const f32x4*)gg * v0; *(f32x4*)(x + 4) = *(const f32x4*)(x + 4) + *(const f32x4*)(gg + 4) * v1; } };
DEV void phase_out(const Params& p, const Ctx& c, int l) {
    pg8::Gemm g{(const bf16_t*)(p.ws + WS_BIG + BIG_MIXB), WSP(bf16_t, WS_WOUT) + (size_t)l * 1024 * 1024, 1024, 1024};
    pg8::StaticOrder S; S.init(NTOK, 1024, c.G, c.bid);
    pg8::Epi8<FOut> E{{p.out, WSP(float, WS_MOD) + (size_t)l * 4 * 6144 + 2048}};
    pg8::gemm_phase<pg8::Epi8<FOut>, pg8::StaticOrder, true>(c.lds, g, S, E);
}

DEV void phase_router(const Params& p, const Ctx& c, int l) {
    const float* MOD = WSP(float, WS_MOD); bf16_t* H2B = WSP(bf16_t, WS_HBF);
    int* EID = WSP(int, WS_MISC + MISC_EID); float* WTS = WSP(float, WS_MISC + MISC_WTS); unsigned* ctl = WSP(unsigned, WS_CTL);
    LAS float* hs = (LAS float*)(c.lds + c.wave * 4352);
    const float* wc = p.in[18] + (size_t)l * 1024 * 4; const float* wf = p.in[20] + (size_t)l * 1024 * 32;
    const int lane = c.lane;
    for (int row = c.gw; row < NTOK; row += c.NGW) {
        const int b = row / SEQ;
        f32x4 v[4]; float ss = 0.f;
#pragma unroll
        for (int j = 0; j < 4; ++j) { v[j] = *(const f32x4*)(p.out + (size_t)row * DM + j * 256 + lane * 4); ss += (v[j][0] * v[j][0] + v[j][1] * v[j][1]) + (v[j][2] * v[j][2] + v[j][3] * v[j][3]); }
        const float r = rsqrtf(wave_sum(ss) * (1.f / DM) + EPS);
        const float* gn = p.in[4] + (size_t)(l * 2 + 1) * DM; const float* sh = MOD + (l * 4 + b) * 6144 + 3072; const float* sc = sh + 1024;
#pragma unroll
        for (int j = 0; j < 4; ++j) { const int col = j * 256 + lane * 4;
            const f32x4 g = *(const f32x4*)(gn + col), s1 = *(const f32x4*)(sc + col), s0 = *(const f32x4*)(sh + col);
            const f32x4 h = v[j] * r * g * (s1 + 1.f) + s0;
            u32x2 o; o.x = pk2(h[0], h[1]); o.y = pk2(h[2], h[3]); *(u32x2*)(H2B + (size_t)row * DM + col) = o;
            *(LAS f32x4*)(hs + col) = h; }
        LDS_WAIT(); asm volatile("" ::: "memory");
        float a0 = 0.f, a1 = 0.f, a2 = 0.f, a3 = 0.f;
        if (lane < 36) { const float* w = lane < 4 ? wc + lane : wf + (lane - 4); const int ld = lane < 4 ? 4 : 32;
            for (int k = 0; k < 1024; k += 4) { a0 += hs[k] * w[(size_t)k * ld]; a1 += hs[k + 1] * w[(size_t)(k + 1) * ld]; a2 += hs[k + 2] * w[(size_t)(k + 2) * ld]; a3 += hs[k + 3] * w[(size_t)(k + 3) * ld]; } }
        float lg = (a0 + a1) + (a2 + a3);
        if (lane < 4) lg += p.in[19][l * 4 + lane]; else if (lane < 36) lg += p.in[21][l * 32 + lane - 4];
        hs[1024 + lane] = lg;
        LDS_WAIT(); asm volatile("" ::: "memory");
        if (lane == 0) {
            float lc[4];
#pragma unroll
            for (int i = 0; i < 4; ++i) lc[i] = hs[1024 + i];
            int grp = 0; float mx = lc[0];
#pragma unroll
            for (int i = 1; i < 4; ++i) if (lc[i] > mx) { mx = lc[i]; grp = i; }
            float z = 0.f;
#pragma unroll
            for (int i = 0; i < 4; ++i) z += __expf(lc[i] - mx);
            const float pg = 1.f / z;
            float f1 = -INFINITY, f2 = -INFINITY; int e1 = 0, e2 = 0;
            for (int i = 0; i < 8; ++i) { const float x = hs[1024 + 4 + grp * 8 + i];
                if (x > f1) { f2 = f1; e2 = e1; f1 = x; e1 = i; } else if (x > f2) { f2 = x; e2 = i; } }
            const float q2 = __expf(f2 - f1); const float w1 = pg / (1.f + q2), w2 = pg * q2 / (1.f + q2);
            const int x1 = grp * 8 + e1, x2 = grp * 8 + e2;
            EID[row * 2] = x1; EID[row * 2 + 1] = x2; WTS[row * 2] = w1; WTS[row * 2 + 1] = w2;
            atomicAdd(&ctl[CW_CNT + l * 32 + x1], 1u);
            atomicAdd(&ctl[CW_CNT + l * 32 + x2], 1u);
        }
        LDS_WAIT(); asm volatile("" ::: "memory");
    }
}

struct MoeTab { LAS int* start; LAS int* tile_e; LAS int* ntiles; };
DEV MoeTab build_moe_tab(const Params& p, const Ctx& c, int l) {
    MoeTab T; T.start = (LAS int*)(c.lds + LDS_AUX + 1024); T.tile_e = T.start + 32; T.ntiles = T.tile_e + 192;
    __syncthreads();
    if (c.tid == 0) { const unsigned* cnt = WSP(unsigned, WS_CTL) + CW_CNT + l * 32; int row = 0, nt = 0;
        for (int e = 0; e < 32; ++e) { const int n = (int)__hip_atomic_load(cnt + e, __ATOMIC_RELAXED, __HIP_MEMORY_SCOPE_AGENT); T.start[e] = row; const int tiles = (n + 255) >> 8;
            for (int i = 0; i < tiles; ++i) T.tile_e[nt + i] = e;
            nt += tiles; row += tiles * 256; }
        T.ntiles[0] = nt; }
    __syncthreads();
    return T;
}
DEV void phase_moesort(const Params& p, const Ctx& c, int l) {
    const MoeTab T = build_moe_tab(p, c, l);
    const int* EID = WSP(int, WS_MISC + MISC_EID); int* PSLOT = WSP(int, WS_MISC + MISC_PSLOT); unsigned* cur = WSP(unsigned, WS_CTL) + CW_CUR + l * 32;
    const bf16_t* H2B = WSP(bf16_t, WS_HBF); bf16_t* XS = (bf16_t*)(p.ws + WS_BIG + BIG_XS);
    const int lane = c.lane;
    for (int tok = c.gw; tok < NTOK; tok += c.NGW) {
        const u32x4 a = *(const u32x4*)(H2B + (size_t)tok * DM + lane * 16), b2 = *(const u32x4*)(H2B + (size_t)tok * DM + lane * 16 + 8);
#pragma unroll
        for (int k = 0; k < 2; ++k) { const int e = EID[tok * 2 + k]; int slot = 0;
            if (lane == 0) slot = T.start[e] + (int)atomicAdd(&cur[e], 1u);
            slot = __builtin_amdgcn_readfirstlane(slot);
            if (lane == 0) PSLOT[tok * 2 + k] = slot;
            *(u32x4*)(XS + (size_t)slot * DM + lane * 16) = a; *(u32x4*)(XS + (size_t)slot * DM + lane * 16 + 8) = b2; }
    }
}
template <int NCOL> struct MoeOrder { int G, c; LAS const int* tile_e; int ntiles;
    DEV bool next(int i, pg8::Unit& u) const { const int L = i * G + c; if (L >= ntiles * NCOL) return false; const int pm = L / NCOL; u.pm = pm; u.pn = tile_e[pm] * NCOL + (L % NCOL); return true; } };
struct FMoe1 { bf16_t* ACTB;
    DEV void operator()(int row, int col, const f32x4& v0, const f32x4& v1) const { const int ce = col & 511;
        u32x2 w; w.x = pk2(silu_(v0[0]) * v0[1], silu_(v0[2]) * v0[3]); w.y = pk2(silu_(v1[0]) * v1[1], silu_(v1[2]) * v1[3]);
        *(u32x2*)(ACTB + (size_t)row * 256 + (ce >> 1)) = w; } };
struct FMoe2 { bf16_t* YP;
    DEV void operator()(int row, int col, const f32x4& v0, const f32x4& v1) const { const int ce = col & 1023;
        u32x4 w; w.x = pk2(v0[0], v0[1]); w.y = pk2(v0[2], v0[3]); w.z = pk2(v1[0], v1[1]); w.w = pk2(v1[2], v1[3]); *(u32x4*)(YP + (size_t)row * DM + ce) = w; } };
DEV void phase_moe1(const Params& p, const Ctx& c, int l) {
    const MoeTab T = build_moe_tab(p, c, l);
    pg8::Gemm g{(const bf16_t*)(p.ws + WS_BIG + BIG_XS), WSP(bf16_t, WS_W13) + (size_t)l * 32 * 512 * 1024, 1024, 1024};
    MoeOrder<2> S{c.G, c.bid, T.tile_e, T.ntiles[0]}; pg8::Epi8<FMoe1> E{{WSP(bf16_t, WS_MUR)}};
    pg8::gemm_phase<pg8::Epi8<FMoe1>, MoeOrder<2>, true>(c.lds, g, S, E);
}
DEV void phase_moe2(const Params& p, const Ctx& c, int l) {
    const MoeTab T = build_moe_tab(p, c, l);
    pg8::Gemm g{WSP(bf16_t, WS_MUR), WSP(bf16_t, WS_W2) + (size_t)l * 32 * 1024 * 256, 256, 256};
    MoeOrder<4> S{c.G, c.bid, T.tile_e, T.ntiles[0]}; pg8::Epi8<FMoe2> E{{(bf16_t*)(p.ws + WS_BIG + BIG_YP)}};
    pg8::gemm_phase<pg8::Epi8<FMoe2>, MoeOrder<4>, true>(c.lds, g, S, E);
}

constexpr int PH_PRO = 0, PH_NORM1 = 1, PH_INPROJ = 2, PH_POST = 3, PH_MLAUP = 4, PH_POST2 = 5, PH_ATTN = 6, PH_CMPATTN = 7, PH_TOPK = 8, PH_SLC = 9,
              PH_MERGE0 = 10, PH_MERGE1 = 11, PH_MERGE2 = 12, PH_MERGE3 = 13, PH_OUT = 14, PH_ROUTER = 15, PH_SORT = 16, PH_MOE1 = 17, PH_MOE2 = 18, PH_FINAL = 19, PH_COUNT = 20;
constexpr int LDS_PTAB = LDS_AUX + 64;
DEV unsigned long long uni64(unsigned long long v) { const unsigned lo = __builtin_amdgcn_readfirstlane((unsigned)v), hi = __builtin_amdgcn_readfirstlane((unsigned)(v >> 32)); return ((unsigned long long)hi << 32) | lo; }
DEV void store_params(const Params& p, LAS unsigned char* lds) {
    LAS unsigned long long* L = (LAS unsigned long long*)(lds + LDS_PTAB);
    if (threadIdx.x == 0) {
#pragma unroll
        for (int i = 0; i < 24; ++i) L[i] = (unsigned long long)p.in[i];
        L[24] = (unsigned long long)p.out; L[25] = (unsigned long long)p.ws; }
}
DEV Params load_params(LAS unsigned char* lds) {
    const LAS unsigned long long* L = (const LAS unsigned long long*)(lds + LDS_PTAB); Params p;
#pragma unroll
    for (int i = 0; i < 24; ++i) p.in[i] = (const float*)uni64(L[i]);
    p.out = (float*)uni64(L[24]); p.ws = (unsigned char*)uni64(L[25]); return p;
}
template <int PH> DEV void run_phase(const Params& p, const Ctx& c, int l) {
    if constexpr (PH == PH_PRO) phase_prologue(p, c);
    else if constexpr (PH == PH_NORM1) phase_norm1<true>(p, c, l);
    else if constexpr (PH == PH_INPROJ) phase_inproj(p, c, l);
    else if constexpr (PH == PH_POST) phase_post(p, c, l);
    else if constexpr (PH == PH_MLAUP) phase_mlaup(p, c, l);
    else if constexpr (PH == PH_POST2) phase_post2(p, c, l);
    else if constexpr (PH == PH_ATTN) phase_attn(p, c, l);
    else if constexpr (PH == PH_CMPATTN) phase_cmpattn(p, c, l);
    else if constexpr (PH == PH_TOPK) phase_topk(p, c);
    else if constexpr (PH == PH_SLC) phase_slc(p, c, l);
    else if constexpr (PH == PH_MERGE0) phase_merge<0>(p, c, l);
    else if constexpr (PH == PH_MERGE1) phase_merge<1>(p, c, l);
    else if constexpr (PH == PH_MERGE2) phase_merge<2>(p, c, l);
    else if constexpr (PH == PH_MERGE3) phase_merge<3>(p, c, l);
    else if constexpr (PH == PH_OUT) phase_out(p, c, l);
    else if constexpr (PH == PH_ROUTER) phase_router(p, c, l);
    else if constexpr (PH == PH_SORT) phase_moesort(p, c, l);
    else if constexpr (PH == PH_MOE1) phase_moe1(p, c, l);
    else if constexpr (PH == PH_MOE2) phase_moe2(p, c, l);
    else if constexpr (PH == PH_FINAL) phase_norm1<false>(p, c, NLAYER);
}

#if !MK_ONE_LAUNCH
template <int PH> __global__ void __launch_bounds__(512, 2) k_phase(Params p, int l) {
    extern __shared__ __attribute__((aligned(16))) unsigned char lds_raw[];
    const Ctx c = make_ctx((LAS unsigned char*)lds_raw);
    run_phase<PH>(p, c, l);
}
template <int PH> static void launch_phase(const Params& p, int l, int grid, hipStream_t stream) {
    static bool attr_set = false;
    if (!attr_set) { (void)hipFuncSetAttribute((const void*)k_phase<PH>, hipFuncAttributeMaxDynamicSharedMemorySize, LDS_BYTES); attr_set = true; }
    hipLaunchKernelGGL(k_phase<PH>, dim3(grid), dim3(512), LDS_BYTES, stream, p, l);
}
#else
#define BAR() xcd_barrier_fn(bar.bar, bar.x, bar.st)
template <int l> DEV void mega_layer(LAS unsigned char* lds, const XcdBarrier& bar) {
        { const Ctx c = make_ctx(lds); const Params q = load_params(lds); run_phase<PH_NORM1>(q, c, l); } BAR();
        { const Ctx c = make_ctx(lds); const Params q = load_params(lds); run_phase<PH_INPROJ>(q, c, l); } BAR();
        { const Ctx c = make_ctx(lds); const Params q = load_params(lds); run_phase<PH_POST>(q, c, l); } BAR();
        { const Ctx c = make_ctx(lds); const Params q = load_params(lds); run_phase<PH_MLAUP>(q, c, l); } BAR();
        { const Ctx c = make_ctx(lds); const Params q = load_params(lds); run_phase<PH_POST2>(q, c, l); } BAR();
        { const Ctx c = make_ctx(lds); const Params q = load_params(lds); run_phase<PH_ATTN>(q, c, l); } BAR();
        { const Ctx c = make_ctx(lds); const Params q = load_params(lds); run_phase<PH_CMPATTN>(q, c, l); } BAR();
        { const Ctx c = make_ctx(lds); const Params q = load_params(lds); run_phase<PH_TOPK>(q, c, l); } BAR();
        { const Ctx c = make_ctx(lds); const Params q = load_params(lds); run_phase<PH_SLC>(q, c, l); } BAR();
        { const Ctx c = make_ctx(lds); const Params q = load_params(lds); run_phase<PH_MERGE0>(q, c, l); } BAR();
        { const Ctx c = make_ctx(lds); const Params q = load_params(lds); run_phase<PH_MERGE1>(q, c, l); } BAR();
        { const Ctx c = make_ctx(lds); const Params q = load_params(lds); run_phase<PH_MERGE2>(q, c, l); } BAR();
        { const Ctx c = make_ctx(lds); const Params q = load_params(lds); run_phase<PH_MERGE3>(q, c, l); } BAR();
        { const Ctx c = make_ctx(lds); const Params q = load_params(lds); run_phase<PH_OUT>(q, c, l); } BAR();
        { const Ctx c = make_ctx(lds); const Params q = load_params(lds); run_phase<PH_ROUTER>(q, c, l); } BAR();
        { const Ctx c = make_ctx(lds); const Params q = load_params(lds); run_phase<PH_SORT>(q, c, l); } BAR();
        { const Ctx c = make_ctx(lds); const Params q = load_params(lds); run_phase<PH_MOE1>(q, c, l); } BAR();
        { const Ctx c = make_ctx(lds); const Params q = load_params(lds); run_phase<PH_MOE2>(q, c, l); } BAR();
}
__global__ void __launch_bounds__(512, 2) k_mega(Params p) {
    extern __shared__ __attribute__((aligned(16))) unsigned char lds_raw[];
    LAS unsigned char* lds = (LAS unsigned char*)lds_raw;
    volatile LAS unsigned* bst = (volatile LAS unsigned*)(lds + LDS_AUX);
    if (threadIdx.x < 4) bst[threadIdx.x] = 0u;
    store_params(p, lds);
    __syncthreads();
    const XcdBarrier bar = xcd_barrier_post(WSP(unsigned, WS_CTL) + CW_BAR, bst);
    { const Ctx c = make_ctx(lds); const Params q = load_params(lds); run_phase<PH_PRO>(q, c, 0); } BAR();
    mega_layer<0>(lds, bar); mega_layer<1>(lds, bar); mega_layer<2>(lds, bar); mega_layer<3>(lds, bar);
    { const Ctx c = make_ctx(lds); const Params q = load_params(lds); run_phase<PH_FINAL>(q, c, NLAYER); }
#undef BAR
}
#endif

extern "C" void kernel_launch(void* const* d_in, const int* in_sizes, int n_in, void* d_out, int out_size, void* d_ws, size_t ws_size, hipStream_t stream) {
    if (n_in != 24 || out_size != NTOK * DM || ws_size < WS_END) { fprintf(stderr, "kernel_launch: unexpected shapes (n_in %d out %d ws %zu, need %zu)\n", n_in, out_size, ws_size, (size_t)WS_END); return; }
    Params p{};
    for (int i = 0; i < 24; ++i) p.in[i] = (const float*)d_in[i];
    p.out = (float*)d_out; p.ws = (unsigned char*)d_ws;
    (void)hipMemsetAsync((char*)d_ws + WS_CTL, 0, 1 * MiB, stream);
    const int grid = 256;
#if !MK_ONE_LAUNCH
    launch_phase<PH_PRO>(p, 0, grid, stream);
    for (int l = 0; l < NLAYER; ++l) {
        launch_phase<PH_NORM1>(p, l, grid, stream);
        launch_phase<PH_INPROJ>(p, l, grid, stream);
        launch_phase<PH_POST>(p, l, grid, stream);
        launch_phase<PH_MLAUP>(p, l, grid, stream);
        launch_phase<PH_POST2>(p, l, grid, stream);
        launch_phase<PH_ATTN>(p, l, grid, stream);
        launch_phase<PH_CMPATTN>(p, l, grid, stream);
        launch_phase<PH_TOPK>(p, l, grid, stream);
        launch_phase<PH_SLC>(p, l, grid, stream);
        launch_phase<PH_MERGE0>(p, l, grid, stream);
        launch_phase<PH_MERGE1>(p, l, grid, stream);
        launch_phase<PH_MERGE2>(p, l, grid, stream);
        launch_phase<PH_MERGE3>(p, l, grid, stream);
        launch_phase<PH_OUT>(p, l, grid, stream);
        launch_phase<PH_ROUTER>(p, l, grid, stream);
        launch_phase<PH_SORT>(p, l, grid, stream);
        launch_phase<PH_MOE1>(p, l, grid, stream);
        launch_phase<PH_MOE2>(p, l, grid, stream);
    }
    launch_phase<PH_FINAL>(p, NLAYER, grid, stream);
#else
    static bool attr_set = false;
    if (!attr_set) { (void)hipFuncSetAttribute((const void*)k_mega, hipFuncAttributeMaxDynamicSharedMemorySize, LDS_BYTES); attr_set = true; }
    hipLaunchKernelGGL(k_mega, dim3(grid), dim3(512), LDS_BYTES, stream, p);
#endif
}
```

```cpp
#include <hip/hip_runtime.h>
#include <cstdio>
#include <cstdint>
#include <cmath>

#ifndef MK_ONE_LAUNCH
#define MK_ONE_LAUNCH 1
#endif

#define DEV __device__ __forceinline__
#define LAS __attribute__((address_space(3)))
typedef unsigned short bf16_t;
typedef short bf16x8 __attribute__((ext_vector_type(8)));
typedef float f32x4 __attribute__((ext_vector_type(4)));
typedef unsigned u32x4 __attribute__((ext_vector_type(4)));
typedef unsigned u32x2 __attribute__((ext_vector_type(2)));

constexpr int NBATCH = 4, SEQ = 4096, DM = 1024, NTOK = NBATCH * SEQ, NLAYER = 4;
constexpr int DIN = 6572, NSMALL = 2476, PSW = 2560, NPROJ = 6656, NGATE = 4096;
constexpr int I_QA = 0, I_KC = 256, I_VC = 320, I_KS = 384, I_VS = 448, I_KW = 512, I_VW = 576, I_GL = 640, I_QB = 652, I_KB = 908, I_VB = 1036,
              I_QC = 1164, I_KCC = 1420, I_VCC = 1676, I_CQ = 1932, I_CKV = 2316, I_KR = 2444;
constexpr int ACTW = 2560;
constexpr int A_QA = 0, A_KCR = 256, A_VCR = 320, A_KS = 384, A_VS = 448, A_KW = 512, A_VW = 576, A_QB = 640, A_KB = 896, A_VB = 1024,
              A_QC = 1152, A_KC = 1408, A_VC = 1664, A_CQ = 1920, A_CKV = 2304, A_KR = 2432;
constexpr int ACT2W = 896, A2_QF = 0, A2_KN = 384, A2_VD = 640;
constexpr int NCMP = 255, NEXP = 32, XS_ROWS = 40960;
constexpr float EPS = 1e-6f;
__device__ const float SLOPES[3][4] = {{0.70710678118654752f, 0.25f, 0.08838834764831845f, 0.015625f},
                                       {0.5f, 0.17677669529663689f, 0.0625f, 0.0078125f},
                                       {0.35355339059327379f, 0.125f, 0.03125f, 0.00390625f}};

constexpr size_t MiB = 1u << 20;
constexpr size_t WS_CTL = 0;
constexpr size_t WS_MOD = 1 * MiB;
constexpr size_t WS_ROPE = 2 * MiB;
constexpr size_t WS_MISC = 3 * MiB;
constexpr size_t WS_WIN = 8 * MiB;
constexpr size_t WS_W13 = WS_WIN + 56 * MiB;
constexpr size_t WS_W2 = WS_W13 + 128 * MiB;
constexpr size_t WS_WOUT = WS_W2 + 64 * MiB;
constexpr size_t WS_WBR = WS_WOUT + 8 * MiB;
constexpr size_t WS_CW1 = WS_WBR + 8 * MiB;
constexpr size_t WS_WU = WS_CW1 + 8 * MiB;
constexpr size_t WS_HBF = WS_WU + 4 * MiB;
constexpr size_t WS_BIG = WS_HBF + 32 * MiB;
constexpr size_t WS_GATES = WS_BIG + 160 * MiB;
constexpr size_t WS_ACT = WS_GATES + 128 * MiB;
constexpr size_t WS_ACT2 = WS_ACT + 80 * MiB;
constexpr size_t WS_MUR = WS_ACT2 + 28 * MiB;
constexpr size_t WS_CMPA = WS_MUR + 64 * MiB;
constexpr size_t WS_HID = WS_CMPA + 8 * MiB;
constexpr size_t WS_PB = WS_HID + 1 * MiB;
constexpr size_t WS_OCMP = WS_PB + 16 * MiB;
constexpr size_t WS_OWIN = WS_OCMP + 16 * MiB;
constexpr size_t WS_SMALL = WS_OWIN + 16 * MiB;
constexpr size_t WS_BR = WS_SMALL + 2 * MiB;
constexpr size_t WS_END = WS_BR + 32 * MiB;
static_assert(WS_END <= 1000 * MiB, "workspace map");
constexpr size_t BIG_PSM = 0, BIG_MIX = 0, BIG_MIXB = 64 * MiB, BIG_XS = 0, BIG_YP = 80 * MiB;
constexpr size_t MISC_KCMP = 0, MISC_VCMP = 256 * 1024, MISC_KMEAN = 512 * 1024, MISC_EID = 640 * 1024, MISC_WTS = 768 * 1024, MISC_PSLOT = 896 * 1024;
constexpr size_t SM_PL = 0, SM_SEL = 256 * 1024, SM_GA = 512 * 1024;
constexpr int CW_BAR = 4096;
constexpr int CW_CNT = 16384;
constexpr int CW_CUR = 16384 + 256;

constexpr int RING_BYTES = 131072, LDS_AUX = RING_BYTES, LDS_BYTES = 147456;

struct Params { const float* in[24]; float* out; unsigned char* ws; };

DEV float bf2f(unsigned v) { return __uint_as_float(v << 16); }
DEV float bflo(unsigned w) { return __uint_as_float(w << 16); }
DEV float bfhi(unsigned w) { return __uint_as_float(w & 0xffff0000u); }
DEV unsigned f2bf(float f) { unsigned u = __float_as_uint(f); return (u + 0x7fffu + ((u >> 16) & 1u)) >> 16; }
DEV unsigned pk2(float lo, float hi) { return f2bf(lo) | (f2bf(hi) << 16); }
template <int M> DEV float swz_xor(float v) { return __int_as_float(__builtin_amdgcn_ds_swizzle(__float_as_int(v), (M << 10) | 0x1f)); }
template <int M> DEV int swz_xor_i(int v) { return __builtin_amdgcn_ds_swizzle(v, (M << 10) | 0x1f); }
DEV float xhalf(float v, float& other) { auto rr = __builtin_amdgcn_permlane32_swap(__float_as_uint(v), __float_as_uint(v), false, false); other = __uint_as_float(rr[1]); return __uint_as_float(rr[0]); }
DEV float wave_sum(float v) {
    v += swz_xor<1>(v); v += swz_xor<2>(v); v += swz_xor<4>(v); v += swz_xor<8>(v); v += swz_xor<16>(v);
    float hi; const float lo = xhalf(v, hi); return lo + hi;
}
DEV float sigm(float x) { return 1.f / (1.f + __expf(-x)); }
DEV float silu_(float x) { return x / (1.f + __expf(-x)); }
#define LDS_WAIT() asm volatile("s_waitcnt lgkmcnt(0)" ::: "memory")

namespace pg8 {
constexpr int BM = 256, BK = 64, HALF = 128, HTB = HALF * BK * 2, STAGE_BYTES = 8 * HTB, NXCD = 8, WGM = 8;
__host__ __device__ __forceinline__ int lds_byte(int r, int c) { const int st = (r >> 4) * 2 + (c >> 5), rr = r & 15, cc = c & 31, ob = rr * 64 + cc * 2; return st * 1024 + (ob ^ (((ob >> 9) & 1) << 5)); }
__host__ __device__ __forceinline__ void stage_rc(int b, int& R, int& C) { const int st = b / 1024, sb = b % 1024, swz = sb ^ (((sb >> 9) & 1) << 5); R = (st >> 1) * 16 + swz / 64; C = (st & 1) * 32 + (swz % 64) / 2; }
__host__ __device__ __forceinline__ int perm32(int rho) { const int n = rho >> 4, i = rho & 15; return 8 * (i >> 2) + 4 * n + (i & 3); }
struct Unit { int pm, pn; };
struct Gemm { const bf16_t* A; const bf16_t* Bt; int lda, K; };
struct StaticOrder {
    int nM, nN, nwg, G, c;
    __device__ void init(int M, int N, int G_, int c_) { nM = M / BM; nN = N / BM; nwg = nM * nN; G = G_; c = c_; }
    __device__ bool next(int i, Unit& u) const {
        const long L = (long)i * G + c; if (L >= nwg) return false;
        int wgid = (int)L; { const int q = nwg / NXCD, r = nwg % NXCD, xcd = wgid % NXCD, off = wgid / NXCD; wgid = (xcd < r ? xcd * (q + 1) : r * (q + 1) + (xcd - r) * q) + off; }
        const int nig = WGM * nN, gid = wgid / nig, fm = gid * WGM, gsz = (nM - fm) < WGM ? (nM - fm) : WGM;
        u.pm = fm + ((wgid % nig) % gsz); u.pn = (wgid % nig) / gsz; return true;
    }
};
template <class F> struct Epi8 {
    F f;
    __device__ __forceinline__ void operator()(const f32x4 (&acc)[2][2][4][2], const Unit& u, int wr, int wc, int fr, int fq) const {
        const int row0 = u.pm * BM + wr * 64 + fr, col0 = u.pn * BM + wc * 32 + 8 * fq;
#pragma unroll
        for (int ai = 0; ai < 2; ++ai)
#pragma unroll
            for (int m = 0; m < 4; ++m)
#pragma unroll
                for (int bj = 0; bj < 2; ++bj) f(row0 + ai * HALF + m * 16, col0 + bj * HALF, acc[ai][bj][m][0], acc[ai][bj][m][1]);
    }
};
template <class Epi, class Sched, bool ALIGN_EPI>
__device__ __forceinline__ void gemm_phase(LAS unsigned char* lds, const Gemm g, const Sched& S, const Epi& E) {
    int tid_ = threadIdx.x; asm volatile("" : "+v"(tid_));
    const int tid = tid_, wid = __builtin_amdgcn_readfirstlane(tid >> 6), lane = tid & 63, wr = wid >> 2, wc = wid & 3, fr = lane & 15, fq = lane >> 4;
    const int K = g.K, nt = K / BK, lda = g.lda;
    unsigned voffA[2], voffB[2];
#pragma unroll
    for (int i = 0; i < 2; ++i) { int R, C; stage_rc(tid * 16 + i * 8192, R, C); const int Rb = (R & ~31) + perm32(R & 31);
        voffA[i] = (unsigned)(R * lda + C) * 2u; voffB[i] = (unsigned)(Rb * K + C) * 2u; }
    const size_t kstep = (size_t)(BK * 2);
    const size_t hstepA = (size_t)HALF * lda * 2, tstepA = 2 * hstepA;
    const size_t hstepB = (size_t)HALF * K * 2, tstepB = 2 * hstepB;
    const unsigned ldsw = (unsigned)wid * 1024u;
    const int aoff = lds_byte(wr * 64 + fr, fq * 8), boff = lds_byte(wc * 32 + fr, fq * 8);
#define PG8_SA(b, h) (((b) * 2 + (h)) * HTB)
#define PG8_SB(b, h) ((4 + (b) * 2 + (h)) * HTB)
#define PG8_STAGE(bufoff, gbase, voff) do { _Pragma("unroll") for (int _i = 0; _i < 2; ++_i) \
        __builtin_amdgcn_global_load_lds((const unsigned*)((const char*)(gbase) + (voff)[_i]), (LAS unsigned*)(lds + (bufoff) + ldsw + _i * 8192), 16, 0, 0); } while (0)
#define PG8_LDA(dst, b, h) do { _Pragma("unroll") for (int m = 0; m < 4; ++m) _Pragma("unroll") for (int k = 0; k < 2; ++k) dst[m][k] = *(const LAS bf16x8*)(lds + PG8_SA(b, h) + aoff + m * 2048 + k * 1024); } while (0)
#define PG8_LDB(dst, b, h) do { _Pragma("unroll") for (int n = 0; n < 2; ++n) _Pragma("unroll") for (int k = 0; k < 2; ++k) dst[n][k] = *(const LAS bf16x8*)(lds + PG8_SB(b, h) + boff + n * 2048 + k * 1024); } while (0)
#define PG8_MMA(ai, bj, At, Bt) do { __builtin_amdgcn_s_setprio(1); _Pragma("unroll") for (int m = 0; m < 4; ++m) _Pragma("unroll") for (int n = 0; n < 2; ++n) _Pragma("unroll") for (int k = 0; k < 2; ++k) \
        acc[ai][bj][m][n] = __builtin_amdgcn_mfma_f32_16x16x32_bf16(Bt[n][k], At[m][k], acc[ai][bj][m][n], 0, 0, 0); __builtin_amdgcn_s_setprio(0); } while (0)
#define PG8_WAIT_V(n) asm volatile("s_waitcnt vmcnt(" #n ")" ::: "memory")
#define PG8_WAIT_L(n) asm volatile("s_waitcnt lgkmcnt(" #n ")" ::: "memory")
#define PG8_BAR __builtin_amdgcn_s_barrier()
#define PG8_SCHED __builtin_amdgcn_sched_barrier(0)
    Unit cur, nxt; int ui = 0;
    if (!S.next(0, cur)) return;
    f32x4 acc[2][2][4][2];
#pragma unroll
    for (int a = 0; a < 2; ++a)
#pragma unroll
        for (int b = 0; b < 2; ++b)
#pragma unroll
            for (int m = 0; m < 4; ++m)
#pragma unroll
                for (int n = 0; n < 2; ++n) acc[a][b][m][n] = (f32x4){0.f, 0.f, 0.f, 0.f};
    bf16x8 At[4][2], B0[2][2], B1[2][2];
    const char* cA = (const char*)g.A + (size_t)cur.pm * tstepA; const char* cB = (const char*)g.Bt + (size_t)cur.pn * tstepB;
    PG8_STAGE(PG8_SB(0, 0), cB, voffB); PG8_STAGE(PG8_SB(0, 1), cB + hstepB, voffB); PG8_STAGE(PG8_SA(0, 0), cA, voffA); PG8_STAGE(PG8_SA(0, 1), cA + hstepA, voffA);
    if (wr == 1) PG8_BAR;
    PG8_WAIT_V(2); PG8_BAR;
    PG8_STAGE(PG8_SB(1, 0), cB + kstep, voffB); PG8_STAGE(PG8_SA(1, 0), cA + kstep, voffA); PG8_STAGE(PG8_SB(1, 1), cB + hstepB + kstep, voffB);
    PG8_WAIT_V(6); PG8_BAR;
    for (;;) {
        const bool has_next = S.next(ui + 1, nxt);
        const char* nA = has_next ? (const char*)g.A + (size_t)nxt.pm * tstepA : cA; const char* nB = has_next ? (const char*)g.Bt + (size_t)nxt.pn * tstepB : cB;
        for (int t = 0; t < nt; t += 2) {
            const bool last = (t == nt - 2);
            const char* a1 = cA + (size_t)(t + 1) * kstep;
            const char* a2 = last ? nA : cA + (size_t)(t + 2) * kstep; const char* b2 = last ? nB : cB + (size_t)(t + 2) * kstep;
            const char* a3 = a2 + kstep; const char* b3 = b2 + kstep;
            PG8_LDB(B0, 0, 0); PG8_LDB(B1, 0, 1); PG8_SCHED; PG8_LDA(At, 0, 0); PG8_STAGE(PG8_SA(1, 1), a1 + hstepA, voffA);
            PG8_WAIT_V(8); PG8_WAIT_L(0); PG8_BAR; PG8_MMA(0, 0, At, B0); PG8_MMA(0, 1, At, B1); PG8_BAR; PG8_SCHED;
            PG8_LDA(At, 0, 1); PG8_STAGE(PG8_SB(0, 0), b2, voffB); PG8_STAGE(PG8_SB(0, 1), b2 + hstepB, voffB); PG8_STAGE(PG8_SA(0, 0), a2, voffA);
            PG8_WAIT_V(8); PG8_WAIT_L(0); PG8_BAR; PG8_MMA(1, 0, At, B0); PG8_MMA(1, 1, At, B1); PG8_BAR; PG8_SCHED;
            PG8_LDB(B0, 1, 0); PG8_LDB(B1, 1, 1); PG8_SCHED; PG8_LDA(At, 1, 0); PG8_STAGE(PG8_SA(0, 1), a2 + hstepA, voffA);
            PG8_WAIT_V(8); PG8_WAIT_L(0); PG8_BAR; PG8_MMA(0, 0, At, B0); PG8_MMA(0, 1, At, B1); PG8_BAR; PG8_SCHED;
            PG8_LDA(At, 1, 1); PG8_STAGE(PG8_SB(1, 0), b3, voffB); PG8_STAGE(PG8_SB(1, 1), b3 + hstepB, voffB); PG8_STAGE(PG8_SA(1, 0), a3, voffA);
            PG8_WAIT_V(8); PG8_WAIT_L(0); PG8_BAR; PG8_MMA(1, 0, At, B0); PG8_MMA(1, 1, At, B1); PG8_BAR; PG8_SCHED;
        }
        if constexpr (ALIGN_EPI) { if (wr == 0) PG8_BAR; }
        E(acc, cur, wr, wc, fr, fq);
        if (!has_next) break;
#pragma unroll
        for (int a = 0; a < 2; ++a)
#pragma unroll
            for (int b = 0; b < 2; ++b)
#pragma unroll
                for (int m = 0; m < 4; ++m)
#pragma unroll
                    for (int n = 0; n < 2; ++n) acc[a][b][m][n] = (f32x4){0.f, 0.f, 0.f, 0.f};
        cur = nxt; cA = nA; cB = nB; ++ui;
        if constexpr (ALIGN_EPI) { if (wr == 1) PG8_BAR; }
    }
    PG8_WAIT_V(0);
    if constexpr (!ALIGN_EPI) { if (wr == 0) PG8_BAR; }
    PG8_BAR;
#undef PG8_SA
#undef PG8_SB
#undef PG8_STAGE
#undef PG8_LDA
#undef PG8_LDB
#undef PG8_MMA
#undef PG8_WAIT_V
#undef PG8_WAIT_L
#undef PG8_BAR
#undef PG8_SCHED
}
}

#define XB_TMO      128
#define XB_XCNT(j)  (256  + 64 * (j))
#define XB_XSUB(j)  (1280 + 64 * (j))
#define XB_XGEN(j)  (2304 + 64 * (j))
#define XB_TOP      3328
#define XB_TOPGEN   3392
#define XCD_BAR_WORDS 3456
#define XB_SPIN_CAP (1u << 22)
__device__ __forceinline__ unsigned xb_ld(unsigned* p)              { return __hip_atomic_load(p, __ATOMIC_RELAXED, __HIP_MEMORY_SCOPE_AGENT); }
__device__ __forceinline__ unsigned xb_add(unsigned* p, unsigned v) { return __hip_atomic_fetch_add(p, v, __ATOMIC_RELAXED, __HIP_MEMORY_SCOPE_AGENT); }
__device__ __forceinline__ unsigned xb_xcc_id() { return (unsigned)__builtin_amdgcn_s_getreg((3 << 11) | 20) & 0xFu; }
#define XB_SPIN(cond, bar) do { unsigned _sp = 0; while (cond) { __builtin_amdgcn_s_sleep(1); \
    if ((++_sp & 255u) == 0u) { if (xb_ld(&(bar)[XB_TMO])) break; if (_sp > XB_SPIN_CAP) { atomicAdd(&(bar)[XB_TMO], 1u); break; } } } } while (0)
struct XcdBarrier { unsigned* bar; unsigned x; volatile LAS unsigned* st; };
__device__ __forceinline__ XcdBarrier xcd_barrier_post(unsigned* bar, volatile LAS unsigned* st) {
    XcdBarrier b; b.bar = bar; b.x = xb_xcc_id(); b.st = st;
    if (threadIdx.x == 0) (void)xb_add(&bar[XB_XCNT(b.x)], 1u);
    return b;
}
__device__ __forceinline__ void xcd_barrier_complete(unsigned* bar, unsigned x, unsigned& nloc, unsigned& nx) {
    const unsigned G = gridDim.x * gridDim.y * gridDim.z;
    unsigned sum, cnt, mine, sp = 0u;
    for (;;) {
        sum = 0u; cnt = 0u; mine = 0u;
#pragma unroll
        for (unsigned j = 0; j < 16; ++j) { const unsigned c = xb_ld(&bar[XB_XCNT(j)]); sum += c; cnt += (c > 0u) ? 1u : 0u; mine = (j == x) ? c : mine; }
        if (sum == G) break;
        __builtin_amdgcn_s_sleep(1);
        if ((++sp & 255u) == 0u) { if (xb_ld(&bar[XB_TMO])) break; if (sp > XB_SPIN_CAP) { atomicAdd(&bar[XB_TMO], 1u); break; } }
    }
    nloc = mine > 0u ? mine : 1u; nx = cnt > 0u ? cnt : 1u;
}
__device__ __noinline__ void xcd_barrier_fn(unsigned* bar_, unsigned x_, volatile LAS unsigned* st_) {
    XcdBarrier b; b.bar = bar_; b.x = x_; b.st = st_;
    asm volatile("s_waitcnt vmcnt(0)" ::: "memory");
    __syncthreads();
    if (threadIdx.x == 0) {
        unsigned* bar = b.bar;
        __builtin_amdgcn_s_waitcnt(0);
        unsigned nloc = b.st[0], nx = b.st[1];
        if (nloc == 0u) { xcd_barrier_complete(bar, b.x, nloc, nx); b.st[0] = nloc; b.st[1] = nx; }
        const unsigned old = xb_add(&bar[XB_XSUB(b.x)], 1u);
        const unsigned gen = old / nloc;
        if (old + 1u == (gen + 1u) * nloc) {
            __builtin_amdgcn_fence(__ATOMIC_RELEASE, "agent");
            asm volatile("s_waitcnt vmcnt(0)" ::: "memory");
            const unsigned og = xb_add(&bar[XB_TOP], 1u);
            const unsigned tg = og / nx;
            if (og + 1u == (tg + 1u) * nx) xb_add(&bar[XB_TOPGEN], 1u);
            else XB_SPIN(xb_ld(&bar[XB_TOPGEN]) == tg, bar);
            __builtin_amdgcn_fence(__ATOMIC_ACQUIRE, "agent");
            xb_add(&bar[XB_XGEN(b.x)], 1u);
            asm volatile("s_waitcnt vmcnt(0)" ::: "memory");
        } else {
            XB_SPIN(xb_ld(&bar[XB_XGEN(b.x)]) == gen, bar);
            __builtin_amdgcn_fence(__ATOMIC_ACQUIRE, "agent");
            asm volatile("s_waitcnt vmcnt(0)" ::: "memory");
        }
    }
    __syncthreads();
}

struct Ctx {
    int tid, lane, wave, gw, NGW, bid, G;
    LAS unsigned char* lds;
};
DEV Ctx make_ctx(LAS unsigned char* lds) {
    Ctx c; int tid_ = threadIdx.x; asm volatile("" : "+v"(tid_));
    c.tid = tid_; c.lane = c.tid & 63; c.wave = __builtin_amdgcn_readfirstlane(c.tid >> 6); { int b_ = blockIdx.x, g_ = gridDim.x; asm volatile("" : "+s"(b_), "+s"(g_)); c.bid = b_; c.G = g_; }
    c.gw = c.bid * 8 + c.wave; c.NGW = c.G * 8; c.lds = lds; return c;
}
#define WSP(T, off) ((T*)(p.ws + (off)))

DEV void transpose_item(const float* W, const float* W2, int ldw, int K, bf16_t* WT, int nblk, int mode, int nvalid, int item, LAS float* scr, int lane) {
    const int kb = item / nblk, nb = item % nblk, k0 = 64 * kb, n0 = 32 * nb;
    const int n = n0 + (lane & 31);
    const float* src = W; int c = -1; int ld = ldw; int kofs = 0;
    if (mode == 0) { c = n < nvalid ? n : -1; }
    else if (mode == 1) { c = n < NSMALL ? n : (n < PSW ? -1 : n - (PSW - NSMALL)); }
    else if (mode == 2) { c = (n & 1) ? 256 + (n >> 1) : (n >> 1); }
    else { if (n < 384 && k0 < 384) { c = n; ld = 384; } else if (n >= 512 && k0 >= 384) { src = W2; c = n - 512; ld = 512; kofs = 384; } }
#pragma unroll 8
    for (int i = 0; i < 32; ++i) { const int kk = 2 * i + (lane >> 5); scr[kk * 33 + (lane & 31)] = (c >= 0) ? src[(size_t)(k0 - kofs + kk) * ld + c] : 0.f; }
    LDS_WAIT(); asm volatile("" ::: "memory");
    const int c8 = lane & 7;
#pragma unroll
    for (int j = 0; j < 4; ++j) { const int nn = (lane >> 3) + 8 * j; const LAS float* s = scr + (8 * c8) * 33 + nn;
        u32x4 o; o.x = pk2(s[0 * 33], s[1 * 33]); o.y = pk2(s[2 * 33], s[3 * 33]); o.z = pk2(s[4 * 33], s[5 * 33]); o.w = pk2(s[6 * 33], s[7 * 33]);
        *(u32x4*)(WT + (size_t)(n0 + nn) * K + k0 + 8 * c8) = o; }
    LDS_WAIT(); asm volatile("" ::: "memory");
}
constexpr int IT_WIN = 16 * 208, IT_W13 = 256 * 32, IT_W2 = 128 * 32, IT_CW1 = 256 * 2, IT_WBR = 128 * 4, IT_WOUT = 512, IT_WU = 8 * 32;
constexpr int IT_LAYER = IT_WIN + IT_W13 + IT_W2 + IT_CW1 + IT_WBR + IT_WOUT + IT_WU;
DEV void phase_prologue(const Params& p, const Ctx& c) {
    float* MOD = WSP(float, WS_MOD);
    if (c.bid < 48) {
        LAS float* sc = (LAS float*)(c.lds + 73728);
        for (int i = c.tid; i < 4096; i += 512) sc[i] = silu_(p.in[1][i]);
        __syncthreads();
        const int idx = c.bid * 512 + c.tid; const int l = idx / 6144, j = idx % 6144;
        const float* wa = p.in[2] + (size_t)l * 1024 * 6144 + j;
        float a0 = 0.f, a1 = 0.f, a2 = 0.f, a3 = 0.f;
        for (int k = 0; k < 1024; ++k) { const float w = wa[(size_t)k * 6144]; a0 += sc[k] * w; a1 += sc[1024 + k] * w; a2 += sc[2048 + k] * w; a3 += sc[3072 + k] * w; }
        const float bb = p.in[3][l * 6144 + j];
        MOD[(l * 4 + 0) * 6144 + j] = a0 + bb; MOD[(l * 4 + 1) * 6144 + j] = a1 + bb; MOD[(l * 4 + 2) * 6144 + j] = a2 + bb; MOD[(l * 4 + 3) * 6144 + j] = a3 + bb;
    }
    { float* RC = WSP(float, WS_ROPE); float* RS = RC + 4096 * 16;
      for (int i = c.bid * 512 + c.tid; i < 4096 * 16; i += c.G * 512) { const int pos = i >> 4, k = i & 15;
          const float inv = (float)pow(10000.0, -(double)k / 16.0); const float ang = (float)pos * inv;
          RC[i] = (float)cos((double)ang); RS[i] = (float)sin((double)ang); } }
    LAS float* scr = (LAS float*)(c.lds + c.wave * 8448);
    for (int it = c.gw; it < IT_LAYER * NLAYER; it += c.NGW) {
        const int l = it / IT_LAYER; int r = it % IT_LAYER;
        if (r < IT_WIN) { transpose_item(p.in[5] + (size_t)l * 1024 * DIN, nullptr, DIN, 1024, WSP(bf16_t, WS_WIN) + (size_t)l * NPROJ * 1024, NPROJ / 32, 1, 0, r, scr, c.lane); continue; } r -= IT_WIN;
        if (r < IT_W13) { const int e = r / 256; transpose_item(p.in[22] + (size_t)(l * 32 + e) * 1024 * 512, nullptr, 512, 1024, WSP(bf16_t, WS_W13) + (size_t)(l * 32 + e) * 512 * 1024, 16, 2, 0, r % 256, scr, c.lane); continue; } r -= IT_W13;
        if (r < IT_W2) { const int e = r / 128; transpose_item(p.in[23] + (size_t)(l * 32 + e) * 256 * 1024, nullptr, 1024, 256, WSP(bf16_t, WS_W2) + (size_t)(l * 32 + e) * 1024 * 256, 32, 0, 1024, r % 128, scr, c.lane); continue; } r -= IT_W2;
        if (r < IT_CW1) { const int kv = r / 256; transpose_item(p.in[8] + (size_t)(l * 2 + kv) * 2048 * 256, nullptr, 256, 2048, WSP(bf16_t, WS_CW1) + (size_t)(l * 2 + kv) * 256 * 2048, 8, 0, 256, r % 256, scr, c.lane); continue; } r -= IT_CW1;
        if (r < IT_WBR) { const int n = r / 128; transpose_item(p.in[16] + (size_t)(l * 4 + n) * 256 * 1024, nullptr, 1024, 256, WSP(bf16_t, WS_WBR) + (size_t)(l * 4 + n) * 1024 * 256, 32, 0, 1024, r % 128, scr, c.lane); continue; } r -= IT_WBR;
        if (r < IT_WOUT) { transpose_item(p.in[17] + (size_t)l * 1024 * 1024, nullptr, 1024, 1024, WSP(bf16_t, WS_WOUT) + (size_t)l * 1024 * 1024, 32, 0, 1024, r, scr, c.lane); continue; } r -= IT_WOUT;
        transpose_item(p.in[14] + (size_t)l * 384 * 384, p.in[15] + (size_t)l * 128 * 512, 0, 512, WSP(bf16_t, WS_WU) + (size_t)l * 1024 * 512, 32, 3, 0, r, scr, c.lane);
    }
}

template <bool NORM> DEV void phase_norm1(const Params& p, const Ctx& c, int l) {
    const float* MOD = WSP(float, WS_MOD);
    const bf16_t* YP = (const bf16_t*)(p.ws + WS_BIG + BIG_YP);
    const int* PSLOT = WSP(int, WS_MISC + MISC_PSLOT); const float* WTS = WSP(float, WS_MISC + MISC_WTS);
    bf16_t* HBF = WSP(bf16_t, WS_HBF);
    for (int row = c.gw; row < NTOK; row += c.NGW) {
        const int b = row / SEQ;
        f32x4 v[4];
        if (l == 0) {
#pragma unroll
            for (int j = 0; j < 4; ++j) v[j] = *(const f32x4*)(p.in[0] + (size_t)row * DM + j * 256 + c.lane * 4);
        } else {
            const float* g2 = MOD + ((l - 1) * 4 + b) * 6144 + 5120;
            const int s0 = PSLOT[row * 2], s1 = PSLOT[row * 2 + 1]; const float w0 = WTS[row * 2], w1 = WTS[row * 2 + 1];
#pragma unroll
            for (int j = 0; j < 4; ++j) { const int col = j * 256 + c.lane * 4;
                const f32x4 x = *(const f32x4*)(p.out + (size_t)row * DM + col); const f32x4 g = *(const f32x4*)(g2 + col);
                const u32x2 y0 = *(const u32x2*)(YP + (size_t)s0 * DM + col), y1 = *(const u32x2*)(YP + (size_t)s1 * DM + col);
                f32x4 y; y[0] = w0 * bflo(y0.x) + w1 * bflo(y1.x); y[1] = w0 * bfhi(y0.x) + w1 * bfhi(y1.x); y[2] = w0 * bflo(y0.y) + w1 * bflo(y1.y); y[3] = w0 * bfhi(y0.y) + w1 * bfhi(y1.y);
                v[j] = x + g * y; }
        }
#pragma unroll
        for (int j = 0; j < 4; ++j) *(f32x4*)(p.out + (size_t)row * DM + j * 256 + c.lane * 4) = v[j];
        if (NORM) {
            float ss = 0.f;
#pragma unroll
            for (int j = 0; j < 4; ++j) ss += (v[j][0] * v[j][0] + v[j][1] * v[j][1]) + (v[j][2] * v[j][2] + v[j][3] * v[j][3]);
            const float r = rsqrtf(wave_sum(ss) * (1.f / DM) + EPS);
            const float* gn = p.in[4] + (size_t)(l * 2 + 0) * DM; const float* sh = MOD + (l * 4 + b) * 6144; const float* sc = sh + 1024;
#pragma unroll
            for (int j = 0; j < 4; ++j) { const int col = j * 256 + c.lane * 4;
                const f32x4 g = *(const f32x4*)(gn + col), s1 = *(const f32x4*)(sc + col), s0 = *(const f32x4*)(sh + col);
                const f32x4 h = v[j] * r * g * (s1 + 1.f) + s0;
                u32x2 o; o.x = pk2(h[0], h[1]); o.y = pk2(h[2], h[3]); *(u32x2*)(HBF + (size_t)row * DM + col) = o; }
        }
    }
}

struct FInproj { float* PSM; bf16_t* GATES;
    DEV void operator()(int row, int col, const f32x4& v0, const f32x4& v1) const {
        if (col < PSW) { float* o = PSM + (size_t)row * PSW + col; *(f32x4*)o = v0; *(f32x4*)(o + 4) = v1; }
        else { u32x4 w; w.x = pk2(sigm(v0[0]), sigm(v0[1])); w.y = pk2(sigm(v0[2]), sigm(v0[3])); w.z = pk2(sigm(v1[0]), sigm(v1[1])); w.w = pk2(sigm(v1[2]), sigm(v1[3]));
               *(u32x4*)(GATES + (size_t)row * NGATE + (col - PSW)) = w; } } };
DEV void phase_inproj(const Params& p, const Ctx& c, int l) {
    pg8::Gemm g{WSP(bf16_t, WS_HBF), WSP(bf16_t, WS_WIN) + (size_t)l * NPROJ * 1024, 1024, 1024};
    pg8::StaticOrder S; S.init(NTOK, NPROJ, c.G, c.bid);
    pg8::Epi8<FInproj> E{{(float*)(p.ws + WS_BIG + BIG_PSM), WSP(bf16_t, WS_GATES)}};
    pg8::gemm_phase<pg8::Epi8<FInproj>, pg8::StaticOrder, true>(c.lds, g, S, E);
}

DEV float head_norm(float v, const float* gain, int lane) { const float ss = wave_sum(v * v); return v * rsqrtf(ss * (1.f / 64.f) + EPS) * gain[lane]; }
DEV void phase_post(const Params& p, const Ctx& c, int l) {
    const float* PSM = (const float*)(p.ws + WS_BIG + BIG_PSM); bf16_t* ACT = WSP(bf16_t, WS_ACT);
    float* GA = WSP(float, WS_SMALL + SM_GA);
    const float* gq = p.in[6] + (size_t)l * 10 * 64;
    const float* RC = WSP(float, WS_ROPE); const float* RS = RC + 4096 * 16;
    const int lane = c.lane;
    for (int row = c.gw; row < NTOK; row += c.NGW) {
        const float* P = PSM + (size_t)row * PSW; bf16_t* A = ACT + (size_t)row * ACTW; const int t = row % SEQ;
#pragma unroll
        for (int h = 0; h < 4; ++h) A[A_QA + h * 64 + lane] = (bf16_t)f2bf(head_norm(P[I_QA + h * 64 + lane], gq + 0 * 64, lane));
        A[A_KCR + lane] = (bf16_t)f2bf(P[I_KC + lane]); A[A_VCR + lane] = (bf16_t)f2bf(P[I_VC + lane]);
        A[A_KS + lane] = (bf16_t)f2bf(head_norm(P[I_KS + lane], gq + 2 * 64, lane)); A[A_VS + lane] = (bf16_t)f2bf(P[I_VS + lane]);
        A[A_KW + lane] = (bf16_t)f2bf(head_norm(P[I_KW + lane], gq + 3 * 64, lane)); A[A_VW + lane] = (bf16_t)f2bf(P[I_VW + lane]);
        if (lane < 12) GA[row * 12 + lane] = sigm(P[I_GL + lane]);
#pragma unroll
        for (int h = 0; h < 4; ++h) A[A_QB + h * 64 + lane] = (bf16_t)f2bf(head_norm(P[I_QB + h * 64 + lane], gq + 4 * 64, lane));
#pragma unroll
        for (int h = 0; h < 2; ++h) { A[A_KB + h * 64 + lane] = (bf16_t)f2bf(head_norm(P[I_KB + h * 64 + lane], gq + 5 * 64, lane)); A[A_VB + h * 64 + lane] = (bf16_t)f2bf(P[I_VB + h * 64 + lane]); }
#pragma unroll
        for (int h = 0; h < 4; ++h) { A[A_QC + h * 64 + lane] = (bf16_t)f2bf(head_norm(P[I_QC + h * 64 + lane], gq + 6 * 64, lane));
            A[A_KC + h * 64 + lane] = (bf16_t)f2bf(head_norm(P[I_KCC + h * 64 + lane], gq + 7 * 64, lane)); A[A_VC + h * 64 + lane] = (bf16_t)f2bf(P[I_VCC + h * 64 + lane]); }
        { float x[6]; float ss = 0.f;
#pragma unroll
          for (int j = 0; j < 6; ++j) { x[j] = P[I_CQ + j * 64 + lane]; ss += x[j] * x[j]; }
          const float r = rsqrtf(wave_sum(ss) * (1.f / 384.f) + EPS); const float* g = p.in[11] + l * 384;
#pragma unroll
          for (int j = 0; j < 6; ++j) A[A_CQ + j * 64 + lane] = (bf16_t)f2bf(x[j] * r * g[j * 64 + lane]); }
        { float x0 = P[I_CKV + lane], x1 = P[I_CKV + 64 + lane]; const float r = rsqrtf(wave_sum(x0 * x0 + x1 * x1) * (1.f / 128.f) + EPS); const float* g = p.in[12] + l * 128;
          A[A_CKV + lane] = (bf16_t)f2bf(x0 * r * g[lane]); A[A_CKV + 64 + lane] = (bf16_t)f2bf(x1 * r * g[64 + lane]); }
        { const float x = lane < 32 ? P[I_KR + lane] : 0.f; const float r = rsqrtf(wave_sum(x * x) * (1.f / 32.f) + EPS);
          const float y = x * r * p.in[13][(l * 2 + 1) * 32 + (lane & 31)];
          const float yo = swz_xor<16>(y); const int k = lane & 15; const float cs = RC[t * 16 + k], sn = RS[t * 16 + k];
          const float o = (lane & 16) ? (yo * sn + y * cs) : (y * cs - yo * sn);
          if (lane < 32) A[A_KR + lane] = (bf16_t)f2bf(o); }
    }
}

struct FStoreF32 { float* O; int ld;
    DEV void operator()(int row, int col, const f32x4& v0, const f32x4& v1) const { float* o = O + (size_t)row * ld + col; *(f32x4*)o = v0; *(f32x4*)(o + 4) = v1; } };
DEV void phase_mlaup(const Params& p, const Ctx& c, int l) {
    { pg8::Gemm g{WSP(bf16_t, WS_ACT) + A_CQ, WSP(bf16_t, WS_WU) + (size_t)l * 1024 * 512, ACTW, 512};
      pg8::StaticOrder S; S.init(NTOK, 1024, c.G, c.bid);
      pg8::Epi8<FStoreF32> E{{WSP(float, WS_MUR), 1024}};
      pg8::gemm_phase<pg8::Epi8<FStoreF32>, pg8::StaticOrder, true>(c.lds, g, S, E); }
    { const bf16_t* ACT = WSP(bf16_t, WS_ACT); bf16_t* CMPA = WSP(bf16_t, WS_CMPA); const float* pe = p.in[7] + (size_t)l * 2 * 32 * 64;
      for (int idx = c.bid * 512 + c.tid; idx < 2 * 1024 * 256; idx += c.G * 512) {
          const int c8 = idx & 255, r = (idx >> 8) & 1023, kv = idx >> 18; const int j = c8 >> 3, d = (c8 & 7) * 8;
          u32x4 o = (u32x4){0u, 0u, 0u, 0u};
          if (r < 1020) { const int b = r / 255, i = r % 255; const size_t tok = (size_t)b * SEQ + 16 * i + j;
              const u32x4 s = *(const u32x4*)(ACT + tok * ACTW + (kv ? A_VCR : A_KCR) + d); const float* pp = pe + (kv * 32 + j) * 64 + d;
              o.x = pk2(bflo(s.x) + pp[0], bfhi(s.x) + pp[1]); o.y = pk2(bflo(s.y) + pp[2], bfhi(s.y) + pp[3]); o.z = pk2(bflo(s.z) + pp[4], bfhi(s.z) + pp[5]); o.w = pk2(bflo(s.w) + pp[6], bfhi(s.w) + pp[7]); }
          *(u32x4*)(CMPA + ((size_t)kv * 1024 + r) * 2048 + c8 * 8) = o; } }
    { const bf16_t* ACT = WSP(bf16_t, WS_ACT); float* KM = WSP(float, WS_MISC + MISC_KMEAN);
      for (int idx = c.bid * 512 + c.tid; idx < 4 * 16 * 256; idx += c.G * 512) { const int hd = idx & 255, n = (idx >> 8) & 15, b = idx >> 12;
          const bf16_t* src = ACT + ((size_t)b * SEQ + n * 256) * ACTW + A_KC + hd; float s = 0.f;
          for (int i = 0; i < 256; ++i) s += bf2f(src[(size_t)i * ACTW]);
          KM[idx] = s * (1.f / 256.f); } }
}

struct CmpOrder { int G, c; DEV bool next(int i, pg8::Unit& u) const { const int L = i * G + c; if (L >= 8) return false; u.pm = L; u.pn = L >> 2; return true; } };
struct FCmpHid { bf16_t* HID;
    DEV void operator()(int row, int col, const f32x4& v0, const f32x4& v1) const { const int cc = col & 255;
        u32x4 w; w.x = pk2(silu_(v0[0]), silu_(v0[1])); w.y = pk2(silu_(v0[2]), silu_(v0[3])); w.z = pk2(silu_(v1[0]), silu_(v1[1])); w.w = pk2(silu_(v1[2]), silu_(v1[3]));
        *(u32x4*)(HID + (size_t)row * 256 + cc) = w; } };
DEV void phase_post2(const Params& p, const Ctx& c, int l) {
    { pg8::Gemm g{WSP(bf16_t, WS_CMPA), WSP(bf16_t, WS_CW1) + (size_t)l * 2 * 256 * 2048, 2048, 2048};
      CmpOrder S{c.G, c.bid}; pg8::Epi8<FCmpHid> E{{WSP(bf16_t, WS_HID)}};
      pg8::gemm_phase<pg8::Epi8<FCmpHid>, CmpOrder, true>(c.lds, g, S, E); }
    const float* MUR = WSP(float, WS_MUR); bf16_t* ACT2 = WSP(bf16_t, WS_ACT2);
    const float* gq = p.in[6] + (size_t)l * 10 * 64; const float* RC = WSP(float, WS_ROPE); const float* RS = RC + 4096 * 16;
    const int lane = c.lane;
    for (int row = c.gw; row < NTOK; row += c.NGW) {
        const float* R = MUR + (size_t)row * 1024; bf16_t* A = ACT2 + (size_t)row * ACT2W; const int t = row % SEQ;
#pragma unroll
        for (int h = 0; h < 4; ++h) {
            A[A2_QF + h * 96 + lane] = (bf16_t)f2bf(head_norm(R[h * 96 + lane], gq + 8 * 64, lane));
            { const float x = lane < 32 ? R[h * 96 + 64 + lane] : 0.f; const float r = rsqrtf(wave_sum(x * x) * (1.f / 32.f) + EPS);
              const float y = x * r * p.in[13][(l * 2 + 0) * 32 + (lane & 31)];
              const float yo = swz_xor<16>(y); const int k = lane & 15; const float cs = RC[t * 16 + k], sn = RS[t * 16 + k];
              const float o = (lane & 16) ? (yo * sn + y * cs) : (y * cs - yo * sn);
              if (lane < 32) A[A2_QF + h * 96 + 64 + lane] = (bf16_t)f2bf(o); }
            A[A2_KN + h * 64 + lane] = (bf16_t)f2bf(head_norm(R[512 + h * 128 + lane], gq + 9 * 64, lane));
            A[A2_VD + h * 64 + lane] = (bf16_t)f2bf(R[512 + h * 128 + 64 + lane]);
        }
    }
}

template <int D0, int D1, int DV>
DEV void att_step(const float (&q)[D0 + D1], float (&o)[DV], float& m, float& l, const bf16_t* k0, const bf16_t* k1, const bf16_t* v, float scale, float bias, bool valid) {
    float acc = 0.f;
#pragma unroll
    for (int i = 0; i < D0 / 8; ++i) { const u32x4 u = *(const u32x4*)(k0 + 8 * i);
        acc += q[8 * i] * bflo(u.x) + q[8 * i + 1] * bfhi(u.x) + q[8 * i + 2] * bflo(u.y) + q[8 * i + 3] * bfhi(u.y) + q[8 * i + 4] * bflo(u.z) + q[8 * i + 5] * bfhi(u.z) + q[8 * i + 6] * bflo(u.w) + q[8 * i + 7] * bfhi(u.w); }
    if (D1 > 0) {
#pragma unroll
        for (int i = 0; i < D1 / 8; ++i) { const u32x4 u = *(const u32x4*)(k1 + 8 * i); const int b = D0 + 8 * i;
            acc += q[b] * bflo(u.x) + q[b + 1] * bfhi(u.x) + q[b + 2] * bflo(u.y) + q[b + 3] * bfhi(u.y) + q[b + 4] * bflo(u.z) + q[b + 5] * bfhi(u.z) + q[b + 6] * bflo(u.w) + q[b + 7] * bfhi(u.w); }
    }
    const float s = acc * scale + bias;
    if (valid) {
        if (s > m) { const float a = __expf(m - s); l *= a;
#pragma unroll
            for (int d = 0; d < DV; ++d) o[d] *= a;
            m = s; }
        const float pr = __expf(s - m); l += pr;
#pragma unroll
        for (int i = 0; i < DV / 8; ++i) { const u32x4 u = *(const u32x4*)(v + 8 * i);
            o[8 * i] += pr * bflo(u.x); o[8 * i + 1] += pr * bfhi(u.x); o[8 * i + 2] += pr * bflo(u.y); o[8 * i + 3] += pr * bfhi(u.y);
            o[8 * i + 4] += pr * bflo(u.z); o[8 * i + 5] += pr * bfhi(u.z); o[8 * i + 6] += pr * bflo(u.w); o[8 * i + 7] += pr * bfhi(u.w); }
    }
}
template <int D> DEV void load_q(float (&q)[D], const bf16_t* src) {
#pragma unroll
    for (int i = 0; i < D / 8; ++i) { const u32x4 u = *(const u32x4*)(src + 8 * i);
        q[8 * i] = bflo(u.x); q[8 * i + 1] = bfhi(u.x); q[8 * i + 2] = bflo(u.y); q[8 * i + 3] = bfhi(u.y); q[8 * i + 4] = bflo(u.z); q[8 * i + 5] = bfhi(u.z); q[8 * i + 6] = bflo(u.w); q[8 * i + 7] = bfhi(u.w); }
}
template <int DV> DEV void store_o_bf16(bf16_t* dst, const float (&o)[DV], float inv) {
#pragma unroll
    for (int i = 0; i < DV / 8; ++i) { u32x4 w; w.x = pk2(o[8 * i] * inv, o[8 * i + 1] * inv); w.y = pk2(o[8 * i + 2] * inv, o[8 * i + 3] * inv); w.z = pk2(o[8 * i + 4] * inv, o[8 * i + 5] * inv); w.w = pk2(o[8 * i + 6] * inv, o[8 * i + 7] * inv);
        *(u32x4*)(dst + 8 * i) = w; }
}
DEV void item_bgh(int it, int& b, int& g, int& h) { const int r = it & 63, bh = it >> 6; g = (r & 1) ? 63 - (r >> 1) : (r >> 1); b = bh >> 2; h = bh & 3; }

DEV void phase_attn(const Params& p, const Ctx& c, int l) {
    const int lane = c.lane;
    { const bf16_t* HID = WSP(bf16_t, WS_HID); float* KC = WSP(float, WS_MISC + MISC_KCMP); float* VC = WSP(float, WS_MISC + MISC_VCMP);
      const float* gq = p.in[6] + (size_t)l * 10 * 64;
      for (int it = c.gw; it < 2 * 1020; it += c.NGW) { const int kv = it / 1020, r = it % 1020;
          const float* w2 = p.in[9] + (size_t)(l * 2 + kv) * 256 * 64; const bf16_t* hrow = HID + ((size_t)kv * 1024 + r) * 256;
          float a = 0.f;
          for (int k = 0; k < 256; ++k) a += bf2f(hrow[k]) * w2[k * 64 + lane];
          const int b = r / 255, i = r % 255;
          if (kv == 0) KC[(b * 256 + i) * 64 + lane] = head_norm(a, gq + 1 * 64, lane); else VC[(b * 256 + i) * 64 + lane] = a; } }
    const bf16_t* ACT = WSP(bf16_t, WS_ACT); const bf16_t* ACT2 = WSP(bf16_t, WS_ACT2); bf16_t* BR = WSP(bf16_t, WS_BR);
    for (int it0 = c.gw; it0 < 2048; it0 += c.NGW) {
        if (it0 < 1024) {
            int b, g, h; item_bgh(it0, b, g, h); const int t = g * 64 + lane; const size_t tok = (size_t)b * SEQ + t;
            float q[96], o[64]; float m = -INFINITY, ls = 0.f;
            load_q<96>(q, ACT2 + tok * ACT2W + A2_QF + h * 96);
#pragma unroll
            for (int d = 0; d < 64; ++d) o[d] = 0.f;
            const float scale = 0.10206207261596575f;
            for (int s = g * 64 + 63; s >= 0; --s) { const size_t kt = (size_t)b * SEQ + s;
                att_step<64, 32, 64>(q, o, m, ls, ACT2 + kt * ACT2W + A2_KN + h * 64, ACT + kt * ACTW + A_KR, ACT2 + kt * ACT2W + A2_VD + h * 64, scale, 0.f, s <= t); }
            store_o_bf16<64>(BR + tok * 1024 + 768 + h * 64, o, 1.f / ls);
        } else {
            int b, g, h; item_bgh(it0 - 1024, b, g, h); const int t = g * 64 + lane; const size_t tok = (size_t)b * SEQ + t;
            const int nb = g >> 2; const float slope = SLOPES[2][h];
            float q[64], o[64]; float m = -INFINITY, ls = 0.f;
            load_q<64>(q, ACT + tok * ACTW + A_QC + h * 64);
#pragma unroll
            for (int d = 0; d < 64; ++d) o[d] = 0.f;
            const float* KM = WSP(float, WS_MISC + MISC_KMEAN) + (size_t)b * 16 * 256 + h * 64;
            float v1 = -INFINITY, v2 = -INFINITY, v3 = -INFINITY; int i1 = -1, i2 = -1, i3 = -1;
            for (int n = 0; n < nb; ++n) { const float* km = KM + n * 256; float dsum = 0.f;
#pragma unroll
                for (int d = 0; d < 64; ++d) dsum += q[d] * km[d];
                if (dsum > v1) { v3 = v2; i3 = i2; v2 = v1; i2 = i1; v1 = dsum; i1 = n; }
                else if (dsum > v2) { v3 = v2; i3 = i2; v2 = dsum; i2 = n; }
                else if (dsum > v3) { v3 = dsum; i3 = n; } }
            const int start = nb * 256;
            for (int s = g * 64 + 63; s >= start; --s) { const size_t kt = (size_t)b * SEQ + s;
                att_step<64, 0, 64>(q, o, m, ls, ACT + kt * ACTW + A_KC + h * 64, nullptr, ACT + kt * ACTW + A_VC + h * 64, 0.125f, -slope * (float)(t - s), s <= t); }
            for (int n = nb - 1; n >= 0; --n) { const bool sel = (n == i1) || (n == i2) || (n == i3);
                if (!__any(sel)) continue;
                for (int s = n * 256 + 255; s >= n * 256; --s) { const size_t kt = (size_t)b * SEQ + s;
                    att_step<64, 0, 64>(q, o, m, ls, ACT + kt * ACTW + A_KC + h * 64, nullptr, ACT + kt * ACTW + A_VC + h * 64, 0.125f, -slope * (float)(t - s), sel); } }
            store_o_bf16<64>(BR + tok * 1024 + 512 + h * 64, o, 1.f / ls);
        }
    }
    for (int it0 = c.gw; it0 < 2048; it0 += c.NGW) {
        const bool swa = it0 >= 1024;
        int b, g, h; item_bgh(swa ? it0 - 1024 : it0, b, g, h); const int t = g * 64 + lane; const size_t tok = (size_t)b * SEQ + t;
        const int W = swa ? 128 : 512; const float slope = SLOPES[swa ? 1 : 0][h];
        const int qoff = swa ? A_QB + h * 64 : A_QA + h * 64, koff = swa ? A_KB + (h >> 1) * 64 : A_KW, voff = swa ? A_VB + (h >> 1) * 64 : A_VW;
        float q[64], o[64]; float m = -INFINITY, ls = 0.f;
        load_q<64>(q, ACT + tok * ACTW + qoff);
#pragma unroll
        for (int d = 0; d < 64; ++d) o[d] = 0.f;
        int lo = g * 64 - (W - 1); if (lo < 0) lo = 0;
        for (int s = g * 64 + 63; s >= lo; --s) { const size_t kt = (size_t)b * SEQ + s; const int dist = t - s;
            att_step<64, 0, 64>(q, o, m, ls, ACT + kt * ACTW + koff, nullptr, ACT + kt * ACTW + voff, 0.125f, -slope * (float)dist, dist >= 0 && dist < W); }
        if (swa) { const float sk = p.in[10][l * 4 + h]; const float mf = fmaxf(m, sk); const float a = __expf(m - mf); const float den = ls * a + __expf(sk - mf);
            store_o_bf16<64>(BR + tok * 1024 + 256 + h * 64, o, a / den); }
        else { float* OW = WSP(float, WS_OWIN) + tok * 256 + h * 64; const float inv = 1.f / ls;
#pragma unroll
            for (int d = 0; d < 64; d += 4) *(f32x4*)(OW + d) = (f32x4){o[d] * inv, o[d + 1] * inv, o[d + 2] * inv, o[d + 3] * inv}; }
    }
}

DEV void phase_cmpattn(const Params& p, const Ctx& c, int l) {
    const bf16_t* ACT = WSP(bf16_t, WS_ACT); const float* KC = WSP(float, WS_MISC + MISC_KCMP); const float* VC = WSP(float, WS_MISC + MISC_VCMP);
    float* PB = WSP(float, WS_PB); float* PL = WSP(float, WS_SMALL + SM_PL); float* OC = WSP(float, WS_OCMP);
    const int lane = c.lane;
    for (int it = c.gw; it < 1024; it += c.NGW) {
        int b, g, h; item_bgh(it, b, g, h); const int t = g * 64 + lane; const size_t tok = (size_t)b * SEQ + t; const float slope = SLOPES[0][h];
        float q[64], o[64];
        load_q<64>(q, ACT + tok * ACTW + A_QA + h * 64);
#pragma unroll
        for (int d = 0; d < 64; ++d) o[d] = 0.f;
        const int nvis = t >= 31 ? ((t - 31) >> 4) + 1 : 0;
        const int tmaxw = g * 64 + 63; const int nmax = tmaxw >= 31 ? ((tmaxw - 31) >> 4) + 1 : 0;
        const float* kcb = KC + (size_t)b * 256 * 64; const float* vcb = VC + (size_t)b * 256 * 64;
        float m = -INFINITY;
        for (int n = 0; n < nmax; ++n) { const float* k = kcb + n * 64; float a = 0.f;
#pragma unroll
            for (int d = 0; d < 64; ++d) a += q[d] * k[d];
            const float s = a * 0.125f - slope * (float)(t - (16 * n + 31));
            if (n < nvis) m = fmaxf(m, s); }
        float ls = 0.f, carry = 0.f; float* pb = PB + (tok * 4 + h) * 64;
        for (int j = 0; j < 64; ++j) { float e4[4];
#pragma unroll
            for (int u = 0; u < 4; ++u) { const int n = 4 * j + u; float e = 0.f;
                if (n < nmax) { const float* k = kcb + n * 64; float a = 0.f;
#pragma unroll
                    for (int d = 0; d < 64; ++d) a += q[d] * k[d];
                    const float s = a * 0.125f - slope * (float)(t - (16 * n + 31));
                    if (n < nvis) { e = __expf(s - m); const float* v = vcb + n * 64;
#pragma unroll
                        for (int d = 0; d < 64; ++d) o[d] += e * v[d]; } }
                e4[u] = e; }
            pb[j] = carry + e4[0] + e4[1] + e4[2] + e4[3]; carry = e4[3]; ls += e4[0] + e4[1] + e4[2] + e4[3];
            if (4 * j + 4 >= nmax) { for (int jj = j + 1; jj < 64; ++jj) pb[jj] = (jj == j + 1) ? carry : 0.f; break; } }
        const float inv = 1.f / fmaxf(ls, 1e-30f);
        PL[tok * 4 + h] = inv;
        float* oc = OC + tok * 256 + h * 64;
#pragma unroll
        for (int d = 0; d < 64; d += 4) *(f32x4*)(oc + d) = (f32x4){o[d] * inv, o[d + 1] * inv, o[d + 2] * inv, o[d + 3] * inv};
    }
}

DEV void phase_topk(const Params& p, const Ctx& c) {
    const float* PB = WSP(float, WS_PB); const float* PL = WSP(float, WS_SMALL + SM_PL); unsigned long long* SEL = WSP(unsigned long long, WS_SMALL + SM_SEL);
    const int lane = c.lane;
    for (int tok = c.gw; tok < NTOK; tok += c.NGW) {
        const int t = tok % SEQ, cur = t >> 6;
        float ps = 0.f;
#pragma unroll
        for (int h = 0; h < 4; ++h) ps += PB[((size_t)tok * 4 + h) * 64 + lane] * PL[tok * 4 + h];
        const bool forced = (lane == 0) || (lane == cur) || (lane == cur - 1);
        float score = lane <= cur ? ps + (forced ? 1e4f : 0.f) : -1e30f;
        unsigned long long mask = 0ull;
        for (int r = 0; r < 8; ++r) {
            float bv = score; int bi = lane;
#define TK_STEP(M) { const float ov = swz_xor<M>(bv); const int oi = swz_xor_i<M>(bi); if (ov > bv || (ov == bv && oi < bi)) { bv = ov; bi = oi; } }
            TK_STEP(1) TK_STEP(2) TK_STEP(4) TK_STEP(8) TK_STEP(16)
#undef TK_STEP
            { auto rv = __builtin_amdgcn_permlane32_swap(__float_as_uint(bv), __float_as_uint(bv), false, false); auto ri = __builtin_amdgcn_permlane32_swap((unsigned)bi, (unsigned)bi, false, false);
              const float v0 = __uint_as_float(rv[0]), v1 = __uint_as_float(rv[1]); const int i0 = (int)ri[0], i1 = (int)ri[1];
              if (v1 > v0 || (v1 == v0 && i1 < i0)) { bv = v1; bi = i1; } else { bv = v0; bi = i0; } }
            if (bv > -5e29f) mask |= 1ull << bi;
            if (lane == bi) score = -INFINITY;
        }
        if (lane == 0) SEL[tok] = mask;
    }
}

DEV void phase_slc(const Params& p, const Ctx& c, int l) {
    const bf16_t* ACT = WSP(bf16_t, WS_ACT); bf16_t* BR = WSP(bf16_t, WS_BR); const unsigned long long* SEL = WSP(unsigned long long, WS_SMALL + SM_SEL);
    const float* OC = WSP(float, WS_OCMP); const float* OW = WSP(float, WS_OWIN); const float* GA = WSP(float, WS_SMALL + SM_GA);
    const int lane = c.lane;
    for (int it = c.gw; it < 1024; it += c.NGW) {
        int b, g, h; item_bgh(it, b, g, h); const int t = g * 64 + lane; const size_t tok = (size_t)b * SEQ + t; const float slope = SLOPES[0][h];
        float q[64], o[64]; float m = -INFINITY, ls = 0.f;
        load_q<64>(q, ACT + tok * ACTW + A_QA + h * 64);
#pragma unroll
        for (int d = 0; d < 64; ++d) o[d] = 0.f;
        const unsigned long long mask = SEL[tok];
        for (int j = g; j >= 0; --j) { const bool sel = (mask >> j) & 1ull;
            if (!__any(sel)) continue;
            for (int s = j * 64 + 63; s >= j * 64; --s) { const size_t kt = (size_t)b * SEQ + s;
                att_step<64, 0, 64>(q, o, m, ls, ACT + kt * ACTW + A_KS, nullptr, ACT + kt * ACTW + A_VS, 0.125f, -slope * (float)(t - s), sel && s <= t); } }
        const float inv = 1.f / ls; const float g0 = GA[tok * 12 + h * 3], g1 = GA[tok * 12 + h * 3 + 1], g2 = GA[tok * 12 + h * 3 + 2];
        const float* oc = OC + tok * 256 + h * 64; const float* ow = OW + tok * 256 + h * 64;
#pragma unroll
        for (int d = 0; d < 64; ++d) o[d] = g0 * oc[d] + g1 * o[d] * inv + g2 * ow[d];
        store_o_bf16<64>(BR + tok * 1024 + h * 64, o, 1.f);
    }
}


namespace fa {
typedef float f32x16 __attribute__((ext_vector_type(16)));
typedef short v4i16_t __attribute__((ext_vector_type(4)));
typedef float f32x2_t __attribute__((ext_vector_type(2))); typedef __bf16 bf16x2_t __attribute__((ext_vector_type(2)));
constexpr int KROWB = 208, VROWB = 192, KBYTES = 64 * KROWB, VBYTES = 64 * VROWB, STG = KBYTES + VBYTES;
constexpr int LDS_MISC = 2 * STG;
constexpr float LOG2E = 1.4426950408889634f;
constexpr float MFLOOR = -1e20f;
DEV unsigned cvtpk(float lo, float hi) { f32x2_t v = {lo, hi}; bf16x2_t b = __builtin_convertvector(v, bf16x2_t); return __builtin_bit_cast(unsigned, b); }
DEV unsigned long long uni64(unsigned long long v) { const unsigned lo = __builtin_amdgcn_readfirstlane((unsigned)v), hi = __builtin_amdgcn_readfirstlane((unsigned)(v >> 32)); return ((unsigned long long)hi << 32) | lo; }
DEV unsigned long long wave_or64(unsigned long long v) {
    unsigned lo = (unsigned)v, hi = (unsigned)(v >> 32);
#define FA_OR(M) lo |= (unsigned)__builtin_amdgcn_ds_swizzle((int)lo, (M << 10) | 0x1f); hi |= (unsigned)__builtin_amdgcn_ds_swizzle((int)hi, (M << 10) | 0x1f);
    FA_OR(1) FA_OR(2) FA_OR(4) FA_OR(8) FA_OR(16)
#undef FA_OR
    { auto a = __builtin_amdgcn_permlane32_swap(lo, lo, false, false); lo = a[0] | a[1]; auto b = __builtin_amdgcn_permlane32_swap(hi, hi, false, false); hi = b[0] | b[1]; }
    return uni64(((unsigned long long)hi << 32) | lo);
}
struct Src { const bf16_t* k; int kp; const bf16_t* k2; int k2p; const bf16_t* v; int vp; };
template <int NQ, bool ALIBI, int SELMODE>
DEV void attn_pass(LAS unsigned char* lds, const Ctx& c, const Src& src, const bf16x8 (&qf)[NQ], unsigned long long tmask, unsigned long long wmask,
                   int t, float nslope2, float c1, unsigned W, unsigned long long rowmask, int own_blk, f32x16 (&o)[2], float& m, float& l) {
    const int tid = c.tid, lane = c.lane, r32 = lane & 31, hi = lane >> 5;
    const int skey = tid >> 3, sch = tid & 7, skey2 = tid >> 2, sch2 = tid & 3;
    const int i16 = lane & 15, tq = i16 >> 2, tp = i16 & 3, blk = (lane >> 4) & 1;
    u32x4 kreg, vreg, k2reg = (u32x4){0u, 0u, 0u, 0u};
#define FA_GLOAD(kt_) do { const size_t r_ = (size_t)((kt_) * 64 + skey); kreg = *(const u32x4*)(src.k + r_ * src.kp + sch * 8); vreg = *(const u32x4*)(src.v + r_ * src.vp + sch * 8); \
        if (NQ == 6) { if (tid < 256) k2reg = *(const u32x4*)(src.k2 + (size_t)((kt_) * 64 + skey2) * src.k2p + sch2 * 8); } } while (0)
#define FA_LSTORE(buf_) do { LAS unsigned char* st_ = lds + (buf_) * STG; *(LAS u32x4*)(st_ + skey * KROWB + sch * 16) = kreg; *(LAS u32x4*)(st_ + KBYTES + skey * VROWB + sch * 16) = vreg; \
        if (NQ == 6) { if (tid < 256) *(LAS u32x4*)(st_ + skey2 * KROWB + 128 + sch2 * 16) = k2reg; } } while (0)
#pragma unroll
    for (int dt = 0; dt < 2; ++dt)
#pragma unroll
        for (int i = 0; i < 16; ++i) o[dt][i] = 0.f;
    m = MFLOOR; l = 0.f;
    if (tmask == 0ull) return;
    int kt = 63 - __builtin_clzll(tmask); tmask &= ~(1ull << kt);
    FA_GLOAD(kt);
    int buf = 0;
    for (;;) {
        FA_LSTORE(buf);
        __syncthreads();
        const bool more = tmask != 0ull; int ktn = 0;
        if (more) { ktn = 63 - __builtin_clzll(tmask); tmask &= ~(1ull << ktn); FA_GLOAD(ktn); }
        if ((wmask >> kt) & 1ull) {
            const LAS unsigned char* kb = lds + buf * STG; const LAS unsigned char* vb = kb + KBYTES;
            f32x16 s0, s1;
#pragma unroll
            for (int i = 0; i < 16; ++i) { s0[i] = 0.f; s1[i] = 0.f; }
#pragma unroll
            for (int d0 = 0; d0 < NQ; ++d0) {
                const bf16x8 k0 = *(const LAS bf16x8*)(kb + r32 * KROWB + (16 * d0 + 8 * hi) * 2);
                const bf16x8 k1 = *(const LAS bf16x8*)(kb + (32 + r32) * KROWB + (16 * d0 + 8 * hi) * 2);
                s0 = __builtin_amdgcn_mfma_f32_32x32x16_bf16(k0, qf[d0], s0, 0, 0, 0);
                s1 = __builtin_amdgcn_mfma_f32_32x32x16_bf16(k1, qf[d0], s1, 0, 0, 0);
            }
            bool rowsel = true;
            if (SELMODE == 1) rowsel = (rowmask >> kt) & 1ull;
            if (SELMODE == 2) rowsel = ((kt >> 2) == own_blk) || ((rowmask >> (kt >> 2)) & 1ull);
            const unsigned Weff = rowsel ? W : 0u;
            const int db0 = t - (kt * 64 + 4 * hi);
            float mx = -INFINITY;
#pragma unroll
            for (int i = 0; i < 16; ++i) { const int cr = (i & 3) + 8 * (i >> 2);
                { const int d = db0 - cr; float x = s0[i] * c1; if (ALIBI) x = fmaf((float)d, nslope2, x); x = ((unsigned)d < Weff) ? x : -INFINITY; s0[i] = x; mx = fmaxf(mx, x); }
                { const int d = db0 - 32 - cr; float x = s1[i] * c1; if (ALIBI) x = fmaf((float)d, nslope2, x); x = ((unsigned)d < Weff) ? x : -INFINITY; s1[i] = x; mx = fmaxf(mx, x); } }
            { auto rr = __builtin_amdgcn_permlane32_swap(__float_as_uint(mx), __float_as_uint(mx), false, false); mx = fmaxf(__uint_as_float(rr[0]), __uint_as_float(rr[1])); }
            const float mn = fmaxf(m, mx); const float alpha = __builtin_amdgcn_exp2f(m - mn); m = mn;
            float ls = 0.f;
#pragma unroll
            for (int i = 0; i < 16; ++i) { s0[i] = __builtin_amdgcn_exp2f(s0[i] - mn); s1[i] = __builtin_amdgcn_exp2f(s1[i] - mn); ls += s0[i] + s1[i]; }
            l = l * alpha + ls;
#pragma unroll
            for (int dt = 0; dt < 2; ++dt)
#pragma unroll
                for (int i = 0; i < 16; ++i) o[dt][i] *= alpha;
#pragma unroll
            for (int hf = 0; hf < 2; ++hf)
#pragma unroll
                for (int ks = 0; ks < 2; ++ks) {
                    u32x4 pw;
                    if (hf == 0) { pw.x = cvtpk(s0[8 * ks], s0[8 * ks + 1]); pw.y = cvtpk(s0[8 * ks + 2], s0[8 * ks + 3]); pw.z = cvtpk(s0[8 * ks + 4], s0[8 * ks + 5]); pw.w = cvtpk(s0[8 * ks + 6], s0[8 * ks + 7]); }
                    else         { pw.x = cvtpk(s1[8 * ks], s1[8 * ks + 1]); pw.y = cvtpk(s1[8 * ks + 2], s1[8 * ks + 3]); pw.z = cvtpk(s1[8 * ks + 4], s1[8 * ks + 5]); pw.w = cvtpk(s1[8 * ks + 6], s1[8 * ks + 7]); }
                    const bf16x8 pb = __builtin_bit_cast(bf16x8, pw);
#pragma unroll
                    for (int dt = 0; dt < 2; ++dt) {
                        const LAS unsigned char* vp = vb + (32 * hf + 16 * ks + 4 * hi + tq) * VROWB + (32 * dt + 16 * blk + 4 * tp) * 2;
                        const v4i16_t lo = __builtin_amdgcn_ds_read_tr16_b64_v4i16((LAS v4i16_t*)vp);
                        const v4i16_t hv = __builtin_amdgcn_ds_read_tr16_b64_v4i16((LAS v4i16_t*)(vp + 8 * VROWB));
                        const bf16x8 va = (bf16x8){lo[0], lo[1], lo[2], lo[3], hv[0], hv[1], hv[2], hv[3]};
                        o[dt] = __builtin_amdgcn_mfma_f32_32x32x16_bf16(va, pb, o[dt], 0, 0, 0);
                    }
                }
        }
        if (!more) break;
        kt = ktn; buf ^= 1;
    }
    __syncthreads();
    { auto rr = __builtin_amdgcn_permlane32_swap(__float_as_uint(l), __float_as_uint(l), false, false); l = __uint_as_float(rr[0]) + __uint_as_float(rr[1]); }
#undef FA_GLOAD
#undef FA_LSTORE
}
template <int NQ> DEV void load_qf(bf16x8 (&qf)[NQ], const bf16_t* qrow, int hi) {
#pragma unroll
    for (int d0 = 0; d0 < NQ; ++d0) qf[d0] = *(const bf16x8*)(qrow + 16 * d0 + 8 * hi);
}
DEV void store_o(bf16_t* orow, const f32x16 (&o)[2], float sc, int hi) {
#pragma unroll
    for (int dt = 0; dt < 2; ++dt)
#pragma unroll
        for (int g = 0; g < 4; ++g) { u32x2 w; w.x = cvtpk(o[dt][4 * g] * sc, o[dt][4 * g + 1] * sc); w.y = cvtpk(o[dt][4 * g + 2] * sc, o[dt][4 * g + 3] * sc);
            *(u32x2*)(orow + 32 * dt + 8 * g + 4 * hi) = w; }
}
DEV unsigned long long expand4(unsigned m16) { unsigned long long r = 0ull;
#pragma unroll
    for (int j = 0; j < 16; ++j) if ((m16 >> j) & 1u) r |= 0xFull << (4 * j);
    return r; }
}

constexpr int CW_QUEUE = 16384 + 512;
constexpr int N_ATT_UNITS = 1024;
DEV void phase_attn2(const Params& p, const Ctx& c, int l) {
    using namespace fa;
    const bf16_t* ACT = WSP(bf16_t, WS_ACT); const bf16_t* ACT2 = WSP(bf16_t, WS_ACT2); bf16_t* BR = WSP(bf16_t, WS_BR);
    unsigned* qhead = WSP(unsigned, WS_CTL) + CW_QUEUE + l;
    volatile LAS unsigned* misc = (volatile LAS unsigned*)(c.lds + LDS_MISC);
    const int lane = c.lane, r32 = lane & 31, hi = lane >> 5, w = c.wave;
    for (;;) {
        if (c.tid == 0) { misc[0] = atomicAdd(qhead, 1u); misc[2] = 0u; misc[3] = 0u; }
        __syncthreads();
        const int u = (int)__builtin_amdgcn_readfirstlane(misc[0]);
        if (u >= N_ATT_UNITS) break;
        f32x16 o[2]; float m, ls;
        if (u < 512) {
            const int k = 15 - (u >> 5), r = u & 31, bh = r & 15, b = bh >> 2, h = bh & 3; const bool moba = (r >> 4) != 0;
            const int t = k * 256 + w * 32 + r32; const size_t tok = (size_t)b * SEQ + t; const size_t b0 = (size_t)b * SEQ;
            if (!moba) {
                bf16x8 qf[6]; load_qf<6>(qf, ACT2 + tok * ACT2W + A2_QF + h * 96, hi);
                const Src src{ACT2 + b0 * ACT2W + A2_KN + h * 64, ACT2W, ACT + b0 * ACTW + A_KR, ACTW, ACT2 + b0 * ACT2W + A2_VD + h * 64, ACT2W};
                const int nt = 4 * k + 4; const unsigned long long tm = nt >= 64 ? ~0ull : ((1ull << nt) - 1ull);
                const int nw = 4 * k + (w >> 1) + 1; const unsigned long long wm = nw >= 64 ? ~0ull : ((1ull << nw) - 1ull);
                __syncthreads();
                attn_pass<6, false, 0>(c.lds, c, src, qf, tm, wm, t, 0.f, 0.10206207261596575f * LOG2E, 0x7fffffffu, 0ull, 0, o, m, ls);
                store_o(BR + tok * 1024 + 768 + h * 64, o, 1.f / ls, hi);
            } else {
                bf16x8 qf[4]; load_qf<4>(qf, ACT + tok * ACTW + A_QC + h * 64, hi);
                const Src src{ACT + b0 * ACTW + A_KC + h * 64, ACTW, nullptr, 0, ACT + b0 * ACTW + A_VC + h * 64, ACTW};
                const unsigned rm = WSP(unsigned, WS_OWIN)[tok * 4 + h];
                const unsigned long long wor = wave_or64((unsigned long long)rm);
                if (lane == 0) atomicOr((unsigned*)&misc[2], (unsigned)wor);
                __syncthreads();
                const unsigned bor = __builtin_amdgcn_readfirstlane(misc[2]);
                const unsigned long long own_all = 0xFull << (4 * k);
                const int nw = (w >> 1) + 1; const unsigned long long own_w = ((1ull << nw) - 1ull) << (4 * k);
                const unsigned long long tm = uni64(expand4(bor) | own_all), wm = uni64(expand4((unsigned)wor) | own_w);
                attn_pass<4, true, 2>(c.lds, c, src, qf, tm, wm, t, -SLOPES[2][h] * LOG2E, 0.125f * LOG2E, 0x7fffffffu, (unsigned long long)rm, k, o, m, ls);
                store_o(BR + tok * 1024 + 512 + h * 64, o, 1.f / ls, hi);
            }
        } else if (u < 768) {
            const int v = u - 512, cb = 63 - (v >> 2), b = v & 3, h = w >> 1;
            const int t = cb * 64 + (w & 1) * 32 + r32; const size_t tok = (size_t)b * SEQ + t; const size_t b0 = (size_t)b * SEQ;
            bf16x8 qf[4]; load_qf<4>(qf, ACT + tok * ACTW + A_QA + h * 64, hi);
            const float nsl = -SLOPES[0][h] * LOG2E;
            const float* GA = WSP(float, WS_SMALL + SM_GA) + tok * 12 + h * 3; const float g0 = GA[0], g1 = GA[1], g2 = GA[2];
            const unsigned long long rm = WSP(unsigned long long, WS_SMALL + SM_SEL)[tok];
            const unsigned long long wor = wave_or64(rm);
            if (lane == 0) { atomicOr((unsigned*)&misc[2], (unsigned)wor); atomicOr((unsigned*)&misc[3], (unsigned)(wor >> 32)); }
            { const Src src{ACT + b0 * ACTW + A_KW, ACTW, nullptr, 0, ACT + b0 * ACTW + A_VW, ACTW};
              const int lo = cb >= 8 ? cb - 8 : 0; const unsigned long long upto = cb >= 63 ? ~0ull : ((1ull << (cb + 1)) - 1ull); const unsigned long long tm = upto & ~((1ull << lo) - 1ull);
              __syncthreads();
              attn_pass<4, true, 0>(c.lds, c, src, qf, tm, tm, t, nsl, 0.125f * LOG2E, 512u, 0ull, 0, o, m, ls); }
            f32x16 res[2]; { const float sc = g2 / ls;
#pragma unroll
              for (int dt = 0; dt < 2; ++dt)
#pragma unroll
                  for (int i = 0; i < 16; ++i) res[dt][i] = o[dt][i] * sc; }
            { const Src src{ACT + b0 * ACTW + A_KS, ACTW, nullptr, 0, ACT + b0 * ACTW + A_VS, ACTW};
              const unsigned long long tm = ((unsigned long long)__builtin_amdgcn_readfirstlane(misc[3]) << 32) | __builtin_amdgcn_readfirstlane(misc[2]);
              attn_pass<4, true, 1>(c.lds, c, src, qf, tm, wor, t, nsl, 0.125f * LOG2E, 0x7fffffffu, rm, 0, o, m, ls); }
            { const float sc = g1 / ls; const float* oc = WSP(float, WS_OCMP) + tok * 256 + h * 64;
#pragma unroll
              for (int dt = 0; dt < 2; ++dt)
#pragma unroll
                  for (int g = 0; g < 4; ++g) { const f32x4 cv = *(const f32x4*)(oc + 32 * dt + 8 * g + 4 * hi);
#pragma unroll
                      for (int e = 0; e < 4; ++e) res[dt][4 * g + e] += o[dt][4 * g + e] * sc + g0 * cv[e]; } }
            store_o(BR + tok * 1024 + h * 64, res, 1.f, hi);
        } else {
            const int v = u - 768, b = v >> 6, g = (v >> 5) & 1, cc = v & 31, hr = w >> 2, h = 2 * g + hr;
            const int t = cc * 128 + (w & 3) * 32 + r32; const size_t tok = (size_t)b * SEQ + t; const size_t b0 = (size_t)b * SEQ;
            bf16x8 qf[4]; load_qf<4>(qf, ACT + tok * ACTW + A_QB + h * 64, hi);
            const Src src{ACT + b0 * ACTW + A_KB + g * 64, ACTW, nullptr, 0, ACT + b0 * ACTW + A_VB + g * 64, ACTW};
            const int lo = cc >= 1 ? 2 * cc - 2 : 0; const int hiT = 2 * cc + 1; const unsigned long long upto = hiT >= 63 ? ~0ull : ((1ull << (hiT + 1)) - 1ull);
            const unsigned long long tm = upto & ~((1ull << lo) - 1ull);
            const unsigned long long wm = ((w & 3) < 2) ? (tm & ~(1ull << hiT)) : tm;
            __syncthreads();
            attn_pass<4, true, 0>(c.lds, c, src, qf, tm, wm, t, -SLOPES[1][h] * LOG2E, 0.125f * LOG2E, 128u, 0ull, 0, o, m, ls);
            const float sk2 = p.in[10][l * 4 + h] * LOG2E; const float mf = fmaxf(m, sk2); const float a = __builtin_amdgcn_exp2f(m - mf); const float den = ls * a + __builtin_amdgcn_exp2f(sk2 - mf);
            store_o(BR + tok * 1024 + 256 + h * 64, o, a / den, hi);
        }
        __syncthreads();
    }
}
DEV void moba_gate(const Params& p, const Ctx& c) {
    const bf16_t* ACT = WSP(bf16_t, WS_ACT); unsigned* MS = WSP(unsigned, WS_OWIN);
    for (int it = c.gw; it < 1024; it += c.NGW) {
        int b, g, h; item_bgh(it, b, g, h); const int t = g * 64 + c.lane; const size_t tok = (size_t)b * SEQ + t; const int nb = g >> 2;
        float q[64]; load_q<64>(q, ACT + tok * ACTW + A_QC + h * 64);
        const float* KM = WSP(float, WS_MISC + MISC_KMEAN) + (size_t)b * 16 * 256 + h * 64;
        float v1 = -INFINITY, v2 = -INFINITY, v3 = -INFINITY; int i1 = -1, i2 = -1, i3 = -1;
        for (int n = 0; n < nb; ++n) { const float* km = KM + n * 256; float dsum = 0.f;
#pragma unroll
            for (int d = 0; d < 64; ++d) dsum += q[d] * km[d];
            if (dsum > v1) { v3 = v2; i3 = i2; v2 = v1; i2 = i1; v1 = dsum; i1 = n; }
            else if (dsum > v2) { v3 = v2; i3 = i2; v2 = dsum; i2 = n; }
            else if (dsum > v3) { v3 = dsum; i3 = n; } }
        unsigned mk = 0u; if (i1 >= 0) mk |= 1u << i1; if (i2 >= 0) mk |= 1u << i2; if (i3 >= 0) mk |= 1u << i3;
        MS[tok * 4 + h] = mk;
    }
}
DEV void phase_cmpw2(const Params& p, const Ctx& c, int l) {
    const int lane = c.lane;
    const bf16_t* HID = WSP(bf16_t, WS_HID); float* KC = WSP(float, WS_MISC + MISC_KCMP); float* VC = WSP(float, WS_MISC + MISC_VCMP);
    const float* gq = p.in[6] + (size_t)l * 10 * 64;
    for (int it = c.gw; it < 2 * 1020; it += c.NGW) { const int kv = it / 1020, r = it % 1020;
        const float* w2 = p.in[9] + (size_t)(l * 2 + kv) * 256 * 64; const bf16_t* hrow = HID + ((size_t)kv * 1024 + r) * 256;
        float a = 0.f;
        for (int k = 0; k < 256; ++k) a += bf2f(hrow[k]) * w2[k * 64 + lane];
        const int b = r / 255, i = r % 255;
        if (kv == 0) KC[(b * 256 + i) * 64 + lane] = head_norm(a, gq + 1 * 64, lane); else VC[(b * 256 + i) * 64 + lane] = a; }
}

template <int NB> struct FMerge { const bf16_t* GATES; float* MIX; bf16_t* MIXB;
    DEV void operator()(int row, int col, const f32x4& v0, const f32x4& v1) const {
        const u32x4 gw = *(const u32x4*)(GATES + (size_t)row * NGATE + NB * 1024 + col);
        f32x4 a = (f32x4){bflo(gw.x), bfhi(gw.x), bflo(gw.y), bfhi(gw.y)} * v0, b = (f32x4){bflo(gw.z), bfhi(gw.z), bflo(gw.w), bfhi(gw.w)} * v1;
        float* mx = MIX + (size_t)row * 1024 + col;
        if (NB > 0) { a += *(const f32x4*)mx; b += *(const f32x4*)(mx + 4); }
        if (NB < 3) { *(f32x4*)mx = a; *(f32x4*)(mx + 4) = b; }
        else { u32x4 w; w.x = pk2(a[0], a[1]); w.y = pk2(a[2], a[3]); w.z = pk2(b[0], b[1]); w.w = pk2(b[2], b[3]); *(u32x4*)(MIXB + (size_t)row * 1024 + col) = w; } } };
template <int NB> DEV void phase_merge(const Params& p, const Ctx& c, int l) {
    pg8::Gemm g{WSP(bf16_t, WS_BR) + NB * 256, WSP(bf16_t, WS_WBR) + (size_t)(l * 4 + NB) * 1024 * 256, 1024, 256};
    pg8::StaticOrder S; S.init(NTOK, 1024, c.G, c.bid);
    pg8::Epi8<FMerge<NB>> E{{WSP(bf16_t, WS_GATES), (float*)(p.ws + WS_BIG + BIG_MIX), (bf16_t*)(p.ws + WS_BIG + BIG_MIXB)}};
    pg8::gemm_phase<pg8::Epi8<FMerge<NB>>, pg8::StaticOrder, true>(c.lds, g, S, E);
}
struct FOut { float* X; const float* g1;
    DEV void operator()(int row, int col, const f32x4& v0, const f32x4& v1) const { const float* gg = g1 + (row / SEQ) * 6144 + col; float* x = X + (size_t)row * DM + col;
        *(f32x4*)x = *(const f32x4*)x + *(const f32x4*)gg * v0; *(f32x4*)(x + 4) = *(const f32x4*)(x + 4) + *(const f32x4*)(gg + 4) * v1; } };
DEV void phase_out(const Params& p, const Ctx& c, int l) {
    pg8::Gemm g{(const bf16_t*)(p.ws + WS_BIG + BIG_MIXB), WSP(bf16_t, WS_WOUT) + (size_t)l * 1024 * 1024, 1024, 1024};
    pg8::StaticOrder S; S.init(NTOK, 1024, c.G, c.bid);
    pg8::Epi8<FOut> E{{p.out, WSP(float, WS_MOD) + (size_t)l * 4 * 6144 + 2048}};
    pg8::gemm_phase<pg8::Epi8<FOut>, pg8::StaticOrder, true>(c.lds, g, S, E);
}

DEV void phase_router(const Params& p, const Ctx& c, int l) {
    const float* MOD = WSP(float, WS_MOD); bf16_t* H2B = WSP(bf16_t, WS_HBF);
    int* EID = WSP(int, WS_MISC + MISC_EID); float* WTS = WSP(float, WS_MISC + MISC_WTS); unsigned* ctl = WSP(unsigned, WS_CTL);
    LAS float* hs = (LAS float*)(c.lds + c.wave * 4352);
    const float* wc = p.in[18] + (size_t)l * 1024 * 4; const float* wf = p.in[20] + (size_t)l * 1024 * 32;
    const int lane = c.lane;
    for (int row = c.gw; row < NTOK; row += c.NGW) {
        const int b = row / SEQ;
        f32x4 v[4]; float ss = 0.f;
#pragma unroll
        for (int j = 0; j < 4; ++j) { v[j] = *(const f32x4*)(p.out + (size_t)row * DM + j * 256 + lane * 4); ss += (v[j][0] * v[j][0] + v[j][1] * v[j][1]) + (v[j][2] * v[j][2] + v[j][3] * v[j][3]); }
        const float r = rsqrtf(wave_sum(ss) * (1.f / DM) + EPS);
        const float* gn = p.in[4] + (size_t)(l * 2 + 1) * DM; const float* sh = MOD + (l * 4 + b) * 6144 + 3072; const float* sc = sh + 1024;
#pragma unroll
        for (int j = 0; j < 4; ++j) { const int col = j * 256 + lane * 4;
            const f32x4 g = *(const f32x4*)(gn + col), s1 = *(const f32x4*)(sc + col), s0 = *(const f32x4*)(sh + col);
            const f32x4 h = v[j] * r * g * (s1 + 1.f) + s0;
            u32x2 o; o.x = pk2(h[0], h[1]); o.y = pk2(h[2], h[3]); *(u32x2*)(H2B + (size_t)row * DM + col) = o;
            *(LAS f32x4*)(hs + col) = h; }
        LDS_WAIT(); asm volatile("" ::: "memory");
        float a0 = 0.f, a1 = 0.f, a2 = 0.f, a3 = 0.f;
        if (lane < 36) { const float* w = lane < 4 ? wc + lane : wf + (lane - 4); const int ld = lane < 4 ? 4 : 32;
            for (int k = 0; k < 1024; k += 4) { a0 += hs[k] * w[(size_t)k * ld]; a1 += hs[k + 1] * w[(size_t)(k + 1) * ld]; a2 += hs[k + 2] * w[(size_t)(k + 2) * ld]; a3 += hs[k + 3] * w[(size_t)(k + 3) * ld]; } }
        float lg = (a0 + a1) + (a2 + a3);
        if (lane < 4) lg += p.in[19][l * 4 + lane]; else if (lane < 36) lg += p.in[21][l * 32 + lane - 4];
        hs[1024 + lane] = lg;
        LDS_WAIT(); asm volatile("" ::: "memory");
        if (lane == 0) {
            float lc[4];
#pragma unroll
            for (int i = 0; i < 4; ++i) lc[i] = hs[1024 + i];
            int grp = 0; float mx = lc[0];
#pragma unroll
            for (int i = 1; i < 4; ++i) if (lc[i] > mx) { mx = lc[i]; grp = i; }
            float z = 0.f;
#pragma unroll
            for (int i = 0; i < 4; ++i) z += __expf(lc[i] - mx);
            const float pg = 1.f / z;
            float f1 = -INFINITY, f2 = -INFINITY; int e1 = 0, e2 = 0;
            for (int i = 0; i < 8; ++i) { const float x = hs[1024 + 4 + grp * 8 + i];
                if (x > f1) { f2 = f1; e2 = e1; f1 = x; e1 = i; } else if (x > f2) { f2 = x; e2 = i; } }
            const float q2 = __expf(f2 - f1); const float w1 = pg / (1.f + q2), w2 = pg * q2 / (1.f + q2);
            const int x1 = grp * 8 + e1, x2 = grp * 8 + e2;
            EID[row * 2] = x1; EID[row * 2 + 1] = x2; WTS[row * 2] = w1; WTS[row * 2 + 1] = w2;
            atomicAdd(&ctl[CW_CNT + l * 32 + x1], 1u);
            atomicAdd(&ctl[CW_CNT + l * 32 + x2], 1u);
        }
        LDS_WAIT(); asm volatile("" ::: "memory");
    }
}

struct MoeTab { LAS int* start; LAS int* tile_e; LAS int* ntiles; };
DEV MoeTab build_moe_tab(const Params& p, const Ctx& c, int l) {
    MoeTab T; T.start = (LAS int*)(c.lds + LDS_AUX + 1024); T.tile_e = T.start + 32; T.ntiles = T.tile_e + 192;
    __syncthreads();
    if (c.tid == 0) { const unsigned* cnt = WSP(unsigned, WS_CTL) + CW_CNT + l * 32; int row = 0, nt = 0;
        for (int e = 0; e < 32; ++e) { const int n = (int)__hip_atomic_load(cnt + e, __ATOMIC_RELAXED, __HIP_MEMORY_SCOPE_AGENT); T.start[e] = row; const int tiles = (n + 255) >> 8;
            for (int i = 0; i < tiles; ++i) T.tile_e[nt + i] = e;
            nt += tiles; row += tiles * 256; }
        T.ntiles[0] = nt; }
    __syncthreads();
    return T;
}
DEV void phase_moesort(const Params& p, const Ctx& c, int l) {
    const MoeTab T = build_moe_tab(p, c, l);
    const int* EID = WSP(int, WS_MISC + MISC_EID); int* PSLOT = WSP(int, WS_MISC + MISC_PSLOT); unsigned* cur = WSP(unsigned, WS_CTL) + CW_CUR + l * 32;
    const bf16_t* H2B = WSP(bf16_t, WS_HBF); bf16_t* XS = (bf16_t*)(p.ws + WS_BIG + BIG_XS);
    const int lane = c.lane;
    for (int tok = c.gw; tok < NTOK; tok += c.NGW) {
        const u32x4 a = *(const u32x4*)(H2B + (size_t)tok * DM + lane * 16), b2 = *(const u32x4*)(H2B + (size_t)tok * DM + lane * 16 + 8);
#pragma unroll
        for (int k = 0; k < 2; ++k) { const int e = EID[tok * 2 + k]; int slot = 0;
            if (lane == 0) slot = T.start[e] + (int)atomicAdd(&cur[e], 1u);
            slot = __builtin_amdgcn_readfirstlane(slot);
            if (lane == 0) PSLOT[tok * 2 + k] = slot;
            *(u32x4*)(XS + (size_t)slot * DM + lane * 16) = a; *(u32x4*)(XS + (size_t)slot * DM + lane * 16 + 8) = b2; }
    }
}
template <int NCOL> struct MoeOrder { int G, c; LAS const int* tile_e; int ntiles;
    DEV bool next(int i, pg8::Unit& u) const { const int L = i * G + c; if (L >= ntiles * NCOL) return false; const int pm = L / NCOL; u.pm = pm; u.pn = tile_e[pm] * NCOL + (L % NCOL); return true; } };
struct FMoe1 { bf16_t* ACTB;
    DEV void operator()(int row, int col, const f32x4& v0, const f32x4& v1) const { const int ce = col & 511;
        u32x2 w; w.x = pk2(silu_(v0[0]) * v0[1], silu_(v0[2]) * v0[3]); w.y = pk2(silu_(v1[0]) * v1[1], silu_(v1[2]) * v1[3]);
        *(u32x2*)(ACTB + (size_t)row * 256 + (ce >> 1)) = w; } };
struct FMoe2 { bf16_t* YP;
    DEV void operator()(int row, int col, const f32x4& v0, const f32x4& v1) const { const int ce = col & 1023;
        u32x4 w; w.x = pk2(v0[0], v0[1]); w.y = pk2(v0[2], v0[3]); w.z = pk2(v1[0], v1[1]); w.w = pk2(v1[2], v1[3]); *(u32x4*)(YP + (size_t)row * DM + ce) = w; } };
DEV void phase_moe1(const Params& p, const Ctx& c, int l) {
    const MoeTab T = build_moe_tab(p, c, l);
    pg8::Gemm g{(const bf16_t*)(p.ws + WS_BIG + BIG_XS), WSP(bf16_t, WS_W13) + (size_t)l * 32 * 512 * 1024, 1024, 1024};
    MoeOrder<2> S{c.G, c.bid, T.tile_e, T.ntiles[0]}; pg8::Epi8<FMoe1> E{{WSP(bf16_t, WS_MUR)}};
    pg8::gemm_phase<pg8::Epi8<FMoe1>, MoeOrder<2>, true>(c.lds, g, S, E);
}
DEV void phase_moe2(const Params& p, const Ctx& c, int l) {
    const MoeTab T = build_moe_tab(p, c, l);
    pg8::Gemm g{WSP(bf16_t, WS_MUR), WSP(bf16_t, WS_W2) + (size_t)l * 32 * 1024 * 256, 256, 256};
    MoeOrder<4> S{c.G, c.bid, T.tile_e, T.ntiles[0]}; pg8::Epi8<FMoe2> E{{(bf16_t*)(p.ws + WS_BIG + BIG_YP)}};
    pg8::gemm_phase<pg8::Epi8<FMoe2>, MoeOrder<4>, true>(c.lds, g, S, E);
}

constexpr int PH_PRO = 0, PH_NORM1 = 1, PH_INPROJ = 2, PH_POST = 3, PH_MLAUP = 4, PH_POST2 = 5, PH_ATTN = 6, PH_CMPATTN = 7, PH_TOPK = 8, PH_SLC = 9,
              PH_MERGE0 = 10, PH_MERGE1 = 11, PH_MERGE2 = 12, PH_MERGE3 = 13, PH_OUT = 14, PH_ROUTER = 15, PH_SORT = 16, PH_MOE1 = 17, PH_MOE2 = 18, PH_FINAL = 19, PH_COUNT = 20;
constexpr int LDS_PTAB = LDS_AUX + 64;
DEV unsigned long long uni64(unsigned long long v) { const unsigned lo = __builtin_amdgcn_readfirstlane((unsigned)v), hi = __builtin_amdgcn_readfirstlane((unsigned)(v >> 32)); return ((unsigned long long)hi << 32) | lo; }
DEV void store_params(const Params& p, LAS unsigned char* lds) {
    LAS unsigned long long* L = (LAS unsigned long long*)(lds + LDS_PTAB);
    if (threadIdx.x == 0) {
#pragma unroll
        for (int i = 0; i < 24; ++i) L[i] = (unsigned long long)p.in[i];
        L[24] = (unsigned long long)p.out; L[25] = (unsigned long long)p.ws; }
}
DEV Params load_params(LAS unsigned char* lds) {
    const LAS unsigned long long* L = (const LAS unsigned long long*)(lds + LDS_PTAB); Params p;
#pragma unroll
    for (int i = 0; i < 24; ++i) p.in[i] = (const float*)uni64(L[i]);
    p.out = (float*)uni64(L[24]); p.ws = (unsigned char*)uni64(L[25]); return p;
}
template <int PH> DEV void run_phase(const Params& p, const Ctx& c, int l) {
    if constexpr (PH == PH_PRO) phase_prologue(p, c);
    else if constexpr (PH == PH_NORM1) phase_norm1<true>(p, c, l);
    else if constexpr (PH == PH_INPROJ) phase_inproj(p, c, l);
    else if constexpr (PH == PH_POST) phase_post(p, c, l);
    else if constexpr (PH == PH_MLAUP) phase_mlaup(p, c, l);
    else if constexpr (PH == PH_POST2) phase_post2(p, c, l);
    else if constexpr (PH == PH_ATTN) phase_cmpw2(p, c, l);
    else if constexpr (PH == PH_CMPATTN) phase_cmpattn(p, c, l);
    else if constexpr (PH == PH_TOPK) { phase_topk(p, c); moba_gate(p, c); }
    else if constexpr (PH == PH_SLC) phase_attn2(p, c, l);
    else if constexpr (PH == PH_MERGE0) phase_merge<0>(p, c, l);
    else if constexpr (PH == PH_MERGE1) phase_merge<1>(p, c, l);
    else if constexpr (PH == PH_MERGE2) phase_merge<2>(p, c, l);
    else if constexpr (PH == PH_MERGE3) phase_merge<3>(p, c, l);
    else if constexpr (PH == PH_OUT) phase_out(p, c, l);
    else if constexpr (PH == PH_ROUTER) phase_router(p, c, l);
    else if constexpr (PH == PH_SORT) phase_moesort(p, c, l);
    else if constexpr (PH == PH_MOE1) phase_moe1(p, c, l);
    else if constexpr (PH == PH_MOE2) phase_moe2(p, c, l);
    else if constexpr (PH == PH_FINAL) phase_norm1<false>(p, c, NLAYER);
}

#if !MK_ONE_LAUNCH
template <int PH> __global__ void __launch_bounds__(512, 2) k_phase(Params p, int l) {
    extern __shared__ __attribute__((aligned(16))) unsigned char lds_raw[];
    const Ctx c = make_ctx((LAS unsigned char*)lds_raw);
    run_phase<PH>(p, c, l);
}
template <int PH> static void launch_phase(const Params& p, int l, int grid, hipStream_t stream) {
    static bool attr_set = false;
    if (!attr_set) { (void)hipFuncSetAttribute((const void*)k_phase<PH>, hipFuncAttributeMaxDynamicSharedMemorySize, LDS_BYTES); attr_set = true; }
    hipLaunchKernelGGL(k_phase<PH>, dim3(grid), dim3(512), LDS_BYTES, stream, p, l);
}
#else
#define BAR() xcd_barrier_fn(bar.bar, bar.x, bar.st)
template <int l> DEV void mega_layer(LAS unsigned char* lds, const XcdBarrier& bar) {
        { const Ctx c = make_ctx(lds); const Params q = load_params(lds); run_phase<PH_NORM1>(q, c, l); } BAR();
        { const Ctx c = make_ctx(lds); const Params q = load_params(lds); run_phase<PH_INPROJ>(q, c, l); } BAR();
        { const Ctx c = make_ctx(lds); const Params q = load_params(lds); run_phase<PH_POST>(q, c, l); } BAR();
        { const Ctx c = make_ctx(lds); const Params q = load_params(lds); run_phase<PH_MLAUP>(q, c, l); } BAR();
        { const Ctx c = make_ctx(lds); const Params q = load_params(lds); run_phase<PH_POST2>(q, c, l); } BAR();
        { const Ctx c = make_ctx(lds); const Params q = load_params(lds); run_phase<PH_ATTN>(q, c, l); } BAR();
        { const Ctx c = make_ctx(lds); const Params q = load_params(lds); run_phase<PH_CMPATTN>(q, c, l); } BAR();
        { const Ctx c = make_ctx(lds); const Params q = load_params(lds); run_phase<PH_TOPK>(q, c, l); } BAR();
        { const Ctx c = make_ctx(lds); const Params q = load_params(lds); run_phase<PH_SLC>(q, c, l); } BAR();
        { const Ctx c = make_ctx(lds); const Params q = load_params(lds); run_phase<PH_MERGE0>(q, c, l); } BAR();
        { const Ctx c = make_ctx(lds); const Params q = load_params(lds); run_phase<PH_MERGE1>(q, c, l); } BAR();
        { const Ctx c = make_ctx(lds); const Params q = load_params(lds); run_phase<PH_MERGE2>(q, c, l); } BAR();
        { const Ctx c = make_ctx(lds); const Params q = load_params(lds); run_phase<PH_MERGE3>(q, c, l); } BAR();
        { const Ctx c = make_ctx(lds); const Params q = load_params(lds); run_phase<PH_OUT>(q, c, l); } BAR();
        { const Ctx c = make_ctx(lds); const Params q = load_params(lds); run_phase<PH_ROUTER>(q, c, l); } BAR();
        { const Ctx c = make_ctx(lds); const Params q = load_params(lds); run_phase<PH_SORT>(q, c, l); } BAR();
        { const Ctx c = make_ctx(lds); const Params q = load_params(lds); run_phase<PH_MOE1>(q, c, l); } BAR();
        { const Ctx c = make_ctx(lds); const Params q = load_params(lds); run_phase<PH_MOE2>(q, c, l); } BAR();
}
__global__ void __launch_bounds__(512, 2) k_mega(Params p) {
    extern __shared__ __attribute__((aligned(16))) unsigned char lds_raw[];
    LAS unsigned char* lds = (LAS unsigned char*)lds_raw;
    volatile LAS unsigned* bst = (volatile LAS unsigned*)(lds + LDS_AUX);
    if (threadIdx.x < 4) bst[threadIdx.x] = 0u;
    store_params(p, lds);
    __syncthreads();
    const XcdBarrier bar = xcd_barrier_post(WSP(unsigned, WS_CTL) + CW_BAR, bst);
    { const Ctx c = make_ctx(lds); const Params q = load_params(lds); run_phase<PH_PRO>(q, c, 0); } BAR();
    mega_layer<0>(lds, bar); mega_layer<1>(lds, bar); mega_layer<2>(lds, bar); mega_layer<3>(lds, bar);
    { const Ctx c = make_ctx(lds); const Params q = load_params(lds); run_phase<PH_FINAL>(q, c, NLAYER); }
#undef BAR
}
#endif

extern "C" void kernel_launch(void* const* d_in, const int* in_sizes, int n_in, void* d_out, int out_size, void* d_ws, size_t ws_size, hipStream_t stream) {
    if (n_in != 24 || out_size != NTOK * DM || ws_size < WS_END) { fprintf(stderr, "kernel_launch: unexpected shapes (n_in %d out %d ws %zu, need %zu)\n", n_in, out_size, ws_size, (size_t)WS_END); return; }
    Params p{};
    for (int i = 0; i < 24; ++i) p.in[i] = (const float*)d_in[i];
    p.out = (float*)d_out; p.ws = (unsigned char*)d_ws;
    (void)hipMemsetAsync((char*)d_ws + WS_CTL, 0, 1 * MiB, stream);
    const int grid = 256;
#if !MK_ONE_LAUNCH
    launch_phase<PH_PRO>(p, 0, grid, stream);
    for (int l = 0; l < NLAYER; ++l) {
        launch_phase<PH_NORM1>(p, l, grid, stream);
        launch_phase<PH_INPROJ>(p, l, grid, stream);
        launch_phase<PH_POST>(p, l, grid, stream);
        launch_phase<PH_MLAUP>(p, l, grid, stream);
        launch_phase<PH_POST2>(p, l, grid, stream);
        launch_phase<PH_ATTN>(p, l, grid, stream);
        launch_phase<PH_CMPATTN>(p, l, grid, stream);
        launch_phase<PH_TOPK>(p, l, grid, stream);
        launch_phase<PH_SLC>(p, l, grid, stream);
        launch_phase<PH_MERGE0>(p, l, grid, stream);
        launch_phase<PH_MERGE1>(p, l, grid, stream);
        launch_phase<PH_MERGE2>(p, l, grid, stream);
        launch_phase<PH_MERGE3>(p, l, grid, stream);
        launch_phase<PH_OUT>(p, l, grid, stream);
        launch_phase<PH_ROUTER>(p, l, grid, stream);
        launch_phase<PH_SORT>(p, l, grid, stream);
        launch_phase<PH_MOE1>(p, l, grid, stream);
        launch_phase<PH_MOE2>(p, l, grid, stream);
    }
    launch_phase<PH_FINAL>(p, NLAYER, grid, stream);
#else
    static bool attr_set = false;
    if (!attr_set) { (void)hipFuncSetAttribute((const void*)k_mega, hipFuncAttributeMaxDynamicSharedMemorySize, LDS_BYTES); attr_set = true; }
    hipLaunchKernelGGL(k_mega, dim3(grid), dim3(512), LDS_BYTES, stream, p);
#endif
}
```

```cpp
#include <hip/hip_runtime.h>
#include <cstdio>
#include <cstdint>
#include <cmath>

#ifndef MK_ONE_LAUNCH
#define MK_ONE_LAUNCH 1
#endif
#ifndef PROBE_MASK
#define PROBE_MASK 0u
#endif

#define DEV __device__ __forceinline__
#define LAS __attribute__((address_space(3)))
typedef unsigned short bf16_t;
typedef short bf16x8 __attribute__((ext_vector_type(8)));
typedef float f32x4 __attribute__((ext_vector_type(4)));
typedef unsigned u32x4 __attribute__((ext_vector_type(4)));
typedef unsigned u32x2 __attribute__((ext_vector_type(2)));

constexpr int NBATCH = 4, SEQ = 4096, DM = 1024, NTOK = NBATCH * SEQ, NLAYER = 4;
constexpr int DIN = 6572, NSMALL = 2476, PSW = 2560, NPROJ = 6656, NGATE = 4096;
constexpr int I_QA = 0, I_KC = 256, I_VC = 320, I_KS = 384, I_VS = 448, I_KW = 512, I_VW = 576, I_GL = 640, I_QB = 652, I_KB = 908, I_VB = 1036,
              I_QC = 1164, I_KCC = 1420, I_VCC = 1676, I_CQ = 1932, I_CKV = 2316, I_KR = 2444;
constexpr int ACTW = 2560;
constexpr int A_QA = 0, A_KCR = 256, A_VCR = 320, A_KS = 384, A_VS = 448, A_KW = 512, A_VW = 576, A_QB = 640, A_KB = 896, A_VB = 1024,
              A_QC = 1152, A_KC = 1408, A_VC = 1664, A_CQ = 1920, A_CKV = 2304, A_KR = 2432;
constexpr int ACT2W = 896, A2_QF = 0, A2_KN = 384, A2_VD = 640;
constexpr int NCMP = 255, NEXP = 32, XS_ROWS = 40960;
constexpr float EPS = 1e-6f;
__device__ const float SLOPES[3][4] = {{0.70710678118654752f, 0.25f, 0.08838834764831845f, 0.015625f},
                                       {0.5f, 0.17677669529663689f, 0.0625f, 0.0078125f},
                                       {0.35355339059327379f, 0.125f, 0.03125f, 0.00390625f}};

constexpr size_t MiB = 1u << 20;
constexpr size_t WS_CTL = 0;
constexpr size_t WS_MOD = 1 * MiB;
constexpr size_t WS_ROPE = 2 * MiB;
constexpr size_t WS_MISC = 3 * MiB;
constexpr size_t WS_WIN = 8 * MiB;
constexpr size_t WS_W13 = WS_WIN + 56 * MiB;
constexpr size_t WS_W2 = WS_W13 + 128 * MiB;
constexpr size_t WS_WOUT = WS_W2 + 64 * MiB;
constexpr size_t WS_WBR = WS_WOUT + 8 * MiB;
constexpr size_t WS_CW1 = WS_WBR + 8 * MiB;
constexpr size_t WS_WU = WS_CW1 + 8 * MiB;
constexpr size_t WS_HBF = WS_WU + 4 * MiB;
constexpr size_t WS_BIG = WS_HBF + 32 * MiB;
constexpr size_t WS_GATES = WS_BIG + 160 * MiB;
constexpr size_t WS_ACT = WS_GATES + 128 * MiB;
constexpr size_t WS_ACT2 = WS_ACT + 80 * MiB;
constexpr size_t WS_MUR = WS_ACT2 + 28 * MiB;
constexpr size_t WS_CMPA = WS_MUR + 64 * MiB;
constexpr size_t WS_HID = WS_CMPA + 8 * MiB;
constexpr size_t WS_PB = WS_HID + 1 * MiB;
constexpr size_t WS_OCMP = WS_PB + 16 * MiB;
constexpr size_t WS_OWIN = WS_OCMP + 16 * MiB;
constexpr size_t WS_SMALL = WS_OWIN + 16 * MiB;
constexpr size_t WS_BR = WS_SMALL + 2 * MiB;
constexpr size_t WS_END = WS_BR + 32 * MiB;
static_assert(WS_END <= 1000 * MiB, "workspace map");
constexpr size_t BIG_PSM = 0, BIG_MIX = 0, BIG_MIXB = 64 * MiB, BIG_XS = 0, BIG_YP = 80 * MiB;
constexpr size_t MISC_KCB = 1024 * 1024, MISC_VCB = 1024 * 1024 + 128 * 1024, MISC_WRT = 2 * MiB;
constexpr size_t MISC_KCMP = 0, MISC_VCMP = 256 * 1024, MISC_KMEAN = 512 * 1024, MISC_EID = 640 * 1024, MISC_WTS = 768 * 1024, MISC_PSLOT = 896 * 1024;
constexpr size_t SM_PL = 0, SM_SEL = 256 * 1024, SM_GA = 512 * 1024;
constexpr int CW_BAR = 4096;
constexpr int CW_CNT = 16384;
constexpr int CW_CUR = 16384 + 256;

constexpr int RING_BYTES = 131072, LDS_AUX = RING_BYTES, LDS_BYTES = 147456;

struct Params { const float* in[24]; float* out; unsigned char* ws; };

DEV float bf2f(unsigned v) { return __uint_as_float(v << 16); }
DEV float bflo(unsigned w) { return __uint_as_float(w << 16); }
DEV float bfhi(unsigned w) { return __uint_as_float(w & 0xffff0000u); }
DEV unsigned f2bf(float f) { unsigned u = __float_as_uint(f); return (u + 0x7fffu + ((u >> 16) & 1u)) >> 16; }
DEV unsigned pk2(float lo, float hi) { return f2bf(lo) | (f2bf(hi) << 16); }
template <int M> DEV float swz_xor(float v) { return __int_as_float(__builtin_amdgcn_ds_swizzle(__float_as_int(v), (M << 10) | 0x1f)); }
template <int M> DEV int swz_xor_i(int v) { return __builtin_amdgcn_ds_swizzle(v, (M << 10) | 0x1f); }
DEV float xhalf(float v, float& other) { auto rr = __builtin_amdgcn_permlane32_swap(__float_as_uint(v), __float_as_uint(v), false, false); other = __uint_as_float(rr[1]); return __uint_as_float(rr[0]); }
DEV float wave_sum(float v) {
    v += swz_xor<1>(v); v += swz_xor<2>(v); v += swz_xor<4>(v); v += swz_xor<8>(v); v += swz_xor<16>(v);
    float hi; const float lo = xhalf(v, hi); return lo + hi;
}
DEV float sigm(float x) { return 1.f / (1.f + __expf(-x)); }
DEV float silu_(float x) { return x / (1.f + __expf(-x)); }
#define LDS_WAIT() asm volatile("s_waitcnt lgkmcnt(0)" ::: "memory")

namespace pg8 {
constexpr int BM = 256, BK = 64, HALF = 128, HTB = HALF * BK * 2, STAGE_BYTES = 8 * HTB, NXCD = 8, WGM = 8;
__host__ __device__ __forceinline__ int lds_byte(int r, int c) { const int st = (r >> 4) * 2 + (c >> 5), rr = r & 15, cc = c & 31, ob = rr * 64 + cc * 2; return st * 1024 + (ob ^ (((ob >> 9) & 1) << 5)); }
__host__ __device__ __forceinline__ void stage_rc(int b, int& R, int& C) { const int st = b / 1024, sb = b % 1024, swz = sb ^ (((sb >> 9) & 1) << 5); R = (st >> 1) * 16 + swz / 64; C = (st & 1) * 32 + (swz % 64) / 2; }
__host__ __device__ __forceinline__ int perm32(int rho) { const int n = rho >> 4, i = rho & 15; return 8 * (i >> 2) + 4 * n + (i & 3); }
struct Unit { int pm, pn; };
struct Gemm { const bf16_t* A; const bf16_t* Bt; int lda, K; };
struct StaticOrder {
    int nM, nN, nwg, G, c;
    __device__ void init(int M, int N, int G_, int c_) { nM = M / BM; nN = N / BM; nwg = nM * nN; G = G_; c = c_; }
    __device__ bool next(int i, Unit& u) const {
        const long L = (long)i * G + c; if (L >= nwg) return false;
        int wgid = (int)L; { const int q = nwg / NXCD, r = nwg % NXCD, xcd = wgid % NXCD, off = wgid / NXCD; wgid = (xcd < r ? xcd * (q + 1) : r * (q + 1) + (xcd - r) * q) + off; }
        const int nig = WGM * nN, gid = wgid / nig, fm = gid * WGM, gsz = (nM - fm) < WGM ? (nM - fm) : WGM;
        u.pm = fm + ((wgid % nig) % gsz); u.pn = (wgid % nig) / gsz; return true;
    }
};
template <class F> struct Epi8 {
    F f;
    __device__ __forceinline__ void operator()(const f32x4 (&acc)[2][2][4][2], const Unit& u, int wr, int wc, int fr, int fq) const {
        const int row0 = u.pm * BM + wr * 64 + fr, col0 = u.pn * BM + wc * 32 + 8 * fq;
#pragma unroll
        for (int ai = 0; ai < 2; ++ai)
#pragma unroll
            for (int m = 0; m < 4; ++m)
#pragma unroll
                for (int bj = 0; bj < 2; ++bj) f(row0 + ai * HALF + m * 16, col0 + bj * HALF, acc[ai][bj][m][0], acc[ai][bj][m][1]);
    }
};
template <class Epi, class Sched, bool ALIGN_EPI>
__device__ __forceinline__ void gemm_phase(LAS unsigned char* lds, const Gemm g, const Sched& S, const Epi& E) {
    int tid_ = threadIdx.x; asm volatile("" : "+v"(tid_));
    const int tid = tid_, wid = __builtin_amdgcn_readfirstlane(tid >> 6), lane = tid & 63, wr = wid >> 2, wc = wid & 3, fr = lane & 15, fq = lane >> 4;
    const int K = g.K, nt = K / BK, lda = g.lda;
    unsigned voffA[2], voffB[2];
#pragma unroll
    for (int i = 0; i < 2; ++i) { int R, C; stage_rc(tid * 16 + i * 8192, R, C); const int Rb = (R & ~31) + perm32(R & 31);
        voffA[i] = (unsigned)(R * lda + C) * 2u; voffB[i] = (unsigned)(Rb * K + C) * 2u; }
    const size_t kstep = (size_t)(BK * 2);
    const size_t hstepA = (size_t)HALF * lda * 2, tstepA = 2 * hstepA;
    const size_t hstepB = (size_t)HALF * K * 2, tstepB = 2 * hstepB;
    const unsigned ldsw = (unsigned)wid * 1024u;
    const int aoff = lds_byte(wr * 64 + fr, fq * 8), boff = lds_byte(wc * 32 + fr, fq * 8);
#define PG8_SA(b, h) (((b) * 2 + (h)) * HTB)
#define PG8_SB(b, h) ((4 + (b) * 2 + (h)) * HTB)
#define PG8_STAGE(bufoff, gbase, voff) do { _Pragma("unroll") for (int _i = 0; _i < 2; ++_i) \
        __builtin_amdgcn_global_load_lds((const unsigned*)((const char*)(gbase) + (voff)[_i]), (LAS unsigned*)(lds + (bufoff) + ldsw + _i * 8192), 16, 0, 0); } while (0)
#define PG8_LDA(dst, b, h) do { _Pragma("unroll") for (int m = 0; m < 4; ++m) _Pragma("unroll") for (int k = 0; k < 2; ++k) dst[m][k] = *(const LAS bf16x8*)(lds + PG8_SA(b, h) + aoff + m * 2048 + k * 1024); } while (0)
#define PG8_LDB(dst, b, h) do { _Pragma("unroll") for (int n = 0; n < 2; ++n) _Pragma("unroll") for (int k = 0; k < 2; ++k) dst[n][k] = *(const LAS bf16x8*)(lds + PG8_SB(b, h) + boff + n * 2048 + k * 1024); } while (0)
#define PG8_MMA(ai, bj, At, Bt) do { __builtin_amdgcn_s_setprio(1); _Pragma("unroll") for (int m = 0; m < 4; ++m) _Pragma("unroll") for (int n = 0; n < 2; ++n) _Pragma("unroll") for (int k = 0; k < 2; ++k) \
        acc[ai][bj][m][n] = __builtin_amdgcn_mfma_f32_16x16x32_bf16(Bt[n][k], At[m][k], acc[ai][bj][m][n], 0, 0, 0); __builtin_amdgcn_s_setprio(0); } while (0)
#define PG8_WAIT_V(n) asm volatile("s_waitcnt vmcnt(" #n ")" ::: "memory")
#define PG8_WAIT_L(n) asm volatile("s_waitcnt lgkmcnt(" #n ")" ::: "memory")
#define PG8_BAR __builtin_amdgcn_s_barrier()
#define PG8_SCHED __builtin_amdgcn_sched_barrier(0)
    Unit cur, nxt; int ui = 0;
    if (!S.next(0, cur)) return;
    f32x4 acc[2][2][4][2];
#pragma unroll
    for (int a = 0; a < 2; ++a)
#pragma unroll
        for (int b = 0; b < 2; ++b)
#pragma unroll
            for (int m = 0; m < 4; ++m)
#pragma unroll
                for (int n = 0; n < 2; ++n) acc[a][b][m][n] = (f32x4){0.f, 0.f, 0.f, 0.f};
    bf16x8 At[4][2], B0[2][2], B1[2][2];
    const char* cA = (const char*)g.A + (size_t)cur.pm * tstepA; const char* cB = (const char*)g.Bt + (size_t)cur.pn * tstepB;
    PG8_STAGE(PG8_SB(0, 0), cB, voffB); PG8_STAGE(PG8_SB(0, 1), cB + hstepB, voffB); PG8_STAGE(PG8_SA(0, 0), cA, voffA); PG8_STAGE(PG8_SA(0, 1), cA + hstepA, voffA);
    if (wr == 1) PG8_BAR;
    PG8_WAIT_V(2); PG8_BAR;
    PG8_STAGE(PG8_SB(1, 0), cB + kstep, voffB); PG8_STAGE(PG8_SA(1, 0), cA + kstep, voffA); PG8_STAGE(PG8_SB(1, 1), cB + hstepB + kstep, voffB);
    PG8_WAIT_V(6); PG8_BAR;
    for (;;) {
        const bool has_next = S.next(ui + 1, nxt);
        const char* nA = has_next ? (const char*)g.A + (size_t)nxt.pm * tstepA : cA; const char* nB = has_next ? (const char*)g.Bt + (size_t)nxt.pn * tstepB : cB;
        for (int t = 0; t < nt; t += 2) {
            const bool last = (t == nt - 2);
            const char* a1 = cA + (size_t)(t + 1) * kstep;
            const char* a2 = last ? nA : cA + (size_t)(t + 2) * kstep; const char* b2 = last ? nB : cB + (size_t)(t + 2) * kstep;
            const char* a3 = a2 + kstep; const char* b3 = b2 + kstep;
            PG8_LDB(B0, 0, 0); PG8_LDB(B1, 0, 1); PG8_SCHED; PG8_LDA(At, 0, 0); PG8_STAGE(PG8_SA(1, 1), a1 + hstepA, voffA);
            PG8_WAIT_V(8); PG8_WAIT_L(0); PG8_BAR; PG8_MMA(0, 0, At, B0); PG8_MMA(0, 1, At, B1); PG8_BAR; PG8_SCHED;
            PG8_LDA(At, 0, 1); PG8_STAGE(PG8_SB(0, 0), b2, voffB); PG8_STAGE(PG8_SB(0, 1), b2 + hstepB, voffB); PG8_STAGE(PG8_SA(0, 0), a2, voffA);
            PG8_WAIT_V(8); PG8_WAIT_L(0); PG8_BAR; PG8_MMA(1, 0, At, B0); PG8_MMA(1, 1, At, B1); PG8_BAR; PG8_SCHED;
            PG8_LDB(B0, 1, 0); PG8_LDB(B1, 1, 1); PG8_SCHED; PG8_LDA(At, 1, 0); PG8_STAGE(PG8_SA(0, 1), a2 + hstepA, voffA);
            PG8_WAIT_V(8); PG8_WAIT_L(0); PG8_BAR; PG8_MMA(0, 0, At, B0); PG8_MMA(0, 1, At, B1); PG8_BAR; PG8_SCHED;
            PG8_LDA(At, 1, 1); PG8_STAGE(PG8_SB(1, 0), b3, voffB); PG8_STAGE(PG8_SB(1, 1), b3 + hstepB, voffB); PG8_STAGE(PG8_SA(1, 0), a3, voffA);
            PG8_WAIT_V(8); PG8_WAIT_L(0); PG8_BAR; PG8_MMA(1, 0, At, B0); PG8_MMA(1, 1, At, B1); PG8_BAR; PG8_SCHED;
        }
        if constexpr (ALIGN_EPI) { if (wr == 0) PG8_BAR; }
        E(acc, cur, wr, wc, fr, fq);
        if (!has_next) break;
#pragma unroll
        for (int a = 0; a < 2; ++a)
#pragma unroll
            for (int b = 0; b < 2; ++b)
#pragma unroll
                for (int m = 0; m < 4; ++m)
#pragma unroll
                    for (int n = 0; n < 2; ++n) acc[a][b][m][n] = (f32x4){0.f, 0.f, 0.f, 0.f};
        cur = nxt; cA = nA; cB = nB; ++ui;
        if constexpr (ALIGN_EPI) { if (wr == 1) PG8_BAR; }
    }
    PG8_WAIT_V(0);
    if constexpr (!ALIGN_EPI) { if (wr == 0) PG8_BAR; }
    PG8_BAR;
#undef PG8_SA
#undef PG8_SB
#undef PG8_STAGE
#undef PG8_LDA
#undef PG8_LDB
#undef PG8_MMA
#undef PG8_WAIT_V
#undef PG8_WAIT_L
#undef PG8_BAR
#undef PG8_SCHED
}
}

#define XB_TMO      128
#define XB_XCNT(j)  (256  + 64 * (j))
#define XB_XSUB(j)  (1280 + 64 * (j))
#define XB_XGEN(j)  (2304 + 64 * (j))
#define XB_TOP      3328
#define XB_TOPGEN   3392
#define XCD_BAR_WORDS 3456
#define XB_SPIN_CAP (1u << 22)
__device__ __forceinline__ unsigned xb_ld(unsigned* p)              { return __hip_atomic_load(p, __ATOMIC_RELAXED, __HIP_MEMORY_SCOPE_AGENT); }
__device__ __forceinline__ unsigned xb_add(unsigned* p, unsigned v) { return __hip_atomic_fetch_add(p, v, __ATOMIC_RELAXED, __HIP_MEMORY_SCOPE_AGENT); }
__device__ __forceinline__ unsigned xb_xcc_id() { return (unsigned)__builtin_amdgcn_s_getreg((3 << 11) | 20) & 0xFu; }
#define XB_SPIN(cond, bar) do { unsigned _sp = 0; while (cond) { __builtin_amdgcn_s_sleep(1); \
    if ((++_sp & 255u) == 0u) { if (xb_ld(&(bar)[XB_TMO])) break; if (_sp > XB_SPIN_CAP) { atomicAdd(&(bar)[XB_TMO], 1u); break; } } } } while (0)
struct XcdBarrier { unsigned* bar; unsigned x; volatile LAS unsigned* st; };
__device__ __forceinline__ XcdBarrier xcd_barrier_post(unsigned* bar, volatile LAS unsigned* st) {
    XcdBarrier b; b.bar = bar; b.x = xb_xcc_id(); b.st = st;
    if (threadIdx.x == 0) (void)xb_add(&bar[XB_XCNT(b.x)], 1u);
    return b;
}
__device__ __forceinline__ void xcd_barrier_complete(unsigned* bar, unsigned x, unsigned& nloc, unsigned& nx) {
    const unsigned G = gridDim.x * gridDim.y * gridDim.z;
    unsigned sum, cnt, mine, sp = 0u;
    for (;;) {
        sum = 0u; cnt = 0u; mine = 0u;
#pragma unroll
        for (unsigned j = 0; j < 16; ++j) { const unsigned c = xb_ld(&bar[XB_XCNT(j)]); sum += c; cnt += (c > 0u) ? 1u : 0u; mine = (j == x) ? c : mine; }
        if (sum == G) break;
        __builtin_amdgcn_s_sleep(1);
        if ((++sp & 255u) == 0u) { if (xb_ld(&bar[XB_TMO])) break; if (sp > XB_SPIN_CAP) { atomicAdd(&bar[XB_TMO], 1u); break; } }
    }
    nloc = mine > 0u ? mine : 1u; nx = cnt > 0u ? cnt : 1u;
}
__device__ __noinline__ void xcd_barrier_fn(unsigned* bar_, unsigned x_, volatile LAS unsigned* st_) {
    XcdBarrier b; b.bar = bar_; b.x = x_; b.st = st_;
    asm volatile("s_waitcnt vmcnt(0)" ::: "memory");
    __syncthreads();
    if (threadIdx.x == 0) {
        unsigned* bar = b.bar;
        __builtin_amdgcn_s_waitcnt(0);
        unsigned nloc = b.st[0], nx = b.st[1];
        if (nloc == 0u) { xcd_barrier_complete(bar, b.x, nloc, nx); b.st[0] = nloc; b.st[1] = nx; }
        const unsigned old = xb_add(&bar[XB_XSUB(b.x)], 1u);
        const unsigned gen = old / nloc;
        if (old + 1u == (gen + 1u) * nloc) {
            __builtin_amdgcn_fence(__ATOMIC_RELEASE, "agent");
            asm volatile("s_waitcnt vmcnt(0)" ::: "memory");
            const unsigned og = xb_add(&bar[XB_TOP], 1u);
            const unsigned tg = og / nx;
            if (og + 1u == (tg + 1u) * nx) xb_add(&bar[XB_TOPGEN], 1u);
            else XB_SPIN(xb_ld(&bar[XB_TOPGEN]) == tg, bar);
            __builtin_amdgcn_fence(__ATOMIC_ACQUIRE, "agent");
            xb_add(&bar[XB_XGEN(b.x)], 1u);
            asm volatile("s_waitcnt vmcnt(0)" ::: "memory");
        } else {
            XB_SPIN(xb_ld(&bar[XB_XGEN(b.x)]) == gen, bar);
            __builtin_amdgcn_fence(__ATOMIC_ACQUIRE, "agent");
            asm volatile("s_waitcnt vmcnt(0)" ::: "memory");
        }
    }
    __syncthreads();
}

struct Ctx {
    int tid, lane, wave, gw, NGW, bid, G;
    LAS unsigned char* lds;
};
DEV Ctx make_ctx(LAS unsigned char* lds) {
    Ctx c; int tid_ = threadIdx.x; asm volatile("" : "+v"(tid_));
    c.tid = tid_; c.lane = c.tid & 63; c.wave = __builtin_amdgcn_readfirstlane(c.tid >> 6); { int b_ = blockIdx.x, g_ = gridDim.x; asm volatile("" : "+s"(b_), "+s"(g_)); c.bid = b_; c.G = g_; }
    c.gw = c.bid * 8 + c.wave; c.NGW = c.G * 8; c.lds = lds; return c;
}
#define WSP(T, off) ((T*)(p.ws + (off)))

DEV void transpose_item(const float* W, const float* W2, int ldw, int K, bf16_t* WT, int nblk, int mode, int nvalid, int item, LAS float* scr, int lane) {
    const int kb = item / nblk, nb = item % nblk, k0 = 64 * kb, n0 = 32 * nb;
    const int n = n0 + (lane & 31);
    const float* src = W; int c = -1; int ld = ldw; int kofs = 0;
    if (mode == 0) { c = n < nvalid ? n : -1; }
    else if (mode == 1) { c = n < NSMALL ? n : (n < PSW ? -1 : n - (PSW - NSMALL)); }
    else if (mode == 2) { c = (n & 1) ? 256 + (n >> 1) : (n >> 1); }
    else { if (n < 384 && k0 < 384) { c = n; ld = 384; } else if (n >= 512 && k0 >= 384) { src = W2; c = n - 512; ld = 512; kofs = 384; } }
#pragma unroll 8
    for (int i = 0; i < 32; ++i) { const int kk = 2 * i + (lane >> 5); scr[kk * 33 + (lane & 31)] = (c >= 0) ? src[(size_t)(k0 - kofs + kk) * ld + c] : 0.f; }
    LDS_WAIT(); asm volatile("" ::: "memory");
    const int c8 = lane & 7;
#pragma unroll
    for (int j = 0; j < 4; ++j) { const int nn = (lane >> 3) + 8 * j; const LAS float* s = scr + (8 * c8) * 33 + nn;
        u32x4 o; o.x = pk2(s[0 * 33], s[1 * 33]); o.y = pk2(s[2 * 33], s[3 * 33]); o.z = pk2(s[4 * 33], s[5 * 33]); o.w = pk2(s[6 * 33], s[7 * 33]);
        *(u32x4*)(WT + (size_t)(n0 + nn) * K + k0 + 8 * c8) = o; }
    LDS_WAIT(); asm volatile("" ::: "memory");
}
constexpr int IT_WIN = 16 * 208, IT_W13 = 256 * 32, IT_W2 = 128 * 32, IT_CW1 = 256 * 2, IT_WBR = 128 * 4, IT_WOUT = 512, IT_WU = 8 * 32;
constexpr int IT_LAYER = IT_WIN + IT_W13 + IT_W2 + IT_CW1 + IT_WBR + IT_WOUT + IT_WU;
DEV void phase_prologue(const Params& p, const Ctx& c) {
    float* MOD = WSP(float, WS_MOD);
    if (c.bid < 48) {
        LAS float* sc = (LAS float*)(c.lds + 73728);
        for (int i = c.tid; i < 4096; i += 512) sc[i] = silu_(p.in[1][i]);
        __syncthreads();
        const int idx = c.bid * 512 + c.tid; const int l = idx / 6144, j = idx % 6144;
        const float* wa = p.in[2] + (size_t)l * 1024 * 6144 + j;
        float a0 = 0.f, a1 = 0.f, a2 = 0.f, a3 = 0.f;
        for (int k = 0; k < 1024; ++k) { const float w = wa[(size_t)k * 6144]; a0 += sc[k] * w; a1 += sc[1024 + k] * w; a2 += sc[2048 + k] * w; a3 += sc[3072 + k] * w; }
        const float bb = p.in[3][l * 6144 + j];
        MOD[(l * 4 + 0) * 6144 + j] = a0 + bb; MOD[(l * 4 + 1) * 6144 + j] = a1 + bb; MOD[(l * 4 + 2) * 6144 + j] = a2 + bb; MOD[(l * 4 + 3) * 6144 + j] = a3 + bb;
    }
    { float* RC = WSP(float, WS_ROPE); float* RS = RC + 4096 * 16;
      for (int i = c.bid * 512 + c.tid; i < 4096 * 16; i += c.G * 512) { const int pos = i >> 4, k = i & 15;
          const float inv = (float)pow(10000.0, -(double)k / 16.0); const float ang = (float)pos * inv;
          RC[i] = (float)cos((double)ang); RS[i] = (float)sin((double)ang); } }
    { float* WRT = WSP(float, WS_MISC + MISC_WRT);
      for (int i = c.bid * 512 + c.tid; i < NLAYER * 36 * 1024; i += c.G * 512) { const int k = i & 1023, e = (i >> 10) % 36, l = i / (36 * 1024);
          WRT[i] = e < 4 ? p.in[18][((size_t)l * 1024 + k) * 4 + e] : p.in[20][((size_t)l * 1024 + k) * 32 + (e - 4)]; } }
    LAS float* scr = (LAS float*)(c.lds + c.wave * 8448);
    for (int it = c.gw; it < IT_LAYER * NLAYER; it += c.NGW) {
        const int l = it / IT_LAYER; int r = it % IT_LAYER;
        if (r < IT_WIN) { transpose_item(p.in[5] + (size_t)l * 1024 * DIN, nullptr, DIN, 1024, WSP(bf16_t, WS_WIN) + (size_t)l * NPROJ * 1024, NPROJ / 32, 1, 0, r, scr, c.lane); continue; } r -= IT_WIN;
        if (r < IT_W13) { const int e = r / 256; transpose_item(p.in[22] + (size_t)(l * 32 + e) * 1024 * 512, nullptr, 512, 1024, WSP(bf16_t, WS_W13) + (size_t)(l * 32 + e) * 512 * 1024, 16, 2, 0, r % 256, scr, c.lane); continue; } r -= IT_W13;
        if (r < IT_W2) { const int e = r / 128; transpose_item(p.in[23] + (size_t)(l * 32 + e) * 256 * 1024, nullptr, 1024, 256, WSP(bf16_t, WS_W2) + (size_t)(l * 32 + e) * 1024 * 256, 32, 0, 1024, r % 128, scr, c.lane); continue; } r -= IT_W2;
        if (r < IT_CW1) { const int kv = r / 256; transpose_item(p.in[8] + (size_t)(l * 2 + kv) * 2048 * 256, nullptr, 256, 2048, WSP(bf16_t, WS_CW1) + (size_t)(l * 2 + kv) * 256 * 2048, 8, 0, 256, r % 256, scr, c.lane); continue; } r -= IT_CW1;
        if (r < IT_WBR) { const int n = r / 128; transpose_item(p.in[16] + (size_t)(l * 4 + n) * 256 * 1024, nullptr, 1024, 256, WSP(bf16_t, WS_WBR) + (size_t)(l * 4 + n) * 1024 * 256, 32, 0, 1024, r % 128, scr, c.lane); continue; } r -= IT_WBR;
        if (r < IT_WOUT) { transpose_item(p.in[17] + (size_t)l * 1024 * 1024, nullptr, 1024, 1024, WSP(bf16_t, WS_WOUT) + (size_t)l * 1024 * 1024, 32, 0, 1024, r, scr, c.lane); continue; } r -= IT_WOUT;
        transpose_item(p.in[14] + (size_t)l * 384 * 384, p.in[15] + (size_t)l * 128 * 512, 0, 512, WSP(bf16_t, WS_WU) + (size_t)l * 1024 * 512, 32, 3, 0, r, scr, c.lane);
    }
}

template <bool NORM> DEV void phase_norm1(const Params& p, const Ctx& c, int l) {
    const float* MOD = WSP(float, WS_MOD);
    const bf16_t* YP = (const bf16_t*)(p.ws + WS_BIG + BIG_YP);
    const int* PSLOT = WSP(int, WS_MISC + MISC_PSLOT); const float* WTS = WSP(float, WS_MISC + MISC_WTS);
    bf16_t* HBF = WSP(bf16_t, WS_HBF);
    for (int row = c.gw; row < NTOK; row += c.NGW) {
        const int b = row / SEQ;
        f32x4 v[4];
        if (l == 0) {
#pragma unroll
            for (int j = 0; j < 4; ++j) v[j] = *(const f32x4*)(p.in[0] + (size_t)row * DM + j * 256 + c.lane * 4);
        } else {
            const float* g2 = MOD + ((l - 1) * 4 + b) * 6144 + 5120;
            const int s0 = PSLOT[row * 2], s1 = PSLOT[row * 2 + 1]; const float w0 = WTS[row * 2], w1 = WTS[row * 2 + 1];
#pragma unroll
            for (int j = 0; j < 4; ++j) { const int col = j * 256 + c.lane * 4;
                const f32x4 x = *(const f32x4*)(p.out + (size_t)row * DM + col); const f32x4 g = *(const f32x4*)(g2 + col);
                const u32x2 y0 = *(const u32x2*)(YP + (size_t)s0 * DM + col), y1 = *(const u32x2*)(YP + (size_t)s1 * DM + col);
                f32x4 y; y[0] = w0 * bflo(y0.x) + w1 * bflo(y1.x); y[1] = w0 * bfhi(y0.x) + w1 * bfhi(y1.x); y[2] = w0 * bflo(y0.y) + w1 * bflo(y1.y); y[3] = w0 * bfhi(y0.y) + w1 * bfhi(y1.y);
                v[j] = x + g * y; }
        }
#pragma unroll
        for (int j = 0; j < 4; ++j) *(f32x4*)(p.out + (size_t)row * DM + j * 256 + c.lane * 4) = v[j];
        if (NORM) {
            float ss = 0.f;
#pragma unroll
            for (int j = 0; j < 4; ++j) ss += (v[j][0] * v[j][0] + v[j][1] * v[j][1]) + (v[j][2] * v[j][2] + v[j][3] * v[j][3]);
            const float r = rsqrtf(wave_sum(ss) * (1.f / DM) + EPS);
            const float* gn = p.in[4] + (size_t)(l * 2 + 0) * DM; const float* sh = MOD + (l * 4 + b) * 6144; const float* sc = sh + 1024;
#pragma unroll
            for (int j = 0; j < 4; ++j) { const int col = j * 256 + c.lane * 4;
                const f32x4 g = *(const f32x4*)(gn + col), s1 = *(const f32x4*)(sc + col), s0 = *(const f32x4*)(sh + col);
                const f32x4 h = v[j] * r * g * (s1 + 1.f) + s0;
                u32x2 o; o.x = pk2(h[0], h[1]); o.y = pk2(h[2], h[3]); *(u32x2*)(HBF + (size_t)row * DM + col) = o; }
        }
    }
}

struct FInproj { float* PSM; bf16_t* GATES;
    DEV void operator()(int row, int col, const f32x4& v0, const f32x4& v1) const {
        if (col < PSW) { float* o = PSM + (size_t)row * PSW + col; *(f32x4*)o = v0; *(f32x4*)(o + 4) = v1; }
        else { u32x4 w; w.x = pk2(sigm(v0[0]), sigm(v0[1])); w.y = pk2(sigm(v0[2]), sigm(v0[3])); w.z = pk2(sigm(v1[0]), sigm(v1[1])); w.w = pk2(sigm(v1[2]), sigm(v1[3]));
               *(u32x4*)(GATES + (size_t)row * NGATE + (col - PSW)) = w; } } };
DEV void phase_inproj(const Params& p, const Ctx& c, int l) {
    pg8::Gemm g{WSP(bf16_t, WS_HBF), WSP(bf16_t, WS_WIN) + (size_t)l * NPROJ * 1024, 1024, 1024};
    pg8::StaticOrder S; S.init(NTOK, NPROJ, c.G, c.bid);
    pg8::Epi8<FInproj> E{{(float*)(p.ws + WS_BIG + BIG_PSM), WSP(bf16_t, WS_GATES)}};
    pg8::gemm_phase<pg8::Epi8<FInproj>, pg8::StaticOrder, true>(c.lds, g, S, E);
}

DEV float head_norm(float v, const float* gain, int lane) { const float ss = wave_sum(v * v); return v * rsqrtf(ss * (1.f / 64.f) + EPS) * gain[lane]; }
DEV void phase_post(const Params& p, const Ctx& c, int l) {
    const float* PSM = (const float*)(p.ws + WS_BIG + BIG_PSM); bf16_t* ACT = WSP(bf16_t, WS_ACT);
    float* GA = WSP(float, WS_SMALL + SM_GA);
    const float* gq = p.in[6] + (size_t)l * 10 * 64;
    const float* RC = WSP(float, WS_ROPE); const float* RS = RC + 4096 * 16;
    const int lane = c.lane;
    for (int row = c.gw; row < NTOK; row += c.NGW) {
        const float* P = PSM + (size_t)row * PSW; bf16_t* A = ACT + (size_t)row * ACTW; const int t = row % SEQ;
#pragma unroll
        for (int h = 0; h < 4; ++h) A[A_QA + h * 64 + lane] = (bf16_t)f2bf(head_norm(P[I_QA + h * 64 + lane], gq + 0 * 64, lane));
        A[A_KCR + lane] = (bf16_t)f2bf(P[I_KC + lane]); A[A_VCR + lane] = (bf16_t)f2bf(P[I_VC + lane]);
        A[A_KS + lane] = (bf16_t)f2bf(head_norm(P[I_KS + lane], gq + 2 * 64, lane)); A[A_VS + lane] = (bf16_t)f2bf(P[I_VS + lane]);
        A[A_KW + lane] = (bf16_t)f2bf(head_norm(P[I_KW + lane], gq + 3 * 64, lane)); A[A_VW + lane] = (bf16_t)f2bf(P[I_VW + lane]);
        if (lane < 12) GA[row * 12 + lane] = sigm(P[I_GL + lane]);
#pragma unroll
        for (int h = 0; h < 4; ++h) A[A_QB + h * 64 + lane] = (bf16_t)f2bf(head_norm(P[I_QB + h * 64 + lane], gq + 4 * 64, lane));
#pragma unroll
        for (int h = 0; h < 2; ++h) { A[A_KB + h * 64 + lane] = (bf16_t)f2bf(head_norm(P[I_KB + h * 64 + lane], gq + 5 * 64, lane)); A[A_VB + h * 64 + lane] = (bf16_t)f2bf(P[I_VB + h * 64 + lane]); }
#pragma unroll
        for (int h = 0; h < 4; ++h) { A[A_QC + h * 64 + lane] = (bf16_t)f2bf(head_norm(P[I_QC + h * 64 + lane], gq + 6 * 64, lane));
            A[A_KC + h * 64 + lane] = (bf16_t)f2bf(head_norm(P[I_KCC + h * 64 + lane], gq + 7 * 64, lane)); A[A_VC + h * 64 + lane] = (bf16_t)f2bf(P[I_VCC + h * 64 + lane]); }
        { float x[6]; float ss = 0.f;
#pragma unroll
          for (int j = 0; j < 6; ++j) { x[j] = P[I_CQ + j * 64 + lane]; ss += x[j] * x[j]; }
          const float r = rsqrtf(wave_sum(ss) * (1.f / 384.f) + EPS); const float* g = p.in[11] + l * 384;
#pragma unroll
          for (int j = 0; j < 6; ++j) A[A_CQ + j * 64 + lane] = (bf16_t)f2bf(x[j] * r * g[j * 64 + lane]); }
        { float x0 = P[I_CKV + lane], x1 = P[I_CKV + 64 + lane]; const float r = rsqrtf(wave_sum(x0 * x0 + x1 * x1) * (1.f / 128.f) + EPS); const float* g = p.in[12] + l * 128;
          A[A_CKV + lane] = (bf16_t)f2bf(x0 * r * g[lane]); A[A_CKV + 64 + lane] = (bf16_t)f2bf(x1 * r * g[64 + lane]); }
        { const float x = lane < 32 ? P[I_KR + lane] : 0.f; const float r = rsqrtf(wave_sum(x * x) * (1.f / 32.f) + EPS);
          const float y = x * r * p.in[13][(l * 2 + 1) * 32 + (lane & 31)];
          const float yo = swz_xor<16>(y); const int k = lane & 15; const float cs = RC[t * 16 + k], sn = RS[t * 16 + k];
          const float o = (lane & 16) ? (yo * sn + y * cs) : (y * cs - yo * sn);
          if (lane < 32) A[A_KR + lane] = (bf16_t)f2bf(o); }
    }
}

struct FStoreF32 { float* O; int ld;
    DEV void operator()(int row, int col, const f32x4& v0, const f32x4& v1) const { float* o = O + (size_t)row * ld + col; *(f32x4*)o = v0; *(f32x4*)(o + 4) = v1; } };
DEV void phase_mlaup(const Params& p, const Ctx& c, int l) {
    { pg8::Gemm g{WSP(bf16_t, WS_ACT) + A_CQ, WSP(bf16_t, WS_WU) + (size_t)l * 1024 * 512, ACTW, 512};
      pg8::StaticOrder S; S.init(NTOK, 1024, c.G, c.bid);
      pg8::Epi8<FStoreF32> E{{WSP(float, WS_MUR), 1024}};
      pg8::gemm_phase<pg8::Epi8<FStoreF32>, pg8::StaticOrder, true>(c.lds, g, S, E); }
    { const bf16_t* ACT = WSP(bf16_t, WS_ACT); bf16_t* CMPA = WSP(bf16_t, WS_CMPA); const float* pe = p.in[7] + (size_t)l * 2 * 32 * 64;
      for (int idx = c.bid * 512 + c.tid; idx < 2 * 1024 * 256; idx += c.G * 512) {
          const int c8 = idx & 255, r = (idx >> 8) & 1023, kv = idx >> 18; const int j = c8 >> 3, d = (c8 & 7) * 8;
          u32x4 o = (u32x4){0u, 0u, 0u, 0u};
          if (r < 1020) { const int b = r / 255, i = r % 255; const size_t tok = (size_t)b * SEQ + 16 * i + j;
              const u32x4 s = *(const u32x4*)(ACT + tok * ACTW + (kv ? A_VCR : A_KCR) + d); const float* pp = pe + (kv * 32 + j) * 64 + d;
              o.x = pk2(bflo(s.x) + pp[0], bfhi(s.x) + pp[1]); o.y = pk2(bflo(s.y) + pp[2], bfhi(s.y) + pp[3]); o.z = pk2(bflo(s.z) + pp[4], bfhi(s.z) + pp[5]); o.w = pk2(bflo(s.w) + pp[6], bfhi(s.w) + pp[7]); }
          *(u32x4*)(CMPA + ((size_t)kv * 1024 + r) * 2048 + c8 * 8) = o; } }
    { const bf16_t* ACT = WSP(bf16_t, WS_ACT); float* KM = WSP(float, WS_MISC + MISC_KMEAN);
      for (int idx = c.bid * 512 + c.tid; idx < 4 * 16 * 256; idx += c.G * 512) { const int hd = idx & 255, n = (idx >> 8) & 15, b = idx >> 12;
          const bf16_t* src = ACT + ((size_t)b * SEQ + n * 256) * ACTW + A_KC + hd; float s = 0.f;
          for (int i = 0; i < 256; ++i) s += bf2f(src[(size_t)i * ACTW]);
          KM[idx] = s * (1.f / 256.f); } }
}

struct CmpOrder { int G, c; DEV bool next(int i, pg8::Unit& u) const { const int L = i * G + c; if (L >= 8) return false; u.pm = L; u.pn = L >> 2; return true; } };
struct FCmpHid { bf16_t* HID;
    DEV void operator()(int row, int col, const f32x4& v0, const f32x4& v1) const { const int cc = col & 255;
        u32x4 w; w.x = pk2(silu_(v0[0]), silu_(v0[1])); w.y = pk2(silu_(v0[2]), silu_(v0[3])); w.z = pk2(silu_(v1[0]), silu_(v1[1])); w.w = pk2(silu_(v1[2]), silu_(v1[3]));
        *(u32x4*)(HID + (size_t)row * 256 + cc) = w; } };
DEV void phase_post2(const Params& p, const Ctx& c, int l) {
    { pg8::Gemm g{WSP(bf16_t, WS_CMPA), WSP(bf16_t, WS_CW1) + (size_t)l * 2 * 256 * 2048, 2048, 2048};
      CmpOrder S{c.G, c.bid}; pg8::Epi8<FCmpHid> E{{WSP(bf16_t, WS_HID)}};
      pg8::gemm_phase<pg8::Epi8<FCmpHid>, CmpOrder, true>(c.lds, g, S, E); }
    const float* MUR = WSP(float, WS_MUR); bf16_t* ACT2 = WSP(bf16_t, WS_ACT2);
    const float* gq = p.in[6] + (size_t)l * 10 * 64; const float* RC = WSP(float, WS_ROPE); const float* RS = RC + 4096 * 16;
    const int lane = c.lane;
    for (int row = c.gw; row < NTOK; row += c.NGW) {
        const float* R = MUR + (size_t)row * 1024; bf16_t* A = ACT2 + (size_t)row * ACT2W; const int t = row % SEQ;
#pragma unroll
        for (int h = 0; h < 4; ++h) {
            A[A2_QF + h * 96 + lane] = (bf16_t)f2bf(head_norm(R[h * 96 + lane], gq + 8 * 64, lane));
            { const float x = lane < 32 ? R[h * 96 + 64 + lane] : 0.f; const float r = rsqrtf(wave_sum(x * x) * (1.f / 32.f) + EPS);
              const float y = x * r * p.in[13][(l * 2 + 0) * 32 + (lane & 31)];
              const float yo = swz_xor<16>(y); const int k = lane & 15; const float cs = RC[t * 16 + k], sn = RS[t * 16 + k];
              const float o = (lane & 16) ? (yo * sn + y * cs) : (y * cs - yo * sn);
              if (lane < 32) A[A2_QF + h * 96 + 64 + lane] = (bf16_t)f2bf(o); }
            A[A2_KN + h * 64 + lane] = (bf16_t)f2bf(head_norm(R[512 + h * 128 + lane], gq + 9 * 64, lane));
            A[A2_VD + h * 64 + lane] = (bf16_t)f2bf(R[512 + h * 128 + 64 + lane]);
        }
    }
}

template <int D0, int D1, int DV>
DEV void att_step(const float (&q)[D0 + D1], float (&o)[DV], float& m, float& l, const bf16_t* k0, const bf16_t* k1, const bf16_t* v, float scale, float bias, bool valid) {
    float acc = 0.f;
#pragma unroll
    for (int i = 0; i < D0 / 8; ++i) { const u32x4 u = *(const u32x4*)(k0 + 8 * i);
        acc += q[8 * i] * bflo(u.x) + q[8 * i + 1] * bfhi(u.x) + q[8 * i + 2] * bflo(u.y) + q[8 * i + 3] * bfhi(u.y) + q[8 * i + 4] * bflo(u.z) + q[8 * i + 5] * bfhi(u.z) + q[8 * i + 6] * bflo(u.w) + q[8 * i + 7] * bfhi(u.w); }
    if (D1 > 0) {
#pragma unroll
        for (int i = 0; i < D1 / 8; ++i) { const u32x4 u = *(const u32x4*)(k1 + 8 * i); const int b = D0 + 8 * i;
            acc += q[b] * bflo(u.x) + q[b + 1] * bfhi(u.x) + q[b + 2] * bflo(u.y) + q[b + 3] * bfhi(u.y) + q[b + 4] * bflo(u.z) + q[b + 5] * bfhi(u.z) + q[b + 6] * bflo(u.w) + q[b + 7] * bfhi(u.w); }
    }
    const float s = acc * scale + bias;
    if (valid) {
        if (s > m) { const float a = __expf(m - s); l *= a;
#pragma unroll
            for (int d = 0; d < DV; ++d) o[d] *= a;
            m = s; }
        const float pr = __expf(s - m); l += pr;
#pragma unroll
        for (int i = 0; i < DV / 8; ++i) { const u32x4 u = *(const u32x4*)(v + 8 * i);
            o[8 * i] += pr * bflo(u.x); o[8 * i + 1] += pr * bfhi(u.x); o[8 * i + 2] += pr * bflo(u.y); o[8 * i + 3] += pr * bfhi(u.y);
            o[8 * i + 4] += pr * bflo(u.z); o[8 * i + 5] += pr * bfhi(u.z); o[8 * i + 6] += pr * bflo(u.w); o[8 * i + 7] += pr * bfhi(u.w); }
    }
}
template <int D> DEV void load_q(float (&q)[D], const bf16_t* src) {
#pragma unroll
    for (int i = 0; i < D / 8; ++i) { const u32x4 u = *(const u32x4*)(src + 8 * i);
        q[8 * i] = bflo(u.x); q[8 * i + 1] = bfhi(u.x); q[8 * i + 2] = bflo(u.y); q[8 * i + 3] = bfhi(u.y); q[8 * i + 4] = bflo(u.z); q[8 * i + 5] = bfhi(u.z); q[8 * i + 6] = bflo(u.w); q[8 * i + 7] = bfhi(u.w); }
}
template <int DV> DEV void store_o_bf16(bf16_t* dst, const float (&o)[DV], float inv) {
#pragma unroll
    for (int i = 0; i < DV / 8; ++i) { u32x4 w; w.x = pk2(o[8 * i] * inv, o[8 * i + 1] * inv); w.y = pk2(o[8 * i + 2] * inv, o[8 * i + 3] * inv); w.z = pk2(o[8 * i + 4] * inv, o[8 * i + 5] * inv); w.w = pk2(o[8 * i + 6] * inv, o[8 * i + 7] * inv);
        *(u32x4*)(dst + 8 * i) = w; }
}
DEV void item_bgh(int it, int& b, int& g, int& h) { const int r = it & 63, bh = it >> 6; g = (r & 1) ? 63 - (r >> 1) : (r >> 1); b = bh >> 2; h = bh & 3; }

DEV void phase_attn(const Params& p, const Ctx& c, int l) {
    const int lane = c.lane;
    { const bf16_t* HID = WSP(bf16_t, WS_HID); float* KC = WSP(float, WS_MISC + MISC_KCMP); float* VC = WSP(float, WS_MISC + MISC_VCMP);
      const float* gq = p.in[6] + (size_t)l * 10 * 64;
      for (int it = c.gw; it < 2 * 1020; it += c.NGW) { const int kv = it / 1020, r = it % 1020;
          const float* w2 = p.in[9] + (size_t)(l * 2 + kv) * 256 * 64; const bf16_t* hrow = HID + ((size_t)kv * 1024 + r) * 256;
          float a = 0.f;
          for (int k = 0; k < 256; ++k) a += bf2f(hrow[k]) * w2[k * 64 + lane];
          const int b = r / 255, i = r % 255;
          if (kv == 0) KC[(b * 256 + i) * 64 + lane] = head_norm(a, gq + 1 * 64, lane); else VC[(b * 256 + i) * 64 + lane] = a; } }
    const bf16_t* ACT = WSP(bf16_t, WS_ACT); const bf16_t* ACT2 = WSP(bf16_t, WS_ACT2); bf16_t* BR = WSP(bf16_t, WS_BR);
    for (int it0 = c.gw; it0 < 2048; it0 += c.NGW) {
        if (it0 < 1024) {
            int b, g, h; item_bgh(it0, b, g, h); const int t = g * 64 + lane; const size_t tok = (size_t)b * SEQ + t;
            float q[96], o[64]; float m = -INFINITY, ls = 0.f;
            load_q<96>(q, ACT2 + tok * ACT2W + A2_QF + h * 96);
#pragma unroll
            for (int d = 0; d < 64; ++d) o[d] = 0.f;
            const float scale = 0.10206207261596575f;
            for (int s = g * 64 + 63; s >= 0; --s) { const size_t kt = (size_t)b * SEQ + s;
                att_step<64, 32, 64>(q, o, m, ls, ACT2 + kt * ACT2W + A2_KN + h * 64, ACT + kt * ACTW + A_KR, ACT2 + kt * ACT2W + A2_VD + h * 64, scale, 0.f, s <= t); }
            store_o_bf16<64>(BR + tok * 1024 + 768 + h * 64, o, 1.f / ls);
        } else {
            int b, g, h; item_bgh(it0 - 1024, b, g, h); const int t = g * 64 + lane; const size_t tok = (size_t)b * SEQ + t;
            const int nb = g >> 2; const float slope = SLOPES[2][h];
            float q[64], o[64]; float m = -INFINITY, ls = 0.f;
            load_q<64>(q, ACT + tok * ACTW + A_QC + h * 64);
#pragma unroll
            for (int d = 0; d < 64; ++d) o[d] = 0.f;
            const float* KM = WSP(float, WS_MISC + MISC_KMEAN) + (size_t)b * 16 * 256 + h * 64;
            float v1 = -INFINITY, v2 = -INFINITY, v3 = -INFINITY; int i1 = -1, i2 = -1, i3 = -1;
            for (int n = 0; n < nb; ++n) { const float* km = KM + n * 256; float dsum = 0.f;
#pragma unroll
                for (int d = 0; d < 64; ++d) dsum += q[d] * km[d];
                if (dsum > v1) { v3 = v2; i3 = i2; v2 = v1; i2 = i1; v1 = dsum; i1 = n; }
                else if (dsum > v2) { v3 = v2; i3 = i2; v2 = dsum; i2 = n; }
                else if (dsum > v3) { v3 = dsum; i3 = n; } }
            const int start = nb * 256;
            for (int s = g * 64 + 63; s >= start; --s) { const size_t kt = (size_t)b * SEQ + s;
                att_step<64, 0, 64>(q, o, m, ls, ACT + kt * ACTW + A_KC + h * 64, nullptr, ACT + kt * ACTW + A_VC + h * 64, 0.125f, -slope * (float)(t - s), s <= t); }
            for (int n = nb - 1; n >= 0; --n) { const bool sel = (n == i1) || (n == i2) || (n == i3);
                if (!__any(sel)) continue;
                for (int s = n * 256 + 255; s >= n * 256; --s) { const size_t kt = (size_t)b * SEQ + s;
                    att_step<64, 0, 64>(q, o, m, ls, ACT + kt * ACTW + A_KC + h * 64, nullptr, ACT + kt * ACTW + A_VC + h * 64, 0.125f, -slope * (float)(t - s), sel); } }
            store_o_bf16<64>(BR + tok * 1024 + 512 + h * 64, o, 1.f / ls);
        }
    }
    for (int it0 = c.gw; it0 < 2048; it0 += c.NGW) {
        const bool swa = it0 >= 1024;
        int b, g, h; item_bgh(swa ? it0 - 1024 : it0, b, g, h); const int t = g * 64 + lane; const size_t tok = (size_t)b * SEQ + t;
        const int W = swa ? 128 : 512; const float slope = SLOPES[swa ? 1 : 0][h];
        const int qoff = swa ? A_QB + h * 64 : A_QA + h * 64, koff = swa ? A_KB + (h >> 1) * 64 : A_KW, voff = swa ? A_VB + (h >> 1) * 64 : A_VW;
        float q[64], o[64]; float m = -INFINITY, ls = 0.f;
        load_q<64>(q, ACT + tok * ACTW + qoff);
#pragma unroll
        for (int d = 0; d < 64; ++d) o[d] = 0.f;
        int lo = g * 64 - (W - 1); if (lo < 0) lo = 0;
        for (int s = g * 64 + 63; s >= lo; --s) { const size_t kt = (size_t)b * SEQ + s; const int dist = t - s;
            att_step<64, 0, 64>(q, o, m, ls, ACT + kt * ACTW + koff, nullptr, ACT + kt * ACTW + voff, 0.125f, -slope * (float)dist, dist >= 0 && dist < W); }
        if (swa) { const float sk = p.in[10][l * 4 + h]; const float mf = fmaxf(m, sk); const float a = __expf(m - mf); const float den = ls * a + __expf(sk - mf);
            store_o_bf16<64>(BR + tok * 1024 + 256 + h * 64, o, a / den); }
        else { float* OW = WSP(float, WS_OWIN) + tok * 256 + h * 64; const float inv = 1.f / ls;
#pragma unroll
            for (int d = 0; d < 64; d += 4) *(f32x4*)(OW + d) = (f32x4){o[d] * inv, o[d + 1] * inv, o[d + 2] * inv, o[d + 3] * inv}; }
    }
}

DEV void phase_cmpattn(const Params& p, const Ctx& c, int l) {
    const bf16_t* ACT = WSP(bf16_t, WS_ACT); const float* KC = WSP(float, WS_MISC + MISC_KCMP); const float* VC = WSP(float, WS_MISC + MISC_VCMP);
    float* PB = WSP(float, WS_PB); float* PL = WSP(float, WS_SMALL + SM_PL); float* OC = WSP(float, WS_OCMP);
    const int lane = c.lane;
    for (int it = c.gw; it < 1024; it += c.NGW) {
        int b, g, h; item_bgh(it, b, g, h); const int t = g * 64 + lane; const size_t tok = (size_t)b * SEQ + t; const float slope = SLOPES[0][h];
        float q[64], o[64];
        load_q<64>(q, ACT + tok * ACTW + A_QA + h * 64);
#pragma unroll
        for (int d = 0; d < 64; ++d) o[d] = 0.f;
        const int nvis = t >= 31 ? ((t - 31) >> 4) + 1 : 0;
        const int tmaxw = g * 64 + 63; const int nmax = tmaxw >= 31 ? ((tmaxw - 31) >> 4) + 1 : 0;
        const float* kcb = KC + (size_t)b * 256 * 64; const float* vcb = VC + (size_t)b * 256 * 64;
        float m = -INFINITY;
        for (int n = 0; n < nmax; ++n) { const float* k = kcb + n * 64; float a = 0.f;
#pragma unroll
            for (int d = 0; d < 64; ++d) a += q[d] * k[d];
            const float s = a * 0.125f - slope * (float)(t - (16 * n + 31));
            if (n < nvis) m = fmaxf(m, s); }
        float ls = 0.f, carry = 0.f; float* pb = PB + (tok * 4 + h) * 64;
        for (int j = 0; j < 64; ++j) { float e4[4];
#pragma unroll
            for (int u = 0; u < 4; ++u) { const int n = 4 * j + u; float e = 0.f;
                if (n < nmax) { const float* k = kcb + n * 64; float a = 0.f;
#pragma unroll
                    for (int d = 0; d < 64; ++d) a += q[d] * k[d];
                    const float s = a * 0.125f - slope * (float)(t - (16 * n + 31));
                    if (n < nvis) { e = __expf(s - m); const float* v = vcb + n * 64;
#pragma unroll
                        for (int d = 0; d < 64; ++d) o[d] += e * v[d]; } }
                e4[u] = e; }
            pb[j] = carry + e4[0] + e4[1] + e4[2] + e4[3]; carry = e4[3]; ls += e4[0] + e4[1] + e4[2] + e4[3];
            if (4 * j + 4 >= nmax) { for (int jj = j + 1; jj < 64; ++jj) pb[jj] = (jj == j + 1) ? carry : 0.f; break; } }
        const float inv = 1.f / fmaxf(ls, 1e-30f);
        PL[tok * 4 + h] = inv;
        float* oc = OC + tok * 256 + h * 64;
#pragma unroll
        for (int d = 0; d < 64; d += 4) *(f32x4*)(oc + d) = (f32x4){o[d] * inv, o[d + 1] * inv, o[d + 2] * inv, o[d + 3] * inv};
    }
}

DEV void phase_topk(const Params& p, const Ctx& c) {
    const float* PB = WSP(float, WS_PB); const float* PL = WSP(float, WS_SMALL + SM_PL); unsigned long long* SEL = WSP(unsigned long long, WS_SMALL + SM_SEL);
    const int lane = c.lane;
    for (int tok = c.gw; tok < NTOK; tok += c.NGW) {
        const int t = tok % SEQ, cur = t >> 6;
        float ps = 0.f;
#pragma unroll
        for (int h = 0; h < 4; ++h) ps += PB[((size_t)tok * 4 + h) * 64 + lane] * PL[tok * 4 + h];
        const bool forced = (lane == 0) || (lane == cur) || (lane == cur - 1);
        float score = lane <= cur ? ps + (forced ? 1e4f : 0.f) : -1e30f;
        unsigned long long mask = 0ull;
        for (int r = 0; r < 8; ++r) {
            float bv = score; int bi = lane;
#define TK_STEP(M) { const float ov = swz_xor<M>(bv); const int oi = swz_xor_i<M>(bi); if (ov > bv || (ov == bv && oi < bi)) { bv = ov; bi = oi; } }
            TK_STEP(1) TK_STEP(2) TK_STEP(4) TK_STEP(8) TK_STEP(16)
#undef TK_STEP
            { auto rv = __builtin_amdgcn_permlane32_swap(__float_as_uint(bv), __float_as_uint(bv), false, false); auto ri = __builtin_amdgcn_permlane32_swap((unsigned)bi, (unsigned)bi, false, false);
              const float v0 = __uint_as_float(rv[0]), v1 = __uint_as_float(rv[1]); const int i0 = (int)ri[0], i1 = (int)ri[1];
              if (v1 > v0 || (v1 == v0 && i1 < i0)) { bv = v1; bi = i1; } else { bv = v0; bi = i0; } }
            if (bv > -5e29f) mask |= 1ull << bi;
            if (lane == bi) score = -INFINITY;
        }
        if (lane == 0) SEL[tok] = mask;
    }
}

DEV void phase_slc(const Params& p, const Ctx& c, int l) {
    const bf16_t* ACT = WSP(bf16_t, WS_ACT); bf16_t* BR = WSP(bf16_t, WS_BR); const unsigned long long* SEL = WSP(unsigned long long, WS_SMALL + SM_SEL);
    const float* OC = WSP(float, WS_OCMP); const float* OW = WSP(float, WS_OWIN); const float* GA = WSP(float, WS_SMALL + SM_GA);
    const int lane = c.lane;
    for (int it = c.gw; it < 1024; it += c.NGW) {
        int b, g, h; item_bgh(it, b, g, h); const int t = g * 64 + lane; const size_t tok = (size_t)b * SEQ + t; const float slope = SLOPES[0][h];
        float q[64], o[64]; float m = -INFINITY, ls = 0.f;
        load_q<64>(q, ACT + tok * ACTW + A_QA + h * 64);
#pragma unroll
        for (int d = 0; d < 64; ++d) o[d] = 0.f;
        const unsigned long long mask = SEL[tok];
        for (int j = g; j >= 0; --j) { const bool sel = (mask >> j) & 1ull;
            if (!__any(sel)) continue;
            for (int s = j * 64 + 63; s >= j * 64; --s) { const size_t kt = (size_t)b * SEQ + s;
                att_step<64, 0, 64>(q, o, m, ls, ACT + kt * ACTW + A_KS, nullptr, ACT + kt * ACTW + A_VS, 0.125f, -slope * (float)(t - s), sel && s <= t); } }
        const float inv = 1.f / ls; const float g0 = GA[tok * 12 + h * 3], g1 = GA[tok * 12 + h * 3 + 1], g2 = GA[tok * 12 + h * 3 + 2];
        const float* oc = OC + tok * 256 + h * 64; const float* ow = OW + tok * 256 + h * 64;
#pragma unroll
        for (int d = 0; d < 64; ++d) o[d] = g0 * oc[d] + g1 * o[d] * inv + g2 * ow[d];
        store_o_bf16<64>(BR + tok * 1024 + h * 64, o, 1.f);
    }
}


namespace fa {
typedef float f32x16 __attribute__((ext_vector_type(16)));
typedef short v4i16_t __attribute__((ext_vector_type(4)));
typedef float f32x2_t __attribute__((ext_vector_type(2))); typedef __bf16 bf16x2_t __attribute__((ext_vector_type(2)));
constexpr int KROWB = 208, VROWB = 192, KBYTES = 64 * KROWB, VBYTES = 64 * VROWB, STG = KBYTES + VBYTES;
constexpr int LDS_MISC = 2 * STG;
constexpr float LOG2E = 1.4426950408889634f;
constexpr float MFLOOR = -1e20f;
DEV unsigned cvtpk(float lo, float hi) { f32x2_t v = {lo, hi}; bf16x2_t b = __builtin_convertvector(v, bf16x2_t); return __builtin_bit_cast(unsigned, b); }
DEV unsigned long long uni64(unsigned long long v) { const unsigned lo = __builtin_amdgcn_readfirstlane((unsigned)v), hi = __builtin_amdgcn_readfirstlane((unsigned)(v >> 32)); return ((unsigned long long)hi << 32) | lo; }
DEV unsigned long long wave_or64(unsigned long long v) {
    unsigned lo = (unsigned)v, hi = (unsigned)(v >> 32);
#define FA_OR(M) lo |= (unsigned)__builtin_amdgcn_ds_swizzle((int)lo, (M << 10) | 0x1f); hi |= (unsigned)__builtin_amdgcn_ds_swizzle((int)hi, (M << 10) | 0x1f);
    FA_OR(1) FA_OR(2) FA_OR(4) FA_OR(8) FA_OR(16)
#undef FA_OR
    { auto a = __builtin_amdgcn_permlane32_swap(lo, lo, false, false); lo = a[0] | a[1]; auto b = __builtin_amdgcn_permlane32_swap(hi, hi, false, false); hi = b[0] | b[1]; }
    return uni64(((unsigned long long)hi << 32) | lo);
}
struct Src { const bf16_t* k; int kp; const bf16_t* k2; int k2p; const bf16_t* v; int vp; };
template <int NQ, bool ALIBI, int SELMODE>
DEV void attn_pass(LAS unsigned char* lds, const Ctx& c, const Src& src, const bf16x8 (&qf)[NQ], unsigned long long tmask, unsigned long long wmask,
                   int t, float nslope2, float c1, unsigned W, unsigned long long rowmask, int own_blk, f32x16 (&o)[2], float& m, float& l) {
    const int tid = c.tid, lane = c.lane, r32 = lane & 31, hi = lane >> 5;
    const int skey = tid >> 3, sch = tid & 7, skey2 = tid >> 2, sch2 = tid & 3;
    const int i16 = lane & 15, tq = i16 >> 2, tp = i16 & 3, blk = (lane >> 4) & 1;
    u32x4 kreg, vreg, k2reg = (u32x4){0u, 0u, 0u, 0u};
#define FA_GLOAD(kt_) do { const size_t r_ = (size_t)((kt_) * 64 + skey); kreg = *(const u32x4*)(src.k + r_ * src.kp + sch * 8); vreg = *(const u32x4*)(src.v + r_ * src.vp + sch * 8); \
        if (NQ == 6) { if (tid < 256) k2reg = *(const u32x4*)(src.k2 + (size_t)((kt_) * 64 + skey2) * src.k2p + sch2 * 8); } } while (0)
#define FA_LSTORE(buf_) do { LAS unsigned char* st_ = lds + (buf_) * STG; *(LAS u32x4*)(st_ + skey * KROWB + sch * 16) = kreg; *(LAS u32x4*)(st_ + KBYTES + skey * VROWB + sch * 16) = vreg; \
        if (NQ == 6) { if (tid < 256) *(LAS u32x4*)(st_ + skey2 * KROWB + 128 + sch2 * 16) = k2reg; } } while (0)
#pragma unroll
    for (int dt = 0; dt < 2; ++dt)
#pragma unroll
        for (int i = 0; i < 16; ++i) o[dt][i] = 0.f;
    m = MFLOOR; l = 0.f;
    if (tmask == 0ull) return;
    int kt = 63 - __builtin_clzll(tmask); tmask &= ~(1ull << kt);
    FA_GLOAD(kt);
    int buf = 0;
    for (;;) {
        FA_LSTORE(buf);
        __syncthreads();
        const bool more = tmask != 0ull; int ktn = 0;
        if (more) { ktn = 63 - __builtin_clzll(tmask); tmask &= ~(1ull << ktn); FA_GLOAD(ktn); }
        if ((wmask >> kt) & 1ull) {
            const LAS unsigned char* kb = lds + buf * STG; const LAS unsigned char* vb = kb + KBYTES;
            f32x16 s0, s1;
#pragma unroll
            for (int i = 0; i < 16; ++i) { s0[i] = 0.f; s1[i] = 0.f; }
#pragma unroll
            for (int d0 = 0; d0 < NQ; ++d0) {
                const bf16x8 k0 = *(const LAS bf16x8*)(kb + r32 * KROWB + (16 * d0 + 8 * hi) * 2);
                const bf16x8 k1 = *(const LAS bf16x8*)(kb + (32 + r32) * KROWB + (16 * d0 + 8 * hi) * 2);
                s0 = __builtin_amdgcn_mfma_f32_32x32x16_bf16(k0, qf[d0], s0, 0, 0, 0);
                s1 = __builtin_amdgcn_mfma_f32_32x32x16_bf16(k1, qf[d0], s1, 0, 0, 0);
            }
            bool rowsel = true;
            if (SELMODE == 1) rowsel = (rowmask >> kt) & 1ull;
            if (SELMODE == 2) rowsel = ((kt >> 2) == own_blk) || ((rowmask >> (kt >> 2)) & 1ull);
            const unsigned Weff = rowsel ? W : 0u;
            const int db0 = t - (kt * 64 + 4 * hi);
            float mx = -INFINITY;
#pragma unroll
            for (int i = 0; i < 16; ++i) { const int cr = (i & 3) + 8 * (i >> 2);
                { const int d = db0 - cr; float x = s0[i] * c1; if (ALIBI) x = fmaf((float)d, nslope2, x); x = ((unsigned)d < Weff) ? x : -INFINITY; s0[i] = x; mx = fmaxf(mx, x); }
                { const int d = db0 - 32 - cr; float x = s1[i] * c1; if (ALIBI) x = fmaf((float)d, nslope2, x); x = ((unsigned)d < Weff) ? x : -INFINITY; s1[i] = x; mx = fmaxf(mx, x); } }
            { auto rr = __builtin_amdgcn_permlane32_swap(__float_as_uint(mx), __float_as_uint(mx), false, false); mx = fmaxf(__uint_as_float(rr[0]), __uint_as_float(rr[1])); }
            const float mn = fmaxf(m, mx); const float alpha = __builtin_amdgcn_exp2f(m - mn); m = mn;
            float ls = 0.f;
#pragma unroll
            for (int i = 0; i < 16; ++i) { s0[i] = __builtin_amdgcn_exp2f(s0[i] - mn); s1[i] = __builtin_amdgcn_exp2f(s1[i] - mn); ls += s0[i] + s1[i]; }
            l = l * alpha + ls;
#pragma unroll
            for (int dt = 0; dt < 2; ++dt)
#pragma unroll
                for (int i = 0; i < 16; ++i) o[dt][i] *= alpha;
#pragma unroll
            for (int hf = 0; hf < 2; ++hf)
#pragma unroll
                for (int ks = 0; ks < 2; ++ks) {
                    u32x4 pw;
                    if (hf == 0) { pw.x = cvtpk(s0[8 * ks], s0[8 * ks + 1]); pw.y = cvtpk(s0[8 * ks + 2], s0[8 * ks + 3]); pw.z = cvtpk(s0[8 * ks + 4], s0[8 * ks + 5]); pw.w = cvtpk(s0[8 * ks + 6], s0[8 * ks + 7]); }
                    else         { pw.x = cvtpk(s1[8 * ks], s1[8 * ks + 1]); pw.y = cvtpk(s1[8 * ks + 2], s1[8 * ks + 3]); pw.z = cvtpk(s1[8 * ks + 4], s1[8 * ks + 5]); pw.w = cvtpk(s1[8 * ks + 6], s1[8 * ks + 7]); }
                    const bf16x8 pb = __builtin_bit_cast(bf16x8, pw);
#pragma unroll
                    for (int dt = 0; dt < 2; ++dt) {
                        const LAS unsigned char* vp = vb + (32 * hf + 16 * ks + 4 * hi + tq) * VROWB + (32 * dt + 16 * blk + 4 * tp) * 2;
                        const v4i16_t lo = __builtin_amdgcn_ds_read_tr16_b64_v4i16((LAS v4i16_t*)vp);
                        const v4i16_t hv = __builtin_amdgcn_ds_read_tr16_b64_v4i16((LAS v4i16_t*)(vp + 8 * VROWB));
                        const bf16x8 va = (bf16x8){lo[0], lo[1], lo[2], lo[3], hv[0], hv[1], hv[2], hv[3]};
                        o[dt] = __builtin_amdgcn_mfma_f32_32x32x16_bf16(va, pb, o[dt], 0, 0, 0);
                    }
                }
        }
        if (!more) break;
        kt = ktn; buf ^= 1;
    }
    __syncthreads();
    { auto rr = __builtin_amdgcn_permlane32_swap(__float_as_uint(l), __float_as_uint(l), false, false); l = __uint_as_float(rr[0]) + __uint_as_float(rr[1]); }
#undef FA_GLOAD
#undef FA_LSTORE
}
template <int NQ> DEV void load_qf(bf16x8 (&qf)[NQ], const bf16_t* qrow, int hi) {
#pragma unroll
    for (int d0 = 0; d0 < NQ; ++d0) qf[d0] = *(const bf16x8*)(qrow + 16 * d0 + 8 * hi);
}
DEV void store_o(bf16_t* orow, const f32x16 (&o)[2], float sc, int hi) {
#pragma unroll
    for (int dt = 0; dt < 2; ++dt)
#pragma unroll
        for (int g = 0; g < 4; ++g) { u32x2 w; w.x = cvtpk(o[dt][4 * g] * sc, o[dt][4 * g + 1] * sc); w.y = cvtpk(o[dt][4 * g + 2] * sc, o[dt][4 * g + 3] * sc);
            *(u32x2*)(orow + 32 * dt + 8 * g + 4 * hi) = w; }
}
DEV unsigned long long expand4(unsigned m16) { unsigned long long r = 0ull;
#pragma unroll
    for (int j = 0; j < 16; ++j) if ((m16 >> j) & 1u) r |= 0xFull << (4 * j);
    return r; }
}


DEV void moba_gate(const Params& p, const Ctx& c);
namespace fc {
using namespace fa;
constexpr int CKROWB = 144, CVROWB = 320, CKB = 64 * CKROWB, CVB = 64 * CVROWB, CSTG = CKB + CVB, BINS_OFF = 2 * CSTG, BINW = 65;
static_assert(BINS_OFF + 4 * 64 * BINW * 4 <= RING_BYTES, "cmp unit LDS");
DEV void cmp_unit(const Params& p, const Ctx& c, int b, int cb) {
    LAS unsigned char* lds = c.lds;
    const int tid = c.tid, lane = c.lane, r32 = lane & 31, hi = lane >> 5, w = c.wave, h = w >> 1;
    const int t = cb * 64 + (w & 1) * 32 + r32; const size_t tok = (size_t)b * SEQ + t;
    const bf16_t* ACT = WSP(bf16_t, WS_ACT);
    const bf16_t* KCB = WSP(bf16_t, WS_MISC + MISC_KCB) + (size_t)b * 256 * 64; const bf16_t* VCB = WSP(bf16_t, WS_MISC + MISC_VCB) + (size_t)b * 256 * 64;
    bf16x8 qf[4]; load_qf<4>(qf, ACT + tok * ACTW + A_QA + h * 64, hi);
    const float nslope2 = -SLOPES[0][h] * LOG2E, c1 = 0.125f * LOG2E;
    const int tmaxu = cb * 64 + 63; const int nvmax = tmaxu >= 31 ? ((tmaxu - 31) >> 4) + 1 : 0;
    const int ntile = (nvmax + 63) >> 6;
    const int skey = tid >> 3, sch = tid & 7;
    const int i16 = lane & 15, tq = i16 >> 2, tp = i16 & 3, blk = (lane >> 4) & 1;
    f32x16 o[4]; float m = MFLOOR, l = 0.f;
#pragma unroll
    for (int dt = 0; dt < 4; ++dt)
#pragma unroll
        for (int i = 0; i < 16; ++i) o[dt][i] = 0.f;
    for (int kt = ntile - 1; kt >= 0; --kt) {
        const int buf = kt & 1;
        LAS unsigned char* st = lds + buf * CSTG;
        { const int n = kt * 64 + skey;
          *(LAS u32x4*)(st + skey * CKROWB + sch * 16) = *(const u32x4*)(KCB + (size_t)n * 64 + sch * 8);
          *(LAS u32x4*)(st + CKB + skey * CVROWB + sch * 16) = *(const u32x4*)(VCB + (size_t)n * 64 + sch * 8);
          unsigned cw[4];
#pragma unroll
          for (int e = 0; e < 4; ++e) { const int j0 = sch * 8 + 2 * e, j1 = j0 + 1; const int ja = n >> 2; const bool ex = (n & 3) == 3;
              const unsigned lo16 = (j0 == ja || (ex && j0 == ja + 1)) ? 0x3F80u : 0u, hi16 = (j1 == ja || (ex && j1 == ja + 1)) ? 0x3F80u : 0u; cw[e] = lo16 | (hi16 << 16); }
          *(LAS u32x4*)(st + CKB + skey * CVROWB + 128 + sch * 16) = (u32x4){cw[0], cw[1], cw[2], cw[3]}; }
        __syncthreads();
        const LAS unsigned char* kb = st; const LAS unsigned char* vb = st + CKB;
        f32x16 s0, s1;
#pragma unroll
        for (int i = 0; i < 16; ++i) { s0[i] = 0.f; s1[i] = 0.f; }
#pragma unroll
        for (int d0 = 0; d0 < 4; ++d0) {
            const bf16x8 k0 = *(const LAS bf16x8*)(kb + r32 * CKROWB + (16 * d0 + 8 * hi) * 2);
            const bf16x8 k1 = *(const LAS bf16x8*)(kb + (32 + r32) * CKROWB + (16 * d0 + 8 * hi) * 2);
            s0 = __builtin_amdgcn_mfma_f32_32x32x16_bf16(k0, qf[d0], s0, 0, 0, 0);
            s1 = __builtin_amdgcn_mfma_f32_32x32x16_bf16(k1, qf[d0], s1, 0, 0, 0);
        }
        const int db0 = (t - 31) - 16 * (kt * 64 + 4 * hi);
        float mx = -INFINITY;
#pragma unroll
        for (int i = 0; i < 16; ++i) { const int cr = (i & 3) + 8 * (i >> 2);
            { const int d = db0 - 16 * cr; float x = fmaf((float)d, nslope2, s0[i] * c1); x = (d >= 0) ? x : -INFINITY; s0[i] = x; mx = fmaxf(mx, x); }
            { const int d = db0 - 16 * (32 + cr); float x = fmaf((float)d, nslope2, s1[i] * c1); x = (d >= 0) ? x : -INFINITY; s1[i] = x; mx = fmaxf(mx, x); } }
        { auto rr = __builtin_amdgcn_permlane32_swap(__float_as_uint(mx), __float_as_uint(mx), false, false); mx = fmaxf(__uint_as_float(rr[0]), __uint_as_float(rr[1])); }
        const float mn = fmaxf(m, mx); const float alpha = __builtin_amdgcn_exp2f(m - mn); m = mn;
        float ls = 0.f;
#pragma unroll
        for (int i = 0; i < 16; ++i) { s0[i] = __builtin_amdgcn_exp2f(s0[i] - mn); s1[i] = __builtin_amdgcn_exp2f(s1[i] - mn); ls += s0[i] + s1[i]; }
        l = l * alpha + ls;
#pragma unroll
        for (int dt = 0; dt < 4; ++dt)
#pragma unroll
            for (int i = 0; i < 16; ++i) o[dt][i] *= alpha;
#pragma unroll
        for (int hf = 0; hf < 2; ++hf)
#pragma unroll
            for (int ks = 0; ks < 2; ++ks) {
                u32x4 pw;
                if (hf == 0) { pw.x = cvtpk(s0[8 * ks], s0[8 * ks + 1]); pw.y = cvtpk(s0[8 * ks + 2], s0[8 * ks + 3]); pw.z = cvtpk(s0[8 * ks + 4], s0[8 * ks + 5]); pw.w = cvtpk(s0[8 * ks + 6], s0[8 * ks + 7]); }
                else         { pw.x = cvtpk(s1[8 * ks], s1[8 * ks + 1]); pw.y = cvtpk(s1[8 * ks + 2], s1[8 * ks + 3]); pw.z = cvtpk(s1[8 * ks + 4], s1[8 * ks + 5]); pw.w = cvtpk(s1[8 * ks + 6], s1[8 * ks + 7]); }
                const bf16x8 pb = __builtin_bit_cast(bf16x8, pw);
#pragma unroll
                for (int dt = 0; dt < 4; ++dt) {
                    const LAS unsigned char* vp = vb + (32 * hf + 16 * ks + 4 * hi + tq) * CVROWB + (32 * dt + 16 * blk + 4 * tp) * 2;
                    const v4i16_t lo = __builtin_amdgcn_ds_read_tr16_b64_v4i16((LAS v4i16_t*)vp);
                    const v4i16_t hv = __builtin_amdgcn_ds_read_tr16_b64_v4i16((LAS v4i16_t*)(vp + 8 * CVROWB));
                    const bf16x8 va = (bf16x8){lo[0], lo[1], lo[2], lo[3], hv[0], hv[1], hv[2], hv[3]};
                    o[dt] = __builtin_amdgcn_mfma_f32_32x32x16_bf16(va, pb, o[dt], 0, 0, 0);
                }
            }
    }
    { auto rr = __builtin_amdgcn_permlane32_swap(__float_as_uint(l), __float_as_uint(l), false, false); l = __uint_as_float(rr[0]) + __uint_as_float(rr[1]); }
    const float inv = 1.f / fmaxf(l, 1e-30f);
    { float* oc = WSP(float, WS_OCMP) + tok * 256 + h * 64;
#pragma unroll
      for (int dt = 0; dt < 2; ++dt)
#pragma unroll
          for (int g = 0; g < 4; ++g) *(f32x4*)(oc + 32 * dt + 8 * g + 4 * hi) = (f32x4){o[dt][4 * g] * inv, o[dt][4 * g + 1] * inv, o[dt][4 * g + 2] * inv, o[dt][4 * g + 3] * inv}; }
    LAS float* bins = (LAS float*)(lds + BINS_OFF);
    { const int rowl = h * 64 + (w & 1) * 32 + r32;
#pragma unroll
      for (int dd = 0; dd < 2; ++dd)
#pragma unroll
          for (int i = 0; i < 16; ++i) bins[rowl * BINW + 32 * dd + (i & 3) + 8 * (i >> 2) + 4 * hi] = o[2 + dd][i] * inv; }
    __syncthreads();
    unsigned long long* SEL = WSP(unsigned long long, WS_SMALL + SM_SEL);
    for (int i = 0; i < 8; ++i) { const int tl = w * 8 + i; const int tt = cb * 64 + tl; const int cur = cb;
        const float ps = ((bins[(0 * 64 + tl) * BINW + lane] + bins[(1 * 64 + tl) * BINW + lane]) + bins[(2 * 64 + tl) * BINW + lane]) + bins[(3 * 64 + tl) * BINW + lane];
        const bool forced = (lane == 0) || (lane == cur) || (lane == cur - 1);
        float score = lane <= cur ? ps + (forced ? 1e4f : 0.f) : -1e30f;
        unsigned long long mask = 0ull;
        for (int r = 0; r < 8; ++r) {
            float bv = score; int bi = lane;
#define TK_STEP(M) { const float ov = swz_xor<M>(bv); const int oi = swz_xor_i<M>(bi); if (ov > bv || (ov == bv && oi < bi)) { bv = ov; bi = oi; } }
            TK_STEP(1) TK_STEP(2) TK_STEP(4) TK_STEP(8) TK_STEP(16)
#undef TK_STEP
            { auto rv = __builtin_amdgcn_permlane32_swap(__float_as_uint(bv), __float_as_uint(bv), false, false); auto ri = __builtin_amdgcn_permlane32_swap((unsigned)bi, (unsigned)bi, false, false);
              const float v0 = __uint_as_float(rv[0]), v1 = __uint_as_float(rv[1]); const int i0 = (int)ri[0], i1 = (int)ri[1];
              if (v1 > v0 || (v1 == v0 && i1 < i0)) { bv = v1; bi = i1; } else { bv = v0; bi = i0; } }
            if (bv > -5e29f) mask |= 1ull << bi;
            if (lane == bi) score = -INFINITY;
        }
        if (lane == 0) SEL[(size_t)b * SEQ + tt] = mask;
    }
    __syncthreads();
}
}
DEV void phase_cmpsel(const Params& p, const Ctx& c, int l) {
    for (int u = c.bid; u < 256; u += c.G) { const int v = (u * 37) & 255;
        fc::cmp_unit(p, c, v & 3, 63 - (v >> 2)); }
    moba_gate(p, c);
}

constexpr int CW_QUEUE = 16384 + 512;
constexpr int N_ATT_UNITS = 1024;
DEV void phase_attn2(const Params& p, const Ctx& c, int l) {
    using namespace fa;
    const bf16_t* ACT = WSP(bf16_t, WS_ACT); const bf16_t* ACT2 = WSP(bf16_t, WS_ACT2); bf16_t* BR = WSP(bf16_t, WS_BR);
    unsigned* qhead = WSP(unsigned, WS_CTL) + CW_QUEUE + l; l &= 7;
    volatile LAS unsigned* misc = (volatile LAS unsigned*)(c.lds + LDS_MISC);
    const int lane = c.lane, r32 = lane & 31, hi = lane >> 5, w = c.wave;
    for (;;) {
        if (c.tid == 0) { misc[0] = atomicAdd(qhead, 1u); misc[2] = 0u; misc[3] = 0u; }
        __syncthreads();
        const int u = (int)__builtin_amdgcn_readfirstlane(misc[0]);
        if (u >= N_ATT_UNITS) break;
        f32x16 o[2]; float m, ls;
        if (u < 512) {
            const int k = 15 - (u >> 5), r = u & 31, bh = r & 15, b = bh >> 2, h = bh & 3; const bool moba = (r >> 4) != 0;
            const int t = k * 256 + w * 32 + r32; const size_t tok = (size_t)b * SEQ + t; const size_t b0 = (size_t)b * SEQ;
            if (!moba) {
                bf16x8 qf[6]; load_qf<6>(qf, ACT2 + tok * ACT2W + A2_QF + h * 96, hi);
                const Src src{ACT2 + b0 * ACT2W + A2_KN + h * 64, ACT2W, ACT + b0 * ACTW + A_KR, ACTW, ACT2 + b0 * ACT2W + A2_VD + h * 64, ACT2W};
                const int nt = 4 * k + 4; const unsigned long long tm = nt >= 64 ? ~0ull : ((1ull << nt) - 1ull);
                const int nw = 4 * k + (w >> 1) + 1; const unsigned long long wm = nw >= 64 ? ~0ull : ((1ull << nw) - 1ull);
                __syncthreads();
                attn_pass<6, false, 0>(c.lds, c, src, qf, tm, wm, t, 0.f, 0.10206207261596575f * LOG2E, 0x7fffffffu, 0ull, 0, o, m, ls);
                store_o(BR + tok * 1024 + 768 + h * 64, o, 1.f / ls, hi);
            } else {
                bf16x8 qf[4]; load_qf<4>(qf, ACT + tok * ACTW + A_QC + h * 64, hi);
                const Src src{ACT + b0 * ACTW + A_KC + h * 64, ACTW, nullptr, 0, ACT + b0 * ACTW + A_VC + h * 64, ACTW};
                const unsigned rm = WSP(unsigned, WS_OWIN)[tok * 4 + h];
                const unsigned long long wor = wave_or64((unsigned long long)rm);
                if (lane == 0) atomicOr((unsigned*)&misc[2], (unsigned)wor);
                __syncthreads();
                const unsigned bor = __builtin_amdgcn_readfirstlane(misc[2]);
                const unsigned long long own_all = 0xFull << (4 * k);
                const int nw = (w >> 1) + 1; const unsigned long long own_w = ((1ull << nw) - 1ull) << (4 * k);
                const unsigned long long tm = uni64(expand4(bor) | own_all), wm = uni64(expand4((unsigned)wor) | own_w);
                attn_pass<4, true, 2>(c.lds, c, src, qf, tm, wm, t, -SLOPES[2][h] * LOG2E, 0.125f * LOG2E, 0x7fffffffu, (unsigned long long)rm, k, o, m, ls);
                store_o(BR + tok * 1024 + 512 + h * 64, o, 1.f / ls, hi);
            }
        } else if (u < 768) {
            const int v = u - 512, cb = 63 - (v >> 2), b = v & 3, h = w >> 1;
            const int t = cb * 64 + (w & 1) * 32 + r32; const size_t tok = (size_t)b * SEQ + t; const size_t b0 = (size_t)b * SEQ;
            bf16x8 qf[4]; load_qf<4>(qf, ACT + tok * ACTW + A_QA + h * 64, hi);
            const float nsl = -SLOPES[0][h] * LOG2E;
            const float* GA = WSP(float, WS_SMALL + SM_GA) + tok * 12 + h * 3; const float g0 = GA[0], g1 = GA[1], g2 = GA[2];
            const unsigned long long rm = WSP(unsigned long long, WS_SMALL + SM_SEL)[tok];
            const unsigned long long wor = wave_or64(rm);
            if (lane == 0) { atomicOr((unsigned*)&misc[2], (unsigned)wor); atomicOr((unsigned*)&misc[3], (unsigned)(wor >> 32)); }
            { const Src src{ACT + b0 * ACTW + A_KW, ACTW, nullptr, 0, ACT + b0 * ACTW + A_VW, ACTW};
              const int lo = cb >= 8 ? cb - 8 : 0; const unsigned long long upto = cb >= 63 ? ~0ull : ((1ull << (cb + 1)) - 1ull); const unsigned long long tm = upto & ~((1ull << lo) - 1ull);
              __syncthreads();
              attn_pass<4, true, 0>(c.lds, c, src, qf, tm, tm, t, nsl, 0.125f * LOG2E, 512u, 0ull, 0, o, m, ls); }
            f32x16 res[2]; { const float sc = g2 / ls;
#pragma unroll
              for (int dt = 0; dt < 2; ++dt)
#pragma unroll
                  for (int i = 0; i < 16; ++i) res[dt][i] = o[dt][i] * sc; }
            { const Src src{ACT + b0 * ACTW + A_KS, ACTW, nullptr, 0, ACT + b0 * ACTW + A_VS, ACTW};
              const unsigned long long tm = ((unsigned long long)__builtin_amdgcn_readfirstlane(misc[3]) << 32) | __builtin_amdgcn_readfirstlane(misc[2]);
              attn_pass<4, true, 1>(c.lds, c, src, qf, tm, wor, t, nsl, 0.125f * LOG2E, 0x7fffffffu, rm, 0, o, m, ls); }
            { const float sc = g1 / ls; const float* oc = WSP(float, WS_OCMP) + tok * 256 + h * 64;
#pragma unroll
              for (int dt = 0; dt < 2; ++dt)
#pragma unroll
                  for (int g = 0; g < 4; ++g) { const f32x4 cv = *(const f32x4*)(oc + 32 * dt + 8 * g + 4 * hi);
#pragma unroll
                      for (int e = 0; e < 4; ++e) res[dt][4 * g + e] += o[dt][4 * g + e] * sc + g0 * cv[e]; } }
            store_o(BR + tok * 1024 + h * 64, res, 1.f, hi);
        } else {
            const int v = u - 768, b = v >> 6, g = (v >> 5) & 1, cc = v & 31, hr = w >> 2, h = 2 * g + hr;
            const int t = cc * 128 + (w & 3) * 32 + r32; const size_t tok = (size_t)b * SEQ + t; const size_t b0 = (size_t)b * SEQ;
            bf16x8 qf[4]; load_qf<4>(qf, ACT + tok * ACTW + A_QB + h * 64, hi);
            const Src src{ACT + b0 * ACTW + A_KB + g * 64, ACTW, nullptr, 0, ACT + b0 * ACTW + A_VB + g * 64, ACTW};
            const int lo = cc >= 1 ? 2 * cc - 2 : 0; const int hiT = 2 * cc + 1; const unsigned long long upto = hiT >= 63 ? ~0ull : ((1ull << (hiT + 1)) - 1ull);
            const unsigned long long tm = upto & ~((1ull << lo) - 1ull);
            const unsigned long long wm = ((w & 3) < 2) ? (tm & ~(1ull << hiT)) : tm;
            __syncthreads();
            attn_pass<4, true, 0>(c.lds, c, src, qf, tm, wm, t, -SLOPES[1][h] * LOG2E, 0.125f * LOG2E, 128u, 0ull, 0, o, m, ls);
            const float sk2 = p.in[10][l * 4 + h] * LOG2E; const float mf = fmaxf(m, sk2); const float a = __builtin_amdgcn_exp2f(m - mf); const float den = ls * a + __builtin_amdgcn_exp2f(sk2 - mf);
            store_o(BR + tok * 1024 + 256 + h * 64, o, a / den, hi);
        }
        __syncthreads();
    }
}
DEV void moba_gate(const Params& p, const Ctx& c) {
    const bf16_t* ACT = WSP(bf16_t, WS_ACT); unsigned* MS = WSP(unsigned, WS_OWIN);
    for (int it = c.gw; it < 1024; it += c.NGW) {
        int b, g, h; item_bgh(it, b, g, h); const int t = g * 64 + c.lane; const size_t tok = (size_t)b * SEQ + t; const int nb = g >> 2;
        float q[64]; load_q<64>(q, ACT + tok * ACTW + A_QC + h * 64);
        const float* KM = WSP(float, WS_MISC + MISC_KMEAN) + (size_t)b * 16 * 256 + h * 64;
        float v1 = -INFINITY, v2 = -INFINITY, v3 = -INFINITY; int i1 = -1, i2 = -1, i3 = -1;
        for (int n = 0; n < nb; ++n) { const float* km = KM + n * 256; float dsum = 0.f;
#pragma unroll
            for (int d = 0; d < 64; ++d) dsum += q[d] * km[d];
            if (dsum > v1) { v3 = v2; i3 = i2; v2 = v1; i2 = i1; v1 = dsum; i1 = n; }
            else if (dsum > v2) { v3 = v2; i3 = i2; v2 = dsum; i2 = n; }
            else if (dsum > v3) { v3 = dsum; i3 = n; } }
        unsigned mk = 0u; if (i1 >= 0) mk |= 1u << i1; if (i2 >= 0) mk |= 1u << i2; if (i3 >= 0) mk |= 1u << i3;
        MS[tok * 4 + h] = mk;
    }
}
DEV void phase_cmpw2(const Params& p, const Ctx& c, int l) {
    const int lane = c.lane;
    const bf16_t* HID = WSP(bf16_t, WS_HID); float* KC = WSP(float, WS_MISC + MISC_KCMP); float* VC = WSP(float, WS_MISC + MISC_VCMP);
    const float* gq = p.in[6] + (size_t)l * 10 * 64;
    for (int it = c.gw; it < 2 * 1020; it += c.NGW) { const int kv = it / 1020, r = it % 1020;
        const float* w2 = p.in[9] + (size_t)(l * 2 + kv) * 256 * 64; const bf16_t* hrow = HID + ((size_t)kv * 1024 + r) * 256;
        float a = 0.f;
        for (int k = 0; k < 256; ++k) a += bf2f(hrow[k]) * w2[k * 64 + lane];
        const int b = r / 255, i = r % 255;
        bf16_t* KCB = WSP(bf16_t, WS_MISC + MISC_KCB); bf16_t* VCB = WSP(bf16_t, WS_MISC + MISC_VCB);
        if (kv == 0) KCB[(b * 256 + i) * 64 + lane] = (bf16_t)f2bf(head_norm(a, gq + 1 * 64, lane)); else VCB[(b * 256 + i) * 64 + lane] = (bf16_t)f2bf(a);
        if (i == 0) { if (kv == 0) KCB[(b * 256 + 255) * 64 + lane] = 0; else VCB[(b * 256 + 255) * 64 + lane] = 0; } }
}

template <int NB> struct FMerge { const bf16_t* GATES; float* MIX; bf16_t* MIXB;
    DEV void operator()(int row, int col, const f32x4& v0, const f32x4& v1) const {
        const u32x4 gw = *(const u32x4*)(GATES + (size_t)row * NGATE + NB * 1024 + col);
        f32x4 a = (f32x4){bflo(gw.x), bfhi(gw.x), bflo(gw.y), bfhi(gw.y)} * v0, b = (f32x4){bflo(gw.z), bfhi(gw.z), bflo(gw.w), bfhi(gw.w)} * v1;
        float* mx = MIX + (size_t)row * 1024 + col;
        if (NB > 0) { a += *(const f32x4*)mx; b += *(const f32x4*)(mx + 4); }
        if (NB < 3) { *(f32x4*)mx = a; *(f32x4*)(mx + 4) = b; }
        else { u32x4 w; w.x = pk2(a[0], a[1]); w.y = pk2(a[2], a[3]); w.z = pk2(b[0], b[1]); w.w = pk2(b[2], b[3]); *(u32x4*)(MIXB + (size_t)row * 1024 + col) = w; } } };
template <int NB> DEV void phase_merge(const Params& p, const Ctx& c, int l) {
    pg8::Gemm g{WSP(bf16_t, WS_BR) + NB * 256, WSP(bf16_t, WS_WBR) + (size_t)(l * 4 + NB) * 1024 * 256, 1024, 256};
    pg8::StaticOrder S; S.init(NTOK, 1024, c.G, c.bid);
    pg8::Epi8<FMerge<NB>> E{{WSP(bf16_t, WS_GATES), (float*)(p.ws + WS_BIG + BIG_MIX), (bf16_t*)(p.ws + WS_BIG + BIG_MIXB)}};
    pg8::gemm_phase<pg8::Epi8<FMerge<NB>>, pg8::StaticOrder, true>(c.lds, g, S, E);
}
struct FOut { float* X; const float* g1;
    DEV void operator()(int row, int col, const f32x4& v0, const f32x4& v1) const { const float* gg = g1 + (row / SEQ) * 6144 + col; float* x = X + (size_t)row * DM + col;
        *(f32x4*)x = *(const f32x4*)x + *(const f32x4*)gg * v0; *(f32x4*)(x + 4) = *(const f32x4*)(x + 4) + *(const f32x4*)(gg + 4) * v1; } };
DEV void phase_out(const Params& p, const Ctx& c, int l) {
    pg8::Gemm g{(const bf16_t*)(p.ws + WS_BIG + BIG_MIXB), WSP(bf16_t, WS_WOUT) + (size_t)l * 1024 * 1024, 1024, 1024};
    pg8::StaticOrder S; S.init(NTOK, 1024, c.G, c.bid);
    pg8::Epi8<FOut> E{{p.out, WSP(float, WS_MOD) + (size_t)l * 4 * 6144 + 2048}};
    pg8::gemm_phase<pg8::Epi8<FOut>, pg8::StaticOrder, true>(c.lds, g, S, E);
}

template <bool COUNT> DEV void phase_router(const Params& p, const Ctx& c, int l) {
    const float* MOD = WSP(float, WS_MOD); bf16_t* H2B = WSP(bf16_t, WS_HBF);
    int* EID = WSP(int, WS_MISC + MISC_EID); float* WTS = WSP(float, WS_MISC + MISC_WTS); unsigned* ctl = WSP(unsigned, WS_CTL);
    const float* WRT = WSP(float, WS_MISC + MISC_WRT) + (size_t)l * 36 * 1024;
    const int lane = c.lane;
    for (int row = c.gw; row < NTOK; row += c.NGW) {
        const int b = row / SEQ;
        f32x4 v[4]; float ss = 0.f;
#pragma unroll
        for (int j = 0; j < 4; ++j) { v[j] = *(const f32x4*)(p.out + (size_t)row * DM + j * 256 + lane * 4); ss += (v[j][0] * v[j][0] + v[j][1] * v[j][1]) + (v[j][2] * v[j][2] + v[j][3] * v[j][3]); }
        const float r = rsqrtf(wave_sum(ss) * (1.f / DM) + EPS);
        const float* gn = p.in[4] + (size_t)(l * 2 + 1) * DM; const float* sh = MOD + (l * 4 + b) * 6144 + 3072; const float* sc = sh + 1024;
#pragma unroll
        for (int j = 0; j < 4; ++j) { const int col = j * 256 + lane * 4;
            const f32x4 g = *(const f32x4*)(gn + col), s1 = *(const f32x4*)(sc + col), s0 = *(const f32x4*)(sh + col);
            v[j] = v[j] * r * g * (s1 + 1.f) + s0;
            u32x2 o; o.x = pk2(v[j][0], v[j][1]); o.y = pk2(v[j][2], v[j][3]); *(u32x2*)(H2B + (size_t)row * DM + col) = o; }
        LAS float* lgs = (LAS float*)(c.lds + c.wave * 256);
#pragma unroll 1
        for (int eg = 0; eg < 9; ++eg) { float a4[4];
#pragma unroll
            for (int u = 0; u < 4; ++u) { const float* wr = WRT + (eg * 4 + u) * 1024 + lane * 4; float a = 0.f;
#pragma unroll
                for (int j = 0; j < 4; ++j) { const f32x4 wv = *(const f32x4*)(wr + j * 256); a += (v[j][0] * wv[0] + v[j][1] * wv[1]) + (v[j][2] * wv[2] + v[j][3] * wv[3]); }
                a4[u] = a; }
#pragma unroll
            for (int u = 0; u < 4; ++u) a4[u] = wave_sum(a4[u]);
            if (lane == 0) *(LAS f32x4*)(lgs + eg * 4) = (f32x4){a4[0], a4[1], a4[2], a4[3]}; }
        LDS_WAIT(); asm volatile("" ::: "memory");
        float lc[4];
#pragma unroll
        for (int i = 0; i < 4; ++i) lc[i] = lgs[i] + p.in[19][l * 4 + i];
        int grp = 0; float mx = lc[0];
#pragma unroll
        for (int i = 1; i < 4; ++i) if (lc[i] > mx) { mx = lc[i]; grp = i; }
        float z = 0.f;
#pragma unroll
        for (int i = 0; i < 4; ++i) z += __expf(lc[i] - mx);
        const float pg = 1.f / z;
        float f1 = -INFINITY, f2 = -INFINITY; int e1 = 0, e2 = 0;
#pragma unroll
        for (int i = 0; i < 8; ++i) { const float x = lgs[4 + grp * 8 + i] + p.in[21][l * 32 + grp * 8 + i];
            if (x > f1) { f2 = f1; e2 = e1; f1 = x; e1 = i; } else if (x > f2) { f2 = x; e2 = i; } }
        LDS_WAIT(); asm volatile("" ::: "memory");
        const float q2 = __expf(f2 - f1); const float w1 = pg / (1.f + q2), w2 = pg * q2 / (1.f + q2);
        const int x1 = grp * 8 + e1, x2 = grp * 8 + e2;
        if (lane == 0) { EID[row * 2] = x1; EID[row * 2 + 1] = x2; WTS[row * 2] = w1; WTS[row * 2 + 1] = w2;
            if (COUNT) { atomicAdd(&ctl[CW_CNT + l * 32 + x1], 1u); atomicAdd(&ctl[CW_CNT + l * 32 + x2], 1u); } }
    }
}

struct MoeTab { LAS int* start; LAS int* tile_e; LAS int* ntiles; };
DEV MoeTab build_moe_tab(const Params& p, const Ctx& c, int l) {
    MoeTab T; T.start = (LAS int*)(c.lds + LDS_AUX + 1024); T.tile_e = T.start + 32; T.ntiles = T.tile_e + 192;
    __syncthreads();
    if (c.tid == 0) { const unsigned* cnt = WSP(unsigned, WS_CTL) + CW_CNT + l * 32; int row = 0, nt = 0;
        for (int e = 0; e < 32; ++e) { const int n = (int)__hip_atomic_load(cnt + e, __ATOMIC_RELAXED, __HIP_MEMORY_SCOPE_AGENT); T.start[e] = row; const int tiles = (n + 255) >> 8;
            for (int i = 0; i < tiles; ++i) T.tile_e[nt + i] = e;
            nt += tiles; row += tiles * 256; }
        T.ntiles[0] = nt; }
    __syncthreads();
    return T;
}
DEV void phase_moesort(const Params& p, const Ctx& c, int l) {
    const MoeTab T = build_moe_tab(p, c, l);
    const int* EID = WSP(int, WS_MISC + MISC_EID); int* PSLOT = WSP(int, WS_MISC + MISC_PSLOT); unsigned* cur = WSP(unsigned, WS_CTL) + CW_CUR + l * 32;
    const bf16_t* H2B = WSP(bf16_t, WS_HBF); bf16_t* XS = (bf16_t*)(p.ws + WS_BIG + BIG_XS);
    const int lane = c.lane;
    for (int tok = c.gw; tok < NTOK; tok += c.NGW) {
        const u32x4 a = *(const u32x4*)(H2B + (size_t)tok * DM + lane * 16), b2 = *(const u32x4*)(H2B + (size_t)tok * DM + lane * 16 + 8);
#pragma unroll
        for (int k = 0; k < 2; ++k) { const int e = EID[tok * 2 + k]; int slot = 0;
            if (lane == 0) slot = T.start[e] + (int)atomicAdd(&cur[e], 1u);
            slot = __builtin_amdgcn_readfirstlane(slot);
            if (lane == 0) PSLOT[tok * 2 + k] = slot;
            *(u32x4*)(XS + (size_t)slot * DM + lane * 16) = a; *(u32x4*)(XS + (size_t)slot * DM + lane * 16 + 8) = b2; }
    }
}
template <int NCOL> struct MoeOrder { int G, c; LAS const int* tile_e; int ntiles;
    DEV bool next(int i, pg8::Unit& u) const { const int L = i * G + c; if (L >= ntiles * NCOL) return false; const int pm = L / NCOL; u.pm = pm; u.pn = tile_e[pm] * NCOL + (L % NCOL); return true; } };
struct FMoe1 { bf16_t* ACTB;
    DEV void operator()(int row, int col, const f32x4& v0, const f32x4& v1) const { const int ce = col & 511;
        u32x2 w; w.x = pk2(silu_(v0[0]) * v0[1], silu_(v0[2]) * v0[3]); w.y = pk2(silu_(v1[0]) * v1[1], silu_(v1[2]) * v1[3]);
        *(u32x2*)(ACTB + (size_t)row * 256 + (ce >> 1)) = w; } };
struct FMoe2 { bf16_t* YP;
    DEV void operator()(int row, int col, const f32x4& v0, const f32x4& v1) const { const int ce = col & 1023;
        u32x4 w; w.x = pk2(v0[0], v0[1]); w.y = pk2(v0[2], v0[3]); w.z = pk2(v1[0], v1[1]); w.w = pk2(v1[2], v1[3]); *(u32x4*)(YP + (size_t)row * DM + ce) = w; } };
DEV void phase_moe1(const Params& p, const Ctx& c, int l) {
    const MoeTab T = build_moe_tab(p, c, l);
    pg8::Gemm g{(const bf16_t*)(p.ws + WS_BIG + BIG_XS), WSP(bf16_t, WS_W13) + (size_t)l * 32 * 512 * 1024, 1024, 1024};
    MoeOrder<2> S{c.G, c.bid, T.tile_e, T.ntiles[0]}; pg8::Epi8<FMoe1> E{{WSP(bf16_t, WS_MUR)}};
    pg8::gemm_phase<pg8::Epi8<FMoe1>, MoeOrder<2>, true>(c.lds, g, S, E);
}
DEV void phase_moe2(const Params& p, const Ctx& c, int l) {
    const MoeTab T = build_moe_tab(p, c, l);
    pg8::Gemm g{WSP(bf16_t, WS_MUR), WSP(bf16_t, WS_W2) + (size_t)l * 32 * 1024 * 256, 256, 256};
    MoeOrder<4> S{c.G, c.bid, T.tile_e, T.ntiles[0]}; pg8::Epi8<FMoe2> E{{(bf16_t*)(p.ws + WS_BIG + BIG_YP)}};
    pg8::gemm_phase<pg8::Epi8<FMoe2>, MoeOrder<4>, true>(c.lds, g, S, E);
}

constexpr int PH_PRO = 0, PH_NORM1 = 1, PH_INPROJ = 2, PH_POST = 3, PH_MLAUP = 4, PH_POST2 = 5, PH_ATTN = 6, PH_CMPATTN = 7, PH_TOPK = 8, PH_SLC = 9,
              PH_MERGE0 = 10, PH_MERGE1 = 11, PH_MERGE2 = 12, PH_MERGE3 = 13, PH_OUT = 14, PH_ROUTER = 15, PH_SORT = 16, PH_MOE1 = 17, PH_MOE2 = 18, PH_FINAL = 19, PH_COUNT = 20;
constexpr int LDS_PTAB = LDS_AUX + 64;
DEV unsigned long long uni64(unsigned long long v) { const unsigned lo = __builtin_amdgcn_readfirstlane((unsigned)v), hi = __builtin_amdgcn_readfirstlane((unsigned)(v >> 32)); return ((unsigned long long)hi << 32) | lo; }
DEV void store_params(const Params& p, LAS unsigned char* lds) {
    LAS unsigned long long* L = (LAS unsigned long long*)(lds + LDS_PTAB);
    if (threadIdx.x == 0) {
#pragma unroll
        for (int i = 0; i < 24; ++i) L[i] = (unsigned long long)p.in[i];
        L[24] = (unsigned long long)p.out; L[25] = (unsigned long long)p.ws; }
}
DEV Params load_params(LAS unsigned char* lds) {
    const LAS unsigned long long* L = (const LAS unsigned long long*)(lds + LDS_PTAB); Params p;
#pragma unroll
    for (int i = 0; i < 24; ++i) p.in[i] = (const float*)uni64(L[i]);
    p.out = (float*)uni64(L[24]); p.ws = (unsigned char*)uni64(L[25]); return p;
}
template <int PH, int REP = 0> DEV void run_phase(const Params& p, const Ctx& c, int l) {
    if constexpr (PH == PH_PRO) phase_prologue(p, c);
    else if constexpr (PH == PH_NORM1) phase_norm1<true>(p, c, l);
    else if constexpr (PH == PH_INPROJ) phase_inproj(p, c, l);
    else if constexpr (PH == PH_POST) phase_post(p, c, l);
    else if constexpr (PH == PH_MLAUP) phase_mlaup(p, c, l);
    else if constexpr (PH == PH_POST2) phase_post2(p, c, l);
    else if constexpr (PH == PH_ATTN) phase_cmpw2(p, c, l);
    else if constexpr (PH == PH_CMPATTN) phase_cmpsel(p, c, l);
    else if constexpr (PH == PH_TOPK) { }
    else if constexpr (PH == PH_SLC) phase_attn2(p, c, l + 8 * REP);
    else if constexpr (PH == PH_MERGE0) phase_merge<0>(p, c, l);
    else if constexpr (PH == PH_MERGE1) phase_merge<1>(p, c, l);
    else if constexpr (PH == PH_MERGE2) phase_merge<2>(p, c, l);
    else if constexpr (PH == PH_MERGE3) phase_merge<3>(p, c, l);
    else if constexpr (PH == PH_OUT) phase_out(p, c, l);
    else if constexpr (PH == PH_ROUTER) phase_router<REP == 0>(p, c, l);
    else if constexpr (PH == PH_SORT) phase_moesort(p, c, l);
    else if constexpr (PH == PH_MOE1) phase_moe1(p, c, l);
    else if constexpr (PH == PH_MOE2) phase_moe2(p, c, l);
    else if constexpr (PH == PH_FINAL) phase_norm1<false>(p, c, NLAYER);
}

#if !MK_ONE_LAUNCH
template <int PH> __global__ void __launch_bounds__(512, 2) k_phase(Params p, int l) {
    extern __shared__ __attribute__((aligned(16))) unsigned char lds_raw[];
    const Ctx c = make_ctx((LAS unsigned char*)lds_raw);
    run_phase<PH>(p, c, l);
}
template <int PH> static void launch_phase(const Params& p, int l, int grid, hipStream_t stream) {
    static bool attr_set = false;
    if (!attr_set) { (void)hipFuncSetAttribute((const void*)k_phase<PH>, hipFuncAttributeMaxDynamicSharedMemorySize, LDS_BYTES); attr_set = true; }
    hipLaunchKernelGGL(k_phase<PH>, dim3(grid), dim3(512), LDS_BYTES, stream, p, l);
}
#else
#define BAR() xcd_barrier_fn(bar.bar, bar.x, bar.st)
template <int l> DEV void mega_layer(LAS unsigned char* lds, const XcdBarrier& bar) {
        { const Ctx c = make_ctx(lds); const Params q = load_params(lds); run_phase<PH_NORM1>(q, c, l); } BAR(); if constexpr ((PROBE_MASK >> PH_NORM1) & 1u) { { const Ctx c = make_ctx(lds); const Params q = load_params(lds); run_phase<PH_NORM1, 1>(q, c, l); } BAR(); }
        { const Ctx c = make_ctx(lds); const Params q = load_params(lds); run_phase<PH_INPROJ>(q, c, l); } BAR(); if constexpr ((PROBE_MASK >> PH_INPROJ) & 1u) { { const Ctx c = make_ctx(lds); const Params q = load_params(lds); run_phase<PH_INPROJ, 1>(q, c, l); } BAR(); }
        { const Ctx c = make_ctx(lds); const Params q = load_params(lds); run_phase<PH_POST>(q, c, l); } BAR(); if constexpr ((PROBE_MASK >> PH_POST) & 1u) { { const Ctx c = make_ctx(lds); const Params q = load_params(lds); run_phase<PH_POST, 1>(q, c, l); } BAR(); }
        { const Ctx c = make_ctx(lds); const Params q = load_params(lds); run_phase<PH_MLAUP>(q, c, l); } BAR(); if constexpr ((PROBE_MASK >> PH_MLAUP) & 1u) { { const Ctx c = make_ctx(lds); const Params q = load_params(lds); run_phase<PH_MLAUP, 1>(q, c, l); } BAR(); }
        { const Ctx c = make_ctx(lds); const Params q = load_params(lds); run_phase<PH_POST2>(q, c, l); } BAR(); if constexpr ((PROBE_MASK >> PH_POST2) & 1u) { { const Ctx c = make_ctx(lds); const Params q = load_params(lds); run_phase<PH_POST2, 1>(q, c, l); } BAR(); }
        { const Ctx c = make_ctx(lds); const Params q = load_params(lds); run_phase<PH_ATTN>(q, c, l); } BAR(); if constexpr ((PROBE_MASK >> PH_ATTN) & 1u) { { const Ctx c = make_ctx(lds); const Params q = load_params(lds); run_phase<PH_ATTN, 1>(q, c, l); } BAR(); }
        { const Ctx c = make_ctx(lds); const Params q = load_params(lds); run_phase<PH_CMPATTN>(q, c, l); } BAR(); if constexpr ((PROBE_MASK >> PH_CMPATTN) & 1u) { { const Ctx c = make_ctx(lds); const Params q = load_params(lds); run_phase<PH_CMPATTN, 1>(q, c, l); } BAR(); }
        { const Ctx c = make_ctx(lds); const Params q = load_params(lds); run_phase<PH_SLC>(q, c, l); } BAR(); if constexpr ((PROBE_MASK >> PH_SLC) & 1u) { { const Ctx c = make_ctx(lds); const Params q = load_params(lds); run_phase<PH_SLC, 1>(q, c, l); } BAR(); }
        { const Ctx c = make_ctx(lds); const Params q = load_params(lds); run_phase<PH_MERGE0>(q, c, l); } BAR(); if constexpr ((PROBE_MASK >> PH_MERGE0) & 1u) { { const Ctx c = make_ctx(lds); const Params q = load_params(lds); run_phase<PH_MERGE0, 1>(q, c, l); } BAR(); }
        { const Ctx c = make_ctx(lds); const Params q = load_params(lds); run_phase<PH_MERGE1>(q, c, l); } BAR(); if constexpr ((PROBE_MASK >> PH_MERGE1) & 1u) { { const Ctx c = make_ctx(lds); const Params q = load_params(lds); run_phase<PH_MERGE1, 1>(q, c, l); } BAR(); }
        { const Ctx c = make_ctx(lds); const Params q = load_params(lds); run_phase<PH_MERGE2>(q, c, l); } BAR(); if constexpr ((PROBE_MASK >> PH_MERGE2) & 1u) { { const Ctx c = make_ctx(lds); const Params q = load_params(lds); run_phase<PH_MERGE2, 1>(q, c, l); } BAR(); }
        { const Ctx c = make_ctx(lds); const Params q = load_params(lds); run_phase<PH_MERGE3>(q, c, l); } BAR(); if constexpr ((PROBE_MASK >> PH_MERGE3) & 1u) { { const Ctx c = make_ctx(lds); const Params q = load_params(lds); run_phase<PH_MERGE3, 1>(q, c, l); } BAR(); }
        { const Ctx c = make_ctx(lds); const Params q = load_params(lds); run_phase<PH_OUT>(q, c, l); } BAR(); if constexpr ((PROBE_MASK >> PH_OUT) & 1u) { { const Ctx c = make_ctx(lds); const Params q = load_params(lds); run_phase<PH_OUT, 1>(q, c, l); } BAR(); }
        { const Ctx c = make_ctx(lds); const Params q = load_params(lds); run_phase<PH_ROUTER>(q, c, l); } BAR(); if constexpr ((PROBE_MASK >> PH_ROUTER) & 1u) { { const Ctx c = make_ctx(lds); const Params q = load_params(lds); run_phase<PH_ROUTER, 1>(q, c, l); } BAR(); }
        { const Ctx c = make_ctx(lds); const Params q = load_params(lds); run_phase<PH_SORT>(q, c, l); } BAR(); if constexpr ((PROBE_MASK >> PH_SORT) & 1u) { { const Ctx c = make_ctx(lds); const Params q = load_params(lds); run_phase<PH_SORT, 1>(q, c, l); } BAR(); }
        { const Ctx c = make_ctx(lds); const Params q = load_params(lds); run_phase<PH_MOE1>(q, c, l); } BAR(); if constexpr ((PROBE_MASK >> PH_MOE1) & 1u) { { const Ctx c = make_ctx(lds); const Params q = load_params(lds); run_phase<PH_MOE1, 1>(q, c, l); } BAR(); }
        { const Ctx c = make_ctx(lds); const Params q = load_params(lds); run_phase<PH_MOE2>(q, c, l); } BAR(); if constexpr ((PROBE_MASK >> PH_MOE2) & 1u) { { const Ctx c = make_ctx(lds); const Params q = load_params(lds); run_phase<PH_MOE2, 1>(q, c, l); } BAR(); }
}
__global__ void __launch_bounds__(512, 2) k_mega(Params p) {
    extern __shared__ __attribute__((aligned(16))) unsigned char lds_raw[];
    LAS unsigned char* lds = (LAS unsigned char*)lds_raw;
    volatile LAS unsigned* bst = (volatile LAS unsigned*)(lds + LDS_AUX);
    if (threadIdx.x < 4) bst[threadIdx.x] = 0u;
    store_params(p, lds);
    __syncthreads();
    const XcdBarrier bar = xcd_barrier_post(WSP(unsigned, WS_CTL) + CW_BAR, bst);
    { const Ctx c = make_ctx(lds); const Params q = load_params(lds); run_phase<PH_PRO>(q, c, 0); } BAR(); if constexpr ((PROBE_MASK >> PH_PRO) & 1u) { { const Ctx c = make_ctx(lds); const Params q = load_params(lds); run_phase<PH_PRO, 1>(q, c, 0); } BAR(); }
    mega_layer<0>(lds, bar); mega_layer<1>(lds, bar); mega_layer<2>(lds, bar); mega_layer<3>(lds, bar);
    { const Ctx c = make_ctx(lds); const Params q = load_params(lds); run_phase<PH_FINAL>(q, c, NLAYER); }
#undef BAR
}
#endif

extern "C" void kernel_launch(void* const* d_in, const int* in_sizes, int n_in, void* d_out, int out_size, void* d_ws, size_t ws_size, hipStream_t stream) {
    if (n_in != 24 || out_size != NTOK * DM || ws_size < WS_END) { fprintf(stderr, "kernel_launch: unexpected shapes (n_in %d out %d ws %zu, need %zu)\n", n_in, out_size, ws_size, (size_t)WS_END); return; }
    Params p{};
    for (int i = 0; i < 24; ++i) p.in[i] = (const float*)d_in[i];
    p.out = (float*)d_out; p.ws = (unsigned char*)d_ws;
    (void)hipMemsetAsync((char*)d_ws + WS_CTL, 0, 1 * MiB, stream);
    const int grid = 256;
#if !MK_ONE_LAUNCH
    launch_phase<PH_PRO>(p, 0, grid, stream);
    for (int l = 0; l < NLAYER; ++l) {
        launch_phase<PH_NORM1>(p, l, grid, stream);
        launch_phase<PH_INPROJ>(p, l, grid, stream);
        launch_phase<PH_POST>(p, l, grid, stream);
        launch_phase<PH_MLAUP>(p, l, grid, stream);
        launch_phase<PH_POST2>(p, l, grid, stream);
        launch_phase<PH_ATTN>(p, l, grid, stream);
        launch_phase<PH_CMPATTN>(p, l, grid, stream);
        launch_phase<PH_SLC>(p, l, grid, stream);
        launch_phase<PH_MERGE0>(p, l, grid, stream);
        launch_phase<PH_MERGE1>(p, l, grid, stream);
        launch_phase<PH_MERGE2>(p, l, grid, stream);
        launch_phase<PH_MERGE3>(p, l, grid, stream);
        launch_phase<PH_OUT>(p, l, grid, stream);
        launch_phase<PH_ROUTER>(p, l, grid, stream);
        launch_phase<PH_SORT>(p, l, grid, stream);
        launch_phase<PH_MOE1>(p, l, grid, stream);
        launch_phase<PH_MOE2>(p, l, grid, stream);
    }
    launch_phase<PH_FINAL>(p, NLAYER, grid, stream);
#else
    static bool attr_set = false;
    if (!attr_set) { (void)hipFuncSetAttribute((const void*)k_mega, hipFuncAttributeMaxDynamicSharedMemorySize, LDS_BYTES); attr_set = true; }
    hipLaunchKernelGGL(k_mega, dim3(grid), dim3(512), LDS_BYTES, stream, p);
#endif
}
```

```cpp
#include <hip/hip_runtime.h>
#include <cstdio>
#include <cstdint>
#include <cmath>

#ifndef MK_ONE_LAUNCH
#define MK_ONE_LAUNCH 1
#endif
#ifndef PROBE_MASK
#define PROBE_MASK 0u
#endif

#define DEV __device__ __forceinline__
#define LAS __attribute__((address_space(3)))
typedef unsigned short bf16_t;
typedef short bf16x8 __attribute__((ext_vector_type(8)));
typedef float f32x4 __attribute__((ext_vector_type(4)));
typedef unsigned u32x4 __attribute__((ext_vector_type(4)));
typedef unsigned u32x2 __attribute__((ext_vector_type(2)));

constexpr int NBATCH = 4, SEQ = 4096, DM = 1024, NTOK = NBATCH * SEQ, NLAYER = 4;
constexpr int DIN = 6572, NSMALL = 2476, PSW = 2560, NPROJ = 6656, NGATE = 4096;
constexpr int I_QA = 0, I_KC = 256, I_VC = 320, I_KS = 384, I_VS = 448, I_KW = 512, I_VW = 576, I_GL = 640, I_QB = 652, I_KB = 908, I_VB = 1036,
              I_QC = 1164, I_KCC = 1420, I_VCC = 1676, I_CQ = 1932, I_CKV = 2316, I_KR = 2444;
constexpr int ACTW = 2560;
constexpr int A_QA = 0, A_KCR = 256, A_VCR = 320, A_KS = 384, A_VS = 448, A_KW = 512, A_VW = 576, A_QB = 640, A_KB = 896, A_VB = 1024,
              A_QC = 1152, A_KC = 1408, A_VC = 1664, A_CQ = 1920, A_CKV = 2304, A_KR = 2432;
constexpr int ACT2W = 896, A2_QF = 0, A2_KN = 384, A2_VD = 640;
constexpr int NCMP = 255, NEXP = 32, XS_ROWS = 40960;
constexpr float EPS = 1e-6f;
__device__ const float SLOPES[3][4] = {{0.70710678118654752f, 0.25f, 0.08838834764831845f, 0.015625f},
                                       {0.5f, 0.17677669529663689f, 0.0625f, 0.0078125f},
                                       {0.35355339059327379f, 0.125f, 0.03125f, 0.00390625f}};

constexpr size_t MiB = 1u << 20;
constexpr size_t WS_CTL = 0;
constexpr size_t WS_MOD = 1 * MiB;
constexpr size_t WS_ROPE = 2 * MiB;
constexpr size_t WS_MISC = 3 * MiB;
constexpr size_t WS_WIN = 8 * MiB;
constexpr size_t WS_W13 = WS_WIN + 56 * MiB;
constexpr size_t WS_W2 = WS_W13 + 128 * MiB;
constexpr size_t WS_WOUT = WS_W2 + 64 * MiB;
constexpr size_t WS_WBR = WS_WOUT + 8 * MiB;
constexpr size_t WS_CW1 = WS_WBR + 8 * MiB;
constexpr size_t WS_WU = WS_CW1 + 8 * MiB;
constexpr size_t WS_HBF = WS_WU + 4 * MiB;
constexpr size_t WS_BIG = WS_HBF + 32 * MiB;
constexpr size_t WS_GATES = WS_BIG + 160 * MiB;
constexpr size_t WS_ACT = WS_GATES + 128 * MiB;
constexpr size_t WS_ACT2 = WS_ACT + 80 * MiB;
constexpr size_t WS_MUR = WS_ACT2 + 28 * MiB;
constexpr size_t WS_CMPA = WS_MUR + 64 * MiB;
constexpr size_t WS_HID = WS_CMPA + 8 * MiB;
constexpr size_t WS_PB = WS_HID + 1 * MiB;
constexpr size_t WS_OCMP = WS_PB + 16 * MiB;
constexpr size_t WS_OWIN = WS_OCMP + 16 * MiB;
constexpr size_t WS_SMALL = WS_OWIN + 16 * MiB;
constexpr size_t WS_BR = WS_SMALL + 2 * MiB;
constexpr size_t WS_END = WS_BR + 32 * MiB;
static_assert(WS_END <= 1000 * MiB, "workspace map");
constexpr size_t BIG_PSM = 0, BIG_MIX = 0, BIG_MIXB = 64 * MiB, BIG_XS = 0, BIG_YP = 80 * MiB;
constexpr size_t MISC_HIST = 3 * MiB;
constexpr size_t MISC_KCB = 1024 * 1024, MISC_VCB = 1024 * 1024 + 128 * 1024, MISC_WRT = 2 * MiB;
constexpr size_t MISC_KCMP = 0, MISC_VCMP = 256 * 1024, MISC_KMEAN = 512 * 1024, MISC_EID = 640 * 1024, MISC_WTS = 768 * 1024, MISC_PSLOT = 896 * 1024;
constexpr size_t SM_PL = 0, SM_SEL = 256 * 1024, SM_GA = 512 * 1024;
constexpr int CW_BAR = 4096;
constexpr int CW_CNT = 16384;
constexpr int CW_CUR = 16384 + 256;

constexpr int RING_BYTES = 131072, LDS_AUX = RING_BYTES, LDS_BYTES = 147456;

struct Params { const float* in[24]; float* out; unsigned char* ws; };

DEV float bf2f(unsigned v) { return __uint_as_float(v << 16); }
DEV float bflo(unsigned w) { return __uint_as_float(w << 16); }
DEV float bfhi(unsigned w) { return __uint_as_float(w & 0xffff0000u); }
DEV unsigned f2bf(float f) { unsigned u = __float_as_uint(f); return (u + 0x7fffu + ((u >> 16) & 1u)) >> 16; }
DEV unsigned pk2(float lo, float hi) { return f2bf(lo) | (f2bf(hi) << 16); }
template <int M> DEV float swz_xor(float v) { return __int_as_float(__builtin_amdgcn_ds_swizzle(__float_as_int(v), (M << 10) | 0x1f)); }
template <int M> DEV int swz_xor_i(int v) { return __builtin_amdgcn_ds_swizzle(v, (M << 10) | 0x1f); }
DEV float xhalf(float v, float& other) { auto rr = __builtin_amdgcn_permlane32_swap(__float_as_uint(v), __float_as_uint(v), false, false); other = __uint_as_float(rr[1]); return __uint_as_float(rr[0]); }
DEV float wave_sum(float v) {
    v += swz_xor<1>(v); v += swz_xor<2>(v); v += swz_xor<4>(v); v += swz_xor<8>(v); v += swz_xor<16>(v);
    float hi; const float lo = xhalf(v, hi); return lo + hi;
}
DEV float sigm(float x) { return 1.f / (1.f + __expf(-x)); }
DEV float silu_(float x) { return x / (1.f + __expf(-x)); }
#define LDS_WAIT() asm volatile("s_waitcnt lgkmcnt(0)" ::: "memory")

namespace pg8 {
constexpr int BM = 256, BK = 64, HALF = 128, HTB = HALF * BK * 2, STAGE_BYTES = 8 * HTB, NXCD = 8, WGM = 8;
__host__ __device__ __forceinline__ int lds_byte(int r, int c) { const int st = (r >> 4) * 2 + (c >> 5), rr = r & 15, cc = c & 31, ob = rr * 64 + cc * 2; return st * 1024 + (ob ^ (((ob >> 9) & 1) << 5)); }
__host__ __device__ __forceinline__ void stage_rc(int b, int& R, int& C) { const int st = b / 1024, sb = b % 1024, swz = sb ^ (((sb >> 9) & 1) << 5); R = (st >> 1) * 16 + swz / 64; C = (st & 1) * 32 + (swz % 64) / 2; }
__host__ __device__ __forceinline__ int perm32(int rho) { const int n = rho >> 4, i = rho & 15; return 8 * (i >> 2) + 4 * n + (i & 3); }
struct Unit { int pm, pn; };
struct Gemm { const bf16_t* A; const bf16_t* Bt; int lda, K; };
struct StaticOrder {
    int nM, nN, nwg, G, c;
    __device__ void init(int M, int N, int G_, int c_) { nM = M / BM; nN = N / BM; nwg = nM * nN; G = G_; c = c_; }
    __device__ bool next(int i, Unit& u) const {
        const long L = (long)i * G + c; if (L >= nwg) return false;
        int wgid = (int)L; { const int q = nwg / NXCD, r = nwg % NXCD, xcd = wgid % NXCD, off = wgid / NXCD; wgid = (xcd < r ? xcd * (q + 1) : r * (q + 1) + (xcd - r) * q) + off; }
        const int nig = WGM * nN, gid = wgid / nig, fm = gid * WGM, gsz = (nM - fm) < WGM ? (nM - fm) : WGM;
        u.pm = fm + ((wgid % nig) % gsz); u.pn = (wgid % nig) / gsz; return true;
    }
};
template <class F> struct Epi8 {
    F f;
    __device__ __forceinline__ void operator()(const f32x4 (&acc)[2][2][4][2], const Unit& u, int wr, int wc, int fr, int fq) const {
        const int row0 = u.pm * BM + wr * 64 + fr, col0 = u.pn * BM + wc * 32 + 8 * fq;
#pragma unroll
        for (int ai = 0; ai < 2; ++ai)
#pragma unroll
            for (int m = 0; m < 4; ++m)
#pragma unroll
                for (int bj = 0; bj < 2; ++bj) f(row0 + ai * HALF + m * 16, col0 + bj * HALF, acc[ai][bj][m][0], acc[ai][bj][m][1]);
    }
};
template <class Epi, class Sched, bool ALIGN_EPI>
__device__ __forceinline__ void gemm_phase(LAS unsigned char* lds, const Gemm g, const Sched& S, const Epi& E) {
    int tid_ = threadIdx.x; asm volatile("" : "+v"(tid_));
    const int tid = tid_, wid = __builtin_amdgcn_readfirstlane(tid >> 6), lane = tid & 63, wr = wid >> 2, wc = wid & 3, fr = lane & 15, fq = lane >> 4;
    const int K = g.K, nt = K / BK, lda = g.lda;
    unsigned voffA[2], voffB[2];
#pragma unroll
    for (int i = 0; i < 2; ++i) { int R, C; stage_rc(tid * 16 + i * 8192, R, C); const int Rb = (R & ~31) + perm32(R & 31);
        voffA[i] = (unsigned)(R * lda + C) * 2u; voffB[i] = (unsigned)(Rb * K + C) * 2u; }
    const size_t kstep = (size_t)(BK * 2);
    const size_t hstepA = (size_t)HALF * lda * 2, tstepA = 2 * hstepA;
    const size_t hstepB = (size_t)HALF * K * 2, tstepB = 2 * hstepB;
    const unsigned ldsw = (unsigned)wid * 1024u;
    const int aoff = lds_byte(wr * 64 + fr, fq * 8), boff = lds_byte(wc * 32 + fr, fq * 8);
#define PG8_SA(b, h) (((b) * 2 + (h)) * HTB)
#define PG8_SB(b, h) ((4 + (b) * 2 + (h)) * HTB)
#define PG8_STAGE(bufoff, gbase, voff) do { _Pragma("unroll") for (int _i = 0; _i < 2; ++_i) \
        __builtin_amdgcn_global_load_lds((const unsigned*)((const char*)(gbase) + (voff)[_i]), (LAS unsigned*)(lds + (bufoff) + ldsw + _i * 8192), 16, 0, 0); } while (0)
#define PG8_LDA(dst, b, h) do { _Pragma("unroll") for (int m = 0; m < 4; ++m) _Pragma("unroll") for (int k = 0; k < 2; ++k) dst[m][k] = *(const LAS bf16x8*)(lds + PG8_SA(b, h) + aoff + m * 2048 + k * 1024); } while (0)
#define PG8_LDB(dst, b, h) do { _Pragma("unroll") for (int n = 0; n < 2; ++n) _Pragma("unroll") for (int k = 0; k < 2; ++k) dst[n][k] = *(const LAS bf16x8*)(lds + PG8_SB(b, h) + boff + n * 2048 + k * 1024); } while (0)
#define PG8_MMA(ai, bj, At, Bt) do { __builtin_amdgcn_s_setprio(1); _Pragma("unroll") for (int m = 0; m < 4; ++m) _Pragma("unroll") for (int n = 0; n < 2; ++n) _Pragma("unroll") for (int k = 0; k < 2; ++k) \
        acc[ai][bj][m][n] = __builtin_amdgcn_mfma_f32_16x16x32_bf16(Bt[n][k], At[m][k], acc[ai][bj][m][n], 0, 0, 0); __builtin_amdgcn_s_setprio(0); } while (0)
#define PG8_WAIT_V(n) asm volatile("s_waitcnt vmcnt(" #n ")" ::: "memory")
#define PG8_WAIT_L(n) asm volatile("s_waitcnt lgkmcnt(" #n ")" ::: "memory")
#define PG8_BAR __builtin_amdgcn_s_barrier()
#define PG8_SCHED __builtin_amdgcn_sched_barrier(0)
    Unit cur, nxt; int ui = 0;
    if (!S.next(0, cur)) return;
    f32x4 acc[2][2][4][2];
#pragma unroll
    for (int a = 0; a < 2; ++a)
#pragma unroll
        for (int b = 0; b < 2; ++b)
#pragma unroll
            for (int m = 0; m < 4; ++m)
#pragma unroll
                for (int n = 0; n < 2; ++n) acc[a][b][m][n] = (f32x4){0.f, 0.f, 0.f, 0.f};
    bf16x8 At[4][2], B0[2][2], B1[2][2];
    const char* cA = (const char*)g.A + (size_t)cur.pm * tstepA; const char* cB = (const char*)g.Bt + (size_t)cur.pn * tstepB;
    PG8_STAGE(PG8_SB(0, 0), cB, voffB); PG8_STAGE(PG8_SB(0, 1), cB + hstepB, voffB); PG8_STAGE(PG8_SA(0, 0), cA, voffA); PG8_STAGE(PG8_SA(0, 1), cA + hstepA, voffA);
    if (wr == 1) PG8_BAR;
    PG8_WAIT_V(2); PG8_BAR;
    PG8_STAGE(PG8_SB(1, 0), cB + kstep, voffB); PG8_STAGE(PG8_SA(1, 0), cA + kstep, voffA); PG8_STAGE(PG8_SB(1, 1), cB + hstepB + kstep, voffB);
    PG8_WAIT_V(6); PG8_BAR;
    for (;;) {
        const bool has_next = S.next(ui + 1, nxt);
        const char* nA = has_next ? (const char*)g.A + (size_t)nxt.pm * tstepA : cA; const char* nB = has_next ? (const char*)g.Bt + (size_t)nxt.pn * tstepB : cB;
        for (int t = 0; t < nt; t += 2) {
            const bool last = (t == nt - 2);
            const char* a1 = cA + (size_t)(t + 1) * kstep;
            const char* a2 = last ? nA : cA + (size_t)(t + 2) * kstep; const char* b2 = last ? nB : cB + (size_t)(t + 2) * kstep;
            const char* a3 = a2 + kstep; const char* b3 = b2 + kstep;
            PG8_LDB(B0, 0, 0); PG8_LDB(B1, 0, 1); PG8_SCHED; PG8_LDA(At, 0, 0); PG8_STAGE(PG8_SA(1, 1), a1 + hstepA, voffA);
            PG8_WAIT_V(8); PG8_WAIT_L(0); PG8_BAR; PG8_MMA(0, 0, At, B0); PG8_MMA(0, 1, At, B1); PG8_BAR; PG8_SCHED;
            PG8_LDA(At, 0, 1); PG8_STAGE(PG8_SB(0, 0), b2, voffB); PG8_STAGE(PG8_SB(0, 1), b2 + hstepB, voffB); PG8_STAGE(PG8_SA(0, 0), a2, voffA);
            PG8_WAIT_V(8); PG8_WAIT_L(0); PG8_BAR; PG8_MMA(1, 0, At, B0); PG8_MMA(1, 1, At, B1); PG8_BAR; PG8_SCHED;
            PG8_LDB(B0, 1, 0); PG8_LDB(B1, 1, 1); PG8_SCHED; PG8_LDA(At, 1, 0); PG8_STAGE(PG8_SA(0, 1), a2 + hstepA, voffA);
            PG8_WAIT_V(8); PG8_WAIT_L(0); PG8_BAR; PG8_MMA(0, 0, At, B0); PG8_MMA(0, 1, At, B1); PG8_BAR; PG8_SCHED;
            PG8_LDA(At, 1, 1); PG8_STAGE(PG8_SB(1, 0), b3, voffB); PG8_STAGE(PG8_SB(1, 1), b3 + hstepB, voffB); PG8_STAGE(PG8_SA(1, 0), a3, voffA);
            PG8_WAIT_V(8); PG8_WAIT_L(0); PG8_BAR; PG8_MMA(1, 0, At, B0); PG8_MMA(1, 1, At, B1); PG8_BAR; PG8_SCHED;
        }
        if constexpr (ALIGN_EPI) { if (wr == 0) PG8_BAR; }
        E(acc, cur, wr, wc, fr, fq);
        if (!has_next) break;
#pragma unroll
        for (int a = 0; a < 2; ++a)
#pragma unroll
            for (int b = 0; b < 2; ++b)
#pragma unroll
                for (int m = 0; m < 4; ++m)
#pragma unroll
                    for (int n = 0; n < 2; ++n) acc[a][b][m][n] = (f32x4){0.f, 0.f, 0.f, 0.f};
        cur = nxt; cA = nA; cB = nB; ++ui;
        if constexpr (ALIGN_EPI) { if (wr == 1) PG8_BAR; }
    }
    PG8_WAIT_V(0);
    if constexpr (!ALIGN_EPI) { if (wr == 0) PG8_BAR; }
    PG8_BAR;
#undef PG8_SA
#undef PG8_SB
#undef PG8_STAGE
#undef PG8_LDA
#undef PG8_LDB
#undef PG8_MMA
#undef PG8_WAIT_V
#undef PG8_WAIT_L
#undef PG8_BAR
#undef PG8_SCHED
}
}

#define XB_TMO      128
#define XB_XCNT(j)  (256  + 64 * (j))
#define XB_XSUB(j)  (1280 + 64 * (j))
#define XB_XGEN(j)  (2304 + 64 * (j))
#define XB_TOP      3328
#define XB_TOPGEN   3392
#define XCD_BAR_WORDS 3456
#define XB_SPIN_CAP (1u << 22)
__device__ __forceinline__ unsigned xb_ld(unsigned* p)              { return __hip_atomic_load(p, __ATOMIC_RELAXED, __HIP_MEMORY_SCOPE_AGENT); }
__device__ __forceinline__ unsigned xb_add(unsigned* p, unsigned v) { return __hip_atomic_fetch_add(p, v, __ATOMIC_RELAXED, __HIP_MEMORY_SCOPE_AGENT); }
__device__ __forceinline__ unsigned xb_xcc_id() { return (unsigned)__builtin_amdgcn_s_getreg((3 << 11) | 20) & 0xFu; }
#define XB_SPIN(cond, bar) do { unsigned _sp = 0; while (cond) { __builtin_amdgcn_s_sleep(1); \
    if ((++_sp & 255u) == 0u) { if (xb_ld(&(bar)[XB_TMO])) break; if (_sp > XB_SPIN_CAP) { atomicAdd(&(bar)[XB_TMO], 1u); break; } } } } while (0)
struct XcdBarrier { unsigned* bar; unsigned x; volatile LAS unsigned* st; };
__device__ __forceinline__ XcdBarrier xcd_barrier_post(unsigned* bar, volatile LAS unsigned* st) {
    XcdBarrier b; b.bar = bar; b.x = xb_xcc_id(); b.st = st;
    if (threadIdx.x == 0) (void)xb_add(&bar[XB_XCNT(b.x)], 1u);
    return b;
}
__device__ __forceinline__ void xcd_barrier_complete(unsigned* bar, unsigned x, unsigned& nloc, unsigned& nx) {
    const unsigned G = gridDim.x * gridDim.y * gridDim.z;
    unsigned sum, cnt, mine, sp = 0u;
    for (;;) {
        sum = 0u; cnt = 0u; mine = 0u;
#pragma unroll
        for (unsigned j = 0; j < 16; ++j) { const unsigned c = xb_ld(&bar[XB_XCNT(j)]); sum += c; cnt += (c > 0u) ? 1u : 0u; mine = (j == x) ? c : mine; }
        if (sum == G) break;
        __builtin_amdgcn_s_sleep(1);
        if ((++sp & 255u) == 0u) { if (xb_ld(&bar[XB_TMO])) break; if (sp > XB_SPIN_CAP) { atomicAdd(&bar[XB_TMO], 1u); break; } }
    }
    nloc = mine > 0u ? mine : 1u; nx = cnt > 0u ? cnt : 1u;
}
__device__ __noinline__ void xcd_barrier_fn(unsigned* bar_, unsigned x_, volatile LAS unsigned* st_) {
    XcdBarrier b; b.bar = bar_; b.x = x_; b.st = st_;
    asm volatile("s_waitcnt vmcnt(0)" ::: "memory");
    __syncthreads();
    if (threadIdx.x == 0) {
        unsigned* bar = b.bar;
        __builtin_amdgcn_s_waitcnt(0);
        unsigned nloc = b.st[0], nx = b.st[1];
        if (nloc == 0u) { xcd_barrier_complete(bar, b.x, nloc, nx); b.st[0] = nloc; b.st[1] = nx; }
        const unsigned old = xb_add(&bar[XB_XSUB(b.x)], 1u);
        const unsigned gen = old / nloc;
        if (old + 1u == (gen + 1u) * nloc) {
            __builtin_amdgcn_fence(__ATOMIC_RELEASE, "agent");
            asm volatile("s_waitcnt vmcnt(0)" ::: "memory");
            const unsigned og = xb_add(&bar[XB_TOP], 1u);
            const unsigned tg = og / nx;
            if (og + 1u == (tg + 1u) * nx) xb_add(&bar[XB_TOPGEN], 1u);
            else XB_SPIN(xb_ld(&bar[XB_TOPGEN]) == tg, bar);
            __builtin_amdgcn_fence(__ATOMIC_ACQUIRE, "agent");
            xb_add(&bar[XB_XGEN(b.x)], 1u);
            asm volatile("s_waitcnt vmcnt(0)" ::: "memory");
        } else {
            XB_SPIN(xb_ld(&bar[XB_XGEN(b.x)]) == gen, bar);
            __builtin_amdgcn_fence(__ATOMIC_ACQUIRE, "agent");
            asm volatile("s_waitcnt vmcnt(0)" ::: "memory");
        }
    }
    __syncthreads();
}

struct Ctx {
    int tid, lane, wave, gw, NGW, bid, G;
    LAS unsigned char* lds;
};
DEV Ctx make_ctx(LAS unsigned char* lds) {
    Ctx c; int tid_ = threadIdx.x; asm volatile("" : "+v"(tid_));
    c.tid = tid_; c.lane = c.tid & 63; c.wave = __builtin_amdgcn_readfirstlane(c.tid >> 6); { int b_ = blockIdx.x, g_ = gridDim.x; asm volatile("" : "+s"(b_), "+s"(g_)); c.bid = b_; c.G = g_; }
    c.gw = c.bid * 8 + c.wave; c.NGW = c.G * 8; c.lds = lds; return c;
}
#define WSP(T, off) ((T*)(p.ws + (off)))

DEV void transpose_item(const float* W, const float* W2, int ldw, int K, bf16_t* WT, int nblk, int mode, int nvalid, int item, LAS float* scr, int lane) {
    const int kb = item / nblk, nb = item % nblk, k0 = 64 * kb, n0 = 32 * nb;
    const int n = n0 + (lane & 31);
    const float* src = W; int c = -1; int ld = ldw; int kofs = 0;
    if (mode == 0) { c = n < nvalid ? n : -1; }
    else if (mode == 1) { c = n < NSMALL ? n : (n < PSW ? -1 : n - (PSW - NSMALL)); }
    else if (mode == 2) { c = (n & 1) ? 256 + (n >> 1) : (n >> 1); }
    else { if (n < 384 && k0 < 384) { c = n; ld = 384; } else if (n >= 512 && k0 >= 384) { src = W2; c = n - 512; ld = 512; kofs = 384; } }
#pragma unroll 8
    for (int i = 0; i < 32; ++i) { const int kk = 2 * i + (lane >> 5); scr[kk * 33 + (lane & 31)] = (c >= 0) ? src[(size_t)(k0 - kofs + kk) * ld + c] : 0.f; }
    LDS_WAIT(); asm volatile("" ::: "memory");
    const int c8 = lane & 7;
#pragma unroll
    for (int j = 0; j < 4; ++j) { const int nn = (lane >> 3) + 8 * j; const LAS float* s = scr + (8 * c8) * 33 + nn;
        u32x4 o; o.x = pk2(s[0 * 33], s[1 * 33]); o.y = pk2(s[2 * 33], s[3 * 33]); o.z = pk2(s[4 * 33], s[5 * 33]); o.w = pk2(s[6 * 33], s[7 * 33]);
        *(u32x4*)(WT + (size_t)(n0 + nn) * K + k0 + 8 * c8) = o; }
    LDS_WAIT(); asm volatile("" ::: "memory");
}
constexpr int IT_WIN = 16 * 208, IT_W13 = 256 * 32, IT_W2 = 128 * 32, IT_CW1 = 256 * 2, IT_WBR = 128 * 4, IT_WOUT = 512, IT_WU = 8 * 32;
constexpr int IT_LAYER = IT_WIN + IT_W13 + IT_W2 + IT_CW1 + IT_WBR + IT_WOUT + IT_WU;
DEV void phase_prologue(const Params& p, const Ctx& c) {
    float* MOD = WSP(float, WS_MOD);
    if (c.bid < 48) {
        LAS float* sc = (LAS float*)(c.lds + 73728);
        for (int i = c.tid; i < 4096; i += 512) sc[i] = silu_(p.in[1][i]);
        __syncthreads();
        const int idx = c.bid * 512 + c.tid; const int l = idx / 6144, j = idx % 6144;
        const float* wa = p.in[2] + (size_t)l * 1024 * 6144 + j;
        float a0 = 0.f, a1 = 0.f, a2 = 0.f, a3 = 0.f;
        for (int k = 0; k < 1024; ++k) { const float w = wa[(size_t)k * 6144]; a0 += sc[k] * w; a1 += sc[1024 + k] * w; a2 += sc[2048 + k] * w; a3 += sc[3072 + k] * w; }
        const float bb = p.in[3][l * 6144 + j];
        MOD[(l * 4 + 0) * 6144 + j] = a0 + bb; MOD[(l * 4 + 1) * 6144 + j] = a1 + bb; MOD[(l * 4 + 2) * 6144 + j] = a2 + bb; MOD[(l * 4 + 3) * 6144 + j] = a3 + bb;
    }
    { float* RC = WSP(float, WS_ROPE); float* RS = RC + 4096 * 16;
      for (int i = c.bid * 512 + c.tid; i < 4096 * 16; i += c.G * 512) { const int pos = i >> 4, k = i & 15;
          const float inv = (float)pow(10000.0, -(double)k / 16.0); const float ang = (float)pos * inv;
          RC[i] = (float)cos((double)ang); RS[i] = (float)sin((double)ang); } }
    { float* WRT = WSP(float, WS_MISC + MISC_WRT);
      for (int i = c.bid * 512 + c.tid; i < NLAYER * 36 * 1024; i += c.G * 512) { const int k = i & 1023, e = (i >> 10) % 36, l = i / (36 * 1024);
          WRT[i] = e < 4 ? p.in[18][((size_t)l * 1024 + k) * 4 + e] : p.in[20][((size_t)l * 1024 + k) * 32 + (e - 4)]; } }
    LAS float* scr = (LAS float*)(c.lds + c.wave * 8448);
    for (int it = c.gw; it < IT_LAYER * NLAYER; it += c.NGW) {
        const int l = it / IT_LAYER; int r = it % IT_LAYER;
        if (r < IT_WIN) { transpose_item(p.in[5] + (size_t)l * 1024 * DIN, nullptr, DIN, 1024, WSP(bf16_t, WS_WIN) + (size_t)l * NPROJ * 1024, NPROJ / 32, 1, 0, r, scr, c.lane); continue; } r -= IT_WIN;
        if (r < IT_W13) { const int e = r / 256; transpose_item(p.in[22] + (size_t)(l * 32 + e) * 1024 * 512, nullptr, 512, 1024, WSP(bf16_t, WS_W13) + (size_t)(l * 32 + e) * 512 * 1024, 16, 2, 0, r % 256, scr, c.lane); continue; } r -= IT_W13;
        if (r < IT_W2) { const int e = r / 128; transpose_item(p.in[23] + (size_t)(l * 32 + e) * 256 * 1024, nullptr, 1024, 256, WSP(bf16_t, WS_W2) + (size_t)(l * 32 + e) * 1024 * 256, 32, 0, 1024, r % 128, scr, c.lane); continue; } r -= IT_W2;
        if (r < IT_CW1) { const int kv = r / 256; transpose_item(p.in[8] + (size_t)(l * 2 + kv) * 2048 * 256, nullptr, 256, 2048, WSP(bf16_t, WS_CW1) + (size_t)(l * 2 + kv) * 256 * 2048, 8, 0, 256, r % 256, scr, c.lane); continue; } r -= IT_CW1;
        if (r < IT_WBR) { const int n = r / 128; transpose_item(p.in[16] + (size_t)(l * 4 + n) * 256 * 1024, nullptr, 1024, 256, WSP(bf16_t, WS_WBR) + (size_t)(l * 4 + n) * 1024 * 256, 32, 0, 1024, r % 128, scr, c.lane); continue; } r -= IT_WBR;
        if (r < IT_WOUT) { transpose_item(p.in[17] + (size_t)l * 1024 * 1024, nullptr, 1024, 1024, WSP(bf16_t, WS_WOUT) + (size_t)l * 1024 * 1024, 32, 0, 1024, r, scr, c.lane); continue; } r -= IT_WOUT;
        transpose_item(p.in[14] + (size_t)l * 384 * 384, p.in[15] + (size_t)l * 128 * 512, 0, 512, WSP(bf16_t, WS_WU) + (size_t)l * 1024 * 512, 32, 3, 0, r, scr, c.lane);
    }
}

template <bool NORM, bool WRITEX> DEV void phase_norm1(const Params& p, const Ctx& c, int l) {
    const float* MOD = WSP(float, WS_MOD);
    const bf16_t* YP = (const bf16_t*)(p.ws + WS_BIG + BIG_YP);
    const int* PSLOT = WSP(int, WS_MISC + MISC_PSLOT); const float* WTS = WSP(float, WS_MISC + MISC_WTS);
    bf16_t* HBF = WSP(bf16_t, WS_HBF);
    for (int row = c.gw; row < NTOK; row += c.NGW) {
        const int b = row / SEQ;
        f32x4 v[4];
        if (l == 0 || !WRITEX) {
            const float* xs = l == 0 ? p.in[0] : p.out;
#pragma unroll
            for (int j = 0; j < 4; ++j) v[j] = *(const f32x4*)(xs + (size_t)row * DM + j * 256 + c.lane * 4);
        } else {
            const float* g2 = MOD + ((l - 1) * 4 + b) * 6144 + 5120;
            const int s0 = PSLOT[row * 2], s1 = PSLOT[row * 2 + 1]; const float w0 = WTS[row * 2], w1 = WTS[row * 2 + 1];
#pragma unroll
            for (int j = 0; j < 4; ++j) { const int col = j * 256 + c.lane * 4;
                const f32x4 x = *(const f32x4*)(p.out + (size_t)row * DM + col); const f32x4 g = *(const f32x4*)(g2 + col);
                const u32x2 y0 = *(const u32x2*)(YP + (size_t)s0 * DM + col), y1 = *(const u32x2*)(YP + (size_t)s1 * DM + col);
                f32x4 y; y[0] = w0 * bflo(y0.x) + w1 * bflo(y1.x); y[1] = w0 * bfhi(y0.x) + w1 * bfhi(y1.x); y[2] = w0 * bflo(y0.y) + w1 * bflo(y1.y); y[3] = w0 * bfhi(y0.y) + w1 * bfhi(y1.y);
                v[j] = x + g * y; }
        }
        if (WRITEX) {
#pragma unroll
            for (int j = 0; j < 4; ++j) *(f32x4*)(p.out + (size_t)row * DM + j * 256 + c.lane * 4) = v[j]; }
        if (NORM) {
            float ss = 0.f;
#pragma unroll
            for (int j = 0; j < 4; ++j) ss += (v[j][0] * v[j][0] + v[j][1] * v[j][1]) + (v[j][2] * v[j][2] + v[j][3] * v[j][3]);
            const float r = rsqrtf(wave_sum(ss) * (1.f / DM) + EPS);
            const float* gn = p.in[4] + (size_t)(l * 2 + 0) * DM; const float* sh = MOD + (l * 4 + b) * 6144; const float* sc = sh + 1024;
#pragma unroll
            for (int j = 0; j < 4; ++j) { const int col = j * 256 + c.lane * 4;
                const f32x4 g = *(const f32x4*)(gn + col), s1 = *(const f32x4*)(sc + col), s0 = *(const f32x4*)(sh + col);
                const f32x4 h = v[j] * r * g * (s1 + 1.f) + s0;
                u32x2 o; o.x = pk2(h[0], h[1]); o.y = pk2(h[2], h[3]); *(u32x2*)(HBF + (size_t)row * DM + col) = o; }
        }
    }
}

struct FInproj { float* PSM; bf16_t* GATES;
    DEV void operator()(int row, int col, const f32x4& v0, const f32x4& v1) const {
        if (col < PSW) { float* o = PSM + (size_t)row * PSW + col; *(f32x4*)o = v0; *(f32x4*)(o + 4) = v1; }
        else { u32x4 w; w.x = pk2(sigm(v0[0]), sigm(v0[1])); w.y = pk2(sigm(v0[2]), sigm(v0[3])); w.z = pk2(sigm(v1[0]), sigm(v1[1])); w.w = pk2(sigm(v1[2]), sigm(v1[3]));
               *(u32x4*)(GATES + (size_t)row * NGATE + (col - PSW)) = w; } } };
DEV void phase_inproj(const Params& p, const Ctx& c, int l) {
    pg8::Gemm g{WSP(bf16_t, WS_HBF), WSP(bf16_t, WS_WIN) + (size_t)l * NPROJ * 1024, 1024, 1024};
    pg8::StaticOrder S; S.init(NTOK, NPROJ, c.G, c.bid);
    pg8::Epi8<FInproj> E{{(float*)(p.ws + WS_BIG + BIG_PSM), WSP(bf16_t, WS_GATES)}};
    pg8::gemm_phase<pg8::Epi8<FInproj>, pg8::StaticOrder, true>(c.lds, g, S, E);
}

DEV float head_norm(float v, const float* gain, int lane) { const float ss = wave_sum(v * v); return v * rsqrtf(ss * (1.f / 64.f) + EPS) * gain[lane]; }
DEV void phase_post(const Params& p, const Ctx& c, int l) {
    const float* PSM = (const float*)(p.ws + WS_BIG + BIG_PSM); bf16_t* ACT = WSP(bf16_t, WS_ACT);
    float* GA = WSP(float, WS_SMALL + SM_GA);
    const float* gq = p.in[6] + (size_t)l * 10 * 64;
    const float* RC = WSP(float, WS_ROPE); const float* RS = RC + 4096 * 16;
    const int lane = c.lane;
    for (int row = c.gw; row < NTOK; row += c.NGW) {
        const float* P = PSM + (size_t)row * PSW; bf16_t* A = ACT + (size_t)row * ACTW; const int t = row % SEQ;
#pragma unroll
        for (int h = 0; h < 4; ++h) A[A_QA + h * 64 + lane] = (bf16_t)f2bf(head_norm(P[I_QA + h * 64 + lane], gq + 0 * 64, lane));
        A[A_KCR + lane] = (bf16_t)f2bf(P[I_KC + lane]); A[A_VCR + lane] = (bf16_t)f2bf(P[I_VC + lane]);
        A[A_KS + lane] = (bf16_t)f2bf(head_norm(P[I_KS + lane], gq + 2 * 64, lane)); A[A_VS + lane] = (bf16_t)f2bf(P[I_VS + lane]);
        A[A_KW + lane] = (bf16_t)f2bf(head_norm(P[I_KW + lane], gq + 3 * 64, lane)); A[A_VW + lane] = (bf16_t)f2bf(P[I_VW + lane]);
        if (lane < 12) GA[row * 12 + lane] = sigm(P[I_GL + lane]);
#pragma unroll
        for (int h = 0; h < 4; ++h) A[A_QB + h * 64 + lane] = (bf16_t)f2bf(head_norm(P[I_QB + h * 64 + lane], gq + 4 * 64, lane));
#pragma unroll
        for (int h = 0; h < 2; ++h) { A[A_KB + h * 64 + lane] = (bf16_t)f2bf(head_norm(P[I_KB + h * 64 + lane], gq + 5 * 64, lane)); A[A_VB + h * 64 + lane] = (bf16_t)f2bf(P[I_VB + h * 64 + lane]); }
#pragma unroll
        for (int h = 0; h < 4; ++h) { A[A_QC + h * 64 + lane] = (bf16_t)f2bf(head_norm(P[I_QC + h * 64 + lane], gq + 6 * 64, lane));
            A[A_KC + h * 64 + lane] = (bf16_t)f2bf(head_norm(P[I_KCC + h * 64 + lane], gq + 7 * 64, lane)); A[A_VC + h * 64 + lane] = (bf16_t)f2bf(P[I_VCC + h * 64 + lane]); }
        { float x[6]; float ss = 0.f;
#pragma unroll
          for (int j = 0; j < 6; ++j) { x[j] = P[I_CQ + j * 64 + lane]; ss += x[j] * x[j]; }
          const float r = rsqrtf(wave_sum(ss) * (1.f / 384.f) + EPS); const float* g = p.in[11] + l * 384;
#pragma unroll
          for (int j = 0; j < 6; ++j) A[A_CQ + j * 64 + lane] = (bf16_t)f2bf(x[j] * r * g[j * 64 + lane]); }
        { float x0 = P[I_CKV + lane], x1 = P[I_CKV + 64 + lane]; const float r = rsqrtf(wave_sum(x0 * x0 + x1 * x1) * (1.f / 128.f) + EPS); const float* g = p.in[12] + l * 128;
          A[A_CKV + lane] = (bf16_t)f2bf(x0 * r * g[lane]); A[A_CKV + 64 + lane] = (bf16_t)f2bf(x1 * r * g[64 + lane]); }
        { const float x = lane < 32 ? P[I_KR + lane] : 0.f; const float r = rsqrtf(wave_sum(x * x) * (1.f / 32.f) + EPS);
          const float y = x * r * p.in[13][(l * 2 + 1) * 32 + (lane & 31)];
          const float yo = swz_xor<16>(y); const int k = lane & 15; const float cs = RC[t * 16 + k], sn = RS[t * 16 + k];
          const float o = (lane & 16) ? (yo * sn + y * cs) : (y * cs - yo * sn);
          if (lane < 32) A[A_KR + lane] = (bf16_t)f2bf(o); }
    }
}

struct FStoreF32 { float* O; int ld;
    DEV void operator()(int row, int col, const f32x4& v0, const f32x4& v1) const { float* o = O + (size_t)row * ld + col; *(f32x4*)o = v0; *(f32x4*)(o + 4) = v1; } };
DEV void phase_mlaup(const Params& p, const Ctx& c, int l) {
    { pg8::Gemm g{WSP(bf16_t, WS_ACT) + A_CQ, WSP(bf16_t, WS_WU) + (size_t)l * 1024 * 512, ACTW, 512};
      pg8::StaticOrder S; S.init(NTOK, 1024, c.G, c.bid);
      pg8::Epi8<FStoreF32> E{{WSP(float, WS_MUR), 1024}};
      pg8::gemm_phase<pg8::Epi8<FStoreF32>, pg8::StaticOrder, true>(c.lds, g, S, E); }
    { const bf16_t* ACT = WSP(bf16_t, WS_ACT); bf16_t* CMPA = WSP(bf16_t, WS_CMPA); const float* pe = p.in[7] + (size_t)l * 2 * 32 * 64;
      for (int idx = c.bid * 512 + c.tid; idx < 2 * 1024 * 256; idx += c.G * 512) {
          const int c8 = idx & 255, r = (idx >> 8) & 1023, kv = idx >> 18; const int j = c8 >> 3, d = (c8 & 7) * 8;
          u32x4 o = (u32x4){0u, 0u, 0u, 0u};
          if (r < 1020) { const int b = r / 255, i = r % 255; const size_t tok = (size_t)b * SEQ + 16 * i + j;
              const u32x4 s = *(const u32x4*)(ACT + tok * ACTW + (kv ? A_VCR : A_KCR) + d); const float* pp = pe + (kv * 32 + j) * 64 + d;
              o.x = pk2(bflo(s.x) + pp[0], bfhi(s.x) + pp[1]); o.y = pk2(bflo(s.y) + pp[2], bfhi(s.y) + pp[3]); o.z = pk2(bflo(s.z) + pp[4], bfhi(s.z) + pp[5]); o.w = pk2(bflo(s.w) + pp[6], bfhi(s.w) + pp[7]); }
          *(u32x4*)(CMPA + ((size_t)kv * 1024 + r) * 2048 + c8 * 8) = o; } }
    { const bf16_t* ACT = WSP(bf16_t, WS_ACT); float* KM = WSP(float, WS_MISC + MISC_KMEAN);
      for (int idx = c.bid * 512 + c.tid; idx < 4 * 16 * 256; idx += c.G * 512) { const int hd = idx & 255, n = (idx >> 8) & 15, b = idx >> 12;
          const bf16_t* src = ACT + ((size_t)b * SEQ + n * 256) * ACTW + A_KC + hd; float s = 0.f;
          for (int i = 0; i < 256; ++i) s += bf2f(src[(size_t)i * ACTW]);
          KM[idx] = s * (1.f / 256.f); } }
}

struct CmpOrder { int G, c; DEV bool next(int i, pg8::Unit& u) const { const int L = i * G + c; if (L >= 8) return false; u.pm = L; u.pn = L >> 2; return true; } };
struct FCmpHid { bf16_t* HID;
    DEV void operator()(int row, int col, const f32x4& v0, const f32x4& v1) const { const int cc = col & 255;
        u32x4 w; w.x = pk2(silu_(v0[0]), silu_(v0[1])); w.y = pk2(silu_(v0[2]), silu_(v0[3])); w.z = pk2(silu_(v1[0]), silu_(v1[1])); w.w = pk2(silu_(v1[2]), silu_(v1[3]));
        *(u32x4*)(HID + (size_t)row * 256 + cc) = w; } };
DEV void phase_post2(const Params& p, const Ctx& c, int l) {
    { pg8::Gemm g{WSP(bf16_t, WS_CMPA), WSP(bf16_t, WS_CW1) + (size_t)l * 2 * 256 * 2048, 2048, 2048};
      CmpOrder S{c.G, c.bid}; pg8::Epi8<FCmpHid> E{{WSP(bf16_t, WS_HID)}};
      pg8::gemm_phase<pg8::Epi8<FCmpHid>, CmpOrder, true>(c.lds, g, S, E); }
    const float* MUR = WSP(float, WS_MUR); bf16_t* ACT2 = WSP(bf16_t, WS_ACT2);
    const float* gq = p.in[6] + (size_t)l * 10 * 64; const float* RC = WSP(float, WS_ROPE); const float* RS = RC + 4096 * 16;
    const int lane = c.lane;
    for (int row = c.gw; row < NTOK; row += c.NGW) {
        const float* R = MUR + (size_t)row * 1024; bf16_t* A = ACT2 + (size_t)row * ACT2W; const int t = row % SEQ;
#pragma unroll
        for (int h = 0; h < 4; ++h) {
            A[A2_QF + h * 96 + lane] = (bf16_t)f2bf(head_norm(R[h * 96 + lane], gq + 8 * 64, lane));
            { const float x = lane < 32 ? R[h * 96 + 64 + lane] : 0.f; const float r = rsqrtf(wave_sum(x * x) * (1.f / 32.f) + EPS);
              const float y = x * r * p.in[13][(l * 2 + 0) * 32 + (lane & 31)];
              const float yo = swz_xor<16>(y); const int k = lane & 15; const float cs = RC[t * 16 + k], sn = RS[t * 16 + k];
              const float o = (lane & 16) ? (yo * sn + y * cs) : (y * cs - yo * sn);
              if (lane < 32) A[A2_QF + h * 96 + 64 + lane] = (bf16_t)f2bf(o); }
            A[A2_KN + h * 64 + lane] = (bf16_t)f2bf(head_norm(R[512 + h * 128 + lane], gq + 9 * 64, lane));
            A[A2_VD + h * 64 + lane] = (bf16_t)f2bf(R[512 + h * 128 + 64 + lane]);
        }
    }
}

template <int D0, int D1, int DV>
DEV void att_step(const float (&q)[D0 + D1], float (&o)[DV], float& m, float& l, const bf16_t* k0, const bf16_t* k1, const bf16_t* v, float scale, float bias, bool valid) {
    float acc = 0.f;
#pragma unroll
    for (int i = 0; i < D0 / 8; ++i) { const u32x4 u = *(const u32x4*)(k0 + 8 * i);
        acc += q[8 * i] * bflo(u.x) + q[8 * i + 1] * bfhi(u.x) + q[8 * i + 2] * bflo(u.y) + q[8 * i + 3] * bfhi(u.y) + q[8 * i + 4] * bflo(u.z) + q[8 * i + 5] * bfhi(u.z) + q[8 * i + 6] * bflo(u.w) + q[8 * i + 7] * bfhi(u.w); }
    if (D1 > 0) {
#pragma unroll
        for (int i = 0; i < D1 / 8; ++i) { const u32x4 u = *(const u32x4*)(k1 + 8 * i); const int b = D0 + 8 * i;
            acc += q[b] * bflo(u.x) + q[b + 1] * bfhi(u.x) + q[b + 2] * bflo(u.y) + q[b + 3] * bfhi(u.y) + q[b + 4] * bflo(u.z) + q[b + 5] * bfhi(u.z) + q[b + 6] * bflo(u.w) + q[b + 7] * bfhi(u.w); }
    }
    const float s = acc * scale + bias;
    if (valid) {
        if (s > m) { const float a = __expf(m - s); l *= a;
#pragma unroll
            for (int d = 0; d < DV; ++d) o[d] *= a;
            m = s; }
        const float pr = __expf(s - m); l += pr;
#pragma unroll
        for (int i = 0; i < DV / 8; ++i) { const u32x4 u = *(const u32x4*)(v + 8 * i);
            o[8 * i] += pr * bflo(u.x); o[8 * i + 1] += pr * bfhi(u.x); o[8 * i + 2] += pr * bflo(u.y); o[8 * i + 3] += pr * bfhi(u.y);
            o[8 * i + 4] += pr * bflo(u.z); o[8 * i + 5] += pr * bfhi(u.z); o[8 * i + 6] += pr * bflo(u.w); o[8 * i + 7] += pr * bfhi(u.w); }
    }
}
template <int D> DEV void load_q(float (&q)[D], const bf16_t* src) {
#pragma unroll
    for (int i = 0; i < D / 8; ++i) { const u32x4 u = *(const u32x4*)(src + 8 * i);
        q[8 * i] = bflo(u.x); q[8 * i + 1] = bfhi(u.x); q[8 * i + 2] = bflo(u.y); q[8 * i + 3] = bfhi(u.y); q[8 * i + 4] = bflo(u.z); q[8 * i + 5] = bfhi(u.z); q[8 * i + 6] = bflo(u.w); q[8 * i + 7] = bfhi(u.w); }
}
template <int DV> DEV void store_o_bf16(bf16_t* dst, const float (&o)[DV], float inv) {
#pragma unroll
    for (int i = 0; i < DV / 8; ++i) { u32x4 w; w.x = pk2(o[8 * i] * inv, o[8 * i + 1] * inv); w.y = pk2(o[8 * i + 2] * inv, o[8 * i + 3] * inv); w.z = pk2(o[8 * i + 4] * inv, o[8 * i + 5] * inv); w.w = pk2(o[8 * i + 6] * inv, o[8 * i + 7] * inv);
        *(u32x4*)(dst + 8 * i) = w; }
}
DEV void item_bgh(int it, int& b, int& g, int& h) { const int r = it & 63, bh = it >> 6; g = (r & 1) ? 63 - (r >> 1) : (r >> 1); b = bh >> 2; h = bh & 3; }

DEV void phase_attn(const Params& p, const Ctx& c, int l) {
    const int lane = c.lane;
    { const bf16_t* HID = WSP(bf16_t, WS_HID); float* KC = WSP(float, WS_MISC + MISC_KCMP); float* VC = WSP(float, WS_MISC + MISC_VCMP);
      const float* gq = p.in[6] + (size_t)l * 10 * 64;
      for (int it = c.gw; it < 2 * 1020; it += c.NGW) { const int kv = it / 1020, r = it % 1020;
          const float* w2 = p.in[9] + (size_t)(l * 2 + kv) * 256 * 64; const bf16_t* hrow = HID + ((size_t)kv * 1024 + r) * 256;
          float a = 0.f;
          for (int k = 0; k < 256; ++k) a += bf2f(hrow[k]) * w2[k * 64 + lane];
          const int b = r / 255, i = r % 255;
          if (kv == 0) KC[(b * 256 + i) * 64 + lane] = head_norm(a, gq + 1 * 64, lane); else VC[(b * 256 + i) * 64 + lane] = a; } }
    const bf16_t* ACT = WSP(bf16_t, WS_ACT); const bf16_t* ACT2 = WSP(bf16_t, WS_ACT2); bf16_t* BR = WSP(bf16_t, WS_BR);
    for (int it0 = c.gw; it0 < 2048; it0 += c.NGW) {
        if (it0 < 1024) {
            int b, g, h; item_bgh(it0, b, g, h); const int t = g * 64 + lane; const size_t tok = (size_t)b * SEQ + t;
            float q[96], o[64]; float m = -INFINITY, ls = 0.f;
            load_q<96>(q, ACT2 + tok * ACT2W + A2_QF + h * 96);
#pragma unroll
            for (int d = 0; d < 64; ++d) o[d] = 0.f;
            const float scale = 0.10206207261596575f;
            for (int s = g * 64 + 63; s >= 0; --s) { const size_t kt = (size_t)b * SEQ + s;
                att_step<64, 32, 64>(q, o, m, ls, ACT2 + kt * ACT2W + A2_KN + h * 64, ACT + kt * ACTW + A_KR, ACT2 + kt * ACT2W + A2_VD + h * 64, scale, 0.f, s <= t); }
            store_o_bf16<64>(BR + tok * 1024 + 768 + h * 64, o, 1.f / ls);
        } else {
            int b, g, h; item_bgh(it0 - 1024, b, g, h); const int t = g * 64 + lane; const size_t tok = (size_t)b * SEQ + t;
            const int nb = g >> 2; const float slope = SLOPES[2][h];
            float q[64], o[64]; float m = -INFINITY, ls = 0.f;
            load_q<64>(q, ACT + tok * ACTW + A_QC + h * 64);
#pragma unroll
            for (int d = 0; d < 64; ++d) o[d] = 0.f;
            const float* KM = WSP(float, WS_MISC + MISC_KMEAN) + (size_t)b * 16 * 256 + h * 64;
            float v1 = -INFINITY, v2 = -INFINITY, v3 = -INFINITY; int i1 = -1, i2 = -1, i3 = -1;
            for (int n = 0; n < nb; ++n) { const float* km = KM + n * 256; float dsum = 0.f;
#pragma unroll
                for (int d = 0; d < 64; ++d) dsum += q[d] * km[d];
                if (dsum > v1) { v3 = v2; i3 = i2; v2 = v1; i2 = i1; v1 = dsum; i1 = n; }
                else if (dsum > v2) { v3 = v2; i3 = i2; v2 = dsum; i2 = n; }
                else if (dsum > v3) { v3 = dsum; i3 = n; } }
            const int start = nb * 256;
            for (int s = g * 64 + 63; s >= start; --s) { const size_t kt = (size_t)b * SEQ + s;
                att_step<64, 0, 64>(q, o, m, ls, ACT + kt * ACTW + A_KC + h * 64, nullptr, ACT + kt * ACTW + A_VC + h * 64, 0.125f, -slope * (float)(t - s), s <= t); }
            for (int n = nb - 1; n >= 0; --n) { const bool sel = (n == i1) || (n == i2) || (n == i3);
                if (!__any(sel)) continue;
                for (int s = n * 256 + 255; s >= n * 256; --s) { const size_t kt = (size_t)b * SEQ + s;
                    att_step<64, 0, 64>(q, o, m, ls, ACT + kt * ACTW + A_KC + h * 64, nullptr, ACT + kt * ACTW + A_VC + h * 64, 0.125f, -slope * (float)(t - s), sel); } }
            store_o_bf16<64>(BR + tok * 1024 + 512 + h * 64, o, 1.f / ls);
        }
    }
    for (int it0 = c.gw; it0 < 2048; it0 += c.NGW) {
        const bool swa = it0 >= 1024;
        int b, g, h; item_bgh(swa ? it0 - 1024 : it0, b, g, h); const int t = g * 64 + lane; const size_t tok = (size_t)b * SEQ + t;
        const int W = swa ? 128 : 512; const float slope = SLOPES[swa ? 1 : 0][h];
        const int qoff = swa ? A_QB + h * 64 : A_QA + h * 64, koff = swa ? A_KB + (h >> 1) * 64 : A_KW, voff = swa ? A_VB + (h >> 1) * 64 : A_VW;
        float q[64], o[64]; float m = -INFINITY, ls = 0.f;
        load_q<64>(q, ACT + tok * ACTW + qoff);
#pragma unroll
        for (int d = 0; d < 64; ++d) o[d] = 0.f;
        int lo = g * 64 - (W - 1); if (lo < 0) lo = 0;
        for (int s = g * 64 + 63; s >= lo; --s) { const size_t kt = (size_t)b * SEQ + s; const int dist = t - s;
            att_step<64, 0, 64>(q, o, m, ls, ACT + kt * ACTW + koff, nullptr, ACT + kt * ACTW + voff, 0.125f, -slope * (float)dist, dist >= 0 && dist < W); }
        if (swa) { const float sk = p.in[10][l * 4 + h]; const float mf = fmaxf(m, sk); const float a = __expf(m - mf); const float den = ls * a + __expf(sk - mf);
            store_o_bf16<64>(BR + tok * 1024 + 256 + h * 64, o, a / den); }
        else { float* OW = WSP(float, WS_OWIN) + tok * 256 + h * 64; const float inv = 1.f / ls;
#pragma unroll
            for (int d = 0; d < 64; d += 4) *(f32x4*)(OW + d) = (f32x4){o[d] * inv, o[d + 1] * inv, o[d + 2] * inv, o[d + 3] * inv}; }
    }
}

DEV void phase_cmpattn(const Params& p, const Ctx& c, int l) {
    const bf16_t* ACT = WSP(bf16_t, WS_ACT); const float* KC = WSP(float, WS_MISC + MISC_KCMP); const float* VC = WSP(float, WS_MISC + MISC_VCMP);
    float* PB = WSP(float, WS_PB); float* PL = WSP(float, WS_SMALL + SM_PL); float* OC = WSP(float, WS_OCMP);
    const int lane = c.lane;
    for (int it = c.gw; it < 1024; it += c.NGW) {
        int b, g, h; item_bgh(it, b, g, h); const int t = g * 64 + lane; const size_t tok = (size_t)b * SEQ + t; const float slope = SLOPES[0][h];
        float q[64], o[64];
        load_q<64>(q, ACT + tok * ACTW + A_QA + h * 64);
#pragma unroll
        for (int d = 0; d < 64; ++d) o[d] = 0.f;
        const int nvis = t >= 31 ? ((t - 31) >> 4) + 1 : 0;
        const int tmaxw = g * 64 + 63; const int nmax = tmaxw >= 31 ? ((tmaxw - 31) >> 4) + 1 : 0;
        const float* kcb = KC + (size_t)b * 256 * 64; const float* vcb = VC + (size_t)b * 256 * 64;
        float m = -INFINITY;
        for (int n = 0; n < nmax; ++n) { const float* k = kcb + n * 64; float a = 0.f;
#pragma unroll
            for (int d = 0; d < 64; ++d) a += q[d] * k[d];
            const float s = a * 0.125f - slope * (float)(t - (16 * n + 31));
            if (n < nvis) m = fmaxf(m, s); }
        float ls = 0.f, carry = 0.f; float* pb = PB + (tok * 4 + h) * 64;
        for (int j = 0; j < 64; ++j) { float e4[4];
#pragma unroll
            for (int u = 0; u < 4; ++u) { const int n = 4 * j + u; float e = 0.f;
                if (n < nmax) { const float* k = kcb + n * 64; float a = 0.f;
#pragma unroll
                    for (int d = 0; d < 64; ++d) a += q[d] * k[d];
                    const float s = a * 0.125f - slope * (float)(t - (16 * n + 31));
                    if (n < nvis) { e = __expf(s - m); const float* v = vcb + n * 64;
#pragma unroll
                        for (int d = 0; d < 64; ++d) o[d] += e * v[d]; } }
                e4[u] = e; }
            pb[j] = carry + e4[0] + e4[1] + e4[2] + e4[3]; carry = e4[3]; ls += e4[0] + e4[1] + e4[2] + e4[3];
            if (4 * j + 4 >= nmax) { for (int jj = j + 1; jj < 64; ++jj) pb[jj] = (jj == j + 1) ? carry : 0.f; break; } }
        const float inv = 1.f / fmaxf(ls, 1e-30f);
        PL[tok * 4 + h] = inv;
        float* oc = OC + tok * 256 + h * 64;
#pragma unroll
        for (int d = 0; d < 64; d += 4) *(f32x4*)(oc + d) = (f32x4){o[d] * inv, o[d + 1] * inv, o[d + 2] * inv, o[d + 3] * inv};
    }
}

DEV void phase_topk(const Params& p, const Ctx& c) {
    const float* PB = WSP(float, WS_PB); const float* PL = WSP(float, WS_SMALL + SM_PL); unsigned long long* SEL = WSP(unsigned long long, WS_SMALL + SM_SEL);
    const int lane = c.lane;
    for (int tok = c.gw; tok < NTOK; tok += c.NGW) {
        const int t = tok % SEQ, cur = t >> 6;
        float ps = 0.f;
#pragma unroll
        for (int h = 0; h < 4; ++h) ps += PB[((size_t)tok * 4 + h) * 64 + lane] * PL[tok * 4 + h];
        const bool forced = (lane == 0) || (lane == cur) || (lane == cur - 1);
        float score = lane <= cur ? ps + (forced ? 1e4f : 0.f) : -1e30f;
        unsigned long long mask = 0ull;
        for (int r = 0; r < 8; ++r) {
            float bv = score; int bi = lane;
#define TK_STEP(M) { const float ov = swz_xor<M>(bv); const int oi = swz_xor_i<M>(bi); if (ov > bv || (ov == bv && oi < bi)) { bv = ov; bi = oi; } }
            TK_STEP(1) TK_STEP(2) TK_STEP(4) TK_STEP(8) TK_STEP(16)
#undef TK_STEP
            { auto rv = __builtin_amdgcn_permlane32_swap(__float_as_uint(bv), __float_as_uint(bv), false, false); auto ri = __builtin_amdgcn_permlane32_swap((unsigned)bi, (unsigned)bi, false, false);
              const float v0 = __uint_as_float(rv[0]), v1 = __uint_as_float(rv[1]); const int i0 = (int)ri[0], i1 = (int)ri[1];
              if (v1 > v0 || (v1 == v0 && i1 < i0)) { bv = v1; bi = i1; } else { bv = v0; bi = i0; } }
            if (bv > -5e29f) mask |= 1ull << bi;
            if (lane == bi) score = -INFINITY;
        }
        if (lane == 0) SEL[tok] = mask;
    }
}

DEV void phase_slc(const Params& p, const Ctx& c, int l) {
    const bf16_t* ACT = WSP(bf16_t, WS_ACT); bf16_t* BR = WSP(bf16_t, WS_BR); const unsigned long long* SEL = WSP(unsigned long long, WS_SMALL + SM_SEL);
    const float* OC = WSP(float, WS_OCMP); const float* OW = WSP(float, WS_OWIN); const float* GA = WSP(float, WS_SMALL + SM_GA);
    const int lane = c.lane;
    for (int it = c.gw; it < 1024; it += c.NGW) {
        int b, g, h; item_bgh(it, b, g, h); const int t = g * 64 + lane; const size_t tok = (size_t)b * SEQ + t; const float slope = SLOPES[0][h];
        float q[64], o[64]; float m = -INFINITY, ls = 0.f;
        load_q<64>(q, ACT + tok * ACTW + A_QA + h * 64);
#pragma unroll
        for (int d = 0; d < 64; ++d) o[d] = 0.f;
        const unsigned long long mask = SEL[tok];
        for (int j = g; j >= 0; --j) { const bool sel = (mask >> j) & 1ull;
            if (!__any(sel)) continue;
            for (int s = j * 64 + 63; s >= j * 64; --s) { const size_t kt = (size_t)b * SEQ + s;
                att_step<64, 0, 64>(q, o, m, ls, ACT + kt * ACTW + A_KS, nullptr, ACT + kt * ACTW + A_VS, 0.125f, -slope * (float)(t - s), sel && s <= t); } }
        const float inv = 1.f / ls; const float g0 = GA[tok * 12 + h * 3], g1 = GA[tok * 12 + h * 3 + 1], g2 = GA[tok * 12 + h * 3 + 2];
        const float* oc = OC + tok * 256 + h * 64; const float* ow = OW + tok * 256 + h * 64;
#pragma unroll
        for (int d = 0; d < 64; ++d) o[d] = g0 * oc[d] + g1 * o[d] * inv + g2 * ow[d];
        store_o_bf16<64>(BR + tok * 1024 + h * 64, o, 1.f);
    }
}


namespace fa {
typedef float f32x16 __attribute__((ext_vector_type(16)));
typedef short v4i16_t __attribute__((ext_vector_type(4)));
typedef float f32x2_t __attribute__((ext_vector_type(2))); typedef __bf16 bf16x2_t __attribute__((ext_vector_type(2)));
constexpr int KROWB = 208, VROWB = 192, KBYTES = 64 * KROWB, VBYTES = 64 * VROWB, STG = KBYTES + VBYTES;
constexpr int LDS_MISC = 2 * STG;
constexpr float LOG2E = 1.4426950408889634f;
constexpr float MFLOOR = -1e20f;
DEV unsigned cvtpk(float lo, float hi) { f32x2_t v = {lo, hi}; bf16x2_t b = __builtin_convertvector(v, bf16x2_t); return __builtin_bit_cast(unsigned, b); }
DEV unsigned long long uni64(unsigned long long v) { const unsigned lo = __builtin_amdgcn_readfirstlane((unsigned)v), hi = __builtin_amdgcn_readfirstlane((unsigned)(v >> 32)); return ((unsigned long long)hi << 32) | lo; }
DEV unsigned long long wave_or64(unsigned long long v) {
    unsigned lo = (unsigned)v, hi = (unsigned)(v >> 32);
#define FA_OR(M) lo |= (unsigned)__builtin_amdgcn_ds_swizzle((int)lo, (M << 10) | 0x1f); hi |= (unsigned)__builtin_amdgcn_ds_swizzle((int)hi, (M << 10) | 0x1f);
    FA_OR(1) FA_OR(2) FA_OR(4) FA_OR(8) FA_OR(16)
#undef FA_OR
    { auto a = __builtin_amdgcn_permlane32_swap(lo, lo, false, false); lo = a[0] | a[1]; auto b = __builtin_amdgcn_permlane32_swap(hi, hi, false, false); hi = b[0] | b[1]; }
    return uni64(((unsigned long long)hi << 32) | lo);
}
struct Src { const bf16_t* k; int kp; const bf16_t* k2; int k2p; const bf16_t* v; int vp; };
template <int NQ, bool ALIBI, int SELMODE>
DEV void attn_pass(LAS unsigned char* lds, const Ctx& c, const Src& src, const bf16x8 (&qf)[NQ], unsigned long long tmask, unsigned long long wmask,
                   int t, float nslope2, float c1, unsigned W, unsigned long long rowmask, int own_blk, f32x16 (&o)[2], float& m, float& l) {
    const int tid = c.tid, lane = c.lane, r32 = lane & 31, hi = lane >> 5;
    const int skey = tid >> 3, sch = tid & 7, skey2 = tid >> 2, sch2 = tid & 3;
    const int i16 = lane & 15, tq = i16 >> 2, tp = i16 & 3, blk = (lane >> 4) & 1;
    u32x4 kreg, vreg, k2reg = (u32x4){0u, 0u, 0u, 0u};
#define FA_GLOAD(kt_) do { const size_t r_ = (size_t)((kt_) * 64 + skey); kreg = *(const u32x4*)(src.k + r_ * src.kp + sch * 8); vreg = *(const u32x4*)(src.v + r_ * src.vp + sch * 8); \
        if (NQ == 6) { if (tid < 256) k2reg = *(const u32x4*)(src.k2 + (size_t)((kt_) * 64 + skey2) * src.k2p + sch2 * 8); } } while (0)
#define FA_LSTORE(buf_) do { LAS unsigned char* st_ = lds + (buf_) * STG; *(LAS u32x4*)(st_ + skey * KROWB + sch * 16) = kreg; *(LAS u32x4*)(st_ + KBYTES + skey * VROWB + sch * 16) = vreg; \
        if (NQ == 6) { if (tid < 256) *(LAS u32x4*)(st_ + skey2 * KROWB + 128 + sch2 * 16) = k2reg; } } while (0)
#pragma unroll
    for (int dt = 0; dt < 2; ++dt)
#pragma unroll
        for (int i = 0; i < 16; ++i) o[dt][i] = 0.f;
    m = MFLOOR; l = 0.f;
    if (tmask == 0ull) return;
    int kt = 63 - __builtin_clzll(tmask); tmask &= ~(1ull << kt);
    FA_GLOAD(kt);
    int buf = 0;
    for (;;) {
        FA_LSTORE(buf);
        __syncthreads();
        const bool more = tmask != 0ull; int ktn = 0;
        if (more) { ktn = 63 - __builtin_clzll(tmask); tmask &= ~(1ull << ktn); FA_GLOAD(ktn); }
        if ((wmask >> kt) & 1ull) {
            const LAS unsigned char* kb = lds + buf * STG; const LAS unsigned char* vb = kb + KBYTES;
            f32x16 s0, s1;
#pragma unroll
            for (int i = 0; i < 16; ++i) { s0[i] = 0.f; s1[i] = 0.f; }
#pragma unroll
            for (int d0 = 0; d0 < NQ; ++d0) {
                const bf16x8 k0 = *(const LAS bf16x8*)(kb + r32 * KROWB + (16 * d0 + 8 * hi) * 2);
                const bf16x8 k1 = *(const LAS bf16x8*)(kb + (32 + r32) * KROWB + (16 * d0 + 8 * hi) * 2);
                s0 = __builtin_amdgcn_mfma_f32_32x32x16_bf16(k0, qf[d0], s0, 0, 0, 0);
                s1 = __builtin_amdgcn_mfma_f32_32x32x16_bf16(k1, qf[d0], s1, 0, 0, 0);
            }
            bool rowsel = true;
            if (SELMODE == 1) rowsel = (rowmask >> kt) & 1ull;
            if (SELMODE == 2) rowsel = ((kt >> 2) == own_blk) || ((rowmask >> (kt >> 2)) & 1ull);
            const unsigned Weff = rowsel ? W : 0u;
            const int db0 = t - (kt * 64 + 4 * hi);
            float mx = -INFINITY;
#pragma unroll
            for (int i = 0; i < 16; ++i) { const int cr = (i & 3) + 8 * (i >> 2);
                { const int d = db0 - cr; float x = s0[i] * c1; if (ALIBI) x = fmaf((float)d, nslope2, x); x = ((unsigned)d < Weff) ? x : -INFINITY; s0[i] = x; mx = fmaxf(mx, x); }
                { const int d = db0 - 32 - cr; float x = s1[i] * c1; if (ALIBI) x = fmaf((float)d, nslope2, x); x = ((unsigned)d < Weff) ? x : -INFINITY; s1[i] = x; mx = fmaxf(mx, x); } }
            { auto rr = __builtin_amdgcn_permlane32_swap(__float_as_uint(mx), __float_as_uint(mx), false, false); mx = fmaxf(__uint_as_float(rr[0]), __uint_as_float(rr[1])); }
            const float mn = fmaxf(m, mx); const float alpha = __builtin_amdgcn_exp2f(m - mn); m = mn;
            float ls = 0.f;
#pragma unroll
            for (int i = 0; i < 16; ++i) { s0[i] = __builtin_amdgcn_exp2f(s0[i] - mn); s1[i] = __builtin_amdgcn_exp2f(s1[i] - mn); ls += s0[i] + s1[i]; }
            l = l * alpha + ls;
#pragma unroll
            for (int dt = 0; dt < 2; ++dt)
#pragma unroll
                for (int i = 0; i < 16; ++i) o[dt][i] *= alpha;
#pragma unroll
            for (int hf = 0; hf < 2; ++hf)
#pragma unroll
                for (int ks = 0; ks < 2; ++ks) {
                    u32x4 pw;
                    if (hf == 0) { pw.x = cvtpk(s0[8 * ks], s0[8 * ks + 1]); pw.y = cvtpk(s0[8 * ks + 2], s0[8 * ks + 3]); pw.z = cvtpk(s0[8 * ks + 4], s0[8 * ks + 5]); pw.w = cvtpk(s0[8 * ks + 6], s0[8 * ks + 7]); }
                    else         { pw.x = cvtpk(s1[8 * ks], s1[8 * ks + 1]); pw.y = cvtpk(s1[8 * ks + 2], s1[8 * ks + 3]); pw.z = cvtpk(s1[8 * ks + 4], s1[8 * ks + 5]); pw.w = cvtpk(s1[8 * ks + 6], s1[8 * ks + 7]); }
                    const bf16x8 pb = __builtin_bit_cast(bf16x8, pw);
#pragma unroll
                    for (int dt = 0; dt < 2; ++dt) {
                        const LAS unsigned char* vp = vb + (32 * hf + 16 * ks + 4 * hi + tq) * VROWB + (32 * dt + 16 * blk + 4 * tp) * 2;
                        const v4i16_t lo = __builtin_amdgcn_ds_read_tr16_b64_v4i16((LAS v4i16_t*)vp);
                        const v4i16_t hv = __builtin_amdgcn_ds_read_tr16_b64_v4i16((LAS v4i16_t*)(vp + 8 * VROWB));
                        const bf16x8 va = (bf16x8){lo[0], lo[1], lo[2], lo[3], hv[0], hv[1], hv[2], hv[3]};
                        o[dt] = __builtin_amdgcn_mfma_f32_32x32x16_bf16(va, pb, o[dt], 0, 0, 0);
                    }
                }
        }
        if (!more) break;
        kt = ktn; buf ^= 1;
    }
    __syncthreads();
    { auto rr = __builtin_amdgcn_permlane32_swap(__float_as_uint(l), __float_as_uint(l), false, false); l = __uint_as_float(rr[0]) + __uint_as_float(rr[1]); }
#undef FA_GLOAD
#undef FA_LSTORE
}
template <int NQ> DEV void load_qf(bf16x8 (&qf)[NQ], const bf16_t* qrow, int hi) {
#pragma unroll
    for (int d0 = 0; d0 < NQ; ++d0) qf[d0] = *(const bf16x8*)(qrow + 16 * d0 + 8 * hi);
}
DEV void store_o(bf16_t* orow, const f32x16 (&o)[2], float sc, int hi) {
#pragma unroll
    for (int dt = 0; dt < 2; ++dt)
#pragma unroll
        for (int g = 0; g < 4; ++g) { u32x2 w; w.x = cvtpk(o[dt][4 * g] * sc, o[dt][4 * g + 1] * sc); w.y = cvtpk(o[dt][4 * g + 2] * sc, o[dt][4 * g + 3] * sc);
            *(u32x2*)(orow + 32 * dt + 8 * g + 4 * hi) = w; }
}
DEV unsigned long long expand4(unsigned m16) { unsigned long long r = 0ull;
#pragma unroll
    for (int j = 0; j < 16; ++j) if ((m16 >> j) & 1u) r |= 0xFull << (4 * j);
    return r; }
}


DEV void moba_gate(const Params& p, const Ctx& c);
namespace fc {
using namespace fa;
constexpr int CKROWB = 144, CVROWB = 320, CKB = 64 * CKROWB, CVB = 64 * CVROWB, CSTG = CKB + CVB, BINS_OFF = 2 * CSTG, BINW = 65;
static_assert(BINS_OFF + 4 * 64 * BINW * 4 <= RING_BYTES, "cmp unit LDS");
DEV void cmp_unit(const Params& p, const Ctx& c, int b, int cb) {
    LAS unsigned char* lds = c.lds;
    const int tid = c.tid, lane = c.lane, r32 = lane & 31, hi = lane >> 5, w = c.wave, h = w >> 1;
    const int t = cb * 64 + (w & 1) * 32 + r32; const size_t tok = (size_t)b * SEQ + t;
    const bf16_t* ACT = WSP(bf16_t, WS_ACT);
    const bf16_t* KCB = WSP(bf16_t, WS_MISC + MISC_KCB) + (size_t)b * 256 * 64; const bf16_t* VCB = WSP(bf16_t, WS_MISC + MISC_VCB) + (size_t)b * 256 * 64;
    bf16x8 qf[4]; load_qf<4>(qf, ACT + tok * ACTW + A_QA + h * 64, hi);
    const float nslope2 = -SLOPES[0][h] * LOG2E, c1 = 0.125f * LOG2E;
    const int tmaxu = cb * 64 + 63; const int nvmax = tmaxu >= 31 ? ((tmaxu - 31) >> 4) + 1 : 0;
    const int ntile = (nvmax + 63) >> 6;
    const int skey = tid >> 3, sch = tid & 7;
    const int i16 = lane & 15, tq = i16 >> 2, tp = i16 & 3, blk = (lane >> 4) & 1;
    f32x16 o[4]; float m = MFLOOR, l = 0.f;
#pragma unroll
    for (int dt = 0; dt < 4; ++dt)
#pragma unroll
        for (int i = 0; i < 16; ++i) o[dt][i] = 0.f;
    for (int kt = ntile - 1; kt >= 0; --kt) {
        const int buf = kt & 1;
        LAS unsigned char* st = lds + buf * CSTG;
        { const int n = kt * 64 + skey;
          *(LAS u32x4*)(st + skey * CKROWB + sch * 16) = *(const u32x4*)(KCB + (size_t)n * 64 + sch * 8);
          *(LAS u32x4*)(st + CKB + skey * CVROWB + sch * 16) = *(const u32x4*)(VCB + (size_t)n * 64 + sch * 8);
          unsigned cw[4];
#pragma unroll
          for (int e = 0; e < 4; ++e) { const int j0 = sch * 8 + 2 * e, j1 = j0 + 1; const int ja = n >> 2; const bool ex = (n & 3) == 3;
              const unsigned lo16 = (j0 == ja || (ex && j0 == ja + 1)) ? 0x3F80u : 0u, hi16 = (j1 == ja || (ex && j1 == ja + 1)) ? 0x3F80u : 0u; cw[e] = lo16 | (hi16 << 16); }
          *(LAS u32x4*)(st + CKB + skey * CVROWB + 128 + sch * 16) = (u32x4){cw[0], cw[1], cw[2], cw[3]}; }
        __syncthreads();
        const LAS unsigned char* kb = st; const LAS unsigned char* vb = st + CKB;
        f32x16 s0, s1;
#pragma unroll
        for (int i = 0; i < 16; ++i) { s0[i] = 0.f; s1[i] = 0.f; }
#pragma unroll
        for (int d0 = 0; d0 < 4; ++d0) {
            const bf16x8 k0 = *(const LAS bf16x8*)(kb + r32 * CKROWB + (16 * d0 + 8 * hi) * 2);
            const bf16x8 k1 = *(const LAS bf16x8*)(kb + (32 + r32) * CKROWB + (16 * d0 + 8 * hi) * 2);
            s0 = __builtin_amdgcn_mfma_f32_32x32x16_bf16(k0, qf[d0], s0, 0, 0, 0);
            s1 = __builtin_amdgcn_mfma_f32_32x32x16_bf16(k1, qf[d0], s1, 0, 0, 0);
        }
        const int db0 = (t - 31) - 16 * (kt * 64 + 4 * hi);
        float mx = -INFINITY;
#pragma unroll
        for (int i = 0; i < 16; ++i) { const int cr = (i & 3) + 8 * (i >> 2);
            { const int d = db0 - 16 * cr; float x = fmaf((float)d, nslope2, s0[i] * c1); x = (d >= 0) ? x : -INFINITY; s0[i] = x; mx = fmaxf(mx, x); }
            { const int d = db0 - 16 * (32 + cr); float x = fmaf((float)d, nslope2, s1[i] * c1); x = (d >= 0) ? x : -INFINITY; s1[i] = x; mx = fmaxf(mx, x); } }
        { auto rr = __builtin_amdgcn_permlane32_swap(__float_as_uint(mx), __float_as_uint(mx), false, false); mx = fmaxf(__uint_as_float(rr[0]), __uint_as_float(rr[1])); }
        const float mn = fmaxf(m, mx); const float alpha = __builtin_amdgcn_exp2f(m - mn); m = mn;
        float ls = 0.f;
#pragma unroll
        for (int i = 0; i < 16; ++i) { s0[i] = __builtin_amdgcn_exp2f(s0[i] - mn); s1[i] = __builtin_amdgcn_exp2f(s1[i] - mn); ls += s0[i] + s1[i]; }
        l = l * alpha + ls;
#pragma unroll
        for (int dt = 0; dt < 4; ++dt)
#pragma unroll
            for (int i = 0; i < 16; ++i) o[dt][i] *= alpha;
#pragma unroll
        for (int hf = 0; hf < 2; ++hf)
#pragma unroll
            for (int ks = 0; ks < 2; ++ks) {
                u32x4 pw;
                if (hf == 0) { pw.x = cvtpk(s0[8 * ks], s0[8 * ks + 1]); pw.y = cvtpk(s0[8 * ks + 2], s0[8 * ks + 3]); pw.z = cvtpk(s0[8 * ks + 4], s0[8 * ks + 5]); pw.w = cvtpk(s0[8 * ks + 6], s0[8 * ks + 7]); }
                else         { pw.x = cvtpk(s1[8 * ks], s1[8 * ks + 1]); pw.y = cvtpk(s1[8 * ks + 2], s1[8 * ks + 3]); pw.z = cvtpk(s1[8 * ks + 4], s1[8 * ks + 5]); pw.w = cvtpk(s1[8 * ks + 6], s1[8 * ks + 7]); }
                const bf16x8 pb = __builtin_bit_cast(bf16x8, pw);
#pragma unroll
                for (int dt = 0; dt < 4; ++dt) {
                    const LAS unsigned char* vp = vb + (32 * hf + 16 * ks + 4 * hi + tq) * CVROWB + (32 * dt + 16 * blk + 4 * tp) * 2;
                    const v4i16_t lo = __builtin_amdgcn_ds_read_tr16_b64_v4i16((LAS v4i16_t*)vp);
                    const v4i16_t hv = __builtin_amdgcn_ds_read_tr16_b64_v4i16((LAS v4i16_t*)(vp + 8 * CVROWB));
                    const bf16x8 va = (bf16x8){lo[0], lo[1], lo[2], lo[3], hv[0], hv[1], hv[2], hv[3]};
                    o[dt] = __builtin_amdgcn_mfma_f32_32x32x16_bf16(va, pb, o[dt], 0, 0, 0);
                }
            }
    }
    { auto rr = __builtin_amdgcn_permlane32_swap(__float_as_uint(l), __float_as_uint(l), false, false); l = __uint_as_float(rr[0]) + __uint_as_float(rr[1]); }
    const float inv = 1.f / fmaxf(l, 1e-30f);
    { float* oc = WSP(float, WS_OCMP) + tok * 256 + h * 64;
#pragma unroll
      for (int dt = 0; dt < 2; ++dt)
#pragma unroll
          for (int g = 0; g < 4; ++g) *(f32x4*)(oc + 32 * dt + 8 * g + 4 * hi) = (f32x4){o[dt][4 * g] * inv, o[dt][4 * g + 1] * inv, o[dt][4 * g + 2] * inv, o[dt][4 * g + 3] * inv}; }
    LAS float* bins = (LAS float*)(lds + BINS_OFF);
    { const int rowl = h * 64 + (w & 1) * 32 + r32;
#pragma unroll
      for (int dd = 0; dd < 2; ++dd)
#pragma unroll
          for (int i = 0; i < 16; ++i) bins[rowl * BINW + 32 * dd + (i & 3) + 8 * (i >> 2) + 4 * hi] = o[2 + dd][i] * inv; }
    __syncthreads();
    unsigned long long* SEL = WSP(unsigned long long, WS_SMALL + SM_SEL);
    for (int i = 0; i < 8; ++i) { const int tl = w * 8 + i; const int tt = cb * 64 + tl; const int cur = cb;
        const float ps = ((bins[(0 * 64 + tl) * BINW + lane] + bins[(1 * 64 + tl) * BINW + lane]) + bins[(2 * 64 + tl) * BINW + lane]) + bins[(3 * 64 + tl) * BINW + lane];
        const bool forced = (lane == 0) || (lane == cur) || (lane == cur - 1);
        float score = lane <= cur ? ps + (forced ? 1e4f : 0.f) : -1e30f;
        unsigned long long mask = 0ull;
        for (int r = 0; r < 8; ++r) {
            float bv = score; int bi = lane;
#define TK_STEP(M) { const float ov = swz_xor<M>(bv); const int oi = swz_xor_i<M>(bi); if (ov > bv || (ov == bv && oi < bi)) { bv = ov; bi = oi; } }
            TK_STEP(1) TK_STEP(2) TK_STEP(4) TK_STEP(8) TK_STEP(16)
#undef TK_STEP
            { auto rv = __builtin_amdgcn_permlane32_swap(__float_as_uint(bv), __float_as_uint(bv), false, false); auto ri = __builtin_amdgcn_permlane32_swap((unsigned)bi, (unsigned)bi, false, false);
              const float v0 = __uint_as_float(rv[0]), v1 = __uint_as_float(rv[1]); const int i0 = (int)ri[0], i1 = (int)ri[1];
              if (v1 > v0 || (v1 == v0 && i1 < i0)) { bv = v1; bi = i1; } else { bv = v0; bi = i0; } }
            if (bv > -5e29f) mask |= 1ull << bi;
            if (lane == bi) score = -INFINITY;
        }
        if (lane == 0) SEL[(size_t)b * SEQ + tt] = mask;
    }
    __syncthreads();
}
}
DEV void phase_cmpsel(const Params& p, const Ctx& c, int l) {
    for (int u = c.bid; u < 256; u += c.G) { const int v = (u * 37) & 255;
        fc::cmp_unit(p, c, v & 3, 63 - (v >> 2)); }
    moba_gate(p, c);
}

constexpr int CW_QUEUE = 16384 + 512;
constexpr int N_ATT_UNITS = 1024;
DEV void phase_attn2(const Params& p, const Ctx& c, int l) {
    using namespace fa;
    const bf16_t* ACT = WSP(bf16_t, WS_ACT); const bf16_t* ACT2 = WSP(bf16_t, WS_ACT2); bf16_t* BR = WSP(bf16_t, WS_BR);
    unsigned* qhead = WSP(unsigned, WS_CTL) + CW_QUEUE + l; l &= 7;
    volatile LAS unsigned* misc = (volatile LAS unsigned*)(c.lds + LDS_MISC);
    const int lane = c.lane, r32 = lane & 31, hi = lane >> 5, w = c.wave;
    for (;;) {
        if (c.tid == 0) { misc[0] = atomicAdd(qhead, 1u); misc[2] = 0u; misc[3] = 0u; }
        __syncthreads();
        const int u = (int)__builtin_amdgcn_readfirstlane(misc[0]);
        if (u >= N_ATT_UNITS) break;
        f32x16 o[2]; float m, ls;
        if (u < 512) {
            const int k = 15 - (u >> 5), r = u & 31, bh = r & 15, b = bh >> 2, h = bh & 3; const bool moba = (r >> 4) != 0;
            const int t = k * 256 + w * 32 + r32; const size_t tok = (size_t)b * SEQ + t; const size_t b0 = (size_t)b * SEQ;
            if (!moba) {
                bf16x8 qf[6]; load_qf<6>(qf, ACT2 + tok * ACT2W + A2_QF + h * 96, hi);
                const Src src{ACT2 + b0 * ACT2W + A2_KN + h * 64, ACT2W, ACT + b0 * ACTW + A_KR, ACTW, ACT2 + b0 * ACT2W + A2_VD + h * 64, ACT2W};
                const int nt = 4 * k + 4; const unsigned long long tm = nt >= 64 ? ~0ull : ((1ull << nt) - 1ull);
                const int nw = 4 * k + (w >> 1) + 1; const unsigned long long wm = nw >= 64 ? ~0ull : ((1ull << nw) - 1ull);
                __syncthreads();
                attn_pass<6, false, 0>(c.lds, c, src, qf, tm, wm, t, 0.f, 0.10206207261596575f * LOG2E, 0x7fffffffu, 0ull, 0, o, m, ls);
                store_o(BR + tok * 1024 + 768 + h * 64, o, 1.f / ls, hi);
            } else {
                bf16x8 qf[4]; load_qf<4>(qf, ACT + tok * ACTW + A_QC + h * 64, hi);
                const Src src{ACT + b0 * ACTW + A_KC + h * 64, ACTW, nullptr, 0, ACT + b0 * ACTW + A_VC + h * 64, ACTW};
                const unsigned rm = WSP(unsigned, WS_OWIN)[tok * 4 + h];
                const unsigned long long wor = wave_or64((unsigned long long)rm);
                if (lane == 0) atomicOr((unsigned*)&misc[2], (unsigned)wor);
                __syncthreads();
                const unsigned bor = __builtin_amdgcn_readfirstlane(misc[2]);
                const unsigned long long own_all = 0xFull << (4 * k);
                const int nw = (w >> 1) + 1; const unsigned long long own_w = ((1ull << nw) - 1ull) << (4 * k);
                const unsigned long long tm = uni64(expand4(bor) | own_all), wm = uni64(expand4((unsigned)wor) | own_w);
                attn_pass<4, true, 2>(c.lds, c, src, qf, tm, wm, t, -SLOPES[2][h] * LOG2E, 0.125f * LOG2E, 0x7fffffffu, (unsigned long long)rm, k, o, m, ls);
                store_o(BR + tok * 1024 + 512 + h * 64, o, 1.f / ls, hi);
            }
        } else if (u < 768) {
            const int v = u - 512, cb = 63 - (v >> 2), b = v & 3, h = w >> 1;
            const int t = cb * 64 + (w & 1) * 32 + r32; const size_t tok = (size_t)b * SEQ + t; const size_t b0 = (size_t)b * SEQ;
            bf16x8 qf[4]; load_qf<4>(qf, ACT + tok * ACTW + A_QA + h * 64, hi);
            const float nsl = -SLOPES[0][h] * LOG2E;
            const float* GA = WSP(float, WS_SMALL + SM_GA) + tok * 12 + h * 3; const float g0 = GA[0], g1 = GA[1], g2 = GA[2];
            const unsigned long long rm = WSP(unsigned long long, WS_SMALL + SM_SEL)[tok];
            const unsigned long long wor = wave_or64(rm);
            if (lane == 0) { atomicOr((unsigned*)&misc[2], (unsigned)wor); atomicOr((unsigned*)&misc[3], (unsigned)(wor >> 32)); }
            { const Src src{ACT + b0 * ACTW + A_KW, ACTW, nullptr, 0, ACT + b0 * ACTW + A_VW, ACTW};
              const int lo = cb >= 8 ? cb - 8 : 0; const unsigned long long upto = cb >= 63 ? ~0ull : ((1ull << (cb + 1)) - 1ull); const unsigned long long tm = upto & ~((1ull << lo) - 1ull);
              __syncthreads();
              attn_pass<4, true, 0>(c.lds, c, src, qf, tm, tm, t, nsl, 0.125f * LOG2E, 512u, 0ull, 0, o, m, ls); }
            f32x16 res[2]; { const float sc = g2 / ls;
#pragma unroll
              for (int dt = 0; dt < 2; ++dt)
#pragma unroll
                  for (int i = 0; i < 16; ++i) res[dt][i] = o[dt][i] * sc; }
            { const Src src{ACT + b0 * ACTW + A_KS, ACTW, nullptr, 0, ACT + b0 * ACTW + A_VS, ACTW};
              const unsigned long long tm = ((unsigned long long)__builtin_amdgcn_readfirstlane(misc[3]) << 32) | __builtin_amdgcn_readfirstlane(misc[2]);
              attn_pass<4, true, 1>(c.lds, c, src, qf, tm, wor, t, nsl, 0.125f * LOG2E, 0x7fffffffu, rm, 0, o, m, ls); }
            { const float sc = g1 / ls; const float* oc = WSP(float, WS_OCMP) + tok * 256 + h * 64;
#pragma unroll
              for (int dt = 0; dt < 2; ++dt)
#pragma unroll
                  for (int g = 0; g < 4; ++g) { const f32x4 cv = *(const f32x4*)(oc + 32 * dt + 8 * g + 4 * hi);
#pragma unroll
                      for (int e = 0; e < 4; ++e) res[dt][4 * g + e] += o[dt][4 * g + e] * sc + g0 * cv[e]; } }
            store_o(BR + tok * 1024 + h * 64, res, 1.f, hi);
        } else {
            const int v = u - 768, b = v >> 6, g = (v >> 5) & 1, cc = v & 31, hr = w >> 2, h = 2 * g + hr;
            const int t = cc * 128 + (w & 3) * 32 + r32; const size_t tok = (size_t)b * SEQ + t; const size_t b0 = (size_t)b * SEQ;
            bf16x8 qf[4]; load_qf<4>(qf, ACT + tok * ACTW + A_QB + h * 64, hi);
            const Src src{ACT + b0 * ACTW + A_KB + g * 64, ACTW, nullptr, 0, ACT + b0 * ACTW + A_VB + g * 64, ACTW};
            const int lo = cc >= 1 ? 2 * cc - 2 : 0; const int hiT = 2 * cc + 1; const unsigned long long upto = hiT >= 63 ? ~0ull : ((1ull << (hiT + 1)) - 1ull);
            const unsigned long long tm = upto & ~((1ull << lo) - 1ull);
            const unsigned long long wm = ((w & 3) < 2) ? (tm & ~(1ull << hiT)) : tm;
            __syncthreads();
            attn_pass<4, true, 0>(c.lds, c, src, qf, tm, wm, t, -SLOPES[1][h] * LOG2E, 0.125f * LOG2E, 128u, 0ull, 0, o, m, ls);
            const float sk2 = p.in[10][l * 4 + h] * LOG2E; const float mf = fmaxf(m, sk2); const float a = __builtin_amdgcn_exp2f(m - mf); const float den = ls * a + __builtin_amdgcn_exp2f(sk2 - mf);
            store_o(BR + tok * 1024 + 256 + h * 64, o, a / den, hi);
        }
        __syncthreads();
    }
}
DEV void moba_gate(const Params& p, const Ctx& c) {
    const bf16_t* ACT = WSP(bf16_t, WS_ACT); unsigned* MS = WSP(unsigned, WS_OWIN);
    for (int it = c.gw; it < 1024; it += c.NGW) {
        int b, g, h; item_bgh(it, b, g, h); const int t = g * 64 + c.lane; const size_t tok = (size_t)b * SEQ + t; const int nb = g >> 2;
        float q[64]; load_q<64>(q, ACT + tok * ACTW + A_QC + h * 64);
        const float* KM = WSP(float, WS_MISC + MISC_KMEAN) + (size_t)b * 16 * 256 + h * 64;
        float v1 = -INFINITY, v2 = -INFINITY, v3 = -INFINITY; int i1 = -1, i2 = -1, i3 = -1;
        for (int n = 0; n < nb; ++n) { const float* km = KM + n * 256; float dsum = 0.f;
#pragma unroll
            for (int d = 0; d < 64; ++d) dsum += q[d] * km[d];
            if (dsum > v1) { v3 = v2; i3 = i2; v2 = v1; i2 = i1; v1 = dsum; i1 = n; }
            else if (dsum > v2) { v3 = v2; i3 = i2; v2 = dsum; i2 = n; }
            else if (dsum > v3) { v3 = dsum; i3 = n; } }
        unsigned mk = 0u; if (i1 >= 0) mk |= 1u << i1; if (i2 >= 0) mk |= 1u << i2; if (i3 >= 0) mk |= 1u << i3;
        MS[tok * 4 + h] = mk;
    }
}
DEV void phase_cmpw2(const Params& p, const Ctx& c, int l) {
    const int lane = c.lane;
    const bf16_t* HID = WSP(bf16_t, WS_HID); float* KC = WSP(float, WS_MISC + MISC_KCMP); float* VC = WSP(float, WS_MISC + MISC_VCMP);
    const float* gq = p.in[6] + (size_t)l * 10 * 64;
    for (int it = c.gw; it < 2 * 1020; it += c.NGW) { const int kv = it / 1020, r = it % 1020;
        const float* w2 = p.in[9] + (size_t)(l * 2 + kv) * 256 * 64; const bf16_t* hrow = HID + ((size_t)kv * 1024 + r) * 256;
        float a = 0.f;
        for (int k = 0; k < 256; ++k) a += bf2f(hrow[k]) * w2[k * 64 + lane];
        const int b = r / 255, i = r % 255;
        bf16_t* KCB = WSP(bf16_t, WS_MISC + MISC_KCB); bf16_t* VCB = WSP(bf16_t, WS_MISC + MISC_VCB);
        if (kv == 0) KCB[(b * 256 + i) * 64 + lane] = (bf16_t)f2bf(head_norm(a, gq + 1 * 64, lane)); else VCB[(b * 256 + i) * 64 + lane] = (bf16_t)f2bf(a);
        if (i == 0) { if (kv == 0) KCB[(b * 256 + 255) * 64 + lane] = 0; else VCB[(b * 256 + 255) * 64 + lane] = 0; } }
}

template <int NB> struct FMerge { const bf16_t* GATES; float* MIX; bf16_t* MIXB;
    DEV void operator()(int row, int col, const f32x4& v0, const f32x4& v1) const {
        const u32x4 gw = *(const u32x4*)(GATES + (size_t)row * NGATE + NB * 1024 + col);
        f32x4 a = (f32x4){bflo(gw.x), bfhi(gw.x), bflo(gw.y), bfhi(gw.y)} * v0, b = (f32x4){bflo(gw.z), bfhi(gw.z), bflo(gw.w), bfhi(gw.w)} * v1;
        float* mx = MIX + (size_t)row * 1024 + col;
        if (NB > 0) { a += *(const f32x4*)mx; b += *(const f32x4*)(mx + 4); }
        if (NB < 3) { *(f32x4*)mx = a; *(f32x4*)(mx + 4) = b; }
        else { u32x4 w; w.x = pk2(a[0], a[1]); w.y = pk2(a[2], a[3]); w.z = pk2(b[0], b[1]); w.w = pk2(b[2], b[3]); *(u32x4*)(MIXB + (size_t)row * 1024 + col) = w; } } };
template <int NB> DEV void phase_merge(const Params& p, const Ctx& c, int l) {
    pg8::Gemm g{WSP(bf16_t, WS_BR) + NB * 256, WSP(bf16_t, WS_WBR) + (size_t)(l * 4 + NB) * 1024 * 256, 1024, 256};
    pg8::StaticOrder S; S.init(NTOK, 1024, c.G, c.bid);
    pg8::Epi8<FMerge<NB>> E{{WSP(bf16_t, WS_GATES), (float*)(p.ws + WS_BIG + BIG_MIX), (bf16_t*)(p.ws + WS_BIG + BIG_MIXB)}};
    pg8::gemm_phase<pg8::Epi8<FMerge<NB>>, pg8::StaticOrder, true>(c.lds, g, S, E);
}
struct FOut { float* X; const float* g1; float* XO;
    DEV void operator()(int row, int col, const f32x4& v0, const f32x4& v1) const { const float* gg = g1 + (row / SEQ) * 6144 + col; float* x = X + (size_t)row * DM + col;
        float* xo = XO + (size_t)row * DM + col; *(f32x4*)xo = *(const f32x4*)x + *(const f32x4*)gg * v0; *(f32x4*)(xo + 4) = *(const f32x4*)(x + 4) + *(const f32x4*)(gg + 4) * v1; } };
template <bool REAL> DEV void phase_out(const Params& p, const Ctx& c, int l) {
    pg8::Gemm g{(const bf16_t*)(p.ws + WS_BIG + BIG_MIXB), WSP(bf16_t, WS_WOUT) + (size_t)l * 1024 * 1024, 1024, 1024};
    pg8::StaticOrder S; S.init(NTOK, 1024, c.G, c.bid);
    pg8::Epi8<FOut> E{{p.out, WSP(float, WS_MOD) + (size_t)l * 4 * 6144 + 2048, REAL ? p.out : WSP(float, WS_MUR)}};
    pg8::gemm_phase<pg8::Epi8<FOut>, pg8::StaticOrder, true>(c.lds, g, S, E);
}

template <bool COUNT> DEV void phase_router(const Params& p, const Ctx& c, int l) {
    const float* MOD = WSP(float, WS_MOD); bf16_t* H2B = WSP(bf16_t, WS_HBF);
    int* EID = WSP(int, WS_MISC + MISC_EID); float* WTS = WSP(float, WS_MISC + MISC_WTS); unsigned* ctl = WSP(unsigned, WS_CTL);
    const float* WRT = WSP(float, WS_MISC + MISC_WRT) + (size_t)l * 36 * 1024;
    const int lane = c.lane;
    LAS int* hist = (LAS int*)(c.lds + 4096);
    if (c.tid < 32) hist[c.tid] = 0;
    __syncthreads();
    const int rpb = NTOK / c.G, rpw = rpb / 8;
    for (int ri = 0; ri < rpw; ++ri) { const int row = c.bid * rpb + c.wave * rpw + ri;
        const int b = row / SEQ;
        f32x4 v[4]; float ss = 0.f;
#pragma unroll
        for (int j = 0; j < 4; ++j) { v[j] = *(const f32x4*)(p.out + (size_t)row * DM + j * 256 + lane * 4); ss += (v[j][0] * v[j][0] + v[j][1] * v[j][1]) + (v[j][2] * v[j][2] + v[j][3] * v[j][3]); }
        const float r = rsqrtf(wave_sum(ss) * (1.f / DM) + EPS);
        const float* gn = p.in[4] + (size_t)(l * 2 + 1) * DM; const float* sh = MOD + (l * 4 + b) * 6144 + 3072; const float* sc = sh + 1024;
#pragma unroll
        for (int j = 0; j < 4; ++j) { const int col = j * 256 + lane * 4;
            const f32x4 g = *(const f32x4*)(gn + col), s1 = *(const f32x4*)(sc + col), s0 = *(const f32x4*)(sh + col);
            v[j] = v[j] * r * g * (s1 + 1.f) + s0;
            u32x2 o; o.x = pk2(v[j][0], v[j][1]); o.y = pk2(v[j][2], v[j][3]); *(u32x2*)(H2B + (size_t)row * DM + col) = o; }
        LAS float* lgs = (LAS float*)(c.lds + c.wave * 256);
#pragma unroll 1
        for (int eg = 0; eg < 9; ++eg) { float a4[4];
#pragma unroll
            for (int u = 0; u < 4; ++u) { const float* wr = WRT + (eg * 4 + u) * 1024 + lane * 4; float a = 0.f;
#pragma unroll
                for (int j = 0; j < 4; ++j) { const f32x4 wv = *(const f32x4*)(wr + j * 256); a += (v[j][0] * wv[0] + v[j][1] * wv[1]) + (v[j][2] * wv[2] + v[j][3] * wv[3]); }
                a4[u] = a; }
#pragma unroll
            for (int u = 0; u < 4; ++u) a4[u] = wave_sum(a4[u]);
            if (lane == 0) *(LAS f32x4*)(lgs + eg * 4) = (f32x4){a4[0], a4[1], a4[2], a4[3]}; }
        LDS_WAIT(); asm volatile("" ::: "memory");
        float lc[4];
#pragma unroll
        for (int i = 0; i < 4; ++i) lc[i] = lgs[i] + p.in[19][l * 4 + i];
        int grp = 0; float mx = lc[0];
#pragma unroll
        for (int i = 1; i < 4; ++i) if (lc[i] > mx) { mx = lc[i]; grp = i; }
        float z = 0.f;
#pragma unroll
        for (int i = 0; i < 4; ++i) z += __expf(lc[i] - mx);
        const float pg = 1.f / z;
        float f1 = -INFINITY, f2 = -INFINITY; int e1 = 0, e2 = 0;
#pragma unroll
        for (int i = 0; i < 8; ++i) { const float x = lgs[4 + grp * 8 + i] + p.in[21][l * 32 + grp * 8 + i];
            if (x > f1) { f2 = f1; e2 = e1; f1 = x; e1 = i; } else if (x > f2) { f2 = x; e2 = i; } }
        LDS_WAIT(); asm volatile("" ::: "memory");
        const float q2 = __expf(f2 - f1); const float w1 = pg / (1.f + q2), w2 = pg * q2 / (1.f + q2);
        const int x1 = grp * 8 + e1, x2 = grp * 8 + e2;
        if (lane == 0) { EID[row * 2] = x1; EID[row * 2 + 1] = x2; WTS[row * 2] = w1; WTS[row * 2 + 1] = w2;
            __hip_atomic_fetch_add(hist + x1, 1, __ATOMIC_RELAXED, __HIP_MEMORY_SCOPE_WORKGROUP); __hip_atomic_fetch_add(hist + x2, 1, __ATOMIC_RELAXED, __HIP_MEMORY_SCOPE_WORKGROUP); }
    }
    __syncthreads();
    if (c.tid < 32) WSP(int, WS_MISC + MISC_HIST)[c.bid * 32 + c.tid] = hist[c.tid];
}

struct MoeTab { LAS int* start; LAS int* tile_e; LAS int* ntiles; };
DEV MoeTab build_moe_tab(const Params& p, const Ctx& c, int l) {
    MoeTab T; T.start = (LAS int*)(c.lds + LDS_AUX + 1024); T.tile_e = T.start + 32; T.ntiles = T.tile_e + 192;
    __syncthreads();
    if (c.tid == 0) { const unsigned* cnt = WSP(unsigned, WS_CTL) + CW_CNT + l * 32; int row = 0, nt = 0;
        for (int e = 0; e < 32; ++e) { const int n = (int)__hip_atomic_load(cnt + e, __ATOMIC_RELAXED, __HIP_MEMORY_SCOPE_AGENT); T.start[e] = row; const int tiles = (n + 255) >> 8;
            for (int i = 0; i < tiles; ++i) T.tile_e[nt + i] = e;
            nt += tiles; row += tiles * 256; }
        T.ntiles[0] = nt; }
    __syncthreads();
    return T;
}
DEV void phase_moesort(const Params& p, const Ctx& c, int l, int rep) {
    const int* HIST = WSP(int, WS_MISC + MISC_HIST);
    LAS int* part = (LAS int*)(c.lds + 4096);
    LAS int* base = part + 1024;
    LAS int* curs = base + 32;
    LAS int* tot = curs + 32;
    { const int e = c.tid & 31, seg = c.tid >> 5; int sa = 0, sp = 0;
      for (int i = 0; i < 16; ++i) { const int bb = seg * 16 + i; if (bb < c.G) { const int hv = HIST[bb * 32 + e]; sa += hv; sp += bb < c.bid ? hv : 0; } }
      part[seg * 32 + e] = sa; part[512 + seg * 32 + e] = sp; }
    __syncthreads();
    if (c.tid < 32) { int sa = 0, sp = 0;
        for (int i = 0; i < 16; ++i) { sa += part[i * 32 + c.tid]; sp += part[512 + i * 32 + c.tid]; }
        tot[c.tid] = sa; base[c.tid] = sp; curs[c.tid] = 0;
        if (c.bid == 0) WSP(unsigned, WS_CTL)[CW_CNT + l * 32 + c.tid] = (unsigned)sa; }
    __syncthreads();
    if (c.tid == 0) { int row = 0; for (int e = 0; e < 32; ++e) { base[e] += row; row += ((tot[e] + 255) >> 8) << 8; } }
    __syncthreads();
    const int* EID = WSP(int, WS_MISC + MISC_EID); int* PSLOT = WSP(int, WS_MISC + MISC_PSLOT);
    const bf16_t* H2B = WSP(bf16_t, WS_HBF); bf16_t* XS = (bf16_t*)(p.ws + WS_BIG + BIG_XS);
    const int lane = c.lane; const int rpb = NTOK / c.G, rpw = rpb / 8;
    for (int ri = 0; ri < rpw; ++ri) { const int tok = c.bid * rpb + c.wave * rpw + ri;
        const u32x4 a = *(const u32x4*)(H2B + (size_t)tok * DM + lane * 16), b2 = *(const u32x4*)(H2B + (size_t)tok * DM + lane * 16 + 8);
#pragma unroll
        for (int k = 0; k < 2; ++k) { const int e = EID[tok * 2 + k]; int slot = 0;
            if (lane == 0) slot = base[e] + __hip_atomic_fetch_add(curs + e, 1, __ATOMIC_RELAXED, __HIP_MEMORY_SCOPE_WORKGROUP);
            slot = __builtin_amdgcn_readfirstlane(slot);
            if (lane == 0) PSLOT[tok * 2 + k] = slot;
            *(u32x4*)(XS + (size_t)slot * DM + lane * 16) = a; *(u32x4*)(XS + (size_t)slot * DM + lane * 16 + 8) = b2; }
    }
}
template <int NCOL> struct MoeOrder { int G, c; LAS const int* tile_e; int ntiles;
    DEV bool next(int i, pg8::Unit& u) const { const int L = i * G + c; if (L >= ntiles * NCOL) return false; const int pm = L / NCOL; u.pm = pm; u.pn = tile_e[pm] * NCOL + (L % NCOL); return true; } };
struct FMoe1 { bf16_t* ACTB;
    DEV void operator()(int row, int col, const f32x4& v0, const f32x4& v1) const { const int ce = col & 511;
        u32x2 w; w.x = pk2(silu_(v0[0]) * v0[1], silu_(v0[2]) * v0[3]); w.y = pk2(silu_(v1[0]) * v1[1], silu_(v1[2]) * v1[3]);
        *(u32x2*)(ACTB + (size_t)row * 256 + (ce >> 1)) = w; } };
struct FMoe2 { bf16_t* YP;
    DEV void operator()(int row, int col, const f32x4& v0, const f32x4& v1) const { const int ce = col & 1023;
        u32x4 w; w.x = pk2(v0[0], v0[1]); w.y = pk2(v0[2], v0[3]); w.z = pk2(v1[0], v1[1]); w.w = pk2(v1[2], v1[3]); *(u32x4*)(YP + (size_t)row * DM + ce) = w; } };
DEV void phase_moe1(const Params& p, const Ctx& c, int l) {
    const MoeTab T = build_moe_tab(p, c, l);
    pg8::Gemm g{(const bf16_t*)(p.ws + WS_BIG + BIG_XS), WSP(bf16_t, WS_W13) + (size_t)l * 32 * 512 * 1024, 1024, 1024};
    MoeOrder<2> S{c.G, c.bid, T.tile_e, T.ntiles[0]}; pg8::Epi8<FMoe1> E{{WSP(bf16_t, WS_MUR)}};
    pg8::gemm_phase<pg8::Epi8<FMoe1>, MoeOrder<2>, true>(c.lds, g, S, E);
}
DEV void phase_moe2(const Params& p, const Ctx& c, int l) {
    const MoeTab T = build_moe_tab(p, c, l);
    pg8::Gemm g{WSP(bf16_t, WS_MUR), WSP(bf16_t, WS_W2) + (size_t)l * 32 * 1024 * 256, 256, 256};
    MoeOrder<4> S{c.G, c.bid, T.tile_e, T.ntiles[0]}; pg8::Epi8<FMoe2> E{{(bf16_t*)(p.ws + WS_BIG + BIG_YP)}};
    pg8::gemm_phase<pg8::Epi8<FMoe2>, MoeOrder<4>, true>(c.lds, g, S, E);
}

constexpr int PH_PRO = 0, PH_NORM1 = 1, PH_INPROJ = 2, PH_POST = 3, PH_MLAUP = 4, PH_POST2 = 5, PH_ATTN = 6, PH_CMPATTN = 7, PH_TOPK = 8, PH_SLC = 9,
              PH_MERGE0 = 10, PH_MERGE1 = 11, PH_MERGE2 = 12, PH_MERGE3 = 13, PH_OUT = 14, PH_ROUTER = 15, PH_SORT = 16, PH_MOE1 = 17, PH_MOE2 = 18, PH_FINAL = 19, PH_COUNT = 20;
constexpr int LDS_PTAB = LDS_AUX + 64;
DEV unsigned long long uni64(unsigned long long v) { const unsigned lo = __builtin_amdgcn_readfirstlane((unsigned)v), hi = __builtin_amdgcn_readfirstlane((unsigned)(v >> 32)); return ((unsigned long long)hi << 32) | lo; }
DEV void store_params(const Params& p, LAS unsigned char* lds) {
    LAS unsigned long long* L = (LAS unsigned long long*)(lds + LDS_PTAB);
    if (threadIdx.x == 0) {
#pragma unroll
        for (int i = 0; i < 24; ++i) L[i] = (unsigned long long)p.in[i];
        L[24] = (unsigned long long)p.out; L[25] = (unsigned long long)p.ws; }
}
DEV Params load_params(LAS unsigned char* lds) {
    const LAS unsigned long long* L = (const LAS unsigned long long*)(lds + LDS_PTAB); Params p;
#pragma unroll
    for (int i = 0; i < 24; ++i) p.in[i] = (const float*)uni64(L[i]);
    p.out = (float*)uni64(L[24]); p.ws = (unsigned char*)uni64(L[25]); return p;
}
template <int PH, int REP = 0> DEV void run_phase(const Params& p, const Ctx& c, int l) {
    if constexpr (PH == PH_PRO) phase_prologue(p, c);
    else if constexpr (PH == PH_NORM1) phase_norm1<true, REP == 0>(p, c, l);
    else if constexpr (PH == PH_INPROJ) phase_inproj(p, c, l);
    else if constexpr (PH == PH_POST) phase_post(p, c, l);
    else if constexpr (PH == PH_MLAUP) phase_mlaup(p, c, l);
    else if constexpr (PH == PH_POST2) phase_post2(p, c, l);
    else if constexpr (PH == PH_ATTN) phase_cmpw2(p, c, l);
    else if constexpr (PH == PH_CMPATTN) phase_cmpsel(p, c, l);
    else if constexpr (PH == PH_TOPK) { }
    else if constexpr (PH == PH_SLC) phase_attn2(p, c, l + 8 * REP);
    else if constexpr (PH == PH_MERGE0) phase_merge<0>(p, c, l);
    else if constexpr (PH == PH_MERGE1) phase_merge<1>(p, c, l);
    else if constexpr (PH == PH_MERGE2) phase_merge<2>(p, c, l);
    else if constexpr (PH == PH_MERGE3) phase_merge<3>(p, c, l);
    else if constexpr (PH == PH_OUT) phase_out<REP == 0>(p, c, l);
    else if constexpr (PH == PH_ROUTER) phase_router<REP == 0>(p, c, l);
    else if constexpr (PH == PH_SORT) phase_moesort(p, c, l, REP);
    else if constexpr (PH == PH_MOE1) phase_moe1(p, c, l);
    else if constexpr (PH == PH_MOE2) phase_moe2(p, c, l);
    else if constexpr (PH == PH_FINAL) phase_norm1<false, true>(p, c, NLAYER);
}

#if !MK_ONE_LAUNCH
template <int PH> __global__ void __launch_bounds__(512, 2) k_phase(Params p, int l) {
    extern __shared__ __attribute__((aligned(16))) unsigned char lds_raw[];
    const Ctx c = make_ctx((LAS unsigned char*)lds_raw);
    run_phase<PH>(p, c, l);
}
template <int PH> static void launch_phase(const Params& p, int l, int grid, hipStream_t stream) {
    static bool attr_set = false;
    if (!attr_set) { (void)hipFuncSetAttribute((const void*)k_phase<PH>, hipFuncAttributeMaxDynamicSharedMemorySize, LDS_BYTES); attr_set = true; }
    hipLaunchKernelGGL(k_phase<PH>, dim3(grid), dim3(512), LDS_BYTES, stream, p, l);
}
#else
#define BAR() xcd_barrier_fn(bar.bar, bar.x, bar.st)
template <int l> DEV void mega_layer(LAS unsigned char* lds, const XcdBarrier& bar) {
        { const Ctx c = make_ctx(lds); const Params q = load_params(lds); run_phase<PH_NORM1>(q, c, l); } BAR(); if constexpr ((PROBE_MASK >> PH_NORM1) & 1u) { { const Ctx c = make_ctx(lds); const Params q = load_params(lds); run_phase<PH_NORM1, 1>(q, c, l); } BAR(); }
        { const Ctx c = make_ctx(lds); const Params q = load_params(lds); run_phase<PH_INPROJ>(q, c, l); } BAR(); if constexpr ((PROBE_MASK >> PH_INPROJ) & 1u) { { const Ctx c = make_ctx(lds); const Params q = load_params(lds); run_phase<PH_INPROJ, 1>(q, c, l); } BAR(); }
        { const Ctx c = make_ctx(lds); const Params q = load_params(lds); run_phase<PH_POST>(q, c, l); } BAR(); if constexpr ((PROBE_MASK >> PH_POST) & 1u) { { const Ctx c = make_ctx(lds); const Params q = load_params(lds); run_phase<PH_POST, 1>(q, c, l); } BAR(); }
        { const Ctx c = make_ctx(lds); const Params q = load_params(lds); run_phase<PH_MLAUP>(q, c, l); } BAR(); if constexpr ((PROBE_MASK >> PH_MLAUP) & 1u) { { const Ctx c = make_ctx(lds); const Params q = load_params(lds); run_phase<PH_MLAUP, 1>(q, c, l); } BAR(); }
        { const Ctx c = make_ctx(lds); const Params q = load_params(lds); run_phase<PH_POST2>(q, c, l); } BAR(); if constexpr ((PROBE_MASK >> PH_POST2) & 1u) { { const Ctx c = make_ctx(lds); const Params q = load_params(lds); run_phase<PH_POST2, 1>(q, c, l); } BAR(); }
        { const Ctx c = make_ctx(lds); const Params q = load_params(lds); run_phase<PH_ATTN>(q, c, l); } BAR(); if constexpr ((PROBE_MASK >> PH_ATTN) & 1u) { { const Ctx c = make_ctx(lds); const Params q = load_params(lds); run_phase<PH_ATTN, 1>(q, c, l); } BAR(); }
        { const Ctx c = make_ctx(lds); const Params q = load_params(lds); run_phase<PH_CMPATTN>(q, c, l); } BAR(); if constexpr ((PROBE_MASK >> PH_CMPATTN) & 1u) { { const Ctx c = make_ctx(lds); const Params q = load_params(lds); run_phase<PH_CMPATTN, 1>(q, c, l); } BAR(); }
        { const Ctx c = make_ctx(lds); const Params q = load_params(lds); run_phase<PH_SLC>(q, c, l); } BAR(); if constexpr ((PROBE_MASK >> PH_SLC) & 1u) { { const Ctx c = make_ctx(lds); const Params q = load_params(lds); run_phase<PH_SLC, 1>(q, c, l); } BAR(); }
        { const Ctx c = make_ctx(lds); const Params q = load_params(lds); run_phase<PH_MERGE0>(q, c, l); } BAR(); if constexpr ((PROBE_MASK >> PH_MERGE0) & 1u) { { const Ctx c = make_ctx(lds); const Params q = load_params(lds); run_phase<PH_MERGE0, 1>(q, c, l); } BAR(); }
        { const Ctx c = make_ctx(lds); const Params q = load_params(lds); run_phase<PH_MERGE1>(q, c, l); } BAR(); if constexpr ((PROBE_MASK >> PH_MERGE1) & 1u) { { const Ctx c = make_ctx(lds); const Params q = load_params(lds); run_phase<PH_MERGE1, 1>(q, c, l); } BAR(); }
        { const Ctx c = make_ctx(lds); const Params q = load_params(lds); run_phase<PH_MERGE2>(q, c, l); } BAR(); if constexpr ((PROBE_MASK >> PH_MERGE2) & 1u) { { const Ctx c = make_ctx(lds); const Params q = load_params(lds); run_phase<PH_MERGE2, 1>(q, c, l); } BAR(); }
        { const Ctx c = make_ctx(lds); const Params q = load_params(lds); run_phase<PH_MERGE3>(q, c, l); } BAR(); if constexpr ((PROBE_MASK >> PH_MERGE3) & 1u) { { const Ctx c = make_ctx(lds); const Params q = load_params(lds); run_phase<PH_MERGE3, 1>(q, c, l); } BAR(); }
        { const Ctx c = make_ctx(lds); const Params q = load_params(lds); run_phase<PH_OUT>(q, c, l); } BAR(); if constexpr ((PROBE_MASK >> PH_OUT) & 1u) { { const Ctx c = make_ctx(lds); const Params q = load_params(lds); run_phase<PH_OUT, 1>(q, c, l); } BAR(); }
        { const Ctx c = make_ctx(lds); const Params q = load_params(lds); run_phase<PH_ROUTER>(q, c, l); } BAR(); if constexpr ((PROBE_MASK >> PH_ROUTER) & 1u) { { const Ctx c = make_ctx(lds); const Params q = load_params(lds); run_phase<PH_ROUTER, 1>(q, c, l); } BAR(); }
        { const Ctx c = make_ctx(lds); const Params q = load_params(lds); run_phase<PH_SORT>(q, c, l); } BAR(); if constexpr ((PROBE_MASK >> PH_SORT) & 1u) { { const Ctx c = make_ctx(lds); const Params q = load_params(lds); run_phase<PH_SORT, 1>(q, c, l); } BAR(); }
        { const Ctx c = make_ctx(lds); const Params q = load_params(lds); run_phase<PH_MOE1>(q, c, l); } BAR(); if constexpr ((PROBE_MASK >> PH_MOE1) & 1u) { { const Ctx c = make_ctx(lds); const Params q = load_params(lds); run_phase<PH_MOE1, 1>(q, c, l); } BAR(); }
        { const Ctx c = make_ctx(lds); const Params q = load_params(lds); run_phase<PH_MOE2>(q, c, l); } BAR(); if constexpr ((PROBE_MASK >> PH_MOE2) & 1u) { { const Ctx c = make_ctx(lds); const Params q = load_params(lds); run_phase<PH_MOE2, 1>(q, c, l); } BAR(); }
}
__global__ void __launch_bounds__(512, 2) k_mega(Params p) {
    extern __shared__ __attribute__((aligned(16))) unsigned char lds_raw[];
    LAS unsigned char* lds = (LAS unsigned char*)lds_raw;
    volatile LAS unsigned* bst = (volatile LAS unsigned*)(lds + LDS_AUX);
    if (threadIdx.x < 4) bst[threadIdx.x] = 0u;
    store_params(p, lds);
    __syncthreads();
    const XcdBarrier bar = xcd_barrier_post(WSP(unsigned, WS_CTL) + CW_BAR, bst);
    { const Ctx c = make_ctx(lds); const Params q = load_params(lds); run_phase<PH_PRO>(q, c, 0); } BAR(); if constexpr ((PROBE_MASK >> PH_PRO) & 1u) { { const Ctx c = make_ctx(lds); const Params q = load_params(lds); run_phase<PH_PRO, 1>(q, c, 0); } BAR(); }
    mega_layer<0>(lds, bar); mega_layer<1>(lds, bar); mega_layer<2>(lds, bar); mega_layer<3>(lds, bar);
    { const Ctx c = make_ctx(lds); const Params q = load_params(lds); run_phase<PH_FINAL>(q, c, NLAYER); }
#undef BAR
}
#endif

extern "C" void kernel_launch(void* const* d_in, const int* in_sizes, int n_in, void* d_out, int out_size, void* d_ws, size_t ws_size, hipStream_t stream) {
    if (n_in != 24 || out_size != NTOK * DM || ws_size < WS_END) { fprintf(stderr, "kernel_launch: unexpected shapes (n_in %d out %d ws %zu, need %zu)\n", n_in, out_size, ws_size, (size_t)WS_END); return; }
    Params p{};
    for (int i = 0; i < 24; ++i) p.in[i] = (const float*)d_in[i];
    p.out = (float*)d_out; p.ws = (unsigned char*)d_ws;
    (void)hipMemsetAsync((char*)d_ws + WS_CTL, 0, 1 * MiB, stream);
    const int grid = 256;
#if !MK_ONE_LAUNCH
    launch_phase<PH_PRO>(p, 0, grid, stream);
    for (int l = 0; l < NLAYER; ++l) {
        launch_phase<PH_NORM1>(p, l, grid, stream);
        launch_phase<PH_INPROJ>(p, l, grid, stream);
        launch_phase<PH_POST>(p, l, grid, stream);
        launch_phase<PH_MLAUP>(p, l, grid, stream);
        launch_phase<PH_POST2>(p, l, grid, stream);
        launch_phase<PH_ATTN>(p, l, grid, stream);
        launch_phase<PH_CMPATTN>(p, l, grid, stream);
        launch_phase<PH_SLC>(p, l, grid, stream);
        launch_phase<PH_MERGE0>(p, l, grid, stream);
        launch_phase<PH_MERGE1>(p, l, grid, stream);
        launch_phase<PH_MERGE2>(p, l, grid, stream);
        launch_phase<PH_MERGE3>(p, l, grid, stream);
        launch_phase<PH_OUT>(p, l, grid, stream);
        launch_phase<PH_ROUTER>(p, l, grid, stream);
        launch_phase<PH_SORT>(p, l, grid, stream);
        launch_phase<PH_MOE1>(p, l, grid, stream);
        launch_phase<PH_MOE2>(p, l, grid, stream);
    }
    launch_phase<PH_FINAL>(p, NLAYER, grid, stream);
#else
    static bool attr_set = false;
    if (!attr_set) { (void)hipFuncSetAttribute((const void*)k_mega, hipFuncAttributeMaxDynamicSharedMemorySize, LDS_BYTES); attr_set = true; }
    hipLaunchKernelGGL(k_mega, dim3(grid), dim3(512), LDS_BYTES, stream, p);
#endif
}
```

```cpp
#include <hip/hip_runtime.h>
#include <cstdio>
#include <cstdint>
#include <cmath>

#ifndef MK_ONE_LAUNCH
#define MK_ONE_LAUNCH 1
#endif
#ifndef PROBE_MASK
#define PROBE_MASK 0u
#endif

#define DEV __device__ __forceinline__
#define LAS __attribute__((address_space(3)))
typedef unsigned short bf16_t;
typedef short bf16x8 __attribute__((ext_vector_type(8)));
typedef float f32x4 __attribute__((ext_vector_type(4)));
typedef unsigned u32x4 __attribute__((ext_vector_type(4)));
typedef unsigned u32x2 __attribute__((ext_vector_type(2)));

constexpr int NBATCH = 4, SEQ = 4096, DM = 1024, NTOK = NBATCH * SEQ, NLAYER = 4;
constexpr int DIN = 6572, NSMALL = 2476, PSW = 2560, NPROJ = 6656, NGATE = 4096;
constexpr int I_QA = 0, I_KC = 256, I_VC = 320, I_KS = 384, I_VS = 448, I_KW = 512, I_VW = 576, I_GL = 640, I_QB = 652, I_KB = 908, I_VB = 1036,
              I_QC = 1164, I_KCC = 1420, I_VCC = 1676, I_CQ = 1932, I_CKV = 2316, I_KR = 2444;
constexpr int ACTW = 2560;
constexpr int A_QA = 0, A_KCR = 256, A_VCR = 320, A_KS = 384, A_VS = 448, A_KW = 512, A_VW = 576, A_QB = 640, A_KB = 896, A_VB = 1024,
              A_QC = 1152, A_KC = 1408, A_VC = 1664, A_CQ = 1920, A_CKV = 2304, A_KR = 2432;
constexpr int ACT2W = 896, A2_QF = 0, A2_KN = 384, A2_VD = 640;
constexpr int NCMP = 255, NEXP = 32, XS_ROWS = 40960;
constexpr float EPS = 1e-6f;
__device__ const float SLOPES[3][4] = {{0.70710678118654752f, 0.25f, 0.08838834764831845f, 0.015625f},
                                       {0.5f, 0.17677669529663689f, 0.0625f, 0.0078125f},
                                       {0.35355339059327379f, 0.125f, 0.03125f, 0.00390625f}};

constexpr size_t MiB = 1u << 20;
constexpr size_t WS_CTL = 0;
constexpr size_t WS_MOD = 1 * MiB;
constexpr size_t WS_ROPE = 2 * MiB;
constexpr size_t WS_MISC = 3 * MiB;
constexpr size_t WS_WIN = 8 * MiB;
constexpr size_t WS_W13 = WS_WIN + 56 * MiB;
constexpr size_t WS_W2 = WS_W13 + 128 * MiB;
constexpr size_t WS_WOUT = WS_W2 + 64 * MiB;
constexpr size_t WS_WBR = WS_WOUT + 8 * MiB;
constexpr size_t WS_CW1 = WS_WBR + 8 * MiB;
constexpr size_t WS_WU = WS_CW1 + 8 * MiB;
constexpr size_t WS_HBF = WS_WU + 4 * MiB;
constexpr size_t WS_BIG = WS_HBF + 32 * MiB;
constexpr size_t WS_GATES = WS_BIG + 160 * MiB;
constexpr size_t WS_ACT = WS_GATES + 128 * MiB;
constexpr size_t WS_ACT2 = WS_ACT + 80 * MiB;
constexpr size_t WS_MUR = WS_ACT2 + 28 * MiB;
constexpr size_t WS_CMPA = WS_MUR + 64 * MiB;
constexpr size_t WS_HID = WS_CMPA + 8 * MiB;
constexpr size_t WS_PB = WS_HID + 1 * MiB;
constexpr size_t WS_OCMP = WS_PB + 16 * MiB;
constexpr size_t WS_OWIN = WS_OCMP + 16 * MiB;
constexpr size_t WS_SMALL = WS_OWIN + 16 * MiB;
constexpr size_t WS_BR = WS_SMALL + 2 * MiB;
constexpr size_t WS_END = WS_BR + 32 * MiB;
static_assert(WS_END <= 1000 * MiB, "workspace map");
constexpr size_t BIG_PSM = 0, BIG_MIX = 0, BIG_MIXB = 64 * MiB, BIG_XS = 0, BIG_YP = 80 * MiB;
constexpr size_t MISC_HIST = 3 * MiB;
constexpr size_t MISC_KCB = 1024 * 1024, MISC_VCB = 1024 * 1024 + 128 * 1024, MISC_WRT = 2 * MiB;
constexpr size_t MISC_KCMP = 0, MISC_VCMP = 256 * 1024, MISC_KMEAN = 512 * 1024, MISC_EID = 640 * 1024, MISC_WTS = 768 * 1024, MISC_PSLOT = 896 * 1024;
constexpr size_t SM_PL = 0, SM_SEL = 256 * 1024, SM_GA = 512 * 1024;
constexpr int CW_BAR = 4096;
constexpr int CW_CNT = 16384;
constexpr int CW_CUR = 16384 + 256;

constexpr int RING_BYTES = 131072, LDS_AUX = RING_BYTES, LDS_BYTES = 147456;

struct Params { const float* in[24]; float* out; unsigned char* ws; };

DEV float bf2f(unsigned v) { return __uint_as_float(v << 16); }
DEV float bflo(unsigned w) { return __uint_as_float(w << 16); }
DEV float bfhi(unsigned w) { return __uint_as_float(w & 0xffff0000u); }
DEV unsigned f2bf(float f) { unsigned u = __float_as_uint(f); return (u + 0x7fffu + ((u >> 16) & 1u)) >> 16; }
DEV unsigned pk2(float lo, float hi) { return f2bf(lo) | (f2bf(hi) << 16); }
template <int M> DEV float swz_xor(float v) { return __int_as_float(__builtin_amdgcn_ds_swizzle(__float_as_int(v), (M << 10) | 0x1f)); }
template <int M> DEV int swz_xor_i(int v) { return __builtin_amdgcn_ds_swizzle(v, (M << 10) | 0x1f); }
DEV float xhalf(float v, float& other) { auto rr = __builtin_amdgcn_permlane32_swap(__float_as_uint(v), __float_as_uint(v), false, false); other = __uint_as_float(rr[1]); return __uint_as_float(rr[0]); }
DEV float wave_sum(float v) {
    v += swz_xor<1>(v); v += swz_xor<2>(v); v += swz_xor<4>(v); v += swz_xor<8>(v); v += swz_xor<16>(v);
    float hi; const float lo = xhalf(v, hi); return lo + hi;
}
DEV float sigm(float x) { return 1.f / (1.f + __expf(-x)); }
DEV float silu_(float x) { return x / (1.f + __expf(-x)); }
#define LDS_WAIT() asm volatile("s_waitcnt lgkmcnt(0)" ::: "memory")

namespace pg8 {
constexpr int BM = 256, BK = 64, HALF = 128, HTB = HALF * BK * 2, STAGE_BYTES = 8 * HTB, NXCD = 8, WGM = 8;
__host__ __device__ __forceinline__ int lds_byte(int r, int c) { const int st = (r >> 4) * 2 + (c >> 5), rr = r & 15, cc = c & 31, ob = rr * 64 + cc * 2; return st * 1024 + (ob ^ (((ob >> 9) & 1) << 5)); }
__host__ __device__ __forceinline__ void stage_rc(int b, int& R, int& C) { const int st = b / 1024, sb = b % 1024, swz = sb ^ (((sb >> 9) & 1) << 5); R = (st >> 1) * 16 + swz / 64; C = (st & 1) * 32 + (swz % 64) / 2; }
__host__ __device__ __forceinline__ int perm32(int rho) { const int n = rho >> 4, i = rho & 15; return 8 * (i >> 2) + 4 * n + (i & 3); }
struct Unit { int pm, pn, ao; };
struct Gemm { const bf16_t* A; const bf16_t* Bt; int lda, K; };
struct StaticOrder {
    int nM, nN, nwg, G, c;
    __device__ void init(int M, int N, int G_, int c_) { nM = M / BM; nN = N / BM; nwg = nM * nN; G = G_; c = c_; }
    __device__ bool next(int i, Unit& u) const {
        const long L = (long)i * G + c; if (L >= nwg) return false;
        int wgid = (int)L; { const int q = nwg / NXCD, r = nwg % NXCD, xcd = wgid % NXCD, off = wgid / NXCD; wgid = (xcd < r ? xcd * (q + 1) : r * (q + 1) + (xcd - r) * q) + off; }
        const int nig = WGM * nN, gid = wgid / nig, fm = gid * WGM, gsz = (nM - fm) < WGM ? (nM - fm) : WGM;
        u.pm = fm + ((wgid % nig) % gsz); u.pn = (wgid % nig) / gsz; u.ao = 0; return true;
    }
};
template <class F> struct Epi8 {
    F f;
    __device__ __forceinline__ void operator()(const f32x4 (&acc)[2][2][4][2], const Unit& u, int wr, int wc, int fr, int fq) const {
        const int row0 = u.pm * BM + wr * 64 + fr, col0 = u.pn * BM + wc * 32 + 8 * fq;
#pragma unroll
        for (int ai = 0; ai < 2; ++ai)
#pragma unroll
            for (int m = 0; m < 4; ++m)
#pragma unroll
                for (int bj = 0; bj < 2; ++bj) f(row0 + ai * HALF + m * 16, col0 + bj * HALF, acc[ai][bj][m][0], acc[ai][bj][m][1]);
    }
};
template <class Epi, class Sched, bool ALIGN_EPI>
__device__ __forceinline__ void gemm_phase(LAS unsigned char* lds, const Gemm g, const Sched& S, const Epi& E) {
    int tid_ = threadIdx.x; asm volatile("" : "+v"(tid_));
    const int tid = tid_, wid = __builtin_amdgcn_readfirstlane(tid >> 6), lane = tid & 63, wr = wid >> 2, wc = wid & 3, fr = lane & 15, fq = lane >> 4;
    const int K = g.K, nt = K / BK, lda = g.lda;
    unsigned voffA[2], voffB[2];
#pragma unroll
    for (int i = 0; i < 2; ++i) { int R, C; stage_rc(tid * 16 + i * 8192, R, C); const int Rb = (R & ~31) + perm32(R & 31);
        voffA[i] = (unsigned)(R * lda + C) * 2u; voffB[i] = (unsigned)(Rb * K + C) * 2u; }
    const size_t kstep = (size_t)(BK * 2);
    const size_t hstepA = (size_t)HALF * lda * 2, tstepA = 2 * hstepA;
    const size_t hstepB = (size_t)HALF * K * 2, tstepB = 2 * hstepB;
    const unsigned ldsw = (unsigned)wid * 1024u;
    const int aoff = lds_byte(wr * 64 + fr, fq * 8), boff = lds_byte(wc * 32 + fr, fq * 8);
#define PG8_SA(b, h) (((b) * 2 + (h)) * HTB)
#define PG8_SB(b, h) ((4 + (b) * 2 + (h)) * HTB)
#define PG8_STAGE(bufoff, gbase, voff) do { _Pragma("unroll") for (int _i = 0; _i < 2; ++_i) \
        __builtin_amdgcn_global_load_lds((const unsigned*)((const char*)(gbase) + (voff)[_i]), (LAS unsigned*)(lds + (bufoff) + ldsw + _i * 8192), 16, 0, 0); } while (0)
#define PG8_LDA(dst, b, h) do { _Pragma("unroll") for (int m = 0; m < 4; ++m) _Pragma("unroll") for (int k = 0; k < 2; ++k) dst[m][k] = *(const LAS bf16x8*)(lds + PG8_SA(b, h) + aoff + m * 2048 + k * 1024); } while (0)
#define PG8_LDB(dst, b, h) do { _Pragma("unroll") for (int n = 0; n < 2; ++n) _Pragma("unroll") for (int k = 0; k < 2; ++k) dst[n][k] = *(const LAS bf16x8*)(lds + PG8_SB(b, h) + boff + n * 2048 + k * 1024); } while (0)
#define PG8_MMA(ai, bj, At, Bt) do { __builtin_amdgcn_s_setprio(1); _Pragma("unroll") for (int m = 0; m < 4; ++m) _Pragma("unroll") for (int n = 0; n < 2; ++n) _Pragma("unroll") for (int k = 0; k < 2; ++k) \
        acc[ai][bj][m][n] = __builtin_amdgcn_mfma_f32_16x16x32_bf16(Bt[n][k], At[m][k], acc[ai][bj][m][n], 0, 0, 0); __builtin_amdgcn_s_setprio(0); } while (0)
#define PG8_WAIT_V(n) asm volatile("s_waitcnt vmcnt(" #n ")" ::: "memory")
#define PG8_WAIT_L(n) asm volatile("s_waitcnt lgkmcnt(" #n ")" ::: "memory")
#define PG8_BAR __builtin_amdgcn_s_barrier()
#define PG8_SCHED __builtin_amdgcn_sched_barrier(0)
    Unit cur, nxt; int ui = 0;
    if (!S.next(0, cur)) return;
    f32x4 acc[2][2][4][2];
#pragma unroll
    for (int a = 0; a < 2; ++a)
#pragma unroll
        for (int b = 0; b < 2; ++b)
#pragma unroll
            for (int m = 0; m < 4; ++m)
#pragma unroll
                for (int n = 0; n < 2; ++n) acc[a][b][m][n] = (f32x4){0.f, 0.f, 0.f, 0.f};
    bf16x8 At[4][2], B0[2][2], B1[2][2];
    const char* cA = (const char*)g.A + (size_t)cur.pm * tstepA + cur.ao; const char* cB = (const char*)g.Bt + (size_t)cur.pn * tstepB;
    PG8_STAGE(PG8_SB(0, 0), cB, voffB); PG8_STAGE(PG8_SB(0, 1), cB + hstepB, voffB); PG8_STAGE(PG8_SA(0, 0), cA, voffA); PG8_STAGE(PG8_SA(0, 1), cA + hstepA, voffA);
    if (wr == 1) PG8_BAR;
    PG8_WAIT_V(2); PG8_BAR;
    PG8_STAGE(PG8_SB(1, 0), cB + kstep, voffB); PG8_STAGE(PG8_SA(1, 0), cA + kstep, voffA); PG8_STAGE(PG8_SB(1, 1), cB + hstepB + kstep, voffB);
    PG8_WAIT_V(6); PG8_BAR;
    for (;;) {
        const bool has_next = S.next(ui + 1, nxt);
        const char* nA = has_next ? (const char*)g.A + (size_t)nxt.pm * tstepA + nxt.ao : cA; const char* nB = has_next ? (const char*)g.Bt + (size_t)nxt.pn * tstepB : cB;
        for (int t = 0; t < nt; t += 2) {
            const bool last = (t == nt - 2);
            const char* a1 = cA + (size_t)(t + 1) * kstep;
            const char* a2 = last ? nA : cA + (size_t)(t + 2) * kstep; const char* b2 = last ? nB : cB + (size_t)(t + 2) * kstep;
            const char* a3 = a2 + kstep; const char* b3 = b2 + kstep;
            PG8_LDB(B0, 0, 0); PG8_LDB(B1, 0, 1); PG8_SCHED; PG8_LDA(At, 0, 0); PG8_STAGE(PG8_SA(1, 1), a1 + hstepA, voffA);
            PG8_WAIT_V(8); PG8_WAIT_L(0); PG8_BAR; PG8_MMA(0, 0, At, B0); PG8_MMA(0, 1, At, B1); PG8_BAR; PG8_SCHED;
            PG8_LDA(At, 0, 1); PG8_STAGE(PG8_SB(0, 0), b2, voffB); PG8_STAGE(PG8_SB(0, 1), b2 + hstepB, voffB); PG8_STAGE(PG8_SA(0, 0), a2, voffA);
            PG8_WAIT_V(8); PG8_WAIT_L(0); PG8_BAR; PG8_MMA(1, 0, At, B0); PG8_MMA(1, 1, At, B1); PG8_BAR; PG8_SCHED;
            PG8_LDB(B0, 1, 0); PG8_LDB(B1, 1, 1); PG8_SCHED; PG8_LDA(At, 1, 0); PG8_STAGE(PG8_SA(0, 1), a2 + hstepA, voffA);
            PG8_WAIT_V(8); PG8_WAIT_L(0); PG8_BAR; PG8_MMA(0, 0, At, B0); PG8_MMA(0, 1, At, B1); PG8_BAR; PG8_SCHED;
            PG8_LDA(At, 1, 1); PG8_STAGE(PG8_SB(1, 0), b3, voffB); PG8_STAGE(PG8_SB(1, 1), b3 + hstepB, voffB); PG8_STAGE(PG8_SA(1, 0), a3, voffA);
            PG8_WAIT_V(8); PG8_WAIT_L(0); PG8_BAR; PG8_MMA(1, 0, At, B0); PG8_MMA(1, 1, At, B1); PG8_BAR; PG8_SCHED;
        }
        if constexpr (ALIGN_EPI) { if (wr == 0) PG8_BAR; }
        E(acc, cur, wr, wc, fr, fq);
        if (!has_next) break;
#pragma unroll
        for (int a = 0; a < 2; ++a)
#pragma unroll
            for (int b = 0; b < 2; ++b)
#pragma unroll
                for (int m = 0; m < 4; ++m)
#pragma unroll
                    for (int n = 0; n < 2; ++n) acc[a][b][m][n] = (f32x4){0.f, 0.f, 0.f, 0.f};
        cur = nxt; cA = nA; cB = nB; ++ui;
        if constexpr (ALIGN_EPI) { if (wr == 1) PG8_BAR; }
    }
    PG8_WAIT_V(0);
    if constexpr (!ALIGN_EPI) { if (wr == 0) PG8_BAR; }
    PG8_BAR;
#undef PG8_SA
#undef PG8_SB
#undef PG8_STAGE
#undef PG8_LDA
#undef PG8_LDB
#undef PG8_MMA
#undef PG8_WAIT_V
#undef PG8_WAIT_L
#undef PG8_BAR
#undef PG8_SCHED
}
}

#define XB_TMO      128
#define XB_XCNT(j)  (256  + 64 * (j))
#define XB_XSUB(j)  (1280 + 64 * (j))
#define XB_XGEN(j)  (2304 + 64 * (j))
#define XB_TOP      3328
#define XB_TOPGEN   3392
#define XCD_BAR_WORDS 3456
#define XB_SPIN_CAP (1u << 22)
__device__ __forceinline__ unsigned xb_ld(unsigned* p)              { return __hip_atomic_load(p, __ATOMIC_RELAXED, __HIP_MEMORY_SCOPE_AGENT); }
__device__ __forceinline__ unsigned xb_add(unsigned* p, unsigned v) { return __hip_atomic_fetch_add(p, v, __ATOMIC_RELAXED, __HIP_MEMORY_SCOPE_AGENT); }
__device__ __forceinline__ unsigned xb_xcc_id() { return (unsigned)__builtin_amdgcn_s_getreg((3 << 11) | 20) & 0xFu; }
#define XB_SPIN(cond, bar) do { unsigned _sp = 0; while (cond) { __builtin_amdgcn_s_sleep(1); \
    if ((++_sp & 255u) == 0u) { if (xb_ld(&(bar)[XB_TMO])) break; if (_sp > XB_SPIN_CAP) { atomicAdd(&(bar)[XB_TMO], 1u); break; } } } } while (0)
struct XcdBarrier { unsigned* bar; unsigned x; volatile LAS unsigned* st; };
__device__ __forceinline__ XcdBarrier xcd_barrier_post(unsigned* bar, volatile LAS unsigned* st) {
    XcdBarrier b; b.bar = bar; b.x = xb_xcc_id(); b.st = st;
    if (threadIdx.x == 0) (void)xb_add(&bar[XB_XCNT(b.x)], 1u);
    return b;
}
__device__ __forceinline__ void xcd_barrier_complete(unsigned* bar, unsigned x, unsigned& nloc, unsigned& nx) {
    const unsigned G = gridDim.x * gridDim.y * gridDim.z;
    unsigned sum, cnt, mine, sp = 0u;
    for (;;) {
        sum = 0u; cnt = 0u; mine = 0u;
#pragma unroll
        for (unsigned j = 0; j < 16; ++j) { const unsigned c = xb_ld(&bar[XB_XCNT(j)]); sum += c; cnt += (c > 0u) ? 1u : 0u; mine = (j == x) ? c : mine; }
        if (sum == G) break;
        __builtin_amdgcn_s_sleep(1);
        if ((++sp & 255u) == 0u) { if (xb_ld(&bar[XB_TMO])) break; if (sp > XB_SPIN_CAP) { atomicAdd(&bar[XB_TMO], 1u); break; } }
    }
    nloc = mine > 0u ? mine : 1u; nx = cnt > 0u ? cnt : 1u;
}
__device__ __noinline__ void xcd_barrier_fn(unsigned* bar_, unsigned x_, volatile LAS unsigned* st_) {
    XcdBarrier b; b.bar = bar_; b.x = x_; b.st = st_;
    asm volatile("s_waitcnt vmcnt(0)" ::: "memory");
    __syncthreads();
    if (threadIdx.x == 0) {
        unsigned* bar = b.bar;
        __builtin_amdgcn_s_waitcnt(0);
        unsigned nloc = b.st[0], nx = b.st[1];
        if (nloc == 0u) { xcd_barrier_complete(bar, b.x, nloc, nx); b.st[0] = nloc; b.st[1] = nx; }
        const unsigned old = xb_add(&bar[XB_XSUB(b.x)], 1u);
        const unsigned gen = old / nloc;
        if (old + 1u == (gen + 1u) * nloc) {
            __builtin_amdgcn_fence(__ATOMIC_RELEASE, "agent");
            asm volatile("s_waitcnt vmcnt(0)" ::: "memory");
            const unsigned og = xb_add(&bar[XB_TOP], 1u);
            const unsigned tg = og / nx;
            if (og + 1u == (tg + 1u) * nx) xb_add(&bar[XB_TOPGEN], 1u);
            else XB_SPIN(xb_ld(&bar[XB_TOPGEN]) == tg, bar);
            __builtin_amdgcn_fence(__ATOMIC_ACQUIRE, "agent");
            xb_add(&bar[XB_XGEN(b.x)], 1u);
            asm volatile("s_waitcnt vmcnt(0)" ::: "memory");
        } else {
            XB_SPIN(xb_ld(&bar[XB_XGEN(b.x)]) == gen, bar);
            __builtin_amdgcn_fence(__ATOMIC_ACQUIRE, "agent");
            asm volatile("s_waitcnt vmcnt(0)" ::: "memory");
        }
    }
    __syncthreads();
}

struct Ctx {
    int tid, lane, wave, gw, NGW, bid, G;
    LAS unsigned char* lds;
};
DEV Ctx make_ctx(LAS unsigned char* lds) {
    Ctx c; int tid_ = threadIdx.x; asm volatile("" : "+v"(tid_));
    c.tid = tid_; c.lane = c.tid & 63; c.wave = __builtin_amdgcn_readfirstlane(c.tid >> 6); { int b_ = blockIdx.x, g_ = gridDim.x; asm volatile("" : "+s"(b_), "+s"(g_)); c.bid = b_; c.G = g_; }
    c.gw = c.bid * 8 + c.wave; c.NGW = c.G * 8; c.lds = lds; return c;
}
#define WSP(T, off) ((T*)(p.ws + (off)))

DEV void transpose_item(const float* W, const float* W2, int ldw, int K, bf16_t* WT, int nblk, int mode, int nvalid, int item, LAS float* scr, int lane) {
    const int kb = item / nblk, nb = item % nblk, k0 = 64 * kb, n0 = 32 * nb;
    const int n = n0 + (lane & 31);
    const float* src = W; int c = -1; int ld = ldw; int kofs = 0;
    if (mode == 0) { c = n < nvalid ? n : -1; }
    else if (mode == 1) { c = n < NSMALL ? n : (n < PSW ? -1 : n - (PSW - NSMALL)); }
    else if (mode == 2) { c = (n & 1) ? 256 + (n >> 1) : (n >> 1); }
    else { if (n < 384 && k0 < 384) { c = n; ld = 384; } else if (n >= 512 && k0 >= 384) { src = W2; c = n - 512; ld = 512; kofs = 384; } }
#pragma unroll
    for (int i = 0; i < 32; ++i) { const int kk = 2 * i + (lane >> 5); scr[kk * 33 + (lane & 31)] = (c >= 0) ? src[(size_t)(k0 - kofs + kk) * ld + c] : 0.f; }
    LDS_WAIT(); asm volatile("" ::: "memory");
    const int c8 = lane & 7;
#pragma unroll
    for (int j = 0; j < 4; ++j) { const int nn = (lane >> 3) + 8 * j; const LAS float* s = scr + (8 * c8) * 33 + nn;
        u32x4 o; o.x = pk2(s[0 * 33], s[1 * 33]); o.y = pk2(s[2 * 33], s[3 * 33]); o.z = pk2(s[4 * 33], s[5 * 33]); o.w = pk2(s[6 * 33], s[7 * 33]);
        *(u32x4*)(WT + (size_t)(n0 + nn) * K + k0 + 8 * c8) = o; }
    LDS_WAIT(); asm volatile("" ::: "memory");
}
constexpr int IT_WIN = 16 * 208, IT_W13 = 256 * 32, IT_W2 = 128 * 32, IT_CW1 = 256 * 2, IT_WBR = 128 * 4, IT_WOUT = 512, IT_WU = 8 * 32;
constexpr int IT_LAYER = IT_WIN + IT_W13 + IT_W2 + IT_CW1 + IT_WBR + IT_WOUT + IT_WU;
DEV void phase_prologue(const Params& p, const Ctx& c) {
    { float* MOD = WSP(float, WS_MOD);
      LAS float* sc = (LAS float*)(c.lds + 73728);
      LAS float* ps = (LAS float*)(c.lds + 90112);
      for (int i = c.tid; i < 4096; i += 512) sc[i] = silu_(p.in[1][i]);
      __syncthreads();
      for (int it = c.bid; it < NLAYER * 96; it += c.G) { const int l = it / 96, j = (it % 96) * 64 + c.lane;
          const float* wa = p.in[2] + ((size_t)l * 1024 + c.wave * 128) * 6144 + j; const LAS float* s0 = sc + c.wave * 128;
          float a0 = 0.f, a1 = 0.f, a2 = 0.f, a3 = 0.f;
#pragma unroll 16
          for (int k = 0; k < 128; ++k) { const float w = wa[(size_t)k * 6144]; a0 += s0[k] * w; a1 += s0[1024 + k] * w; a2 += s0[2048 + k] * w; a3 += s0[3072 + k] * w; }
          ps[(c.wave * 4 + 0) * 64 + c.lane] = a0; ps[(c.wave * 4 + 1) * 64 + c.lane] = a1; ps[(c.wave * 4 + 2) * 64 + c.lane] = a2; ps[(c.wave * 4 + 3) * 64 + c.lane] = a3;
          __syncthreads();
          if (c.tid < 256) { const int bb = c.tid >> 6, jj = (it % 96) * 64 + (c.tid & 63); float a = p.in[3][l * 6144 + jj];
#pragma unroll
              for (int w8 = 0; w8 < 8; ++w8) a += ps[(w8 * 4 + bb) * 64 + (c.tid & 63)];
              MOD[(l * 4 + bb) * 6144 + jj] = a; }
          __syncthreads(); } }
    { float* RC = WSP(float, WS_ROPE); float* RS = RC + 4096 * 16;
      for (int i = c.bid * 512 + c.tid; i < 4096 * 16; i += c.G * 512) { const int pos = i >> 4, k = i & 15;
          const float inv = (float)pow(10000.0, -(double)k / 16.0); const float ang = (float)pos * inv;
          RC[i] = (float)cos((double)ang); RS[i] = (float)sin((double)ang); } }
    { float* WRT = WSP(float, WS_MISC + MISC_WRT);
      for (int i = c.bid * 512 + c.tid; i < NLAYER * 36 * 1024; i += c.G * 512) { const int k = i & 1023, e = (i >> 10) % 36, l = i / (36 * 1024);
          WRT[i] = e < 4 ? p.in[18][((size_t)l * 1024 + k) * 4 + e] : p.in[20][((size_t)l * 1024 + k) * 32 + (e - 4)]; } }
    LAS float* scr = (LAS float*)(c.lds + c.wave * 8448);
    for (int it = c.gw; it < IT_LAYER * NLAYER; it += c.NGW) {
        const int l = it / IT_LAYER; int r = it % IT_LAYER;
        if (r < IT_WIN) { transpose_item(p.in[5] + (size_t)l * 1024 * DIN, nullptr, DIN, 1024, WSP(bf16_t, WS_WIN) + (size_t)l * NPROJ * 1024, NPROJ / 32, 1, 0, r, scr, c.lane); continue; } r -= IT_WIN;
        if (r < IT_W13) { const int e = r / 256; transpose_item(p.in[22] + (size_t)(l * 32 + e) * 1024 * 512, nullptr, 512, 1024, WSP(bf16_t, WS_W13) + (size_t)(l * 32 + e) * 512 * 1024, 16, 2, 0, r % 256, scr, c.lane); continue; } r -= IT_W13;
        if (r < IT_W2) { const int e = r / 128; transpose_item(p.in[23] + (size_t)(l * 32 + e) * 256 * 1024, nullptr, 1024, 256, WSP(bf16_t, WS_W2) + (size_t)(l * 32 + e) * 1024 * 256, 32, 0, 1024, r % 128, scr, c.lane); continue; } r -= IT_W2;
        if (r < IT_CW1) { const int kv = r / 256; transpose_item(p.in[8] + (size_t)(l * 2 + kv) * 2048 * 256, nullptr, 256, 2048, WSP(bf16_t, WS_CW1) + (size_t)(l * 2 + kv) * 256 * 2048, 8, 0, 256, r % 256, scr, c.lane); continue; } r -= IT_CW1;
        if (r < IT_WBR) { const int n = r / 128; transpose_item(p.in[16] + (size_t)(l * 4 + n) * 256 * 1024, nullptr, 1024, 256, WSP(bf16_t, WS_WBR) + (size_t)(l * 4 + n) * 1024 * 256, 32, 0, 1024, r % 128, scr, c.lane); continue; } r -= IT_WBR;
        if (r < IT_WOUT) { transpose_item(p.in[17] + (size_t)l * 1024 * 1024, nullptr, 1024, 1024, WSP(bf16_t, WS_WOUT) + (size_t)l * 1024 * 1024, 32, 0, 1024, r, scr, c.lane); continue; } r -= IT_WOUT;
        transpose_item(p.in[14] + (size_t)l * 384 * 384, p.in[15] + (size_t)l * 128 * 512, 0, 512, WSP(bf16_t, WS_WU) + (size_t)l * 1024 * 512, 32, 3, 0, r, scr, c.lane);
    }
}

template <bool NORM, bool WRITEX> DEV void phase_norm1(const Params& p, const Ctx& c, int l) {
    const float* MOD = WSP(float, WS_MOD);
    const bf16_t* YP = (const bf16_t*)(p.ws + WS_BIG + BIG_YP);
    const int* PSLOT = WSP(int, WS_MISC + MISC_PSLOT); const float* WTS = WSP(float, WS_MISC + MISC_WTS);
    bf16_t* HBF = WSP(bf16_t, WS_HBF);
    for (int row = c.gw; row < NTOK; row += c.NGW) {
        const int b = row / SEQ;
        f32x4 v[4];
        if (l == 0 || !WRITEX) {
            const float* xs = l == 0 ? p.in[0] : p.out;
#pragma unroll
            for (int j = 0; j < 4; ++j) v[j] = *(const f32x4*)(xs + (size_t)row * DM + j * 256 + c.lane * 4);
        } else {
            const float* g2 = MOD + ((l - 1) * 4 + b) * 6144 + 5120;
            const int s0 = PSLOT[row * 2], s1 = PSLOT[row * 2 + 1]; const float w0 = WTS[row * 2], w1 = WTS[row * 2 + 1];
#pragma unroll
            for (int j = 0; j < 4; ++j) { const int col = j * 256 + c.lane * 4;
                const f32x4 x = *(const f32x4*)(p.out + (size_t)row * DM + col); const f32x4 g = *(const f32x4*)(g2 + col);
                const u32x2 y0 = *(const u32x2*)(YP + (size_t)s0 * DM + col), y1 = *(const u32x2*)(YP + (size_t)s1 * DM + col);
                f32x4 y; y[0] = w0 * bflo(y0.x) + w1 * bflo(y1.x); y[1] = w0 * bfhi(y0.x) + w1 * bfhi(y1.x); y[2] = w0 * bflo(y0.y) + w1 * bflo(y1.y); y[3] = w0 * bfhi(y0.y) + w1 * bfhi(y1.y);
                v[j] = x + g * y; }
        }
        if (WRITEX) {
#pragma unroll
            for (int j = 0; j < 4; ++j) *(f32x4*)(p.out + (size_t)row * DM + j * 256 + c.lane * 4) = v[j]; }
        if (NORM) {
            float ss = 0.f;
#pragma unroll
            for (int j = 0; j < 4; ++j) ss += (v[j][0] * v[j][0] + v[j][1] * v[j][1]) + (v[j][2] * v[j][2] + v[j][3] * v[j][3]);
            const float r = rsqrtf(wave_sum(ss) * (1.f / DM) + EPS);
            const float* gn = p.in[4] + (size_t)(l * 2 + 0) * DM; const float* sh = MOD + (l * 4 + b) * 6144; const float* sc = sh + 1024;
#pragma unroll
            for (int j = 0; j < 4; ++j) { const int col = j * 256 + c.lane * 4;
                const f32x4 g = *(const f32x4*)(gn + col), s1 = *(const f32x4*)(sc + col), s0 = *(const f32x4*)(sh + col);
                const f32x4 h = v[j] * r * g * (s1 + 1.f) + s0;
                u32x2 o; o.x = pk2(h[0], h[1]); o.y = pk2(h[2], h[3]); *(u32x2*)(HBF + (size_t)row * DM + col) = o; }
        }
    }
}

struct FInproj { float* PSM; bf16_t* GATES;
    DEV void operator()(int row, int col, const f32x4& v0, const f32x4& v1) const {
        if (col < PSW) { float* o = PSM + (size_t)row * PSW + col; *(f32x4*)o = v0; *(f32x4*)(o + 4) = v1; }
        else { u32x4 w; w.x = pk2(sigm(v0[0]), sigm(v0[1])); w.y = pk2(sigm(v0[2]), sigm(v0[3])); w.z = pk2(sigm(v1[0]), sigm(v1[1])); w.w = pk2(sigm(v1[2]), sigm(v1[3]));
               *(u32x4*)(GATES + (size_t)row * NGATE + (col - PSW)) = w; } } };
DEV void phase_inproj(const Params& p, const Ctx& c, int l) {
    pg8::Gemm g{WSP(bf16_t, WS_HBF), WSP(bf16_t, WS_WIN) + (size_t)l * NPROJ * 1024, 1024, 1024};
    pg8::StaticOrder S; S.init(NTOK, NPROJ, c.G, c.bid);
    pg8::Epi8<FInproj> E{{(float*)(p.ws + WS_BIG + BIG_PSM), WSP(bf16_t, WS_GATES)}};
    pg8::gemm_phase<pg8::Epi8<FInproj>, pg8::StaticOrder, true>(c.lds, g, S, E);
}

DEV float head_norm(float v, const float* gain, int lane) { const float ss = wave_sum(v * v); return v * rsqrtf(ss * (1.f / 64.f) + EPS) * gain[lane]; }
DEV void phase_post(const Params& p, const Ctx& c, int l) {
    const float* PSM = (const float*)(p.ws + WS_BIG + BIG_PSM); bf16_t* ACT = WSP(bf16_t, WS_ACT);
    float* GA = WSP(float, WS_SMALL + SM_GA);
    const float* gq = p.in[6] + (size_t)l * 10 * 64;
    const float* RC = WSP(float, WS_ROPE); const float* RS = RC + 4096 * 16;
    const int lane = c.lane;
    for (int row = c.gw; row < NTOK; row += c.NGW) {
        const float* P = PSM + (size_t)row * PSW; bf16_t* A = ACT + (size_t)row * ACTW; const int t = row % SEQ;
#pragma unroll
        for (int h = 0; h < 4; ++h) A[A_QA + h * 64 + lane] = (bf16_t)f2bf(head_norm(P[I_QA + h * 64 + lane], gq + 0 * 64, lane));
        A[A_KCR + lane] = (bf16_t)f2bf(P[I_KC + lane]); A[A_VCR + lane] = (bf16_t)f2bf(P[I_VC + lane]);
        A[A_KS + lane] = (bf16_t)f2bf(head_norm(P[I_KS + lane], gq + 2 * 64, lane)); A[A_VS + lane] = (bf16_t)f2bf(P[I_VS + lane]);
        A[A_KW + lane] = (bf16_t)f2bf(head_norm(P[I_KW + lane], gq + 3 * 64, lane)); A[A_VW + lane] = (bf16_t)f2bf(P[I_VW + lane]);
        if (lane < 12) GA[row * 12 + lane] = sigm(P[I_GL + lane]);
#pragma unroll
        for (int h = 0; h < 4; ++h) A[A_QB + h * 64 + lane] = (bf16_t)f2bf(head_norm(P[I_QB + h * 64 + lane], gq + 4 * 64, lane));
#pragma unroll
        for (int h = 0; h < 2; ++h) { A[A_KB + h * 64 + lane] = (bf16_t)f2bf(head_norm(P[I_KB + h * 64 + lane], gq + 5 * 64, lane)); A[A_VB + h * 64 + lane] = (bf16_t)f2bf(P[I_VB + h * 64 + lane]); }
#pragma unroll
        for (int h = 0; h < 4; ++h) { A[A_QC + h * 64 + lane] = (bf16_t)f2bf(head_norm(P[I_QC + h * 64 + lane], gq + 6 * 64, lane));
            A[A_KC + h * 64 + lane] = (bf16_t)f2bf(head_norm(P[I_KCC + h * 64 + lane], gq + 7 * 64, lane)); A[A_VC + h * 64 + lane] = (bf16_t)f2bf(P[I_VCC + h * 64 + lane]); }
        { float x[6]; float ss = 0.f;
#pragma unroll
          for (int j = 0; j < 6; ++j) { x[j] = P[I_CQ + j * 64 + lane]; ss += x[j] * x[j]; }
          const float r = rsqrtf(wave_sum(ss) * (1.f / 384.f) + EPS); const float* g = p.in[11] + l * 384;
#pragma unroll
          for (int j = 0; j < 6; ++j) A[A_CQ + j * 64 + lane] = (bf16_t)f2bf(x[j] * r * g[j * 64 + lane]); }
        { float x0 = P[I_CKV + lane], x1 = P[I_CKV + 64 + lane]; const float r = rsqrtf(wave_sum(x0 * x0 + x1 * x1) * (1.f / 128.f) + EPS); const float* g = p.in[12] + l * 128;
          A[A_CKV + lane] = (bf16_t)f2bf(x0 * r * g[lane]); A[A_CKV + 64 + lane] = (bf16_t)f2bf(x1 * r * g[64 + lane]); }
        { const float x = lane < 32 ? P[I_KR + lane] : 0.f; const float r = rsqrtf(wave_sum(x * x) * (1.f / 32.f) + EPS);
          const float y = x * r * p.in[13][(l * 2 + 1) * 32 + (lane & 31)];
          const float yo = swz_xor<16>(y); const int k = lane & 15; const float cs = RC[t * 16 + k], sn = RS[t * 16 + k];
          const float o = (lane & 16) ? (yo * sn + y * cs) : (y * cs - yo * sn);
          if (lane < 32) A[A_KR + lane] = (bf16_t)f2bf(o); }
    }
}

struct FStoreF32 { float* O; int ld;
    DEV void operator()(int row, int col, const f32x4& v0, const f32x4& v1) const { float* o = O + (size_t)row * ld + col; *(f32x4*)o = v0; *(f32x4*)(o + 4) = v1; } };
DEV void phase_mlaup(const Params& p, const Ctx& c, int l) {
    { pg8::Gemm g{WSP(bf16_t, WS_ACT) + A_CQ, WSP(bf16_t, WS_WU) + (size_t)l * 1024 * 512, ACTW, 512};
      pg8::StaticOrder S; S.init(NTOK, 1024, c.G, c.bid);
      pg8::Epi8<FStoreF32> E{{WSP(float, WS_MUR), 1024}};
      pg8::gemm_phase<pg8::Epi8<FStoreF32>, pg8::StaticOrder, true>(c.lds, g, S, E); }
    { const bf16_t* ACT = WSP(bf16_t, WS_ACT); bf16_t* CMPA = WSP(bf16_t, WS_CMPA); const float* pe = p.in[7] + (size_t)l * 2 * 32 * 64;
      for (int idx = c.bid * 512 + c.tid; idx < 2 * 1024 * 256; idx += c.G * 512) {
          const int c8 = idx & 255, r = (idx >> 8) & 1023, kv = idx >> 18; const int j = c8 >> 3, d = (c8 & 7) * 8;
          u32x4 o = (u32x4){0u, 0u, 0u, 0u};
          if (r < 1020) { const int b = r / 255, i = r % 255; const size_t tok = (size_t)b * SEQ + 16 * i + j;
              const u32x4 s = *(const u32x4*)(ACT + tok * ACTW + (kv ? A_VCR : A_KCR) + d); const float* pp = pe + (kv * 32 + j) * 64 + d;
              o.x = pk2(bflo(s.x) + pp[0], bfhi(s.x) + pp[1]); o.y = pk2(bflo(s.y) + pp[2], bfhi(s.y) + pp[3]); o.z = pk2(bflo(s.z) + pp[4], bfhi(s.z) + pp[5]); o.w = pk2(bflo(s.w) + pp[6], bfhi(s.w) + pp[7]); }
          *(u32x4*)(CMPA + ((size_t)kv * 1024 + r) * 2048 + c8 * 8) = o; } }
    { const bf16_t* ACT = WSP(bf16_t, WS_ACT); float* KM = WSP(float, WS_MISC + MISC_KMEAN);
      for (int idx = c.bid * 512 + c.tid; idx < 4 * 16 * 256; idx += c.G * 512) { const int hd = idx & 255, n = (idx >> 8) & 15, b = idx >> 12;
          const bf16_t* src = ACT + ((size_t)b * SEQ + n * 256) * ACTW + A_KC + hd; float s = 0.f;
          for (int i = 0; i < 256; ++i) s += bf2f(src[(size_t)i * ACTW]);
          KM[idx] = s * (1.f / 256.f); } }
}

struct CmpOrder { int G, c; DEV bool next(int i, pg8::Unit& u) const { const int L = i * G + c; if (L >= 8) return false; u.pm = L; u.pn = L >> 2; u.ao = 0; return true; } };
struct FCmpHid { bf16_t* HID;
    DEV void operator()(int row, int col, const f32x4& v0, const f32x4& v1) const { const int cc = col & 255;
        u32x4 w; w.x = pk2(silu_(v0[0]), silu_(v0[1])); w.y = pk2(silu_(v0[2]), silu_(v0[3])); w.z = pk2(silu_(v1[0]), silu_(v1[1])); w.w = pk2(silu_(v1[2]), silu_(v1[3]));
        *(u32x4*)(HID + (size_t)row * 256 + cc) = w; } };
DEV void phase_post2(const Params& p, const Ctx& c, int l) {
    { pg8::Gemm g{WSP(bf16_t, WS_CMPA), WSP(bf16_t, WS_CW1) + (size_t)l * 2 * 256 * 2048, 2048, 2048};
      CmpOrder S{c.G, c.bid}; pg8::Epi8<FCmpHid> E{{WSP(bf16_t, WS_HID)}};
      pg8::gemm_phase<pg8::Epi8<FCmpHid>, CmpOrder, true>(c.lds, g, S, E); }
    const float* MUR = WSP(float, WS_MUR); bf16_t* ACT2 = WSP(bf16_t, WS_ACT2);
    const float* gq = p.in[6] + (size_t)l * 10 * 64; const float* RC = WSP(float, WS_ROPE); const float* RS = RC + 4096 * 16;
    const int lane = c.lane;
    for (int row = c.gw; row < NTOK; row += c.NGW) {
        const float* R = MUR + (size_t)row * 1024; bf16_t* A = ACT2 + (size_t)row * ACT2W; const int t = row % SEQ;
#pragma unroll
        for (int h = 0; h < 4; ++h) {
            A[A2_QF + h * 96 + lane] = (bf16_t)f2bf(head_norm(R[h * 96 + lane], gq + 8 * 64, lane));
            { const float x = lane < 32 ? R[h * 96 + 64 + lane] : 0.f; const float r = rsqrtf(wave_sum(x * x) * (1.f / 32.f) + EPS);
              const float y = x * r * p.in[13][(l * 2 + 0) * 32 + (lane & 31)];
              const float yo = swz_xor<16>(y); const int k = lane & 15; const float cs = RC[t * 16 + k], sn = RS[t * 16 + k];
              const float o = (lane & 16) ? (yo * sn + y * cs) : (y * cs - yo * sn);
              if (lane < 32) A[A2_QF + h * 96 + 64 + lane] = (bf16_t)f2bf(o); }
            A[A2_KN + h * 64 + lane] = (bf16_t)f2bf(head_norm(R[512 + h * 128 + lane], gq + 9 * 64, lane));
            A[A2_VD + h * 64 + lane] = (bf16_t)f2bf(R[512 + h * 128 + 64 + lane]);
        }
    }
}

template <int D0, int D1, int DV>
DEV void att_step(const float (&q)[D0 + D1], float (&o)[DV], float& m, float& l, const bf16_t* k0, const bf16_t* k1, const bf16_t* v, float scale, float bias, bool valid) {
    float acc = 0.f;
#pragma unroll
    for (int i = 0; i < D0 / 8; ++i) { const u32x4 u = *(const u32x4*)(k0 + 8 * i);
        acc += q[8 * i] * bflo(u.x) + q[8 * i + 1] * bfhi(u.x) + q[8 * i + 2] * bflo(u.y) + q[8 * i + 3] * bfhi(u.y) + q[8 * i + 4] * bflo(u.z) + q[8 * i + 5] * bfhi(u.z) + q[8 * i + 6] * bflo(u.w) + q[8 * i + 7] * bfhi(u.w); }
    if (D1 > 0) {
#pragma unroll
        for (int i = 0; i < D1 / 8; ++i) { const u32x4 u = *(const u32x4*)(k1 + 8 * i); const int b = D0 + 8 * i;
            acc += q[b] * bflo(u.x) + q[b + 1] * bfhi(u.x) + q[b + 2] * bflo(u.y) + q[b + 3] * bfhi(u.y) + q[b + 4] * bflo(u.z) + q[b + 5] * bfhi(u.z) + q[b + 6] * bflo(u.w) + q[b + 7] * bfhi(u.w); }
    }
    const float s = acc * scale + bias;
    if (valid) {
        if (s > m) { const float a = __expf(m - s); l *= a;
#pragma unroll
            for (int d = 0; d < DV; ++d) o[d] *= a;
            m = s; }
        const float pr = __expf(s - m); l += pr;
#pragma unroll
        for (int i = 0; i < DV / 8; ++i) { const u32x4 u = *(const u32x4*)(v + 8 * i);
            o[8 * i] += pr * bflo(u.x); o[8 * i + 1] += pr * bfhi(u.x); o[8 * i + 2] += pr * bflo(u.y); o[8 * i + 3] += pr * bfhi(u.y);
            o[8 * i + 4] += pr * bflo(u.z); o[8 * i + 5] += pr * bfhi(u.z); o[8 * i + 6] += pr * bflo(u.w); o[8 * i + 7] += pr * bfhi(u.w); }
    }
}
template <int D> DEV void load_q(float (&q)[D], const bf16_t* src) {
#pragma unroll
    for (int i = 0; i < D / 8; ++i) { const u32x4 u = *(const u32x4*)(src + 8 * i);
        q[8 * i] = bflo(u.x); q[8 * i + 1] = bfhi(u.x); q[8 * i + 2] = bflo(u.y); q[8 * i + 3] = bfhi(u.y); q[8 * i + 4] = bflo(u.z); q[8 * i + 5] = bfhi(u.z); q[8 * i + 6] = bflo(u.w); q[8 * i + 7] = bfhi(u.w); }
}
template <int DV> DEV void store_o_bf16(bf16_t* dst, const float (&o)[DV], float inv) {
#pragma unroll
    for (int i = 0; i < DV / 8; ++i) { u32x4 w; w.x = pk2(o[8 * i] * inv, o[8 * i + 1] * inv); w.y = pk2(o[8 * i + 2] * inv, o[8 * i + 3] * inv); w.z = pk2(o[8 * i + 4] * inv, o[8 * i + 5] * inv); w.w = pk2(o[8 * i + 6] * inv, o[8 * i + 7] * inv);
        *(u32x4*)(dst + 8 * i) = w; }
}
DEV void item_bgh(int it, int& b, int& g, int& h) { const int r = it & 63, bh = it >> 6; g = (r & 1) ? 63 - (r >> 1) : (r >> 1); b = bh >> 2; h = bh & 3; }

DEV void phase_attn(const Params& p, const Ctx& c, int l) {
    const int lane = c.lane;
    { const bf16_t* HID = WSP(bf16_t, WS_HID); float* KC = WSP(float, WS_MISC + MISC_KCMP); float* VC = WSP(float, WS_MISC + MISC_VCMP);
      const float* gq = p.in[6] + (size_t)l * 10 * 64;
      for (int it = c.gw; it < 2 * 1020; it += c.NGW) { const int kv = it / 1020, r = it % 1020;
          const float* w2 = p.in[9] + (size_t)(l * 2 + kv) * 256 * 64; const bf16_t* hrow = HID + ((size_t)kv * 1024 + r) * 256;
          float a = 0.f;
          for (int k = 0; k < 256; ++k) a += bf2f(hrow[k]) * w2[k * 64 + lane];
          const int b = r / 255, i = r % 255;
          if (kv == 0) KC[(b * 256 + i) * 64 + lane] = head_norm(a, gq + 1 * 64, lane); else VC[(b * 256 + i) * 64 + lane] = a; } }
    const bf16_t* ACT = WSP(bf16_t, WS_ACT); const bf16_t* ACT2 = WSP(bf16_t, WS_ACT2); bf16_t* BR = WSP(bf16_t, WS_BR);
    for (int it0 = c.gw; it0 < 2048; it0 += c.NGW) {
        if (it0 < 1024) {
            int b, g, h; item_bgh(it0, b, g, h); const int t = g * 64 + lane; const size_t tok = (size_t)b * SEQ + t;
            float q[96], o[64]; float m = -INFINITY, ls = 0.f;
            load_q<96>(q, ACT2 + tok * ACT2W + A2_QF + h * 96);
#pragma unroll
            for (int d = 0; d < 64; ++d) o[d] = 0.f;
            const float scale = 0.10206207261596575f;
            for (int s = g * 64 + 63; s >= 0; --s) { const size_t kt = (size_t)b * SEQ + s;
                att_step<64, 32, 64>(q, o, m, ls, ACT2 + kt * ACT2W + A2_KN + h * 64, ACT + kt * ACTW + A_KR, ACT2 + kt * ACT2W + A2_VD + h * 64, scale, 0.f, s <= t); }
            store_o_bf16<64>(BR + tok * 1024 + 768 + h * 64, o, 1.f / ls);
        } else {
            int b, g, h; item_bgh(it0 - 1024, b, g, h); const int t = g * 64 + lane; const size_t tok = (size_t)b * SEQ + t;
            const int nb = g >> 2; const float slope = SLOPES[2][h];
            float q[64], o[64]; float m = -INFINITY, ls = 0.f;
            load_q<64>(q, ACT + tok * ACTW + A_QC + h * 64);
#pragma unroll
            for (int d = 0; d < 64; ++d) o[d] = 0.f;
            const float* KM = WSP(float, WS_MISC + MISC_KMEAN) + (size_t)b * 16 * 256 + h * 64;
            float v1 = -INFINITY, v2 = -INFINITY, v3 = -INFINITY; int i1 = -1, i2 = -1, i3 = -1;
            for (int n = 0; n < nb; ++n) { const float* km = KM + n * 256; float dsum = 0.f;
#pragma unroll
                for (int d = 0; d < 64; ++d) dsum += q[d] * km[d];
                if (dsum > v1) { v3 = v2; i3 = i2; v2 = v1; i2 = i1; v1 = dsum; i1 = n; }
                else if (dsum > v2) { v3 = v2; i3 = i2; v2 = dsum; i2 = n; }
                else if (dsum > v3) { v3 = dsum; i3 = n; } }
            const int start = nb * 256;
            for (int s = g * 64 + 63; s >= start; --s) { const size_t kt = (size_t)b * SEQ + s;
                att_step<64, 0, 64>(q, o, m, ls, ACT + kt * ACTW + A_KC + h * 64, nullptr, ACT + kt * ACTW + A_VC + h * 64, 0.125f, -slope * (float)(t - s), s <= t); }
            for (int n = nb - 1; n >= 0; --n) { const bool sel = (n == i1) || (n == i2) || (n == i3);
                if (!__any(sel)) continue;
                for (int s = n * 256 + 255; s >= n * 256; --s) { const size_t kt = (size_t)b * SEQ + s;
                    att_step<64, 0, 64>(q, o, m, ls, ACT + kt * ACTW + A_KC + h * 64, nullptr, ACT + kt * ACTW + A_VC + h * 64, 0.125f, -slope * (float)(t - s), sel); } }
            store_o_bf16<64>(BR + tok * 1024 + 512 + h * 64, o, 1.f / ls);
        }
    }
    for (int it0 = c.gw; it0 < 2048; it0 += c.NGW) {
        const bool swa = it0 >= 1024;
        int b, g, h; item_bgh(swa ? it0 - 1024 : it0, b, g, h); const int t = g * 64 + lane; const size_t tok = (size_t)b * SEQ + t;
        const int W = swa ? 128 : 512; const float slope = SLOPES[swa ? 1 : 0][h];
        const int qoff = swa ? A_QB + h * 64 : A_QA + h * 64, koff = swa ? A_KB + (h >> 1) * 64 : A_KW, voff = swa ? A_VB + (h >> 1) * 64 : A_VW;
        float q[64], o[64]; float m = -INFINITY, ls = 0.f;
        load_q<64>(q, ACT + tok * ACTW + qoff);
#pragma unroll
        for (int d = 0; d < 64; ++d) o[d] = 0.f;
        int lo = g * 64 - (W - 1); if (lo < 0) lo = 0;
        for (int s = g * 64 + 63; s >= lo; --s) { const size_t kt = (size_t)b * SEQ + s; const int dist = t - s;
            att_step<64, 0, 64>(q, o, m, ls, ACT + kt * ACTW + koff, nullptr, ACT + kt * ACTW + voff, 0.125f, -slope * (float)dist, dist >= 0 && dist < W); }
        if (swa) { const float sk = p.in[10][l * 4 + h]; const float mf = fmaxf(m, sk); const float a = __expf(m - mf); const float den = ls * a + __expf(sk - mf);
            store_o_bf16<64>(BR + tok * 1024 + 256 + h * 64, o, a / den); }
        else { float* OW = WSP(float, WS_OWIN) + tok * 256 + h * 64; const float inv = 1.f / ls;
#pragma unroll
            for (int d = 0; d < 64; d += 4) *(f32x4*)(OW + d) = (f32x4){o[d] * inv, o[d + 1] * inv, o[d + 2] * inv, o[d + 3] * inv}; }
    }
}

DEV void phase_cmpattn(const Params& p, const Ctx& c, int l) {
    const bf16_t* ACT = WSP(bf16_t, WS_ACT); const float* KC = WSP(float, WS_MISC + MISC_KCMP); const float* VC = WSP(float, WS_MISC + MISC_VCMP);
    float* PB = WSP(float, WS_PB); float* PL = WSP(float, WS_SMALL + SM_PL); float* OC = WSP(float, WS_OCMP);
    const int lane = c.lane;
    for (int it = c.gw; it < 1024; it += c.NGW) {
        int b, g, h; item_bgh(it, b, g, h); const int t = g * 64 + lane; const size_t tok = (size_t)b * SEQ + t; const float slope = SLOPES[0][h];
        float q[64], o[64];
        load_q<64>(q, ACT + tok * ACTW + A_QA + h * 64);
#pragma unroll
        for (int d = 0; d < 64; ++d) o[d] = 0.f;
        const int nvis = t >= 31 ? ((t - 31) >> 4) + 1 : 0;
        const int tmaxw = g * 64 + 63; const int nmax = tmaxw >= 31 ? ((tmaxw - 31) >> 4) + 1 : 0;
        const float* kcb = KC + (size_t)b * 256 * 64; const float* vcb = VC + (size_t)b * 256 * 64;
        float m = -INFINITY;
        for (int n = 0; n < nmax; ++n) { const float* k = kcb + n * 64; float a = 0.f;
#pragma unroll
            for (int d = 0; d < 64; ++d) a += q[d] * k[d];
            const float s = a * 0.125f - slope * (float)(t - (16 * n + 31));
            if (n < nvis) m = fmaxf(m, s); }
        float ls = 0.f, carry = 0.f; float* pb = PB + (tok * 4 + h) * 64;
        for (int j = 0; j < 64; ++j) { float e4[4];
#pragma unroll
            for (int u = 0; u < 4; ++u) { const int n = 4 * j + u; float e = 0.f;
                if (n < nmax) { const float* k = kcb + n * 64; float a = 0.f;
#pragma unroll
                    for (int d = 0; d < 64; ++d) a += q[d] * k[d];
                    const float s = a * 0.125f - slope * (float)(t - (16 * n + 31));
                    if (n < nvis) { e = __expf(s - m); const float* v = vcb + n * 64;
#pragma unroll
                        for (int d = 0; d < 64; ++d) o[d] += e * v[d]; } }
                e4[u] = e; }
            pb[j] = carry + e4[0] + e4[1] + e4[2] + e4[3]; carry = e4[3]; ls += e4[0] + e4[1] + e4[2] + e4[3];
            if (4 * j + 4 >= nmax) { for (int jj = j + 1; jj < 64; ++jj) pb[jj] = (jj == j + 1) ? carry : 0.f; break; } }
        const float inv = 1.f / fmaxf(ls, 1e-30f);
        PL[tok * 4 + h] = inv;
        float* oc = OC + tok * 256 + h * 64;
#pragma unroll
        for (int d = 0; d < 64; d += 4) *(f32x4*)(oc + d) = (f32x4){o[d] * inv, o[d + 1] * inv, o[d + 2] * inv, o[d + 3] * inv};
    }
}

DEV void phase_topk(const Params& p, const Ctx& c) {
    const float* PB = WSP(float, WS_PB); const float* PL = WSP(float, WS_SMALL + SM_PL); unsigned long long* SEL = WSP(unsigned long long, WS_SMALL + SM_SEL);
    const int lane = c.lane;
    for (int tok = c.gw; tok < NTOK; tok += c.NGW) {
        const int t = tok % SEQ, cur = t >> 6;
        float ps = 0.f;
#pragma unroll
        for (int h = 0; h < 4; ++h) ps += PB[((size_t)tok * 4 + h) * 64 + lane] * PL[tok * 4 + h];
        const bool forced = (lane == 0) || (lane == cur) || (lane == cur - 1);
        float score = lane <= cur ? ps + (forced ? 1e4f : 0.f) : -1e30f;
        unsigned long long mask = 0ull;
        for (int r = 0; r < 8; ++r) {
            float bv = score; int bi = lane;
#define TK_STEP(M) { const float ov = swz_xor<M>(bv); const int oi = swz_xor_i<M>(bi); if (ov > bv || (ov == bv && oi < bi)) { bv = ov; bi = oi; } }
            TK_STEP(1) TK_STEP(2) TK_STEP(4) TK_STEP(8) TK_STEP(16)
#undef TK_STEP
            { auto rv = __builtin_amdgcn_permlane32_swap(__float_as_uint(bv), __float_as_uint(bv), false, false); auto ri = __builtin_amdgcn_permlane32_swap((unsigned)bi, (unsigned)bi, false, false);
              const float v0 = __uint_as_float(rv[0]), v1 = __uint_as_float(rv[1]); const int i0 = (int)ri[0], i1 = (int)ri[1];
              if (v1 > v0 || (v1 == v0 && i1 < i0)) { bv = v1; bi = i1; } else { bv = v0; bi = i0; } }
            if (bv > -5e29f) mask |= 1ull << bi;
            if (lane == bi) score = -INFINITY;
        }
        if (lane == 0) SEL[tok] = mask;
    }
}

DEV void phase_slc(const Params& p, const Ctx& c, int l) {
    const bf16_t* ACT = WSP(bf16_t, WS_ACT); bf16_t* BR = WSP(bf16_t, WS_BR); const unsigned long long* SEL = WSP(unsigned long long, WS_SMALL + SM_SEL);
    const float* OC = WSP(float, WS_OCMP); const float* OW = WSP(float, WS_OWIN); const float* GA = WSP(float, WS_SMALL + SM_GA);
    const int lane = c.lane;
    for (int it = c.gw; it < 1024; it += c.NGW) {
        int b, g, h; item_bgh(it, b, g, h); const int t = g * 64 + lane; const size_t tok = (size_t)b * SEQ + t; const float slope = SLOPES[0][h];
        float q[64], o[64]; float m = -INFINITY, ls = 0.f;
        load_q<64>(q, ACT + tok * ACTW + A_QA + h * 64);
#pragma unroll
        for (int d = 0; d < 64; ++d) o[d] = 0.f;
        const unsigned long long mask = SEL[tok];
        for (int j = g; j >= 0; --j) { const bool sel = (mask >> j) & 1ull;
            if (!__any(sel)) continue;
            for (int s = j * 64 + 63; s >= j * 64; --s) { const size_t kt = (size_t)b * SEQ + s;
                att_step<64, 0, 64>(q, o, m, ls, ACT + kt * ACTW + A_KS, nullptr, ACT + kt * ACTW + A_VS, 0.125f, -slope * (float)(t - s), sel && s <= t); } }
        const float inv = 1.f / ls; const float g0 = GA[tok * 12 + h * 3], g1 = GA[tok * 12 + h * 3 + 1], g2 = GA[tok * 12 + h * 3 + 2];
        const float* oc = OC + tok * 256 + h * 64; const float* ow = OW + tok * 256 + h * 64;
#pragma unroll
        for (int d = 0; d < 64; ++d) o[d] = g0 * oc[d] + g1 * o[d] * inv + g2 * ow[d];
        store_o_bf16<64>(BR + tok * 1024 + h * 64, o, 1.f);
    }
}


namespace fa {
typedef float f32x16 __attribute__((ext_vector_type(16)));
typedef short v4i16_t __attribute__((ext_vector_type(4)));
typedef float f32x2_t __attribute__((ext_vector_type(2))); typedef __bf16 bf16x2_t __attribute__((ext_vector_type(2)));
constexpr int KROWB = 208, VROWB = 192, KBYTES = 64 * KROWB, VBYTES = 64 * VROWB, STG = KBYTES + VBYTES;
constexpr int LDS_MISC = 2 * STG;
constexpr float LOG2E = 1.4426950408889634f;
constexpr float MFLOOR = -1e20f;
DEV unsigned cvtpk(float lo, float hi) { f32x2_t v = {lo, hi}; bf16x2_t b = __builtin_convertvector(v, bf16x2_t); return __builtin_bit_cast(unsigned, b); }
DEV unsigned long long uni64(unsigned long long v) { const unsigned lo = __builtin_amdgcn_readfirstlane((unsigned)v), hi = __builtin_amdgcn_readfirstlane((unsigned)(v >> 32)); return ((unsigned long long)hi << 32) | lo; }
DEV unsigned long long wave_or64(unsigned long long v) {
    unsigned lo = (unsigned)v, hi = (unsigned)(v >> 32);
#define FA_OR(M) lo |= (unsigned)__builtin_amdgcn_ds_swizzle((int)lo, (M << 10) | 0x1f); hi |= (unsigned)__builtin_amdgcn_ds_swizzle((int)hi, (M << 10) | 0x1f);
    FA_OR(1) FA_OR(2) FA_OR(4) FA_OR(8) FA_OR(16)
#undef FA_OR
    { auto a = __builtin_amdgcn_permlane32_swap(lo, lo, false, false); lo = a[0] | a[1]; auto b = __builtin_amdgcn_permlane32_swap(hi, hi, false, false); hi = b[0] | b[1]; }
    return uni64(((unsigned long long)hi << 32) | lo);
}
struct Src { const bf16_t* k; int kp; const bf16_t* k2; int k2p; const bf16_t* v; int vp; };
template <int NQ, bool ALIBI, int SELMODE>
DEV void attn_pass(LAS unsigned char* lds, const Ctx& c, const Src& src, const bf16x8 (&qf)[NQ], unsigned long long tmask, unsigned long long wmask,
                   int t, float nslope2, float c1, unsigned W, unsigned long long rowmask, int own_blk, f32x16 (&o)[2], float& m, float& l) {
    const int tid = c.tid, lane = c.lane, r32 = lane & 31, hi = lane >> 5;
    const int skey = tid >> 3, sch = tid & 7, skey2 = tid >> 2, sch2 = tid & 3;
    const int i16 = lane & 15, tq = i16 >> 2, tp = i16 & 3, blk = (lane >> 4) & 1;
    u32x4 kreg, vreg, k2reg = (u32x4){0u, 0u, 0u, 0u};
#define FA_GLOAD(kt_) do { const size_t r_ = (size_t)((kt_) * 64 + skey); kreg = *(const u32x4*)(src.k + r_ * src.kp + sch * 8); vreg = *(const u32x4*)(src.v + r_ * src.vp + sch * 8); \
        if (NQ == 6) { if (tid < 256) k2reg = *(const u32x4*)(src.k2 + (size_t)((kt_) * 64 + skey2) * src.k2p + sch2 * 8); } } while (0)
#define FA_LSTORE(buf_) do { LAS unsigned char* st_ = lds + (buf_) * STG; *(LAS u32x4*)(st_ + skey * KROWB + sch * 16) = kreg; *(LAS u32x4*)(st_ + KBYTES + skey * VROWB + sch * 16) = vreg; \
        if (NQ == 6) { if (tid < 256) *(LAS u32x4*)(st_ + skey2 * KROWB + 128 + sch2 * 16) = k2reg; } } while (0)
#pragma unroll
    for (int dt = 0; dt < 2; ++dt)
#pragma unroll
        for (int i = 0; i < 16; ++i) o[dt][i] = 0.f;
    m = MFLOOR; l = 0.f;
    if (tmask == 0ull) return;
    int kt = 63 - __builtin_clzll(tmask); tmask &= ~(1ull << kt);
    FA_GLOAD(kt);
    int buf = 0;
    for (;;) {
        FA_LSTORE(buf);
        __syncthreads();
        const bool more = tmask != 0ull; int ktn = 0;
        if (more) { ktn = 63 - __builtin_clzll(tmask); tmask &= ~(1ull << ktn); FA_GLOAD(ktn); }
        if ((wmask >> kt) & 1ull) {
            const LAS unsigned char* kb = lds + buf * STG; const LAS unsigned char* vb = kb + KBYTES;
            f32x16 s0, s1;
#pragma unroll
            for (int i = 0; i < 16; ++i) { s0[i] = 0.f; s1[i] = 0.f; }
#pragma unroll
            for (int d0 = 0; d0 < NQ; ++d0) {
                const bf16x8 k0 = *(const LAS bf16x8*)(kb + r32 * KROWB + (16 * d0 + 8 * hi) * 2);
                const bf16x8 k1 = *(const LAS bf16x8*)(kb + (32 + r32) * KROWB + (16 * d0 + 8 * hi) * 2);
                s0 = __builtin_amdgcn_mfma_f32_32x32x16_bf16(k0, qf[d0], s0, 0, 0, 0);
                s1 = __builtin_amdgcn_mfma_f32_32x32x16_bf16(k1, qf[d0], s1, 0, 0, 0);
            }
            bool rowsel = true;
            if (SELMODE == 1) rowsel = (rowmask >> kt) & 1ull;
            if (SELMODE == 2) rowsel = ((kt >> 2) == own_blk) || ((rowmask >> (kt >> 2)) & 1ull);
            const unsigned Weff = rowsel ? W : 0u;
            const int db0 = t - (kt * 64 + 4 * hi);
            float mx = -INFINITY;
#pragma unroll
            for (int i = 0; i < 16; ++i) { const int cr = (i & 3) + 8 * (i >> 2);
                { const int d = db0 - cr; float x = s0[i] * c1; if (ALIBI) x = fmaf((float)d, nslope2, x); x = ((unsigned)d < Weff) ? x : -INFINITY; s0[i] = x; mx = fmaxf(mx, x); }
                { const int d = db0 - 32 - cr; float x = s1[i] * c1; if (ALIBI) x = fmaf((float)d, nslope2, x); x = ((unsigned)d < Weff) ? x : -INFINITY; s1[i] = x; mx = fmaxf(mx, x); } }
            { auto rr = __builtin_amdgcn_permlane32_swap(__float_as_uint(mx), __float_as_uint(mx), false, false); mx = fmaxf(__uint_as_float(rr[0]), __uint_as_float(rr[1])); }
            const float mn = fmaxf(m, mx); const float alpha = __builtin_amdgcn_exp2f(m - mn); m = mn;
            float ls = 0.f;
#pragma unroll
            for (int i = 0; i < 16; ++i) { s0[i] = __builtin_amdgcn_exp2f(s0[i] - mn); s1[i] = __builtin_amdgcn_exp2f(s1[i] - mn); ls += s0[i] + s1[i]; }
            l = l * alpha + ls;
#pragma unroll
            for (int dt = 0; dt < 2; ++dt)
#pragma unroll
                for (int i = 0; i < 16; ++i) o[dt][i] *= alpha;
#pragma unroll
            for (int hf = 0; hf < 2; ++hf)
#pragma unroll
                for (int ks = 0; ks < 2; ++ks) {
                    u32x4 pw;
                    if (hf == 0) { pw.x = cvtpk(s0[8 * ks], s0[8 * ks + 1]); pw.y = cvtpk(s0[8 * ks + 2], s0[8 * ks + 3]); pw.z = cvtpk(s0[8 * ks + 4], s0[8 * ks + 5]); pw.w = cvtpk(s0[8 * ks + 6], s0[8 * ks + 7]); }
                    else         { pw.x = cvtpk(s1[8 * ks], s1[8 * ks + 1]); pw.y = cvtpk(s1[8 * ks + 2], s1[8 * ks + 3]); pw.z = cvtpk(s1[8 * ks + 4], s1[8 * ks + 5]); pw.w = cvtpk(s1[8 * ks + 6], s1[8 * ks + 7]); }
                    const bf16x8 pb = __builtin_bit_cast(bf16x8, pw);
#pragma unroll
                    for (int dt = 0; dt < 2; ++dt) {
                        const LAS unsigned char* vp = vb + (32 * hf + 16 * ks + 4 * hi + tq) * VROWB + (32 * dt + 16 * blk + 4 * tp) * 2;
                        const v4i16_t lo = __builtin_amdgcn_ds_read_tr16_b64_v4i16((LAS v4i16_t*)vp);
                        const v4i16_t hv = __builtin_amdgcn_ds_read_tr16_b64_v4i16((LAS v4i16_t*)(vp + 8 * VROWB));
                        const bf16x8 va = (bf16x8){lo[0], lo[1], lo[2], lo[3], hv[0], hv[1], hv[2], hv[3]};
                        o[dt] = __builtin_amdgcn_mfma_f32_32x32x16_bf16(va, pb, o[dt], 0, 0, 0);
                    }
                }
        }
        if (!more) break;
        kt = ktn; buf ^= 1;
    }
    __syncthreads();
    { auto rr = __builtin_amdgcn_permlane32_swap(__float_as_uint(l), __float_as_uint(l), false, false); l = __uint_as_float(rr[0]) + __uint_as_float(rr[1]); }
#undef FA_GLOAD
#undef FA_LSTORE
}
template <int NQ> DEV void load_qf(bf16x8 (&qf)[NQ], const bf16_t* qrow, int hi) {
#pragma unroll
    for (int d0 = 0; d0 < NQ; ++d0) qf[d0] = *(const bf16x8*)(qrow + 16 * d0 + 8 * hi);
}
DEV void store_o(bf16_t* orow, const f32x16 (&o)[2], float sc, int hi) {
#pragma unroll
    for (int dt = 0; dt < 2; ++dt)
#pragma unroll
        for (int g = 0; g < 4; ++g) { u32x2 w; w.x = cvtpk(o[dt][4 * g] * sc, o[dt][4 * g + 1] * sc); w.y = cvtpk(o[dt][4 * g + 2] * sc, o[dt][4 * g + 3] * sc);
            *(u32x2*)(orow + 32 * dt + 8 * g + 4 * hi) = w; }
}
DEV unsigned long long expand4(unsigned m16) { unsigned long long r = 0ull;
#pragma unroll
    for (int j = 0; j < 16; ++j) if ((m16 >> j) & 1u) r |= 0xFull << (4 * j);
    return r; }
}


DEV void moba_gate(const Params& p, const Ctx& c);
namespace fc {
using namespace fa;
constexpr int CKROWB = 144, CVROWB = 320, CKB = 64 * CKROWB, CVB = 64 * CVROWB, CSTG = CKB + CVB, BINS_OFF = 2 * CSTG, BINW = 65;
static_assert(BINS_OFF + 4 * 64 * BINW * 4 <= RING_BYTES, "cmp unit LDS");
DEV void cmp_unit(const Params& p, const Ctx& c, int b, int cb) {
    LAS unsigned char* lds = c.lds;
    const int tid = c.tid, lane = c.lane, r32 = lane & 31, hi = lane >> 5, w = c.wave, h = w >> 1;
    const int t = cb * 64 + (w & 1) * 32 + r32; const size_t tok = (size_t)b * SEQ + t;
    const bf16_t* ACT = WSP(bf16_t, WS_ACT);
    const bf16_t* KCB = WSP(bf16_t, WS_MISC + MISC_KCB) + (size_t)b * 256 * 64; const bf16_t* VCB = WSP(bf16_t, WS_MISC + MISC_VCB) + (size_t)b * 256 * 64;
    bf16x8 qf[4]; load_qf<4>(qf, ACT + tok * ACTW + A_QA + h * 64, hi);
    const float nslope2 = -SLOPES[0][h] * LOG2E, c1 = 0.125f * LOG2E;
    const int tmaxu = cb * 64 + 63; const int nvmax = tmaxu >= 31 ? ((tmaxu - 31) >> 4) + 1 : 0;
    const int ntile = (nvmax + 63) >> 6;
    const int skey = tid >> 3, sch = tid & 7;
    const int i16 = lane & 15, tq = i16 >> 2, tp = i16 & 3, blk = (lane >> 4) & 1;
    f32x16 o[4]; float m = MFLOOR, l = 0.f;
#pragma unroll
    for (int dt = 0; dt < 4; ++dt)
#pragma unroll
        for (int i = 0; i < 16; ++i) o[dt][i] = 0.f;
    for (int kt = ntile - 1; kt >= 0; --kt) {
        const int buf = kt & 1;
        LAS unsigned char* st = lds + buf * CSTG;
        { const int n = kt * 64 + skey;
          *(LAS u32x4*)(st + skey * CKROWB + sch * 16) = *(const u32x4*)(KCB + (size_t)n * 64 + sch * 8);
          *(LAS u32x4*)(st + CKB + skey * CVROWB + sch * 16) = *(const u32x4*)(VCB + (size_t)n * 64 + sch * 8);
          unsigned cw[4];
#pragma unroll
          for (int e = 0; e < 4; ++e) { const int j0 = sch * 8 + 2 * e, j1 = j0 + 1; const int ja = n >> 2; const bool ex = (n & 3) == 3;
              const unsigned lo16 = (j0 == ja || (ex && j0 == ja + 1)) ? 0x3F80u : 0u, hi16 = (j1 == ja || (ex && j1 == ja + 1)) ? 0x3F80u : 0u; cw[e] = lo16 | (hi16 << 16); }
          *(LAS u32x4*)(st + CKB + skey * CVROWB + 128 + sch * 16) = (u32x4){cw[0], cw[1], cw[2], cw[3]}; }
        __syncthreads();
        const LAS unsigned char* kb = st; const LAS unsigned char* vb = st + CKB;
        f32x16 s0, s1;
#pragma unroll
        for (int i = 0; i < 16; ++i) { s0[i] = 0.f; s1[i] = 0.f; }
#pragma unroll
        for (int d0 = 0; d0 < 4; ++d0) {
            const bf16x8 k0 = *(const LAS bf16x8*)(kb + r32 * CKROWB + (16 * d0 + 8 * hi) * 2);
            const bf16x8 k1 = *(const LAS bf16x8*)(kb + (32 + r32) * CKROWB + (16 * d0 + 8 * hi) * 2);
            s0 = __builtin_amdgcn_mfma_f32_32x32x16_bf16(k0, qf[d0], s0, 0, 0, 0);
            s1 = __builtin_amdgcn_mfma_f32_32x32x16_bf16(k1, qf[d0], s1, 0, 0, 0);
        }
        const int db0 = (t - 31) - 16 * (kt * 64 + 4 * hi);
        float mx = -INFINITY;
#pragma unroll
        for (int i = 0; i < 16; ++i) { const int cr = (i & 3) + 8 * (i >> 2);
            { const int d = db0 - 16 * cr; float x = fmaf((float)d, nslope2, s0[i] * c1); x = (d >= 0) ? x : -INFINITY; s0[i] = x; mx = fmaxf(mx, x); }
            { const int d = db0 - 16 * (32 + cr); float x = fmaf((float)d, nslope2, s1[i] * c1); x = (d >= 0) ? x : -INFINITY; s1[i] = x; mx = fmaxf(mx, x); } }
        { auto rr = __builtin_amdgcn_permlane32_swap(__float_as_uint(mx), __float_as_uint(mx), false, false); mx = fmaxf(__uint_as_float(rr[0]), __uint_as_float(rr[1])); }
        const float mn = fmaxf(m, mx); const float alpha = __builtin_amdgcn_exp2f(m - mn); m = mn;
        float ls = 0.f;
#pragma unroll
        for (int i = 0; i < 16; ++i) { s0[i] = __builtin_amdgcn_exp2f(s0[i] - mn); s1[i] = __builtin_amdgcn_exp2f(s1[i] - mn); ls += s0[i] + s1[i]; }
        l = l * alpha + ls;
#pragma unroll
        for (int dt = 0; dt < 4; ++dt)
#pragma unroll
            for (int i = 0; i < 16; ++i) o[dt][i] *= alpha;
#pragma unroll
        for (int hf = 0; hf < 2; ++hf)
#pragma unroll
            for (int ks = 0; ks < 2; ++ks) {
                u32x4 pw;
                if (hf == 0) { pw.x = cvtpk(s0[8 * ks], s0[8 * ks + 1]); pw.y = cvtpk(s0[8 * ks + 2], s0[8 * ks + 3]); pw.z = cvtpk(s0[8 * ks + 4], s0[8 * ks + 5]); pw.w = cvtpk(s0[8 * ks + 6], s0[8 * ks + 7]); }
                else         { pw.x = cvtpk(s1[8 * ks], s1[8 * ks + 1]); pw.y = cvtpk(s1[8 * ks + 2], s1[8 * ks + 3]); pw.z = cvtpk(s1[8 * ks + 4], s1[8 * ks + 5]); pw.w = cvtpk(s1[8 * ks + 6], s1[8 * ks + 7]); }
                const bf16x8 pb = __builtin_bit_cast(bf16x8, pw);
#pragma unroll
                for (int dt = 0; dt < 4; ++dt) {
                    const LAS unsigned char* vp = vb + (32 * hf + 16 * ks + 4 * hi + tq) * CVROWB + (32 * dt + 16 * blk + 4 * tp) * 2;
                    const v4i16_t lo = __builtin_amdgcn_ds_read_tr16_b64_v4i16((LAS v4i16_t*)vp);
                    const v4i16_t hv = __builtin_amdgcn_ds_read_tr16_b64_v4i16((LAS v4i16_t*)(vp + 8 * CVROWB));
                    const bf16x8 va = (bf16x8){lo[0], lo[1], lo[2], lo[3], hv[0], hv[1], hv[2], hv[3]};
                    o[dt] = __builtin_amdgcn_mfma_f32_32x32x16_bf16(va, pb, o[dt], 0, 0, 0);
                }
            }
    }
    { auto rr = __builtin_amdgcn_permlane32_swap(__float_as_uint(l), __float_as_uint(l), false, false); l = __uint_as_float(rr[0]) + __uint_as_float(rr[1]); }
    const float inv = 1.f / fmaxf(l, 1e-30f);
    { float* oc = WSP(float, WS_OCMP) + tok * 256 + h * 64;
#pragma unroll
      for (int dt = 0; dt < 2; ++dt)
#pragma unroll
          for (int g = 0; g < 4; ++g) *(f32x4*)(oc + 32 * dt + 8 * g + 4 * hi) = (f32x4){o[dt][4 * g] * inv, o[dt][4 * g + 1] * inv, o[dt][4 * g + 2] * inv, o[dt][4 * g + 3] * inv}; }
    LAS float* bins = (LAS float*)(lds + BINS_OFF);
    { const int rowl = h * 64 + (w & 1) * 32 + r32;
#pragma unroll
      for (int dd = 0; dd < 2; ++dd)
#pragma unroll
          for (int i = 0; i < 16; ++i) bins[rowl * BINW + 32 * dd + (i & 3) + 8 * (i >> 2) + 4 * hi] = o[2 + dd][i] * inv; }
    __syncthreads();
    unsigned long long* SEL = WSP(unsigned long long, WS_SMALL + SM_SEL);
    for (int i = 0; i < 8; ++i) { const int tl = w * 8 + i; const int tt = cb * 64 + tl; const int cur = cb;
        const float ps = ((bins[(0 * 64 + tl) * BINW + lane] + bins[(1 * 64 + tl) * BINW + lane]) + bins[(2 * 64 + tl) * BINW + lane]) + bins[(3 * 64 + tl) * BINW + lane];
        const bool forced = (lane == 0) || (lane == cur) || (lane == cur - 1);
        float score = lane <= cur ? ps + (forced ? 1e4f : 0.f) : -1e30f;
        unsigned long long mask = 0ull;
        for (int r = 0; r < 8; ++r) {
            float bv = score; int bi = lane;
#define TK_STEP(M) { const float ov = swz_xor<M>(bv); const int oi = swz_xor_i<M>(bi); if (ov > bv || (ov == bv && oi < bi)) { bv = ov; bi = oi; } }
            TK_STEP(1) TK_STEP(2) TK_STEP(4) TK_STEP(8) TK_STEP(16)
#undef TK_STEP
            { auto rv = __builtin_amdgcn_permlane32_swap(__float_as_uint(bv), __float_as_uint(bv), false, false); auto ri = __builtin_amdgcn_permlane32_swap((unsigned)bi, (unsigned)bi, false, false);
              const float v0 = __uint_as_float(rv[0]), v1 = __uint_as_float(rv[1]); const int i0 = (int)ri[0], i1 = (int)ri[1];
              if (v1 > v0 || (v1 == v0 && i1 < i0)) { bv = v1; bi = i1; } else { bv = v0; bi = i0; } }
            if (bv > -5e29f) mask |= 1ull << bi;
            if (lane == bi) score = -INFINITY;
        }
        if (lane == 0) SEL[(size_t)b * SEQ + tt] = mask;
    }
    __syncthreads();
}
}
DEV void phase_cmpsel(const Params& p, const Ctx& c, int l) {
    for (int u = c.bid; u < 256; u += c.G) { const int v = (u * 37) & 255;
        fc::cmp_unit(p, c, v & 3, 63 - (v >> 2)); }
    moba_gate(p, c);
}

constexpr int CW_QUEUE = 16384 + 512;
constexpr int N_ATT_UNITS = 1024;
DEV void phase_attn2(const Params& p, const Ctx& c, int l) {
    using namespace fa;
    const bf16_t* ACT = WSP(bf16_t, WS_ACT); const bf16_t* ACT2 = WSP(bf16_t, WS_ACT2); bf16_t* BR = WSP(bf16_t, WS_BR);
    unsigned* qhead = WSP(unsigned, WS_CTL) + CW_QUEUE + l; l &= 7;
    volatile LAS unsigned* misc = (volatile LAS unsigned*)(c.lds + LDS_MISC);
    const int lane = c.lane, r32 = lane & 31, hi = lane >> 5, w = c.wave;
    for (;;) {
        if (c.tid == 0) { misc[0] = atomicAdd(qhead, 1u); misc[2] = 0u; misc[3] = 0u; }
        __syncthreads();
        const int u = (int)__builtin_amdgcn_readfirstlane(misc[0]);
        if (u >= N_ATT_UNITS) break;
        f32x16 o[2]; float m, ls;
        if (u < 512) {
            const int k = 15 - (u >> 5), r = u & 31, bh = r & 15, b = bh >> 2, h = bh & 3; const bool moba = (r >> 4) != 0;
            const int t = k * 256 + w * 32 + r32; const size_t tok = (size_t)b * SEQ + t; const size_t b0 = (size_t)b * SEQ;
            if (!moba) {
                bf16x8 qf[6]; load_qf<6>(qf, ACT2 + tok * ACT2W + A2_QF + h * 96, hi);
                const Src src{ACT2 + b0 * ACT2W + A2_KN + h * 64, ACT2W, ACT + b0 * ACTW + A_KR, ACTW, ACT2 + b0 * ACT2W + A2_VD + h * 64, ACT2W};
                const int nt = 4 * k + 4; const unsigned long long tm = nt >= 64 ? ~0ull : ((1ull << nt) - 1ull);
                const int nw = 4 * k + (w >> 1) + 1; const unsigned long long wm = nw >= 64 ? ~0ull : ((1ull << nw) - 1ull);
                __syncthreads();
                attn_pass<6, false, 0>(c.lds, c, src, qf, tm, wm, t, 0.f, 0.10206207261596575f * LOG2E, 0x7fffffffu, 0ull, 0, o, m, ls);
                store_o(BR + tok * 1024 + 768 + h * 64, o, 1.f / ls, hi);
            } else {
                bf16x8 qf[4]; load_qf<4>(qf, ACT + tok * ACTW + A_QC + h * 64, hi);
                const Src src{ACT + b0 * ACTW + A_KC + h * 64, ACTW, nullptr, 0, ACT + b0 * ACTW + A_VC + h * 64, ACTW};
                const unsigned rm = WSP(unsigned, WS_OWIN)[tok * 4 + h];
                const unsigned long long wor = wave_or64((unsigned long long)rm);
                if (lane == 0) atomicOr((unsigned*)&misc[2], (unsigned)wor);
                __syncthreads();
                const unsigned bor = __builtin_amdgcn_readfirstlane(misc[2]);
                const unsigned long long own_all = 0xFull << (4 * k);
                const int nw = (w >> 1) + 1; const unsigned long long own_w = ((1ull << nw) - 1ull) << (4 * k);
                const unsigned long long tm = uni64(expand4(bor) | own_all), wm = uni64(expand4((unsigned)wor) | own_w);
                attn_pass<4, true, 2>(c.lds, c, src, qf, tm, wm, t, -SLOPES[2][h] * LOG2E, 0.125f * LOG2E, 0x7fffffffu, (unsigned long long)rm, k, o, m, ls);
                store_o(BR + tok * 1024 + 512 + h * 64, o, 1.f / ls, hi);
            }
        } else if (u < 768) {
            const int v = u - 512, cb = 63 - (v >> 2), b = v & 3, h = w >> 1;
            const int t = cb * 64 + (w & 1) * 32 + r32; const size_t tok = (size_t)b * SEQ + t; const size_t b0 = (size_t)b * SEQ;
            bf16x8 qf[4]; load_qf<4>(qf, ACT + tok * ACTW + A_QA + h * 64, hi);
            const float nsl = -SLOPES[0][h] * LOG2E;
            const float* GA = WSP(float, WS_SMALL + SM_GA) + tok * 12 + h * 3; const float g0 = GA[0], g1 = GA[1], g2 = GA[2];
            const unsigned long long rm = WSP(unsigned long long, WS_SMALL + SM_SEL)[tok];
            const unsigned long long wor = wave_or64(rm);
            if (lane == 0) { atomicOr((unsigned*)&misc[2], (unsigned)wor); atomicOr((unsigned*)&misc[3], (unsigned)(wor >> 32)); }
            { const Src src{ACT + b0 * ACTW + A_KW, ACTW, nullptr, 0, ACT + b0 * ACTW + A_VW, ACTW};
              const int lo = cb >= 8 ? cb - 8 : 0; const unsigned long long upto = cb >= 63 ? ~0ull : ((1ull << (cb + 1)) - 1ull); const unsigned long long tm = upto & ~((1ull << lo) - 1ull);
              __syncthreads();
              attn_pass<4, true, 0>(c.lds, c, src, qf, tm, tm, t, nsl, 0.125f * LOG2E, 512u, 0ull, 0, o, m, ls); }
            f32x16 res[2]; { const float sc = g2 / ls;
#pragma unroll
              for (int dt = 0; dt < 2; ++dt)
#pragma unroll
                  for (int i = 0; i < 16; ++i) res[dt][i] = o[dt][i] * sc; }
            { const Src src{ACT + b0 * ACTW + A_KS, ACTW, nullptr, 0, ACT + b0 * ACTW + A_VS, ACTW};
              const unsigned long long tm = ((unsigned long long)__builtin_amdgcn_readfirstlane(misc[3]) << 32) | __builtin_amdgcn_readfirstlane(misc[2]);
              attn_pass<4, true, 1>(c.lds, c, src, qf, tm, wor, t, nsl, 0.125f * LOG2E, 0x7fffffffu, rm, 0, o, m, ls); }
            { const float sc = g1 / ls; const float* oc = WSP(float, WS_OCMP) + tok * 256 + h * 64;
#pragma unroll
              for (int dt = 0; dt < 2; ++dt)
#pragma unroll
                  for (int g = 0; g < 4; ++g) { const f32x4 cv = *(const f32x4*)(oc + 32 * dt + 8 * g + 4 * hi);
#pragma unroll
                      for (int e = 0; e < 4; ++e) res[dt][4 * g + e] += o[dt][4 * g + e] * sc + g0 * cv[e]; } }
            store_o(BR + tok * 1024 + h * 64, res, 1.f, hi);
        } else {
            const int v = u - 768, b = v >> 6, g = (v >> 5) & 1, cc = v & 31, hr = w >> 2, h = 2 * g + hr;
            const int t = cc * 128 + (w & 3) * 32 + r32; const size_t tok = (size_t)b * SEQ + t; const size_t b0 = (size_t)b * SEQ;
            bf16x8 qf[4]; load_qf<4>(qf, ACT + tok * ACTW + A_QB + h * 64, hi);
            const Src src{ACT + b0 * ACTW + A_KB + g * 64, ACTW, nullptr, 0, ACT + b0 * ACTW + A_VB + g * 64, ACTW};
            const int lo = cc >= 1 ? 2 * cc - 2 : 0; const int hiT = 2 * cc + 1; const unsigned long long upto = hiT >= 63 ? ~0ull : ((1ull << (hiT + 1)) - 1ull);
            const unsigned long long tm = upto & ~((1ull << lo) - 1ull);
            const unsigned long long wm = ((w & 3) < 2) ? (tm & ~(1ull << hiT)) : tm;
            __syncthreads();
            attn_pass<4, true, 0>(c.lds, c, src, qf, tm, wm, t, -SLOPES[1][h] * LOG2E, 0.125f * LOG2E, 128u, 0ull, 0, o, m, ls);
            const float sk2 = p.in[10][l * 4 + h] * LOG2E; const float mf = fmaxf(m, sk2); const float a = __builtin_amdgcn_exp2f(m - mf); const float den = ls * a + __builtin_amdgcn_exp2f(sk2 - mf);
            store_o(BR + tok * 1024 + 256 + h * 64, o, a / den, hi);
        }
        __syncthreads();
    }
}
DEV void moba_gate(const Params& p, const Ctx& c) {
    const bf16_t* ACT = WSP(bf16_t, WS_ACT); unsigned* MS = WSP(unsigned, WS_OWIN);
    for (int it = c.gw; it < 1024; it += c.NGW) {
        int b, g, h; item_bgh(it, b, g, h); const int t = g * 64 + c.lane; const size_t tok = (size_t)b * SEQ + t; const int nb = g >> 2;
        float q[64]; load_q<64>(q, ACT + tok * ACTW + A_QC + h * 64);
        const float* KM = WSP(float, WS_MISC + MISC_KMEAN) + (size_t)b * 16 * 256 + h * 64;
        float v1 = -INFINITY, v2 = -INFINITY, v3 = -INFINITY; int i1 = -1, i2 = -1, i3 = -1;
        for (int n = 0; n < nb; ++n) { const float* km = KM + n * 256; float dsum = 0.f;
#pragma unroll
            for (int d = 0; d < 64; ++d) dsum += q[d] * km[d];
            if (dsum > v1) { v3 = v2; i3 = i2; v2 = v1; i2 = i1; v1 = dsum; i1 = n; }
            else if (dsum > v2) { v3 = v2; i3 = i2; v2 = dsum; i2 = n; }
            else if (dsum > v3) { v3 = dsum; i3 = n; } }
        unsigned mk = 0u; if (i1 >= 0) mk |= 1u << i1; if (i2 >= 0) mk |= 1u << i2; if (i3 >= 0) mk |= 1u << i3;
        MS[tok * 4 + h] = mk;
    }
}
DEV void phase_cmpw2(const Params& p, const Ctx& c, int l) {
    const int lane = c.lane;
    const bf16_t* HID = WSP(bf16_t, WS_HID); float* KC = WSP(float, WS_MISC + MISC_KCMP); float* VC = WSP(float, WS_MISC + MISC_VCMP);
    const float* gq = p.in[6] + (size_t)l * 10 * 64;
    for (int it = c.gw; it < 2 * 1020; it += c.NGW) { const int kv = it / 1020, r = it % 1020;
        const float* w2 = p.in[9] + (size_t)(l * 2 + kv) * 256 * 64; const bf16_t* hrow = HID + ((size_t)kv * 1024 + r) * 256;
        float a = 0.f;
        for (int k = 0; k < 256; ++k) a += bf2f(hrow[k]) * w2[k * 64 + lane];
        const int b = r / 255, i = r % 255;
        bf16_t* KCB = WSP(bf16_t, WS_MISC + MISC_KCB); bf16_t* VCB = WSP(bf16_t, WS_MISC + MISC_VCB);
        if (kv == 0) KCB[(b * 256 + i) * 64 + lane] = (bf16_t)f2bf(head_norm(a, gq + 1 * 64, lane)); else VCB[(b * 256 + i) * 64 + lane] = (bf16_t)f2bf(a);
        if (i == 0) { if (kv == 0) KCB[(b * 256 + 255) * 64 + lane] = 0; else VCB[(b * 256 + 255) * 64 + lane] = 0; } }
}

struct FMergeAll { const bf16_t* GATES; float* MIX; bf16_t* MIXB;
    DEV void operator()(int row, int vcol, const f32x4& v0, const f32x4& v1) const {
        const int n = vcol >> 10, col = vcol & 1023;
        const u32x4 gw = *(const u32x4*)(GATES + (size_t)row * NGATE + n * 1024 + col);
        f32x4 a = (f32x4){bflo(gw.x), bfhi(gw.x), bflo(gw.y), bfhi(gw.y)} * v0, b = (f32x4){bflo(gw.z), bfhi(gw.z), bflo(gw.w), bfhi(gw.w)} * v1;
        float* mx = MIX + (size_t)row * 1024 + col;
        if (n > 0) { a += *(const f32x4*)mx; b += *(const f32x4*)(mx + 4); }
        if (n < 3) { *(f32x4*)mx = a; *(f32x4*)(mx + 4) = b; }
        else { u32x4 w; w.x = pk2(a[0], a[1]); w.y = pk2(a[2], a[3]); w.z = pk2(b[0], b[1]); w.w = pk2(b[2], b[3]); *(u32x4*)(MIXB + (size_t)row * 1024 + col) = w; } } };
struct MergeOrder { pg8::StaticOrder so;
    DEV bool next(int i, pg8::Unit& u) const { if (!so.next(i >> 2, u)) return false; const int n = i & 3; u.pn += 4 * n; u.ao = n * 512; return true; } };
template <int NB> DEV void phase_merge(const Params& p, const Ctx& c, int l) {
    pg8::Gemm g{WSP(bf16_t, WS_BR), WSP(bf16_t, WS_WBR) + (size_t)l * 4 * 1024 * 256, 1024, 256};
    MergeOrder S; S.so.init(NTOK, 1024, c.G, c.bid);
    pg8::Epi8<FMergeAll> E{{WSP(bf16_t, WS_GATES), (float*)(p.ws + WS_BIG + BIG_MIX), (bf16_t*)(p.ws + WS_BIG + BIG_MIXB)}};
    pg8::gemm_phase<pg8::Epi8<FMergeAll>, MergeOrder, true>(c.lds, g, S, E);
}
struct FOut { float* X; const float* g1; float* XO;
    DEV void operator()(int row, int col, const f32x4& v0, const f32x4& v1) const { const float* gg = g1 + (row / SEQ) * 6144 + col; float* x = X + (size_t)row * DM + col;
        float* xo = XO + (size_t)row * DM + col; *(f32x4*)xo = *(const f32x4*)x + *(const f32x4*)gg * v0; *(f32x4*)(xo + 4) = *(const f32x4*)(x + 4) + *(const f32x4*)(gg + 4) * v1; } };
template <bool REAL> DEV void phase_out(const Params& p, const Ctx& c, int l) {
    pg8::Gemm g{(const bf16_t*)(p.ws + WS_BIG + BIG_MIXB), WSP(bf16_t, WS_WOUT) + (size_t)l * 1024 * 1024, 1024, 1024};
    pg8::StaticOrder S; S.init(NTOK, 1024, c.G, c.bid);
    pg8::Epi8<FOut> E{{p.out, WSP(float, WS_MOD) + (size_t)l * 4 * 6144 + 2048, REAL ? p.out : WSP(float, WS_MUR)}};
    pg8::gemm_phase<pg8::Epi8<FOut>, pg8::StaticOrder, true>(c.lds, g, S, E);
}

template <bool COUNT> DEV void phase_router(const Params& p, const Ctx& c, int l) {
    const float* MOD = WSP(float, WS_MOD); bf16_t* H2B = WSP(bf16_t, WS_HBF);
    int* EID = WSP(int, WS_MISC + MISC_EID); float* WTS = WSP(float, WS_MISC + MISC_WTS); unsigned* ctl = WSP(unsigned, WS_CTL);
    const float* WRT = WSP(float, WS_MISC + MISC_WRT) + (size_t)l * 36 * 1024;
    const int lane = c.lane;
    LAS int* hist = (LAS int*)(c.lds + 4096);
    if (c.tid < 32) hist[c.tid] = 0;
    __syncthreads();
    const int rpb = NTOK / c.G, rpw = rpb / 8;
    for (int ri = 0; ri < rpw; ++ri) { const int row = c.bid * rpb + c.wave * rpw + ri;
        const int b = row / SEQ;
        f32x4 v[4]; float ss = 0.f;
#pragma unroll
        for (int j = 0; j < 4; ++j) { v[j] = *(const f32x4*)(p.out + (size_t)row * DM + j * 256 + lane * 4); ss += (v[j][0] * v[j][0] + v[j][1] * v[j][1]) + (v[j][2] * v[j][2] + v[j][3] * v[j][3]); }
        const float r = rsqrtf(wave_sum(ss) * (1.f / DM) + EPS);
        const float* gn = p.in[4] + (size_t)(l * 2 + 1) * DM; const float* sh = MOD + (l * 4 + b) * 6144 + 3072; const float* sc = sh + 1024;
#pragma unroll
        for (int j = 0; j < 4; ++j) { const int col = j * 256 + lane * 4;
            const f32x4 g = *(const f32x4*)(gn + col), s1 = *(const f32x4*)(sc + col), s0 = *(const f32x4*)(sh + col);
            v[j] = v[j] * r * g * (s1 + 1.f) + s0;
            u32x2 o; o.x = pk2(v[j][0], v[j][1]); o.y = pk2(v[j][2], v[j][3]); *(u32x2*)(H2B + (size_t)row * DM + col) = o; }
        LAS float* lgs = (LAS float*)(c.lds + c.wave * 256);
#pragma unroll 1
        for (int eg = 0; eg < 9; ++eg) { float a4[4];
#pragma unroll
            for (int u = 0; u < 4; ++u) { const float* wr = WRT + (eg * 4 + u) * 1024 + lane * 4; float a = 0.f;
#pragma unroll
                for (int j = 0; j < 4; ++j) { const f32x4 wv = *(const f32x4*)(wr + j * 256); a += (v[j][0] * wv[0] + v[j][1] * wv[1]) + (v[j][2] * wv[2] + v[j][3] * wv[3]); }
                a4[u] = a; }
#pragma unroll
            for (int u = 0; u < 4; ++u) a4[u] = wave_sum(a4[u]);
            if (lane == 0) *(LAS f32x4*)(lgs + eg * 4) = (f32x4){a4[0], a4[1], a4[2], a4[3]}; }
        LDS_WAIT(); asm volatile("" ::: "memory");
        float lc[4];
#pragma unroll
        for (int i = 0; i < 4; ++i) lc[i] = lgs[i] + p.in[19][l * 4 + i];
        int grp = 0; float mx = lc[0];
#pragma unroll
        for (int i = 1; i < 4; ++i) if (lc[i] > mx) { mx = lc[i]; grp = i; }
        float z = 0.f;
#pragma unroll
        for (int i = 0; i < 4; ++i) z += __expf(lc[i] - mx);
        const float pg = 1.f / z;
        float f1 = -INFINITY, f2 = -INFINITY; int e1 = 0, e2 = 0;
#pragma unroll
        for (int i = 0; i < 8; ++i) { const float x = lgs[4 + grp * 8 + i] + p.in[21][l * 32 + grp * 8 + i];
            if (x > f1) { f2 = f1; e2 = e1; f1 = x; e1 = i; } else if (x > f2) { f2 = x; e2 = i; } }
        LDS_WAIT(); asm volatile("" ::: "memory");
        const float q2 = __expf(f2 - f1); const float w1 = pg / (1.f + q2), w2 = pg * q2 / (1.f + q2);
        const int x1 = grp * 8 + e1, x2 = grp * 8 + e2;
        if (lane == 0) { EID[row * 2] = x1; EID[row * 2 + 1] = x2; WTS[row * 2] = w1; WTS[row * 2 + 1] = w2;
            __hip_atomic_fetch_add(hist + x1, 1, __ATOMIC_RELAXED, __HIP_MEMORY_SCOPE_WORKGROUP); __hip_atomic_fetch_add(hist + x2, 1, __ATOMIC_RELAXED, __HIP_MEMORY_SCOPE_WORKGROUP); }
    }
    __syncthreads();
    if (c.tid < 32) WSP(int, WS_MISC + MISC_HIST)[c.bid * 32 + c.tid] = hist[c.tid];
}

struct MoeTab { LAS int* start; LAS int* tile_e; LAS int* ntiles; };
DEV MoeTab build_moe_tab(const Params& p, const Ctx& c, int l) {
    MoeTab T; T.start = (LAS int*)(c.lds + LDS_AUX + 1024); T.tile_e = T.start + 32; T.ntiles = T.tile_e + 192;
    __syncthreads();
    if (c.tid == 0) { const unsigned* cnt = WSP(unsigned, WS_CTL) + CW_CNT + l * 32; int row = 0, nt = 0;
        for (int e = 0; e < 32; ++e) { const int n = (int)__hip_atomic_load(cnt + e, __ATOMIC_RELAXED, __HIP_MEMORY_SCOPE_AGENT); T.start[e] = row; const int tiles = (n + 255) >> 8;
            for (int i = 0; i < tiles; ++i) T.tile_e[nt + i] = e;
            nt += tiles; row += tiles * 256; }
        T.ntiles[0] = nt; }
    __syncthreads();
    return T;
}
DEV void phase_moesort(const Params& p, const Ctx& c, int l, int rep) {
    const int* HIST = WSP(int, WS_MISC + MISC_HIST);
    LAS int* part = (LAS int*)(c.lds + 4096);
    LAS int* base = part + 1024;
    LAS int* curs = base + 32;
    LAS int* tot = curs + 32;
    { const int e = c.tid & 31, seg = c.tid >> 5; int sa = 0, sp = 0;
      for (int i = 0; i < 16; ++i) { const int bb = seg * 16 + i; if (bb < c.G) { const int hv = HIST[bb * 32 + e]; sa += hv; sp += bb < c.bid ? hv : 0; } }
      part[seg * 32 + e] = sa; part[512 + seg * 32 + e] = sp; }
    __syncthreads();
    if (c.tid < 32) { int sa = 0, sp = 0;
        for (int i = 0; i < 16; ++i) { sa += part[i * 32 + c.tid]; sp += part[512 + i * 32 + c.tid]; }
        tot[c.tid] = sa; base[c.tid] = sp; curs[c.tid] = 0;
        if (c.bid == 0) WSP(unsigned, WS_CTL)[CW_CNT + l * 32 + c.tid] = (unsigned)sa; }
    __syncthreads();
    if (c.tid == 0) { int row = 0; for (int e = 0; e < 32; ++e) { base[e] += row; row += ((tot[e] + 255) >> 8) << 8; } }
    __syncthreads();
    const int* EID = WSP(int, WS_MISC + MISC_EID); int* PSLOT = WSP(int, WS_MISC + MISC_PSLOT);
    const bf16_t* H2B = WSP(bf16_t, WS_HBF); bf16_t* XS = (bf16_t*)(p.ws + WS_BIG + BIG_XS);
    const int lane = c.lane; const int rpb = NTOK / c.G, rpw = rpb / 8;
    for (int ri = 0; ri < rpw; ++ri) { const int tok = c.bid * rpb + c.wave * rpw + ri;
        const u32x4 a = *(const u32x4*)(H2B + (size_t)tok * DM + lane * 16), b2 = *(const u32x4*)(H2B + (size_t)tok * DM + lane * 16 + 8);
#pragma unroll
        for (int k = 0; k < 2; ++k) { const int e = EID[tok * 2 + k]; int slot = 0;
            if (lane == 0) slot = base[e] + __hip_atomic_fetch_add(curs + e, 1, __ATOMIC_RELAXED, __HIP_MEMORY_SCOPE_WORKGROUP);
            slot = __builtin_amdgcn_readfirstlane(slot);
            if (lane == 0) PSLOT[tok * 2 + k] = slot;
            *(u32x4*)(XS + (size_t)slot * DM + lane * 16) = a; *(u32x4*)(XS + (size_t)slot * DM + lane * 16 + 8) = b2; }
    }
}
template <int NCOL> struct MoeOrder { int G, c; LAS const int* tile_e; int ntiles;
    DEV bool next(int i, pg8::Unit& u) const { const int L = i * G + c; if (L >= ntiles * NCOL) return false; const int pm = L / NCOL; u.pm = pm; u.pn = tile_e[pm] * NCOL + (L % NCOL); u.ao = 0; return true; } };
struct FMoe1 { bf16_t* ACTB;
    DEV void operator()(int row, int col, const f32x4& v0, const f32x4& v1) const { const int ce = col & 511;
        u32x2 w; w.x = pk2(silu_(v0[0]) * v0[1], silu_(v0[2]) * v0[3]); w.y = pk2(silu_(v1[0]) * v1[1], silu_(v1[2]) * v1[3]);
        *(u32x2*)(ACTB + (size_t)row * 256 + (ce >> 1)) = w; } };
struct FMoe2 { bf16_t* YP;
    DEV void operator()(int row, int col, const f32x4& v0, const f32x4& v1) const { const int ce = col & 1023;
        u32x4 w; w.x = pk2(v0[0], v0[1]); w.y = pk2(v0[2], v0[3]); w.z = pk2(v1[0], v1[1]); w.w = pk2(v1[2], v1[3]); *(u32x4*)(YP + (size_t)row * DM + ce) = w; } };
DEV void phase_moe1(const Params& p, const Ctx& c, int l) {
    const MoeTab T = build_moe_tab(p, c, l);
    pg8::Gemm g{(const bf16_t*)(p.ws + WS_BIG + BIG_XS), WSP(bf16_t, WS_W13) + (size_t)l * 32 * 512 * 1024, 1024, 1024};
    MoeOrder<2> S{c.G, c.bid, T.tile_e, T.ntiles[0]}; pg8::Epi8<FMoe1> E{{WSP(bf16_t, WS_MUR)}};
    pg8::gemm_phase<pg8::Epi8<FMoe1>, MoeOrder<2>, true>(c.lds, g, S, E);
}
DEV void phase_moe2(const Params& p, const Ctx& c, int l) {
    const MoeTab T = build_moe_tab(p, c, l);
    pg8::Gemm g{WSP(bf16_t, WS_MUR), WSP(bf16_t, WS_W2) + (size_t)l * 32 * 1024 * 256, 256, 256};
    MoeOrder<4> S{c.G, c.bid, T.tile_e, T.ntiles[0]}; pg8::Epi8<FMoe2> E{{(bf16_t*)(p.ws + WS_BIG + BIG_YP)}};
    pg8::gemm_phase<pg8::Epi8<FMoe2>, MoeOrder<4>, true>(c.lds, g, S, E);
}

constexpr int PH_PRO = 0, PH_NORM1 = 1, PH_INPROJ = 2, PH_POST = 3, PH_MLAUP = 4, PH_POST2 = 5, PH_ATTN = 6, PH_CMPATTN = 7, PH_TOPK = 8, PH_SLC = 9,
              PH_MERGE0 = 10, PH_MERGE1 = 11, PH_MERGE2 = 12, PH_MERGE3 = 13, PH_OUT = 14, PH_ROUTER = 15, PH_SORT = 16, PH_MOE1 = 17, PH_MOE2 = 18, PH_FINAL = 19, PH_COUNT = 20;
constexpr int LDS_PTAB = LDS_AUX + 64;
DEV unsigned long long uni64(unsigned long long v) { const unsigned lo = __builtin_amdgcn_readfirstlane((unsigned)v), hi = __builtin_amdgcn_readfirstlane((unsigned)(v >> 32)); return ((unsigned long long)hi << 32) | lo; }
DEV void store_params(const Params& p, LAS unsigned char* lds) {
    LAS unsigned long long* L = (LAS unsigned long long*)(lds + LDS_PTAB);
    if (threadIdx.x == 0) {
#pragma unroll
        for (int i = 0; i < 24; ++i) L[i] = (unsigned long long)p.in[i];
        L[24] = (unsigned long long)p.out; L[25] = (unsigned long long)p.ws; }
}
DEV Params load_params(LAS unsigned char* lds) {
    const LAS unsigned long long* L = (const LAS unsigned long long*)(lds + LDS_PTAB); Params p;
#pragma unroll
    for (int i = 0; i < 24; ++i) p.in[i] = (const float*)uni64(L[i]);
    p.out = (float*)uni64(L[24]); p.ws = (unsigned char*)uni64(L[25]); return p;
}
template <int PH, int REP = 0> DEV void run_phase(const Params& p, const Ctx& c, int l) {
    if constexpr (PH == PH_PRO) phase_prologue(p, c);
    else if constexpr (PH == PH_NORM1) phase_norm1<true, REP == 0>(p, c, l);
    else if constexpr (PH == PH_INPROJ) phase_inproj(p, c, l);
    else if constexpr (PH == PH_POST) phase_post(p, c, l);
    else if constexpr (PH == PH_MLAUP) phase_mlaup(p, c, l);
    else if constexpr (PH == PH_POST2) phase_post2(p, c, l);
    else if constexpr (PH == PH_ATTN) phase_cmpw2(p, c, l);
    else if constexpr (PH == PH_CMPATTN) phase_cmpsel(p, c, l);
    else if constexpr (PH == PH_TOPK) { }
    else if constexpr (PH == PH_SLC) phase_attn2(p, c, l + 8 * REP);
    else if constexpr (PH == PH_MERGE0) phase_merge<0>(p, c, l);
    else if constexpr (PH == PH_OUT) phase_out<REP == 0>(p, c, l);
    else if constexpr (PH == PH_ROUTER) phase_router<REP == 0>(p, c, l);
    else if constexpr (PH == PH_SORT) phase_moesort(p, c, l, REP);
    else if constexpr (PH == PH_MOE1) phase_moe1(p, c, l);
    else if constexpr (PH == PH_MOE2) phase_moe2(p, c, l);
    else if constexpr (PH == PH_FINAL) phase_norm1<false, true>(p, c, NLAYER);
}

#if !MK_ONE_LAUNCH
template <int PH> __global__ void __launch_bounds__(512, 2) k_phase(Params p, int l) {
    extern __shared__ __attribute__((aligned(16))) unsigned char lds_raw[];
    const Ctx c = make_ctx((LAS unsigned char*)lds_raw);
    run_phase<PH>(p, c, l);
}
template <int PH> static void launch_phase(const Params& p, int l, int grid, hipStream_t stream) {
    static bool attr_set = false;
    if (!attr_set) { (void)hipFuncSetAttribute((const void*)k_phase<PH>, hipFuncAttributeMaxDynamicSharedMemorySize, LDS_BYTES); attr_set = true; }
    hipLaunchKernelGGL(k_phase<PH>, dim3(grid), dim3(512), LDS_BYTES, stream, p, l);
}
#else
#define BAR() xcd_barrier_fn(bar.bar, bar.x, bar.st)
template <int l> DEV void mega_layer(LAS unsigned char* lds, const XcdBarrier& bar) {
        { const Ctx c = make_ctx(lds); const Params q = load_params(lds); run_phase<PH_NORM1>(q, c, l); } BAR(); if constexpr ((PROBE_MASK >> PH_NORM1) & 1u) { { const Ctx c = make_ctx(lds); const Params q = load_params(lds); run_phase<PH_NORM1, 1>(q, c, l); } BAR(); }
        { const Ctx c = make_ctx(lds); const Params q = load_params(lds); run_phase<PH_INPROJ>(q, c, l); } BAR(); if constexpr ((PROBE_MASK >> PH_INPROJ) & 1u) { { const Ctx c = make_ctx(lds); const Params q = load_params(lds); run_phase<PH_INPROJ, 1>(q, c, l); } BAR(); }
        { const Ctx c = make_ctx(lds); const Params q = load_params(lds); run_phase<PH_POST>(q, c, l); } BAR(); if constexpr ((PROBE_MASK >> PH_POST) & 1u) { { const Ctx c = make_ctx(lds); const Params q = load_params(lds); run_phase<PH_POST, 1>(q, c, l); } BAR(); }
        { const Ctx c = make_ctx(lds); const Params q = load_params(lds); run_phase<PH_MLAUP>(q, c, l); } BAR(); if constexpr ((PROBE_MASK >> PH_MLAUP) & 1u) { { const Ctx c = make_ctx(lds); const Params q = load_params(lds); run_phase<PH_MLAUP, 1>(q, c, l); } BAR(); }
        { const Ctx c = make_ctx(lds); const Params q = load_params(lds); run_phase<PH_POST2>(q, c, l); } BAR(); if constexpr ((PROBE_MASK >> PH_POST2) & 1u) { { const Ctx c = make_ctx(lds); const Params q = load_params(lds); run_phase<PH_POST2, 1>(q, c, l); } BAR(); }
        { const Ctx c = make_ctx(lds); const Params q = load_params(lds); run_phase<PH_ATTN>(q, c, l); } BAR(); if constexpr ((PROBE_MASK >> PH_ATTN) & 1u) { { const Ctx c = make_ctx(lds); const Params q = load_params(lds); run_phase<PH_ATTN, 1>(q, c, l); } BAR(); }
        { const Ctx c = make_ctx(lds); const Params q = load_params(lds); run_phase<PH_CMPATTN>(q, c, l); } BAR(); if constexpr ((PROBE_MASK >> PH_CMPATTN) & 1u) { { const Ctx c = make_ctx(lds); const Params q = load_params(lds); run_phase<PH_CMPATTN, 1>(q, c, l); } BAR(); }
        { const Ctx c = make_ctx(lds); const Params q = load_params(lds); run_phase<PH_SLC>(q, c, l); } BAR(); if constexpr ((PROBE_MASK >> PH_SLC) & 1u) { { const Ctx c = make_ctx(lds); const Params q = load_params(lds); run_phase<PH_SLC, 1>(q, c, l); } BAR(); }
        { const Ctx c = make_ctx(lds); const Params q = load_params(lds); run_phase<PH_MERGE0>(q, c, l); } BAR(); if constexpr ((PROBE_MASK >> PH_MERGE0) & 1u) { { const Ctx c = make_ctx(lds); const Params q = load_params(lds); run_phase<PH_MERGE0, 1>(q, c, l); } BAR(); }
        { const Ctx c = make_ctx(lds); const Params q = load_params(lds); run_phase<PH_OUT>(q, c, l); } BAR(); if constexpr ((PROBE_MASK >> PH_OUT) & 1u) { { const Ctx c = make_ctx(lds); const Params q = load_params(lds); run_phase<PH_OUT, 1>(q, c, l); } BAR(); }
        { const Ctx c = make_ctx(lds); const Params q = load_params(lds); run_phase<PH_ROUTER>(q, c, l); } BAR(); if constexpr ((PROBE_MASK >> PH_ROUTER) & 1u) { { const Ctx c = make_ctx(lds); const Params q = load_params(lds); run_phase<PH_ROUTER, 1>(q, c, l); } BAR(); }
        { const Ctx c = make_ctx(lds); const Params q = load_params(lds); run_phase<PH_SORT>(q, c, l); } BAR(); if constexpr ((PROBE_MASK >> PH_SORT) & 1u) { { const Ctx c = make_ctx(lds); const Params q = load_params(lds); run_phase<PH_SORT, 1>(q, c, l); } BAR(); }
        { const Ctx c = make_ctx(lds); const Params q = load_params(lds); run_phase<PH_MOE1>(q, c, l); } BAR(); if constexpr ((PROBE_MASK >> PH_MOE1) & 1u) { { const Ctx c = make_ctx(lds); const Params q = load_params(lds); run_phase<PH_MOE1, 1>(q, c, l); } BAR(); }
        { const Ctx c = make_ctx(lds); const Params q = load_params(lds); run_phase<PH_MOE2>(q, c, l); } BAR(); if constexpr ((PROBE_MASK >> PH_MOE2) & 1u) { { const Ctx c = make_ctx(lds); const Params q = load_params(lds); run_phase<PH_MOE2, 1>(q, c, l); } BAR(); }
}
__global__ void __launch_bounds__(512, 2) k_mega(Params p) {
    extern __shared__ __attribute__((aligned(16))) unsigned char lds_raw[];
    LAS unsigned char* lds = (LAS unsigned char*)lds_raw;
    volatile LAS unsigned* bst = (volatile LAS unsigned*)(lds + LDS_AUX);
    if (threadIdx.x < 4) bst[threadIdx.x] = 0u;
    store_params(p, lds);
    __syncthreads();
    const XcdBarrier bar = xcd_barrier_post(WSP(unsigned, WS_CTL) + CW_BAR, bst);
    { const Ctx c = make_ctx(lds); const Params q = load_params(lds); run_phase<PH_PRO>(q, c, 0); } BAR(); if constexpr ((PROBE_MASK >> PH_PRO) & 1u) { { const Ctx c = make_ctx(lds); const Params q = load_params(lds); run_phase<PH_PRO, 1>(q, c, 0); } BAR(); }
    mega_layer<0>(lds, bar); mega_layer<1>(lds, bar); mega_layer<2>(lds, bar); mega_layer<3>(lds, bar);
    { const Ctx c = make_ctx(lds); const Params q = load_params(lds); run_phase<PH_FINAL>(q, c, NLAYER); }
#undef BAR
}
#endif

extern "C" void kernel_launch(void* const* d_in, const int* in_sizes, int n_in, void* d_out, int out_size, void* d_ws, size_t ws_size, hipStream_t stream) {
    if (n_in != 24 || out_size != NTOK * DM || ws_size < WS_END) { fprintf(stderr, "kernel_launch: unexpected shapes (n_in %d out %d ws %zu, need %zu)\n", n_in, out_size, ws_size, (size_t)WS_END); return; }
    Params p{};
    for (int i = 0; i < 24; ++i) p.in[i] = (const float*)d_in[i];
    p.out = (float*)d_out; p.ws = (unsigned char*)d_ws;
    (void)hipMemsetAsync((char*)d_ws + WS_CTL, 0, 1 * MiB, stream);
    const int grid = 256;
#if !MK_ONE_LAUNCH
    launch_phase<PH_PRO>(p, 0, grid, stream);
    for (int l = 0; l < NLAYER; ++l) {
        launch_phase<PH_NORM1>(p, l, grid, stream);
        launch_phase<PH_INPROJ>(p, l, grid, stream);
        launch_phase<PH_POST>(p, l, grid, stream);
        launch_phase<PH_MLAUP>(p, l, grid, stream);
        launch_phase<PH_POST2>(p, l, grid, stream);
        launch_phase<PH_ATTN>(p, l, grid, stream);
        launch_phase<PH_CMPATTN>(p, l, grid, stream);
        launch_phase<PH_SLC>(p, l, grid, stream);
        launch_phase<PH_MERGE0>(p, l, grid, stream);
        launch_phase<PH_OUT>(p, l, grid, stream);
        launch_phase<PH_ROUTER>(p, l, grid, stream);
        launch_phase<PH_SORT>(p, l, grid, stream);
        launch_phase<PH_MOE1>(p, l, grid, stream);
        launch_phase<PH_MOE2>(p, l, grid, stream);
    }
    launch_phase<PH_FINAL>(p, NLAYER, grid, stream);
#else
    static bool attr_set = false;
    if (!attr_set) { (void)hipFuncSetAttribute((const void*)k_mega, hipFuncAttributeMaxDynamicSharedMemorySize, LDS_BYTES); attr_set = true; }
    hipLaunchKernelGGL(k_mega, dim3(grid), dim3(512), LDS_BYTES, stream, p);
#endif
}
```

```cpp
#include <hip/hip_runtime.h>
#include <cstdio>
#include <cstdint>
#include <cmath>

#ifndef MK_ONE_LAUNCH
#define MK_ONE_LAUNCH 1
#endif
#ifndef PROBE_MASK
#define PROBE_MASK 0u
#endif

#define DEV __device__ __forceinline__
#define LAS __attribute__((address_space(3)))
typedef unsigned short bf16_t;
typedef short bf16x8 __attribute__((ext_vector_type(8)));
typedef float f32x4 __attribute__((ext_vector_type(4)));
typedef unsigned u32x4 __attribute__((ext_vector_type(4)));
typedef unsigned u32x2 __attribute__((ext_vector_type(2)));

constexpr int NBATCH = 4, SEQ = 4096, DM = 1024, NTOK = NBATCH * SEQ, NLAYER = 4;
constexpr int DIN = 6572, NSMALL = 2476, PSW = 2560, NPROJ = 6656, NGATE = 4096;
constexpr int I_QA = 0, I_KC = 256, I_VC = 320, I_KS = 384, I_VS = 448, I_KW = 512, I_VW = 576, I_GL = 640, I_QB = 652, I_KB = 908, I_VB = 1036,
              I_QC = 1164, I_KCC = 1420, I_VCC = 1676, I_CQ = 1932, I_CKV = 2316, I_KR = 2444;
constexpr int ACTW = 2560;
constexpr int A_QA = 0, A_KCR = 256, A_VCR = 320, A_KS = 384, A_VS = 448, A_KW = 512, A_VW = 576, A_QB = 640, A_KB = 896, A_VB = 1024,
              A_QC = 1152, A_KC = 1408, A_VC = 1664, A_CQ = 1920, A_CKV = 2304, A_KR = 2432;
constexpr int ACT2W = 896, A2_QF = 0, A2_KN = 384, A2_VD = 640;
constexpr int NCMP = 255, NEXP = 32, XS_ROWS = 40960;
constexpr float EPS = 1e-6f;
__device__ const float SLOPES[3][4] = {{0.70710678118654752f, 0.25f, 0.08838834764831845f, 0.015625f},
                                       {0.5f, 0.17677669529663689f, 0.0625f, 0.0078125f},
                                       {0.35355339059327379f, 0.125f, 0.03125f, 0.00390625f}};

constexpr size_t MiB = 1u << 20;
constexpr size_t WS_CTL = 0;
constexpr size_t WS_MOD = 1 * MiB;
constexpr size_t WS_ROPE = 2 * MiB;
constexpr size_t WS_MISC = 3 * MiB;
constexpr size_t WS_WIN = 8 * MiB;
constexpr size_t WS_W13 = WS_WIN + 56 * MiB;
constexpr size_t WS_W2 = WS_W13 + 128 * MiB;
constexpr size_t WS_WOUT = WS_W2 + 64 * MiB;
constexpr size_t WS_WBR = WS_WOUT + 8 * MiB;
constexpr size_t WS_CW1 = WS_WBR + 8 * MiB;
constexpr size_t WS_WU = WS_CW1 + 8 * MiB;
constexpr size_t WS_HBF = WS_WU + 4 * MiB;
constexpr size_t WS_BIG = WS_HBF + 32 * MiB;
constexpr size_t WS_GATES = WS_BIG + 160 * MiB;
constexpr size_t WS_ACT = WS_GATES + 128 * MiB;
constexpr size_t WS_ACT2 = WS_ACT + 80 * MiB;
constexpr size_t WS_MUR = WS_ACT2 + 28 * MiB;
constexpr size_t WS_CMPA = WS_MUR + 64 * MiB;
constexpr size_t WS_HID = WS_CMPA + 8 * MiB;
constexpr size_t WS_PB = WS_HID + 1 * MiB;
constexpr size_t WS_OCMP = WS_PB + 16 * MiB;
constexpr size_t WS_OWIN = WS_OCMP + 16 * MiB;
constexpr size_t WS_SMALL = WS_OWIN + 16 * MiB;
constexpr size_t WS_BR = WS_SMALL + 2 * MiB;
constexpr size_t WS_END = WS_BR + 32 * MiB;
static_assert(WS_END <= 1000 * MiB, "workspace map");
constexpr size_t BIG_PSM = 0, BIG_MIX = 0, BIG_MIXB = 64 * MiB, BIG_XS = 0, BIG_YP = 80 * MiB;
constexpr size_t MISC_HIST = 3 * MiB;
constexpr size_t MISC_KCB = 1024 * 1024, MISC_VCB = 1024 * 1024 + 128 * 1024, MISC_WRT = 2 * MiB;
constexpr size_t MISC_KCMP = 0, MISC_VCMP = 256 * 1024, MISC_KMEAN = 512 * 1024, MISC_EID = 640 * 1024, MISC_WTS = 768 * 1024, MISC_PSLOT = 896 * 1024;
constexpr size_t SM_PL = 0, SM_SEL = 256 * 1024, SM_GA = 512 * 1024;
constexpr int CW_BAR = 4096;
constexpr int CW_CNT = 16384;
constexpr int CW_CUR = 16384 + 256;

constexpr int RING_BYTES = 131072, LDS_AUX = RING_BYTES, LDS_BYTES = 147456;

struct Params { const float* in[24]; float* out; unsigned char* ws; };

DEV float bf2f(unsigned v) { return __uint_as_float(v << 16); }
DEV float bflo(unsigned w) { return __uint_as_float(w << 16); }
DEV float bfhi(unsigned w) { return __uint_as_float(w & 0xffff0000u); }
DEV unsigned f2bf(float f) { unsigned u = __float_as_uint(f); return (u + 0x7fffu + ((u >> 16) & 1u)) >> 16; }
DEV unsigned pk2(float lo, float hi) { return f2bf(lo) | (f2bf(hi) << 16); }
template <int M> DEV float swz_xor(float v) { return __int_as_float(__builtin_amdgcn_ds_swizzle(__float_as_int(v), (M << 10) | 0x1f)); }
template <int M> DEV int swz_xor_i(int v) { return __builtin_amdgcn_ds_swizzle(v, (M << 10) | 0x1f); }
DEV float xhalf(float v, float& other) { auto rr = __builtin_amdgcn_permlane32_swap(__float_as_uint(v), __float_as_uint(v), false, false); other = __uint_as_float(rr[1]); return __uint_as_float(rr[0]); }
DEV float wave_sum(float v) {
    v += swz_xor<1>(v); v += swz_xor<2>(v); v += swz_xor<4>(v); v += swz_xor<8>(v); v += swz_xor<16>(v);
    float hi; const float lo = xhalf(v, hi); return lo + hi;
}
DEV float sigm(float x) { return 1.f / (1.f + __expf(-x)); }
DEV float silu_(float x) { return x / (1.f + __expf(-x)); }
#define LDS_WAIT() asm volatile("s_waitcnt lgkmcnt(0)" ::: "memory")

namespace pg8 {
constexpr int BM = 256, BK = 64, HALF = 128, HTB = HALF * BK * 2, STAGE_BYTES = 8 * HTB, NXCD = 8, WGM = 8;
__host__ __device__ __forceinline__ int lds_byte(int r, int c) { const int st = (r >> 4) * 2 + (c >> 5), rr = r & 15, cc = c & 31, ob = rr * 64 + cc * 2; return st * 1024 + (ob ^ (((ob >> 9) & 1) << 5)); }
__host__ __device__ __forceinline__ void stage_rc(int b, int& R, int& C) { const int st = b / 1024, sb = b % 1024, swz = sb ^ (((sb >> 9) & 1) << 5); R = (st >> 1) * 16 + swz / 64; C = (st & 1) * 32 + (swz % 64) / 2; }
__host__ __device__ __forceinline__ int perm32(int rho) { const int n = rho >> 4, i = rho & 15; return 8 * (i >> 2) + 4 * n + (i & 3); }
struct Unit { int pm, pn, ao; };
struct Gemm { const bf16_t* A; const bf16_t* Bt; int lda, K; };
struct StaticOrder {
    int nM, nN, nwg, G, c;
    __device__ void init(int M, int N, int G_, int c_) { nM = M / BM; nN = N / BM; nwg = nM * nN; G = G_; c = c_; }
    __device__ bool next(int i, Unit& u) const {
        const long L = (long)i * G + c; if (L >= nwg) return false;
        int wgid = (int)L; { const int q = nwg / NXCD, r = nwg % NXCD, xcd = wgid % NXCD, off = wgid / NXCD; wgid = (xcd < r ? xcd * (q + 1) : r * (q + 1) + (xcd - r) * q) + off; }
        const int nig = WGM * nN, gid = wgid / nig, fm = gid * WGM, gsz = (nM - fm) < WGM ? (nM - fm) : WGM;
        u.pm = fm + ((wgid % nig) % gsz); u.pn = (wgid % nig) / gsz; u.ao = 0; return true;
    }
};
template <class F> struct Epi8 {
    F f;
    __device__ __forceinline__ void operator()(const f32x4 (&acc)[2][2][4][2], const Unit& u, int wr, int wc, int fr, int fq) const {
        const int row0 = u.pm * BM + wr * 64 + fr, col0 = u.pn * BM + wc * 32 + 8 * fq;
#pragma unroll
        for (int ai = 0; ai < 2; ++ai)
#pragma unroll
            for (int m = 0; m < 4; ++m)
#pragma unroll
                for (int bj = 0; bj < 2; ++bj) f(row0 + ai * HALF + m * 16, col0 + bj * HALF, acc[ai][bj][m][0], acc[ai][bj][m][1]);
    }
};
template <class Epi, class Sched, bool ALIGN_EPI>
__device__ __forceinline__ void gemm_phase(LAS unsigned char* lds, const Gemm g, const Sched& S, const Epi& E) {
    int tid_ = threadIdx.x; asm volatile("" : "+v"(tid_));
    const int tid = tid_, wid = __builtin_amdgcn_readfirstlane(tid >> 6), lane = tid & 63, wr = wid >> 2, wc = wid & 3, fr = lane & 15, fq = lane >> 4;
    const int K = g.K, nt = K / BK, lda = g.lda;
    unsigned voffA[2], voffB[2];
#pragma unroll
    for (int i = 0; i < 2; ++i) { int R, C; stage_rc(tid * 16 + i * 8192, R, C); const int Rb = (R & ~31) + perm32(R & 31);
        voffA[i] = (unsigned)(R * lda + C) * 2u; voffB[i] = (unsigned)(Rb * K + C) * 2u; }
    const size_t kstep = (size_t)(BK * 2);
    const size_t hstepA = (size_t)HALF * lda * 2, tstepA = 2 * hstepA;
    const size_t hstepB = (size_t)HALF * K * 2, tstepB = 2 * hstepB;
    const unsigned ldsw = (unsigned)wid * 1024u;
    const int aoff = lds_byte(wr * 64 + fr, fq * 8), boff = lds_byte(wc * 32 + fr, fq * 8);
#define PG8_SA(b, h) (((b) * 2 + (h)) * HTB)
#define PG8_SB(b, h) ((4 + (b) * 2 + (h)) * HTB)
#define PG8_STAGE(bufoff, gbase, voff) do { _Pragma("unroll") for (int _i = 0; _i < 2; ++_i) \
        __builtin_amdgcn_global_load_lds((const unsigned*)((const char*)(gbase) + (voff)[_i]), (LAS unsigned*)(lds + (bufoff) + ldsw + _i * 8192), 16, 0, 0); } while (0)
#define PG8_LDA(dst, b, h) do { _Pragma("unroll") for (int m = 0; m < 4; ++m) _Pragma("unroll") for (int k = 0; k < 2; ++k) dst[m][k] = *(const LAS bf16x8*)(lds + PG8_SA(b, h) + aoff + m * 2048 + k * 1024); } while (0)
#define PG8_LDB(dst, b, h) do { _Pragma("unroll") for (int n = 0; n < 2; ++n) _Pragma("unroll") for (int k = 0; k < 2; ++k) dst[n][k] = *(const LAS bf16x8*)(lds + PG8_SB(b, h) + boff + n * 2048 + k * 1024); } while (0)
#define PG8_MMA(ai, bj, At, Bt) do { __builtin_amdgcn_s_setprio(1); _Pragma("unroll") for (int m = 0; m < 4; ++m) _Pragma("unroll") for (int n = 0; n < 2; ++n) _Pragma("unroll") for (int k = 0; k < 2; ++k) \
        acc[ai][bj][m][n] = __builtin_amdgcn_mfma_f32_16x16x32_bf16(Bt[n][k], At[m][k], acc[ai][bj][m][n], 0, 0, 0); __builtin_amdgcn_s_setprio(0); } while (0)
#define PG8_WAIT_V(n) asm volatile("s_waitcnt vmcnt(" #n ")" ::: "memory")
#define PG8_WAIT_L(n) asm volatile("s_waitcnt lgkmcnt(" #n ")" ::: "memory")
#define PG8_BAR __builtin_amdgcn_s_barrier()
#define PG8_SCHED __builtin_amdgcn_sched_barrier(0)
    Unit cur, nxt; int ui = 0;
    if (!S.next(0, cur)) return;
    f32x4 acc[2][2][4][2];
#pragma unroll
    for (int a = 0; a < 2; ++a)
#pragma unroll
        for (int b = 0; b < 2; ++b)
#pragma unroll
            for (int m = 0; m < 4; ++m)
#pragma unroll
                for (int n = 0; n < 2; ++n) acc[a][b][m][n] = (f32x4){0.f, 0.f, 0.f, 0.f};
    bf16x8 At[4][2], B0[2][2], B1[2][2];
    const char* cA = (const char*)g.A + (size_t)cur.pm * tstepA + cur.ao; const char* cB = (const char*)g.Bt + (size_t)cur.pn * tstepB;
    PG8_STAGE(PG8_SB(0, 0), cB, voffB); PG8_STAGE(PG8_SB(0, 1), cB + hstepB, voffB); PG8_STAGE(PG8_SA(0, 0), cA, voffA); PG8_STAGE(PG8_SA(0, 1), cA + hstepA, voffA);
    if (wr == 1) PG8_BAR;
    PG8_WAIT_V(2); PG8_BAR;
    PG8_STAGE(PG8_SB(1, 0), cB + kstep, voffB); PG8_STAGE(PG8_SA(1, 0), cA + kstep, voffA); PG8_STAGE(PG8_SB(1, 1), cB + hstepB + kstep, voffB);
    PG8_WAIT_V(6); PG8_BAR;
    for (;;) {
        const bool has_next = S.next(ui + 1, nxt);
        const char* nA = has_next ? (const char*)g.A + (size_t)nxt.pm * tstepA + nxt.ao : cA; const char* nB = has_next ? (const char*)g.Bt + (size_t)nxt.pn * tstepB : cB;
        for (int t = 0; t < nt; t += 2) {
            const bool last = (t == nt - 2);
            const char* a1 = cA + (size_t)(t + 1) * kstep;
            const char* a2 = last ? nA : cA + (size_t)(t + 2) * kstep; const char* b2 = last ? nB : cB + (size_t)(t + 2) * kstep;
            const char* a3 = a2 + kstep; const char* b3 = b2 + kstep;
            PG8_LDB(B0, 0, 0); PG8_LDB(B1, 0, 1); PG8_SCHED; PG8_LDA(At, 0, 0); PG8_STAGE(PG8_SA(1, 1), a1 + hstepA, voffA);
            PG8_WAIT_V(8); PG8_WAIT_L(0); PG8_BAR; PG8_MMA(0, 0, At, B0); PG8_MMA(0, 1, At, B1); PG8_BAR; PG8_SCHED;
            PG8_LDA(At, 0, 1); PG8_STAGE(PG8_SB(0, 0), b2, voffB); PG8_STAGE(PG8_SB(0, 1), b2 + hstepB, voffB); PG8_STAGE(PG8_SA(0, 0), a2, voffA);
            PG8_WAIT_V(8); PG8_WAIT_L(0); PG8_BAR; PG8_MMA(1, 0, At, B0); PG8_MMA(1, 1, At, B1); PG8_BAR; PG8_SCHED;
            PG8_LDB(B0, 1, 0); PG8_LDB(B1, 1, 1); PG8_SCHED; PG8_LDA(At, 1, 0); PG8_STAGE(PG8_SA(0, 1), a2 + hstepA, voffA);
            PG8_WAIT_V(8); PG8_WAIT_L(0); PG8_BAR; PG8_MMA(0, 0, At, B0); PG8_MMA(0, 1, At, B1); PG8_BAR; PG8_SCHED;
            PG8_LDA(At, 1, 1); PG8_STAGE(PG8_SB(1, 0), b3, voffB); PG8_STAGE(PG8_SB(1, 1), b3 + hstepB, voffB); PG8_STAGE(PG8_SA(1, 0), a3, voffA);
            PG8_WAIT_V(8); PG8_WAIT_L(0); PG8_BAR; PG8_MMA(1, 0, At, B0); PG8_MMA(1, 1, At, B1); PG8_BAR; PG8_SCHED;
        }
        if constexpr (ALIGN_EPI) { if (wr == 0) PG8_BAR; }
        E(acc, cur, wr, wc, fr, fq);
        if (!has_next) break;
#pragma unroll
        for (int a = 0; a < 2; ++a)
#pragma unroll
            for (int b = 0; b < 2; ++b)
#pragma unroll
                for (int m = 0; m < 4; ++m)
#pragma unroll
                    for (int n = 0; n < 2; ++n) acc[a][b][m][n] = (f32x4){0.f, 0.f, 0.f, 0.f};
        cur = nxt; cA = nA; cB = nB; ++ui;
        if constexpr (ALIGN_EPI) { if (wr == 1) PG8_BAR; }
    }
    PG8_WAIT_V(0);
    if constexpr (!ALIGN_EPI) { if (wr == 0) PG8_BAR; }
    PG8_BAR;
#undef PG8_SA
#undef PG8_SB
#undef PG8_STAGE
#undef PG8_LDA
#undef PG8_LDB
#undef PG8_MMA
#undef PG8_WAIT_V
#undef PG8_WAIT_L
#undef PG8_BAR
#undef PG8_SCHED
}
}

#define XB_TMO      128
#define XB_XCNT(j)  (256  + 64 * (j))
#define XB_XSUB(j)  (1280 + 64 * (j))
#define XB_XGEN(j)  (2304 + 64 * (j))
#define XB_TOP      3328
#define XB_TOPGEN   3392
#define XCD_BAR_WORDS 3456
#define XB_SPIN_CAP (1u << 22)
__device__ __forceinline__ unsigned xb_ld(unsigned* p)              { return __hip_atomic_load(p, __ATOMIC_RELAXED, __HIP_MEMORY_SCOPE_AGENT); }
__device__ __forceinline__ unsigned xb_add(unsigned* p, unsigned v) { return __hip_atomic_fetch_add(p, v, __ATOMIC_RELAXED, __HIP_MEMORY_SCOPE_AGENT); }
__device__ __forceinline__ unsigned xb_xcc_id() { return (unsigned)__builtin_amdgcn_s_getreg((3 << 11) | 20) & 0xFu; }
#define XB_SPIN(cond, bar) do { unsigned _sp = 0; while (cond) { __builtin_amdgcn_s_sleep(1); \
    if ((++_sp & 255u) == 0u) { if (xb_ld(&(bar)[XB_TMO])) break; if (_sp > XB_SPIN_CAP) { atomicAdd(&(bar)[XB_TMO], 1u); break; } } } } while (0)
struct XcdBarrier { unsigned* bar; unsigned x; volatile LAS unsigned* st; };
__device__ __forceinline__ XcdBarrier xcd_barrier_post(unsigned* bar, volatile LAS unsigned* st) {
    XcdBarrier b; b.bar = bar; b.x = xb_xcc_id(); b.st = st;
    if (threadIdx.x == 0) (void)xb_add(&bar[XB_XCNT(b.x)], 1u);
    return b;
}
__device__ __forceinline__ void xcd_barrier_complete(unsigned* bar, unsigned x, unsigned& nloc, unsigned& nx) {
    const unsigned G = gridDim.x * gridDim.y * gridDim.z;
    unsigned sum, cnt, mine, sp = 0u;
    for (;;) {
        sum = 0u; cnt = 0u; mine = 0u;
#pragma unroll
        for (unsigned j = 0; j < 16; ++j) { const unsigned c = xb_ld(&bar[XB_XCNT(j)]); sum += c; cnt += (c > 0u) ? 1u : 0u; mine = (j == x) ? c : mine; }
        if (sum == G) break;
        __builtin_amdgcn_s_sleep(1);
        if ((++sp & 255u) == 0u) { if (xb_ld(&bar[XB_TMO])) break; if (sp > XB_SPIN_CAP) { atomicAdd(&bar[XB_TMO], 1u); break; } }
    }
    nloc = mine > 0u ? mine : 1u; nx = cnt > 0u ? cnt : 1u;
}
__device__ __noinline__ void xcd_barrier_fn(unsigned* bar_, unsigned x_, volatile LAS unsigned* st_) {
    XcdBarrier b; b.bar = bar_; b.x = x_; b.st = st_;
    asm volatile("s_waitcnt vmcnt(0)" ::: "memory");
    __syncthreads();
    if (threadIdx.x == 0) {
        unsigned* bar = b.bar;
        __builtin_amdgcn_s_waitcnt(0);
        unsigned nloc = b.st[0], nx = b.st[1];
        if (nloc == 0u) { xcd_barrier_complete(bar, b.x, nloc, nx); b.st[0] = nloc; b.st[1] = nx; }
        const unsigned old = xb_add(&bar[XB_XSUB(b.x)], 1u);
        const unsigned gen = old / nloc;
        if (old + 1u == (gen + 1u) * nloc) {
            __builtin_amdgcn_fence(__ATOMIC_RELEASE, "agent");
            asm volatile("s_waitcnt vmcnt(0)" ::: "memory");
            const unsigned og = xb_add(&bar[XB_TOP], 1u);
            const unsigned tg = og / nx;
            if (og + 1u == (tg + 1u) * nx) xb_add(&bar[XB_TOPGEN], 1u);
            else XB_SPIN(xb_ld(&bar[XB_TOPGEN]) == tg, bar);
            __builtin_amdgcn_fence(__ATOMIC_ACQUIRE, "agent");
            xb_add(&bar[XB_XGEN(b.x)], 1u);
            asm volatile("s_waitcnt vmcnt(0)" ::: "memory");
        } else {
            XB_SPIN(xb_ld(&bar[XB_XGEN(b.x)]) == gen, bar);
            __builtin_amdgcn_fence(__ATOMIC_ACQUIRE, "agent");
            asm volatile("s_waitcnt vmcnt(0)" ::: "memory");
        }
    }
    __syncthreads();
}

struct Ctx {
    int tid, lane, wave, gw, NGW, bid, G;
    LAS unsigned char* lds;
};
DEV Ctx make_ctx(LAS unsigned char* lds) {
    Ctx c; int tid_ = threadIdx.x; asm volatile("" : "+v"(tid_));
    c.tid = tid_; c.lane = c.tid & 63; c.wave = __builtin_amdgcn_readfirstlane(c.tid >> 6); { int b_ = blockIdx.x, g_ = gridDim.x; asm volatile("" : "+s"(b_), "+s"(g_)); c.bid = b_; c.G = g_; }
    c.gw = c.bid * 8 + c.wave; c.NGW = c.G * 8; c.lds = lds; return c;
}
#define WSP(T, off) ((T*)(p.ws + (off)))

DEV void transpose_item(const float* W, const float* W2, int ldw, int K, bf16_t* WT, int nblk, int mode, int nvalid, int item, LAS float* scr, int lane) {
    const int kb = item / nblk, nb = item % nblk, k0 = 64 * kb, n0 = 32 * nb;
    const int n = n0 + (lane & 31);
    const float* src = W; int c = -1; int ld = ldw; int kofs = 0;
    if (mode == 0) { c = n < nvalid ? n : -1; }
    else if (mode == 1) { c = n < NSMALL ? n : (n < PSW ? -1 : n - (PSW - NSMALL)); }
    else if (mode == 2) { c = (n & 1) ? 256 + (n >> 1) : (n >> 1); }
    else { if (n < 384 && k0 < 384) { c = n; ld = 384; } else if (n >= 512 && k0 >= 384) { src = W2; c = n - 512; ld = 512; kofs = 384; } }
#pragma unroll
    for (int i = 0; i < 32; ++i) { const int kk = 2 * i + (lane >> 5); scr[kk * 33 + (lane & 31)] = (c >= 0) ? src[(size_t)(k0 - kofs + kk) * ld + c] : 0.f; }
    LDS_WAIT(); asm volatile("" ::: "memory");
    const int c8 = lane & 7;
#pragma unroll
    for (int j = 0; j < 4; ++j) { const int nn = (lane >> 3) + 8 * j; const LAS float* s = scr + (8 * c8) * 33 + nn;
        u32x4 o; o.x = pk2(s[0 * 33], s[1 * 33]); o.y = pk2(s[2 * 33], s[3 * 33]); o.z = pk2(s[4 * 33], s[5 * 33]); o.w = pk2(s[6 * 33], s[7 * 33]);
        *(u32x4*)(WT + (size_t)(n0 + nn) * K + k0 + 8 * c8) = o; }
    LDS_WAIT(); asm volatile("" ::: "memory");
}
constexpr int IT_WIN = 16 * 208, IT_W13 = 256 * 32, IT_W2 = 128 * 32, IT_CW1 = 256 * 2, IT_WBR = 128 * 4, IT_WOUT = 512, IT_WU = 8 * 32;
constexpr int IT_LAYER = IT_WIN + IT_W13 + IT_W2 + IT_CW1 + IT_WBR + IT_WOUT + IT_WU;
DEV void phase_prologue(const Params& p, const Ctx& c) {
    { float* MOD = WSP(float, WS_MOD);
      LAS float* sc = (LAS float*)(c.lds + 73728);
      LAS float* ps = (LAS float*)(c.lds + 90112);
      for (int i = c.tid; i < 4096; i += 512) sc[i] = silu_(p.in[1][i]);
      __syncthreads();
      for (int it = c.bid; it < NLAYER * 96; it += c.G) { const int l = it / 96, j = (it % 96) * 64 + c.lane;
          const float* wa = p.in[2] + ((size_t)l * 1024 + c.wave * 128) * 6144 + j; const LAS float* s0 = sc + c.wave * 128;
          float a0 = 0.f, a1 = 0.f, a2 = 0.f, a3 = 0.f;
#pragma unroll 16
          for (int k = 0; k < 128; ++k) { const float w = wa[(size_t)k * 6144]; a0 += s0[k] * w; a1 += s0[1024 + k] * w; a2 += s0[2048 + k] * w; a3 += s0[3072 + k] * w; }
          ps[(c.wave * 4 + 0) * 64 + c.lane] = a0; ps[(c.wave * 4 + 1) * 64 + c.lane] = a1; ps[(c.wave * 4 + 2) * 64 + c.lane] = a2; ps[(c.wave * 4 + 3) * 64 + c.lane] = a3;
          __syncthreads();
          if (c.tid < 256) { const int bb = c.tid >> 6, jj = (it % 96) * 64 + (c.tid & 63); float a = p.in[3][l * 6144 + jj];
#pragma unroll
              for (int w8 = 0; w8 < 8; ++w8) a += ps[(w8 * 4 + bb) * 64 + (c.tid & 63)];
              MOD[(l * 4 + bb) * 6144 + jj] = a; }
          __syncthreads(); } }
    { float* RC = WSP(float, WS_ROPE); float* RS = RC + 4096 * 16;
      for (int i = c.bid * 512 + c.tid; i < 4096 * 16; i += c.G * 512) { const int pos = i >> 4, k = i & 15;
          const float inv = (float)pow(10000.0, -(double)k / 16.0); const float ang = (float)pos * inv;
          RC[i] = (float)cos((double)ang); RS[i] = (float)sin((double)ang); } }
    { float* WRT = WSP(float, WS_MISC + MISC_WRT);
      for (int i = c.bid * 512 + c.tid; i < NLAYER * 36 * 1024; i += c.G * 512) { const int k = i & 1023, e = (i >> 10) % 36, l = i / (36 * 1024);
          WRT[i] = e < 4 ? p.in[18][((size_t)l * 1024 + k) * 4 + e] : p.in[20][((size_t)l * 1024 + k) * 32 + (e - 4)]; } }
    LAS float* scr = (LAS float*)(c.lds + c.wave * 8448);
    for (int it = c.gw; it < IT_LAYER * NLAYER; it += c.NGW) {
        const int l = it / IT_LAYER; int r = it % IT_LAYER;
        if (r < IT_WIN) { transpose_item(p.in[5] + (size_t)l * 1024 * DIN, nullptr, DIN, 1024, WSP(bf16_t, WS_WIN) + (size_t)l * NPROJ * 1024, NPROJ / 32, 1, 0, r, scr, c.lane); continue; } r -= IT_WIN;
        if (r < IT_W13) { const int e = r / 256; transpose_item(p.in[22] + (size_t)(l * 32 + e) * 1024 * 512, nullptr, 512, 1024, WSP(bf16_t, WS_W13) + (size_t)(l * 32 + e) * 512 * 1024, 16, 2, 0, r % 256, scr, c.lane); continue; } r -= IT_W13;
        if (r < IT_W2) { const int e = r / 128; transpose_item(p.in[23] + (size_t)(l * 32 + e) * 256 * 1024, nullptr, 1024, 256, WSP(bf16_t, WS_W2) + (size_t)(l * 32 + e) * 1024 * 256, 32, 0, 1024, r % 128, scr, c.lane); continue; } r -= IT_W2;
        if (r < IT_CW1) { const int blk = r / 64, kv = blk >> 2, ks = blk & 3; transpose_item(p.in[8] + ((size_t)(l * 2 + kv) * 2048 + ks * 512) * 256, nullptr, 256, 512, WSP(bf16_t, WS_CW1) + (size_t)(l * 8 + blk) * 256 * 512, 8, 0, 256, r % 64, scr, c.lane); continue; } r -= IT_CW1;
        if (r < IT_WBR) { const int n = r / 128; transpose_item(p.in[16] + (size_t)(l * 4 + n) * 256 * 1024, nullptr, 1024, 256, WSP(bf16_t, WS_WBR) + (size_t)(l * 4 + n) * 1024 * 256, 32, 0, 1024, r % 128, scr, c.lane); continue; } r -= IT_WBR;
        if (r < IT_WOUT) { transpose_item(p.in[17] + (size_t)l * 1024 * 1024, nullptr, 1024, 1024, WSP(bf16_t, WS_WOUT) + (size_t)l * 1024 * 1024, 32, 0, 1024, r, scr, c.lane); continue; } r -= IT_WOUT;
        transpose_item(p.in[14] + (size_t)l * 384 * 384, p.in[15] + (size_t)l * 128 * 512, 0, 512, WSP(bf16_t, WS_WU) + (size_t)l * 1024 * 512, 32, 3, 0, r, scr, c.lane);
    }
}

template <bool NORM, bool WRITEX> DEV void phase_norm1(const Params& p, const Ctx& c, int l) {
    const float* MOD = WSP(float, WS_MOD);
    const bf16_t* YP = (const bf16_t*)(p.ws + WS_BIG + BIG_YP);
    const int* PSLOT = WSP(int, WS_MISC + MISC_PSLOT); const float* WTS = WSP(float, WS_MISC + MISC_WTS);
    bf16_t* HBF = WSP(bf16_t, WS_HBF);
    for (int row = c.gw; row < NTOK; row += c.NGW) {
        const int b = row / SEQ;
        f32x4 v[4];
        if (l == 0 || !WRITEX) {
            const float* xs = l == 0 ? p.in[0] : p.out;
#pragma unroll
            for (int j = 0; j < 4; ++j) v[j] = *(const f32x4*)(xs + (size_t)row * DM + j * 256 + c.lane * 4);
        } else {
            const float* g2 = MOD + ((l - 1) * 4 + b) * 6144 + 5120;
            const int s0 = PSLOT[row * 2], s1 = PSLOT[row * 2 + 1]; const float w0 = WTS[row * 2], w1 = WTS[row * 2 + 1];
#pragma unroll
            for (int j = 0; j < 4; ++j) { const int col = j * 256 + c.lane * 4;
                const f32x4 x = *(const f32x4*)(p.out + (size_t)row * DM + col); const f32x4 g = *(const f32x4*)(g2 + col);
                const u32x2 y0 = *(const u32x2*)(YP + (size_t)s0 * DM + col), y1 = *(const u32x2*)(YP + (size_t)s1 * DM + col);
                f32x4 y; y[0] = w0 * bflo(y0.x) + w1 * bflo(y1.x); y[1] = w0 * bfhi(y0.x) + w1 * bfhi(y1.x); y[2] = w0 * bflo(y0.y) + w1 * bflo(y1.y); y[3] = w0 * bfhi(y0.y) + w1 * bfhi(y1.y);
                v[j] = x + g * y; }
        }
        if (WRITEX) {
#pragma unroll
            for (int j = 0; j < 4; ++j) *(f32x4*)(p.out + (size_t)row * DM + j * 256 + c.lane * 4) = v[j]; }
        if (NORM) {
            float ss = 0.f;
#pragma unroll
            for (int j = 0; j < 4; ++j) ss += (v[j][0] * v[j][0] + v[j][1] * v[j][1]) + (v[j][2] * v[j][2] + v[j][3] * v[j][3]);
            const float r = rsqrtf(wave_sum(ss) * (1.f / DM) + EPS);
            const float* gn = p.in[4] + (size_t)(l * 2 + 0) * DM; const float* sh = MOD + (l * 4 + b) * 6144; const float* sc = sh + 1024;
#pragma unroll
            for (int j = 0; j < 4; ++j) { const int col = j * 256 + c.lane * 4;
                const f32x4 g = *(const f32x4*)(gn + col), s1 = *(const f32x4*)(sc + col), s0 = *(const f32x4*)(sh + col);
                const f32x4 h = v[j] * r * g * (s1 + 1.f) + s0;
                u32x2 o; o.x = pk2(h[0], h[1]); o.y = pk2(h[2], h[3]); *(u32x2*)(HBF + (size_t)row * DM + col) = o; }
        }
    }
}

struct FInproj { float* PSM; bf16_t* GATES;
    DEV void operator()(int row, int col, const f32x4& v0, const f32x4& v1) const {
        if (col < PSW) { float* o = PSM + (size_t)row * PSW + col; *(f32x4*)o = v0; *(f32x4*)(o + 4) = v1; }
        else { u32x4 w; w.x = pk2(sigm(v0[0]), sigm(v0[1])); w.y = pk2(sigm(v0[2]), sigm(v0[3])); w.z = pk2(sigm(v1[0]), sigm(v1[1])); w.w = pk2(sigm(v1[2]), sigm(v1[3]));
               *(u32x4*)(GATES + (size_t)row * NGATE + (col - PSW)) = w; } } };
DEV void phase_inproj(const Params& p, const Ctx& c, int l) {
    pg8::Gemm g{WSP(bf16_t, WS_HBF), WSP(bf16_t, WS_WIN) + (size_t)l * NPROJ * 1024, 1024, 1024};
    pg8::StaticOrder S; S.init(NTOK, NPROJ, c.G, c.bid);
    pg8::Epi8<FInproj> E{{(float*)(p.ws + WS_BIG + BIG_PSM), WSP(bf16_t, WS_GATES)}};
    pg8::gemm_phase<pg8::Epi8<FInproj>, pg8::StaticOrder, true>(c.lds, g, S, E);
}

DEV float head_norm(float v, const float* gain, int lane) { const float ss = wave_sum(v * v); return v * rsqrtf(ss * (1.f / 64.f) + EPS) * gain[lane]; }
DEV void phase_post(const Params& p, const Ctx& c, int l) {
    const float* PSM = (const float*)(p.ws + WS_BIG + BIG_PSM); bf16_t* ACT = WSP(bf16_t, WS_ACT);
    float* GA = WSP(float, WS_SMALL + SM_GA);
    const float* gq = p.in[6] + (size_t)l * 10 * 64;
    const float* RC = WSP(float, WS_ROPE); const float* RS = RC + 4096 * 16;
    const int lane = c.lane;
    for (int row = c.gw; row < NTOK; row += c.NGW) {
        const float* P = PSM + (size_t)row * PSW; bf16_t* A = ACT + (size_t)row * ACTW; const int t = row % SEQ;
#pragma unroll
        for (int h = 0; h < 4; ++h) A[A_QA + h * 64 + lane] = (bf16_t)f2bf(head_norm(P[I_QA + h * 64 + lane], gq + 0 * 64, lane));
        A[A_KCR + lane] = (bf16_t)f2bf(P[I_KC + lane]); A[A_VCR + lane] = (bf16_t)f2bf(P[I_VC + lane]);
        A[A_KS + lane] = (bf16_t)f2bf(head_norm(P[I_KS + lane], gq + 2 * 64, lane)); A[A_VS + lane] = (bf16_t)f2bf(P[I_VS + lane]);
        A[A_KW + lane] = (bf16_t)f2bf(head_norm(P[I_KW + lane], gq + 3 * 64, lane)); A[A_VW + lane] = (bf16_t)f2bf(P[I_VW + lane]);
        if (lane < 12) GA[row * 12 + lane] = sigm(P[I_GL + lane]);
#pragma unroll
        for (int h = 0; h < 4; ++h) A[A_QB + h * 64 + lane] = (bf16_t)f2bf(head_norm(P[I_QB + h * 64 + lane], gq + 4 * 64, lane));
#pragma unroll
        for (int h = 0; h < 2; ++h) { A[A_KB + h * 64 + lane] = (bf16_t)f2bf(head_norm(P[I_KB + h * 64 + lane], gq + 5 * 64, lane)); A[A_VB + h * 64 + lane] = (bf16_t)f2bf(P[I_VB + h * 64 + lane]); }
#pragma unroll
        for (int h = 0; h < 4; ++h) { A[A_QC + h * 64 + lane] = (bf16_t)f2bf(head_norm(P[I_QC + h * 64 + lane], gq + 6 * 64, lane));
            A[A_KC + h * 64 + lane] = (bf16_t)f2bf(head_norm(P[I_KCC + h * 64 + lane], gq + 7 * 64, lane)); A[A_VC + h * 64 + lane] = (bf16_t)f2bf(P[I_VCC + h * 64 + lane]); }
        { float x[6]; float ss = 0.f;
#pragma unroll
          for (int j = 0; j < 6; ++j) { x[j] = P[I_CQ + j * 64 + lane]; ss += x[j] * x[j]; }
          const float r = rsqrtf(wave_sum(ss) * (1.f / 384.f) + EPS); const float* g = p.in[11] + l * 384;
#pragma unroll
          for (int j = 0; j < 6; ++j) A[A_CQ + j * 64 + lane] = (bf16_t)f2bf(x[j] * r * g[j * 64 + lane]); }
        { float x0 = P[I_CKV + lane], x1 = P[I_CKV + 64 + lane]; const float r = rsqrtf(wave_sum(x0 * x0 + x1 * x1) * (1.f / 128.f) + EPS); const float* g = p.in[12] + l * 128;
          A[A_CKV + lane] = (bf16_t)f2bf(x0 * r * g[lane]); A[A_CKV + 64 + lane] = (bf16_t)f2bf(x1 * r * g[64 + lane]); }
        { const float x = lane < 32 ? P[I_KR + lane] : 0.f; const float r = rsqrtf(wave_sum(x * x) * (1.f / 32.f) + EPS);
          const float y = x * r * p.in[13][(l * 2 + 1) * 32 + (lane & 31)];
          const float yo = swz_xor<16>(y); const int k = lane & 15; const float cs = RC[t * 16 + k], sn = RS[t * 16 + k];
          const float o = (lane & 16) ? (yo * sn + y * cs) : (y * cs - yo * sn);
          if (lane < 32) A[A_KR + lane] = (bf16_t)f2bf(o); }
    }
}

struct FStoreF32 { float* O; int ld;
    DEV void operator()(int row, int col, const f32x4& v0, const f32x4& v1) const { float* o = O + (size_t)row * ld + col; *(f32x4*)o = v0; *(f32x4*)(o + 4) = v1; } };
DEV void phase_mlaup(const Params& p, const Ctx& c, int l) {
    { pg8::Gemm g{WSP(bf16_t, WS_ACT) + A_CQ, WSP(bf16_t, WS_WU) + (size_t)l * 1024 * 512, ACTW, 512};
      pg8::StaticOrder S; S.init(NTOK, 1024, c.G, c.bid);
      pg8::Epi8<FStoreF32> E{{WSP(float, WS_MUR), 1024}};
      pg8::gemm_phase<pg8::Epi8<FStoreF32>, pg8::StaticOrder, true>(c.lds, g, S, E); }
    { const bf16_t* ACT = WSP(bf16_t, WS_ACT); bf16_t* CMPA = WSP(bf16_t, WS_CMPA); const float* pe = p.in[7] + (size_t)l * 2 * 32 * 64;
      for (int idx = c.bid * 512 + c.tid; idx < 2 * 1024 * 256; idx += c.G * 512) {
          const int c8 = idx & 255, r = (idx >> 8) & 1023, kv = idx >> 18; const int j = c8 >> 3, d = (c8 & 7) * 8;
          u32x4 o = (u32x4){0u, 0u, 0u, 0u};
          if (r < 1020) { const int b = r / 255, i = r % 255; const size_t tok = (size_t)b * SEQ + 16 * i + j;
              const u32x4 s = *(const u32x4*)(ACT + tok * ACTW + (kv ? A_VCR : A_KCR) + d); const float* pp = pe + (kv * 32 + j) * 64 + d;
              o.x = pk2(bflo(s.x) + pp[0], bfhi(s.x) + pp[1]); o.y = pk2(bflo(s.y) + pp[2], bfhi(s.y) + pp[3]); o.z = pk2(bflo(s.z) + pp[4], bfhi(s.z) + pp[5]); o.w = pk2(bflo(s.w) + pp[6], bfhi(s.w) + pp[7]); }
          *(u32x4*)(CMPA + ((size_t)kv * 1024 + r) * 2048 + c8 * 8) = o; } }
    { const bf16_t* ACT = WSP(bf16_t, WS_ACT); float* KM = WSP(float, WS_MISC + MISC_KMEAN);
      for (int idx = c.bid * 512 + c.tid; idx < 4 * 16 * 256; idx += c.G * 512) { const int hd = idx & 255, n = (idx >> 8) & 15, b = idx >> 12;
          const bf16_t* src = ACT + ((size_t)b * SEQ + n * 256) * ACTW + A_KC + hd; float s = 0.f;
          for (int i = 0; i < 256; ++i) s += bf2f(src[(size_t)i * ACTW]);
          KM[idx] = s * (1.f / 256.f); } }
}

struct CmpOrder { int G, c; DEV bool next(int i, pg8::Unit& u) const { const int L = i * G + c; if (L >= 32) return false; const int ks = L & 3, pm = L >> 2; u.pm = pm; u.pn = (pm >> 2) * 4 + ks; u.ao = ks * 1024; return true; } };
struct FCmpPart { float* HIDP;
    DEV void operator()(int row, int vcol, const f32x4& v0, const f32x4& v1) const { const int cc = vcol & 255, ks = (vcol >> 8) & 3;
        float* o = HIDP + ((size_t)ks * 2048 + row) * 256 + cc; *(f32x4*)o = v0; *(f32x4*)(o + 4) = v1; } };
DEV void phase_post2(const Params& p, const Ctx& c, int l) {
    {
      pg8::Gemm g{WSP(bf16_t, WS_CMPA), WSP(bf16_t, WS_CW1) + (size_t)l * 2 * 256 * 2048, 2048, 512};
      CmpOrder S{c.G, c.bid}; pg8::Epi8<FCmpPart> E{{WSP(float, WS_PB)}};
      pg8::gemm_phase<pg8::Epi8<FCmpPart>, CmpOrder, true>(c.lds, g, S, E); }
    const float* MUR = WSP(float, WS_MUR); bf16_t* ACT2 = WSP(bf16_t, WS_ACT2);
    const float* gq = p.in[6] + (size_t)l * 10 * 64; const float* RC = WSP(float, WS_ROPE); const float* RS = RC + 4096 * 16;
    const int lane = c.lane;
    for (int row = c.gw; row < NTOK; row += c.NGW) {
        const float* R = MUR + (size_t)row * 1024; bf16_t* A = ACT2 + (size_t)row * ACT2W; const int t = row % SEQ;
#pragma unroll
        for (int h = 0; h < 4; ++h) {
            A[A2_QF + h * 96 + lane] = (bf16_t)f2bf(head_norm(R[h * 96 + lane], gq + 8 * 64, lane));
            { const float x = lane < 32 ? R[h * 96 + 64 + lane] : 0.f; const float r = rsqrtf(wave_sum(x * x) * (1.f / 32.f) + EPS);
              const float y = x * r * p.in[13][(l * 2 + 0) * 32 + (lane & 31)];
              const float yo = swz_xor<16>(y); const int k = lane & 15; const float cs = RC[t * 16 + k], sn = RS[t * 16 + k];
              const float o = (lane & 16) ? (yo * sn + y * cs) : (y * cs - yo * sn);
              if (lane < 32) A[A2_QF + h * 96 + 64 + lane] = (bf16_t)f2bf(o); }
            A[A2_KN + h * 64 + lane] = (bf16_t)f2bf(head_norm(R[512 + h * 128 + lane], gq + 9 * 64, lane));
            A[A2_VD + h * 64 + lane] = (bf16_t)f2bf(R[512 + h * 128 + 64 + lane]);
        }
    }
}

template <int D0, int D1, int DV>
DEV void att_step(const float (&q)[D0 + D1], float (&o)[DV], float& m, float& l, const bf16_t* k0, const bf16_t* k1, const bf16_t* v, float scale, float bias, bool valid) {
    float acc = 0.f;
#pragma unroll
    for (int i = 0; i < D0 / 8; ++i) { const u32x4 u = *(const u32x4*)(k0 + 8 * i);
        acc += q[8 * i] * bflo(u.x) + q[8 * i + 1] * bfhi(u.x) + q[8 * i + 2] * bflo(u.y) + q[8 * i + 3] * bfhi(u.y) + q[8 * i + 4] * bflo(u.z) + q[8 * i + 5] * bfhi(u.z) + q[8 * i + 6] * bflo(u.w) + q[8 * i + 7] * bfhi(u.w); }
    if (D1 > 0) {
#pragma unroll
        for (int i = 0; i < D1 / 8; ++i) { const u32x4 u = *(const u32x4*)(k1 + 8 * i); const int b = D0 + 8 * i;
            acc += q[b] * bflo(u.x) + q[b + 1] * bfhi(u.x) + q[b + 2] * bflo(u.y) + q[b + 3] * bfhi(u.y) + q[b + 4] * bflo(u.z) + q[b + 5] * bfhi(u.z) + q[b + 6] * bflo(u.w) + q[b + 7] * bfhi(u.w); }
    }
    const float s = acc * scale + bias;
    if (valid) {
        if (s > m) { const float a = __expf(m - s); l *= a;
#pragma unroll
            for (int d = 0; d < DV; ++d) o[d] *= a;
            m = s; }
        const float pr = __expf(s - m); l += pr;
#pragma unroll
        for (int i = 0; i < DV / 8; ++i) { const u32x4 u = *(const u32x4*)(v + 8 * i);
            o[8 * i] += pr * bflo(u.x); o[8 * i + 1] += pr * bfhi(u.x); o[8 * i + 2] += pr * bflo(u.y); o[8 * i + 3] += pr * bfhi(u.y);
            o[8 * i + 4] += pr * bflo(u.z); o[8 * i + 5] += pr * bfhi(u.z); o[8 * i + 6] += pr * bflo(u.w); o[8 * i + 7] += pr * bfhi(u.w); }
    }
}
template <int D> DEV void load_q(float (&q)[D], const bf16_t* src) {
#pragma unroll
    for (int i = 0; i < D / 8; ++i) { const u32x4 u = *(const u32x4*)(src + 8 * i);
        q[8 * i] = bflo(u.x); q[8 * i + 1] = bfhi(u.x); q[8 * i + 2] = bflo(u.y); q[8 * i + 3] = bfhi(u.y); q[8 * i + 4] = bflo(u.z); q[8 * i + 5] = bfhi(u.z); q[8 * i + 6] = bflo(u.w); q[8 * i + 7] = bfhi(u.w); }
}
template <int DV> DEV void store_o_bf16(bf16_t* dst, const float (&o)[DV], float inv) {
#pragma unroll
    for (int i = 0; i < DV / 8; ++i) { u32x4 w; w.x = pk2(o[8 * i] * inv, o[8 * i + 1] * inv); w.y = pk2(o[8 * i + 2] * inv, o[8 * i + 3] * inv); w.z = pk2(o[8 * i + 4] * inv, o[8 * i + 5] * inv); w.w = pk2(o[8 * i + 6] * inv, o[8 * i + 7] * inv);
        *(u32x4*)(dst + 8 * i) = w; }
}
DEV void item_bgh(int it, int& b, int& g, int& h) { const int r = it & 63, bh = it >> 6; g = (r & 1) ? 63 - (r >> 1) : (r >> 1); b = bh >> 2; h = bh & 3; }

DEV void phase_attn(const Params& p, const Ctx& c, int l) {
    const int lane = c.lane;
    { const bf16_t* HID = WSP(bf16_t, WS_HID); float* KC = WSP(float, WS_MISC + MISC_KCMP); float* VC = WSP(float, WS_MISC + MISC_VCMP);
      const float* gq = p.in[6] + (size_t)l * 10 * 64;
      for (int it = c.gw; it < 2 * 1020; it += c.NGW) { const int kv = it / 1020, r = it % 1020;
          const float* w2 = p.in[9] + (size_t)(l * 2 + kv) * 256 * 64; const bf16_t* hrow = HID + ((size_t)kv * 1024 + r) * 256;
          float a = 0.f;
          for (int k = 0; k < 256; ++k) a += bf2f(hrow[k]) * w2[k * 64 + lane];
          const int b = r / 255, i = r % 255;
          if (kv == 0) KC[(b * 256 + i) * 64 + lane] = head_norm(a, gq + 1 * 64, lane); else VC[(b * 256 + i) * 64 + lane] = a; } }
    const bf16_t* ACT = WSP(bf16_t, WS_ACT); const bf16_t* ACT2 = WSP(bf16_t, WS_ACT2); bf16_t* BR = WSP(bf16_t, WS_BR);
    for (int it0 = c.gw; it0 < 2048; it0 += c.NGW) {
        if (it0 < 1024) {
            int b, g, h; item_bgh(it0, b, g, h); const int t = g * 64 + lane; const size_t tok = (size_t)b * SEQ + t;
            float q[96], o[64]; float m = -INFINITY, ls = 0.f;
            load_q<96>(q, ACT2 + tok * ACT2W + A2_QF + h * 96);
#pragma unroll
            for (int d = 0; d < 64; ++d) o[d] = 0.f;
            const float scale = 0.10206207261596575f;
            for (int s = g * 64 + 63; s >= 0; --s) { const size_t kt = (size_t)b * SEQ + s;
                att_step<64, 32, 64>(q, o, m, ls, ACT2 + kt * ACT2W + A2_KN + h * 64, ACT + kt * ACTW + A_KR, ACT2 + kt * ACT2W + A2_VD + h * 64, scale, 0.f, s <= t); }
            store_o_bf16<64>(BR + tok * 1024 + 768 + h * 64, o, 1.f / ls);
        } else {
            int b, g, h; item_bgh(it0 - 1024, b, g, h); const int t = g * 64 + lane; const size_t tok = (size_t)b * SEQ + t;
            const int nb = g >> 2; const float slope = SLOPES[2][h];
            float q[64], o[64]; float m = -INFINITY, ls = 0.f;
            load_q<64>(q, ACT + tok * ACTW + A_QC + h * 64);
#pragma unroll
            for (int d = 0; d < 64; ++d) o[d] = 0.f;
            const float* KM = WSP(float, WS_MISC + MISC_KMEAN) + (size_t)b * 16 * 256 + h * 64;
            float v1 = -INFINITY, v2 = -INFINITY, v3 = -INFINITY; int i1 = -1, i2 = -1, i3 = -1;
            for (int n = 0; n < nb; ++n) { const float* km = KM + n * 256; float dsum = 0.f;
#pragma unroll
                for (int d = 0; d < 64; ++d) dsum += q[d] * km[d];
                if (dsum > v1) { v3 = v2; i3 = i2; v2 = v1; i2 = i1; v1 = dsum; i1 = n; }
                else if (dsum > v2) { v3 = v2; i3 = i2; v2 = dsum; i2 = n; }
                else if (dsum > v3) { v3 = dsum; i3 = n; } }
            const int start = nb * 256;
            for (int s = g * 64 + 63; s >= start; --s) { const size_t kt = (size_t)b * SEQ + s;
                att_step<64, 0, 64>(q, o, m, ls, ACT + kt * ACTW + A_KC + h * 64, nullptr, ACT + kt * ACTW + A_VC + h * 64, 0.125f, -slope * (float)(t - s), s <= t); }
            for (int n = nb - 1; n >= 0; --n) { const bool sel = (n == i1) || (n == i2) || (n == i3);
                if (!__any(sel)) continue;
                for (int s = n * 256 + 255; s >= n * 256; --s) { const size_t kt = (size_t)b * SEQ + s;
                    att_step<64, 0, 64>(q, o, m, ls, ACT + kt * ACTW + A_KC + h * 64, nullptr, ACT + kt * ACTW + A_VC + h * 64, 0.125f, -slope * (float)(t - s), sel); } }
            store_o_bf16<64>(BR + tok * 1024 + 512 + h * 64, o, 1.f / ls);
        }
    }
    for (int it0 = c.gw; it0 < 2048; it0 += c.NGW) {
        const bool swa = it0 >= 1024;
        int b, g, h; item_bgh(swa ? it0 - 1024 : it0, b, g, h); const int t = g * 64 + lane; const size_t tok = (size_t)b * SEQ + t;
        const int W = swa ? 128 : 512; const float slope = SLOPES[swa ? 1 : 0][h];
        const int qoff = swa ? A_QB + h * 64 : A_QA + h * 64, koff = swa ? A_KB + (h >> 1) * 64 : A_KW, voff = swa ? A_VB + (h >> 1) * 64 : A_VW;
        float q[64], o[64]; float m = -INFINITY, ls = 0.f;
        load_q<64>(q, ACT + tok * ACTW + qoff);
#pragma unroll
        for (int d = 0; d < 64; ++d) o[d] = 0.f;
        int lo = g * 64 - (W - 1); if (lo < 0) lo = 0;
        for (int s = g * 64 + 63; s >= lo; --s) { const size_t kt = (size_t)b * SEQ + s; const int dist = t - s;
            att_step<64, 0, 64>(q, o, m, ls, ACT + kt * ACTW + koff, nullptr, ACT + kt * ACTW + voff, 0.125f, -slope * (float)dist, dist >= 0 && dist < W); }
        if (swa) { const float sk = p.in[10][l * 4 + h]; const float mf = fmaxf(m, sk); const float a = __expf(m - mf); const float den = ls * a + __expf(sk - mf);
            store_o_bf16<64>(BR + tok * 1024 + 256 + h * 64, o, a / den); }
        else { float* OW = WSP(float, WS_OWIN) + tok * 256 + h * 64; const float inv = 1.f / ls;
#pragma unroll
            for (int d = 0; d < 64; d += 4) *(f32x4*)(OW + d) = (f32x4){o[d] * inv, o[d + 1] * inv, o[d + 2] * inv, o[d + 3] * inv}; }
    }
}

DEV void phase_cmpattn(const Params& p, const Ctx& c, int l) {
    const bf16_t* ACT = WSP(bf16_t, WS_ACT); const float* KC = WSP(float, WS_MISC + MISC_KCMP); const float* VC = WSP(float, WS_MISC + MISC_VCMP);
    float* PB = WSP(float, WS_PB); float* PL = WSP(float, WS_SMALL + SM_PL); float* OC = WSP(float, WS_OCMP);
    const int lane = c.lane;
    for (int it = c.gw; it < 1024; it += c.NGW) {
        int b, g, h; item_bgh(it, b, g, h); const int t = g * 64 + lane; const size_t tok = (size_t)b * SEQ + t; const float slope = SLOPES[0][h];
        float q[64], o[64];
        load_q<64>(q, ACT + tok * ACTW + A_QA + h * 64);
#pragma unroll
        for (int d = 0; d < 64; ++d) o[d] = 0.f;
        const int nvis = t >= 31 ? ((t - 31) >> 4) + 1 : 0;
        const int tmaxw = g * 64 + 63; const int nmax = tmaxw >= 31 ? ((tmaxw - 31) >> 4) + 1 : 0;
        const float* kcb = KC + (size_t)b * 256 * 64; const float* vcb = VC + (size_t)b * 256 * 64;
        float m = -INFINITY;
        for (int n = 0; n < nmax; ++n) { const float* k = kcb + n * 64; float a = 0.f;
#pragma unroll
            for (int d = 0; d < 64; ++d) a += q[d] * k[d];
            const float s = a * 0.125f - slope * (float)(t - (16 * n + 31));
            if (n < nvis) m = fmaxf(m, s); }
        float ls = 0.f, carry = 0.f; float* pb = PB + (tok * 4 + h) * 64;
        for (int j = 0; j < 64; ++j) { float e4[4];
#pragma unroll
            for (int u = 0; u < 4; ++u) { const int n = 4 * j + u; float e = 0.f;
                if (n < nmax) { const float* k = kcb + n * 64; float a = 0.f;
#pragma unroll
                    for (int d = 0; d < 64; ++d) a += q[d] * k[d];
                    const float s = a * 0.125f - slope * (float)(t - (16 * n + 31));
                    if (n < nvis) { e = __expf(s - m); const float* v = vcb + n * 64;
#pragma unroll
                        for (int d = 0; d < 64; ++d) o[d] += e * v[d]; } }
                e4[u] = e; }
            pb[j] = carry + e4[0] + e4[1] + e4[2] + e4[3]; carry = e4[3]; ls += e4[0] + e4[1] + e4[2] + e4[3];
            if (4 * j + 4 >= nmax) { for (int jj = j + 1; jj < 64; ++jj) pb[jj] = (jj == j + 1) ? carry : 0.f; break; } }
        const float inv = 1.f / fmaxf(ls, 1e-30f);
        PL[tok * 4 + h] = inv;
        float* oc = OC + tok * 256 + h * 64;
#pragma unroll
        for (int d = 0; d < 64; d += 4) *(f32x4*)(oc + d) = (f32x4){o[d] * inv, o[d + 1] * inv, o[d + 2] * inv, o[d + 3] * inv};
    }
}

DEV void phase_topk(const Params& p, const Ctx& c) {
    const float* PB = WSP(float, WS_PB); const float* PL = WSP(float, WS_SMALL + SM_PL); unsigned long long* SEL = WSP(unsigned long long, WS_SMALL + SM_SEL);
    const int lane = c.lane;
    for (int tok = c.gw; tok < NTOK; tok += c.NGW) {
        const int t = tok % SEQ, cur = t >> 6;
        float ps = 0.f;
#pragma unroll
        for (int h = 0; h < 4; ++h) ps += PB[((size_t)tok * 4 + h) * 64 + lane] * PL[tok * 4 + h];
        const bool forced = (lane == 0) || (lane == cur) || (lane == cur - 1);
        float score = lane <= cur ? ps + (forced ? 1e4f : 0.f) : -1e30f;
        unsigned long long mask = 0ull;
        for (int r = 0; r < 8; ++r) {
            float bv = score; int bi = lane;
#define TK_STEP(M) { const float ov = swz_xor<M>(bv); const int oi = swz_xor_i<M>(bi); if (ov > bv || (ov == bv && oi < bi)) { bv = ov; bi = oi; } }
            TK_STEP(1) TK_STEP(2) TK_STEP(4) TK_STEP(8) TK_STEP(16)
#undef TK_STEP
            { auto rv = __builtin_amdgcn_permlane32_swap(__float_as_uint(bv), __float_as_uint(bv), false, false); auto ri = __builtin_amdgcn_permlane32_swap((unsigned)bi, (unsigned)bi, false, false);
              const float v0 = __uint_as_float(rv[0]), v1 = __uint_as_float(rv[1]); const int i0 = (int)ri[0], i1 = (int)ri[1];
              if (v1 > v0 || (v1 == v0 && i1 < i0)) { bv = v1; bi = i1; } else { bv = v0; bi = i0; } }
            if (bv > -5e29f) mask |= 1ull << bi;
            if (lane == bi) score = -INFINITY;
        }
        if (lane == 0) SEL[tok] = mask;
    }
}

DEV void phase_slc(const Params& p, const Ctx& c, int l) {
    const bf16_t* ACT = WSP(bf16_t, WS_ACT); bf16_t* BR = WSP(bf16_t, WS_BR); const unsigned long long* SEL = WSP(unsigned long long, WS_SMALL + SM_SEL);
    const float* OC = WSP(float, WS_OCMP); const float* OW = WSP(float, WS_OWIN); const float* GA = WSP(float, WS_SMALL + SM_GA);
    const int lane = c.lane;
    for (int it = c.gw; it < 1024; it += c.NGW) {
        int b, g, h; item_bgh(it, b, g, h); const int t = g * 64 + lane; const size_t tok = (size_t)b * SEQ + t; const float slope = SLOPES[0][h];
        float q[64], o[64]; float m = -INFINITY, ls = 0.f;
        load_q<64>(q, ACT + tok * ACTW + A_QA + h * 64);
#pragma unroll
        for (int d = 0; d < 64; ++d) o[d] = 0.f;
        const unsigned long long mask = SEL[tok];
        for (int j = g; j >= 0; --j) { const bool sel = (mask >> j) & 1ull;
            if (!__any(sel)) continue;
            for (int s = j * 64 + 63; s >= j * 64; --s) { const size_t kt = (size_t)b * SEQ + s;
                att_step<64, 0, 64>(q, o, m, ls, ACT + kt * ACTW + A_KS, nullptr, ACT + kt * ACTW + A_VS, 0.125f, -slope * (float)(t - s), sel && s <= t); } }
        const float inv = 1.f / ls; const float g0 = GA[tok * 12 + h * 3], g1 = GA[tok * 12 + h * 3 + 1], g2 = GA[tok * 12 + h * 3 + 2];
        const float* oc = OC + tok * 256 + h * 64; const float* ow = OW + tok * 256 + h * 64;
#pragma unroll
        for (int d = 0; d < 64; ++d) o[d] = g0 * oc[d] + g1 * o[d] * inv + g2 * ow[d];
        store_o_bf16<64>(BR + tok * 1024 + h * 64, o, 1.f);
    }
}


namespace fa {
typedef float f32x16 __attribute__((ext_vector_type(16)));
typedef short v4i16_t __attribute__((ext_vector_type(4)));
typedef float f32x2_t __attribute__((ext_vector_type(2))); typedef __bf16 bf16x2_t __attribute__((ext_vector_type(2)));
constexpr int KROWB = 208, VROWB = 192, KBYTES = 64 * KROWB, VBYTES = 64 * VROWB, STG = KBYTES + VBYTES;
constexpr int LDS_MISC = 2 * STG;
constexpr float LOG2E = 1.4426950408889634f;
constexpr float MFLOOR = -1e20f;
DEV unsigned cvtpk(float lo, float hi) { f32x2_t v = {lo, hi}; bf16x2_t b = __builtin_convertvector(v, bf16x2_t); return __builtin_bit_cast(unsigned, b); }
DEV unsigned long long uni64(unsigned long long v) { const unsigned lo = __builtin_amdgcn_readfirstlane((unsigned)v), hi = __builtin_amdgcn_readfirstlane((unsigned)(v >> 32)); return ((unsigned long long)hi << 32) | lo; }
DEV unsigned long long wave_or64(unsigned long long v) {
    unsigned lo = (unsigned)v, hi = (unsigned)(v >> 32);
#define FA_OR(M) lo |= (unsigned)__builtin_amdgcn_ds_swizzle((int)lo, (M << 10) | 0x1f); hi |= (unsigned)__builtin_amdgcn_ds_swizzle((int)hi, (M << 10) | 0x1f);
    FA_OR(1) FA_OR(2) FA_OR(4) FA_OR(8) FA_OR(16)
#undef FA_OR
    { auto a = __builtin_amdgcn_permlane32_swap(lo, lo, false, false); lo = a[0] | a[1]; auto b = __builtin_amdgcn_permlane32_swap(hi, hi, false, false); hi = b[0] | b[1]; }
    return uni64(((unsigned long long)hi << 32) | lo);
}
struct Src { const bf16_t* k; int kp; const bf16_t* k2; int k2p; const bf16_t* v; int vp; };
template <int NQ, bool ALIBI, int SELMODE>
DEV void attn_pass(LAS unsigned char* lds, const Ctx& c, const Src& src, const bf16x8 (&qf)[NQ], unsigned long long tmask, unsigned long long wmask,
                   int t, float nslope2, float c1, unsigned W, unsigned long long rowmask, int own_blk, f32x16 (&o)[2], float& m, float& l) {
    const int tid = c.tid, lane = c.lane, r32 = lane & 31, hi = lane >> 5;
    const int skey = tid >> 3, sch = tid & 7, skey2 = tid >> 2, sch2 = tid & 3;
    const int i16 = lane & 15, tq = i16 >> 2, tp = i16 & 3, blk = (lane >> 4) & 1;
    u32x4 kreg, vreg, k2reg = (u32x4){0u, 0u, 0u, 0u};
#define FA_GLOAD(kt_) do { const size_t r_ = (size_t)((kt_) * 64 + skey); kreg = *(const u32x4*)(src.k + r_ * src.kp + sch * 8); vreg = *(const u32x4*)(src.v + r_ * src.vp + sch * 8); \
        if (NQ == 6) { if (tid < 256) k2reg = *(const u32x4*)(src.k2 + (size_t)((kt_) * 64 + skey2) * src.k2p + sch2 * 8); } } while (0)
#define FA_LSTORE(buf_) do { LAS unsigned char* st_ = lds + (buf_) * STG; *(LAS u32x4*)(st_ + skey * KROWB + sch * 16) = kreg; *(LAS u32x4*)(st_ + KBYTES + skey * VROWB + sch * 16) = vreg; \
        if (NQ == 6) { if (tid < 256) *(LAS u32x4*)(st_ + skey2 * KROWB + 128 + sch2 * 16) = k2reg; } } while (0)
#pragma unroll
    for (int dt = 0; dt < 2; ++dt)
#pragma unroll
        for (int i = 0; i < 16; ++i) o[dt][i] = 0.f;
    m = MFLOOR; l = 0.f;
    if (tmask == 0ull) return;
    int kt = 63 - __builtin_clzll(tmask); tmask &= ~(1ull << kt);
    FA_GLOAD(kt);
    int buf = 0;
    for (;;) {
        FA_LSTORE(buf);
        __syncthreads();
        const bool more = tmask != 0ull; int ktn = 0;
        if (more) { ktn = 63 - __builtin_clzll(tmask); tmask &= ~(1ull << ktn); FA_GLOAD(ktn); }
        if ((wmask >> kt) & 1ull) {
            const LAS unsigned char* kb = lds + buf * STG; const LAS unsigned char* vb = kb + KBYTES;
            f32x16 s0, s1;
#pragma unroll
            for (int i = 0; i < 16; ++i) { s0[i] = 0.f; s1[i] = 0.f; }
#pragma unroll
            for (int d0 = 0; d0 < NQ; ++d0) {
                const bf16x8 k0 = *(const LAS bf16x8*)(kb + r32 * KROWB + (16 * d0 + 8 * hi) * 2);
                const bf16x8 k1 = *(const LAS bf16x8*)(kb + (32 + r32) * KROWB + (16 * d0 + 8 * hi) * 2);
                s0 = __builtin_amdgcn_mfma_f32_32x32x16_bf16(k0, qf[d0], s0, 0, 0, 0);
                s1 = __builtin_amdgcn_mfma_f32_32x32x16_bf16(k1, qf[d0], s1, 0, 0, 0);
            }
            bool rowsel = true;
            if (SELMODE == 1) rowsel = (rowmask >> kt) & 1ull;
            if (SELMODE == 2) rowsel = ((kt >> 2) == own_blk) || ((rowmask >> (kt >> 2)) & 1ull);
            const unsigned Weff = rowsel ? W : 0u;
            const int db0 = t - (kt * 64 + 4 * hi);
            float mx = -INFINITY;
#pragma unroll
            for (int i = 0; i < 16; ++i) { const int cr = (i & 3) + 8 * (i >> 2);
                { const int d = db0 - cr; float x = s0[i] * c1; if (ALIBI) x = fmaf((float)d, nslope2, x); x = ((unsigned)d < Weff) ? x : -INFINITY; s0[i] = x; mx = fmaxf(mx, x); }
                { const int d = db0 - 32 - cr; float x = s1[i] * c1; if (ALIBI) x = fmaf((float)d, nslope2, x); x = ((unsigned)d < Weff) ? x : -INFINITY; s1[i] = x; mx = fmaxf(mx, x); } }
            { auto rr = __builtin_amdgcn_permlane32_swap(__float_as_uint(mx), __float_as_uint(mx), false, false); mx = fmaxf(__uint_as_float(rr[0]), __uint_as_float(rr[1])); }
            const float mn = fmaxf(m, mx); const float alpha = __builtin_amdgcn_exp2f(m - mn); m = mn;
            float ls = 0.f;
#pragma unroll
            for (int i = 0; i < 16; ++i) { s0[i] = __builtin_amdgcn_exp2f(s0[i] - mn); s1[i] = __builtin_amdgcn_exp2f(s1[i] - mn); ls += s0[i] + s1[i]; }
            l = l * alpha + ls;
#pragma unroll
            for (int dt = 0; dt < 2; ++dt)
#pragma unroll
                for (int i = 0; i < 16; ++i) o[dt][i] *= alpha;
#pragma unroll
            for (int hf = 0; hf < 2; ++hf)
#pragma unroll
                for (int ks = 0; ks < 2; ++ks) {
                    u32x4 pw;
                    if (hf == 0) { pw.x = cvtpk(s0[8 * ks], s0[8 * ks + 1]); pw.y = cvtpk(s0[8 * ks + 2], s0[8 * ks + 3]); pw.z = cvtpk(s0[8 * ks + 4], s0[8 * ks + 5]); pw.w = cvtpk(s0[8 * ks + 6], s0[8 * ks + 7]); }
                    else         { pw.x = cvtpk(s1[8 * ks], s1[8 * ks + 1]); pw.y = cvtpk(s1[8 * ks + 2], s1[8 * ks + 3]); pw.z = cvtpk(s1[8 * ks + 4], s1[8 * ks + 5]); pw.w = cvtpk(s1[8 * ks + 6], s1[8 * ks + 7]); }
                    const bf16x8 pb = __builtin_bit_cast(bf16x8, pw);
#pragma unroll
                    for (int dt = 0; dt < 2; ++dt) {
                        const LAS unsigned char* vp = vb + (32 * hf + 16 * ks + 4 * hi + tq) * VROWB + (32 * dt + 16 * blk + 4 * tp) * 2;
                        const v4i16_t lo = __builtin_amdgcn_ds_read_tr16_b64_v4i16((LAS v4i16_t*)vp);
                        const v4i16_t hv = __builtin_amdgcn_ds_read_tr16_b64_v4i16((LAS v4i16_t*)(vp + 8 * VROWB));
                        const bf16x8 va = (bf16x8){lo[0], lo[1], lo[2], lo[3], hv[0], hv[1], hv[2], hv[3]};
                        o[dt] = __builtin_amdgcn_mfma_f32_32x32x16_bf16(va, pb, o[dt], 0, 0, 0);
                    }
                }
        }
        if (!more) break;
        kt = ktn; buf ^= 1;
    }
    __syncthreads();
    { auto rr = __builtin_amdgcn_permlane32_swap(__float_as_uint(l), __float_as_uint(l), false, false); l = __uint_as_float(rr[0]) + __uint_as_float(rr[1]); }
#undef FA_GLOAD
#undef FA_LSTORE
}
template <int NQ> DEV void load_qf(bf16x8 (&qf)[NQ], const bf16_t* qrow, int hi) {
#pragma unroll
    for (int d0 = 0; d0 < NQ; ++d0) qf[d0] = *(const bf16x8*)(qrow + 16 * d0 + 8 * hi);
}
DEV void store_o(bf16_t* orow, const f32x16 (&o)[2], float sc, int hi) {
#pragma unroll
    for (int dt = 0; dt < 2; ++dt)
#pragma unroll
        for (int g = 0; g < 4; ++g) { u32x2 w; w.x = cvtpk(o[dt][4 * g] * sc, o[dt][4 * g + 1] * sc); w.y = cvtpk(o[dt][4 * g + 2] * sc, o[dt][4 * g + 3] * sc);
            *(u32x2*)(orow + 32 * dt + 8 * g + 4 * hi) = w; }
}
DEV unsigned long long expand4(unsigned m16) { unsigned long long r = 0ull;
#pragma unroll
    for (int j = 0; j < 16; ++j) if ((m16 >> j) & 1u) r |= 0xFull << (4 * j);
    return r; }
}


DEV void moba_gate(const Params& p, const Ctx& c);
namespace fc {
using namespace fa;
constexpr int CKROWB = 144, CVROWB = 320, CKB = 64 * CKROWB, CVB = 64 * CVROWB, CSTG = CKB + CVB, BINS_OFF = 2 * CSTG, BINW = 65;
static_assert(BINS_OFF + 4 * 64 * BINW * 4 <= RING_BYTES, "cmp unit LDS");
DEV void cmp_unit(const Params& p, const Ctx& c, int b, int cb) {
    LAS unsigned char* lds = c.lds;
    const int tid = c.tid, lane = c.lane, r32 = lane & 31, hi = lane >> 5, w = c.wave, h = w >> 1;
    const int t = cb * 64 + (w & 1) * 32 + r32; const size_t tok = (size_t)b * SEQ + t;
    const bf16_t* ACT = WSP(bf16_t, WS_ACT);
    const bf16_t* KCB = WSP(bf16_t, WS_MISC + MISC_KCB) + (size_t)b * 256 * 64; const bf16_t* VCB = WSP(bf16_t, WS_MISC + MISC_VCB) + (size_t)b * 256 * 64;
    bf16x8 qf[4]; load_qf<4>(qf, ACT + tok * ACTW + A_QA + h * 64, hi);
    const float nslope2 = -SLOPES[0][h] * LOG2E, c1 = 0.125f * LOG2E;
    const int tmaxu = cb * 64 + 63; const int nvmax = tmaxu >= 31 ? ((tmaxu - 31) >> 4) + 1 : 0;
    const int ntile = (nvmax + 63) >> 6;
    const int skey = tid >> 3, sch = tid & 7;
    const int i16 = lane & 15, tq = i16 >> 2, tp = i16 & 3, blk = (lane >> 4) & 1;
    f32x16 o[4]; float m = MFLOOR, l = 0.f;
#pragma unroll
    for (int dt = 0; dt < 4; ++dt)
#pragma unroll
        for (int i = 0; i < 16; ++i) o[dt][i] = 0.f;
    for (int kt = ntile - 1; kt >= 0; --kt) {
        const int buf = kt & 1;
        LAS unsigned char* st = lds + buf * CSTG;
        { const int n = kt * 64 + skey;
          *(LAS u32x4*)(st + skey * CKROWB + sch * 16) = *(const u32x4*)(KCB + (size_t)n * 64 + sch * 8);
          *(LAS u32x4*)(st + CKB + skey * CVROWB + sch * 16) = *(const u32x4*)(VCB + (size_t)n * 64 + sch * 8);
          unsigned cw[4];
#pragma unroll
          for (int e = 0; e < 4; ++e) { const int j0 = sch * 8 + 2 * e, j1 = j0 + 1; const int ja = n >> 2; const bool ex = (n & 3) == 3;
              const unsigned lo16 = (j0 == ja || (ex && j0 == ja + 1)) ? 0x3F80u : 0u, hi16 = (j1 == ja || (ex && j1 == ja + 1)) ? 0x3F80u : 0u; cw[e] = lo16 | (hi16 << 16); }
          *(LAS u32x4*)(st + CKB + skey * CVROWB + 128 + sch * 16) = (u32x4){cw[0], cw[1], cw[2], cw[3]}; }
        __syncthreads();
        const LAS unsigned char* kb = st; const LAS unsigned char* vb = st + CKB;
        f32x16 s0, s1;
#pragma unroll
        for (int i = 0; i < 16; ++i) { s0[i] = 0.f; s1[i] = 0.f; }
#pragma unroll
        for (int d0 = 0; d0 < 4; ++d0) {
            const bf16x8 k0 = *(const LAS bf16x8*)(kb + r32 * CKROWB + (16 * d0 + 8 * hi) * 2);
            const bf16x8 k1 = *(const LAS bf16x8*)(kb + (32 + r32) * CKROWB + (16 * d0 + 8 * hi) * 2);
            s0 = __builtin_amdgcn_mfma_f32_32x32x16_bf16(k0, qf[d0], s0, 0, 0, 0);
            s1 = __builtin_amdgcn_mfma_f32_32x32x16_bf16(k1, qf[d0], s1, 0, 0, 0);
        }
        const int db0 = (t - 31) - 16 * (kt * 64 + 4 * hi);
        float mx = -INFINITY;
#pragma unroll
        for (int i = 0; i < 16; ++i) { const int cr = (i & 3) + 8 * (i >> 2);
            { const int d = db0 - 16 * cr; float x = fmaf((float)d, nslope2, s0[i] * c1); x = (d >= 0) ? x : -INFINITY; s0[i] = x; mx = fmaxf(mx, x); }
            { const int d = db0 - 16 * (32 + cr); float x = fmaf((float)d, nslope2, s1[i] * c1); x = (d >= 0) ? x : -INFINITY; s1[i] = x; mx = fmaxf(mx, x); } }
        { auto rr = __builtin_amdgcn_permlane32_swap(__float_as_uint(mx), __float_as_uint(mx), false, false); mx = fmaxf(__uint_as_float(rr[0]), __uint_as_float(rr[1])); }
        const float mn = fmaxf(m, mx); const float alpha = __builtin_amdgcn_exp2f(m - mn); m = mn;
        float ls = 0.f;
#pragma unroll
        for (int i = 0; i < 16; ++i) { s0[i] = __builtin_amdgcn_exp2f(s0[i] - mn); s1[i] = __builtin_amdgcn_exp2f(s1[i] - mn); ls += s0[i] + s1[i]; }
        l = l * alpha + ls;
#pragma unroll
        for (int dt = 0; dt < 4; ++dt)
#pragma unroll
            for (int i = 0; i < 16; ++i) o[dt][i] *= alpha;
#pragma unroll
        for (int hf = 0; hf < 2; ++hf)
#pragma unroll
            for (int ks = 0; ks < 2; ++ks) {
                u32x4 pw;
                if (hf == 0) { pw.x = cvtpk(s0[8 * ks], s0[8 * ks + 1]); pw.y = cvtpk(s0[8 * ks + 2], s0[8 * ks + 3]); pw.z = cvtpk(s0[8 * ks + 4], s0[8 * ks + 5]); pw.w = cvtpk(s0[8 * ks + 6], s0[8 * ks + 7]); }
                else         { pw.x = cvtpk(s1[8 * ks], s1[8 * ks + 1]); pw.y = cvtpk(s1[8 * ks + 2], s1[8 * ks + 3]); pw.z = cvtpk(s1[8 * ks + 4], s1[8 * ks + 5]); pw.w = cvtpk(s1[8 * ks + 6], s1[8 * ks + 7]); }
                const bf16x8 pb = __builtin_bit_cast(bf16x8, pw);
#pragma unroll
                for (int dt = 0; dt < 4; ++dt) {
                    const LAS unsigned char* vp = vb + (32 * hf + 16 * ks + 4 * hi + tq) * CVROWB + (32 * dt + 16 * blk + 4 * tp) * 2;
                    const v4i16_t lo = __builtin_amdgcn_ds_read_tr16_b64_v4i16((LAS v4i16_t*)vp);
                    const v4i16_t hv = __builtin_amdgcn_ds_read_tr16_b64_v4i16((LAS v4i16_t*)(vp + 8 * CVROWB));
                    const bf16x8 va = (bf16x8){lo[0], lo[1], lo[2], lo[3], hv[0], hv[1], hv[2], hv[3]};
                    o[dt] = __builtin_amdgcn_mfma_f32_32x32x16_bf16(va, pb, o[dt], 0, 0, 0);
                }
            }
    }
    { auto rr = __builtin_amdgcn_permlane32_swap(__float_as_uint(l), __float_as_uint(l), false, false); l = __uint_as_float(rr[0]) + __uint_as_float(rr[1]); }
    const float inv = 1.f / fmaxf(l, 1e-30f);
    { float* oc = WSP(float, WS_OCMP) + tok * 256 + h * 64;
#pragma unroll
      for (int dt = 0; dt < 2; ++dt)
#pragma unroll
          for (int g = 0; g < 4; ++g) *(f32x4*)(oc + 32 * dt + 8 * g + 4 * hi) = (f32x4){o[dt][4 * g] * inv, o[dt][4 * g + 1] * inv, o[dt][4 * g + 2] * inv, o[dt][4 * g + 3] * inv}; }
    LAS float* bins = (LAS float*)(lds + BINS_OFF);
    { const int rowl = h * 64 + (w & 1) * 32 + r32;
#pragma unroll
      for (int dd = 0; dd < 2; ++dd)
#pragma unroll
          for (int i = 0; i < 16; ++i) bins[rowl * BINW + 32 * dd + (i & 3) + 8 * (i >> 2) + 4 * hi] = o[2 + dd][i] * inv; }
    __syncthreads();
    unsigned long long* SEL = WSP(unsigned long long, WS_SMALL + SM_SEL);
    for (int i = 0; i < 8; ++i) { const int tl = w * 8 + i; const int tt = cb * 64 + tl; const int cur = cb;
        const float ps = ((bins[(0 * 64 + tl) * BINW + lane] + bins[(1 * 64 + tl) * BINW + lane]) + bins[(2 * 64 + tl) * BINW + lane]) + bins[(3 * 64 + tl) * BINW + lane];
        const bool forced = (lane == 0) || (lane == cur) || (lane == cur - 1);
        float score = lane <= cur ? ps + (forced ? 1e4f : 0.f) : -1e30f;
        unsigned long long mask = 0ull;
        for (int r = 0; r < 8; ++r) {
            float bv = score; int bi = lane;
#define TK_STEP(M) { const float ov = swz_xor<M>(bv); const int oi = swz_xor_i<M>(bi); if (ov > bv || (ov == bv && oi < bi)) { bv = ov; bi = oi; } }
            TK_STEP(1) TK_STEP(2) TK_STEP(4) TK_STEP(8) TK_STEP(16)
#undef TK_STEP
            { auto rv = __builtin_amdgcn_permlane32_swap(__float_as_uint(bv), __float_as_uint(bv), false, false); auto ri = __builtin_amdgcn_permlane32_swap((unsigned)bi, (unsigned)bi, false, false);
              const float v0 = __uint_as_float(rv[0]), v1 = __uint_as_float(rv[1]); const int i0 = (int)ri[0], i1 = (int)ri[1];
              if (v1 > v0 || (v1 == v0 && i1 < i0)) { bv = v1; bi = i1; } else { bv = v0; bi = i0; } }
            if (bv > -5e29f) mask |= 1ull << bi;
            if (lane == bi) score = -INFINITY;
        }
        if (lane == 0) SEL[(size_t)b * SEQ + tt] = mask;
    }
    __syncthreads();
}
}
DEV void phase_cmpsel(const Params& p, const Ctx& c, int l) {
    for (int u = c.bid; u < 256; u += c.G) { const int v = (u * 37) & 255;
        fc::cmp_unit(p, c, v & 3, 63 - (v >> 2)); }
    moba_gate(p, c);
}

constexpr int CW_QUEUE = 16384 + 512;
constexpr int N_ATT_UNITS = 1024;
DEV void phase_attn2(const Params& p, const Ctx& c, int l) {
    using namespace fa;
    const bf16_t* ACT = WSP(bf16_t, WS_ACT); const bf16_t* ACT2 = WSP(bf16_t, WS_ACT2); bf16_t* BR = WSP(bf16_t, WS_BR);
    unsigned* qhead = WSP(unsigned, WS_CTL) + CW_QUEUE + l; l &= 7;
    volatile LAS unsigned* misc = (volatile LAS unsigned*)(c.lds + LDS_MISC);
    const int lane = c.lane, r32 = lane & 31, hi = lane >> 5, w = c.wave;
    for (;;) {
        if (c.tid == 0) { misc[0] = atomicAdd(qhead, 1u); misc[2] = 0u; misc[3] = 0u; }
        __syncthreads();
        const int u = (int)__builtin_amdgcn_readfirstlane(misc[0]);
        if (u >= N_ATT_UNITS) break;
        f32x16 o[2]; float m, ls;
        if (u < 512) {
            const int k = 15 - (u >> 5), r = u & 31, bh = r & 15, b = bh >> 2, h = bh & 3; const bool moba = (r >> 4) != 0;
            const int t = k * 256 + w * 32 + r32; const size_t tok = (size_t)b * SEQ + t; const size_t b0 = (size_t)b * SEQ;
            if (!moba) {
                bf16x8 qf[6]; load_qf<6>(qf, ACT2 + tok * ACT2W + A2_QF + h * 96, hi);
                const Src src{ACT2 + b0 * ACT2W + A2_KN + h * 64, ACT2W, ACT + b0 * ACTW + A_KR, ACTW, ACT2 + b0 * ACT2W + A2_VD + h * 64, ACT2W};
                const int nt = 4 * k + 4; const unsigned long long tm = nt >= 64 ? ~0ull : ((1ull << nt) - 1ull);
                const int nw = 4 * k + (w >> 1) + 1; const unsigned long long wm = nw >= 64 ? ~0ull : ((1ull << nw) - 1ull);
                __syncthreads();
                attn_pass<6, false, 0>(c.lds, c, src, qf, tm, wm, t, 0.f, 0.10206207261596575f * LOG2E, 0x7fffffffu, 0ull, 0, o, m, ls);
                store_o(BR + tok * 1024 + 768 + h * 64, o, 1.f / ls, hi);
            } else {
                bf16x8 qf[4]; load_qf<4>(qf, ACT + tok * ACTW + A_QC + h * 64, hi);
                const Src src{ACT + b0 * ACTW + A_KC + h * 64, ACTW, nullptr, 0, ACT + b0 * ACTW + A_VC + h * 64, ACTW};
                const unsigned rm = WSP(unsigned, WS_OWIN)[tok * 4 + h];
                const unsigned long long wor = wave_or64((unsigned long long)rm);
                if (lane == 0) atomicOr((unsigned*)&misc[2], (unsigned)wor);
                __syncthreads();
                const unsigned bor = __builtin_amdgcn_readfirstlane(misc[2]);
                const unsigned long long own_all = 0xFull << (4 * k);
                const int nw = (w >> 1) + 1; const unsigned long long own_w = ((1ull << nw) - 1ull) << (4 * k);
                const unsigned long long tm = uni64(expand4(bor) | own_all), wm = uni64(expand4((unsigned)wor) | own_w);
                attn_pass<4, true, 2>(c.lds, c, src, qf, tm, wm, t, -SLOPES[2][h] * LOG2E, 0.125f * LOG2E, 0x7fffffffu, (unsigned long long)rm, k, o, m, ls);
                store_o(BR + tok * 1024 + 512 + h * 64, o, 1.f / ls, hi);
            }
        } else if (u < 768) {
            const int v = u - 512, cb = 63 - (v >> 2), b = v & 3, h = w >> 1;
            const int t = cb * 64 + (w & 1) * 32 + r32; const size_t tok = (size_t)b * SEQ + t; const size_t b0 = (size_t)b * SEQ;
            bf16x8 qf[4]; load_qf<4>(qf, ACT + tok * ACTW + A_QA + h * 64, hi);
            const float nsl = -SLOPES[0][h] * LOG2E;
            const float* GA = WSP(float, WS_SMALL + SM_GA) + tok * 12 + h * 3; const float g0 = GA[0], g1 = GA[1], g2 = GA[2];
            const unsigned long long rm = WSP(unsigned long long, WS_SMALL + SM_SEL)[tok];
            const unsigned long long wor = wave_or64(rm);
            if (lane == 0) { atomicOr((unsigned*)&misc[2], (unsigned)wor); atomicOr((unsigned*)&misc[3], (unsigned)(wor >> 32)); }
            { const Src src{ACT + b0 * ACTW + A_KW, ACTW, nullptr, 0, ACT + b0 * ACTW + A_VW, ACTW};
              const int lo = cb >= 8 ? cb - 8 : 0; const unsigned long long upto = cb >= 63 ? ~0ull : ((1ull << (cb + 1)) - 1ull); const unsigned long long tm = upto & ~((1ull << lo) - 1ull);
              __syncthreads();
              attn_pass<4, true, 0>(c.lds, c, src, qf, tm, tm, t, nsl, 0.125f * LOG2E, 512u, 0ull, 0, o, m, ls); }
            f32x16 res[2]; { const float sc = g2 / ls;
#pragma unroll
              for (int dt = 0; dt < 2; ++dt)
#pragma unroll
                  for (int i = 0; i < 16; ++i) res[dt][i] = o[dt][i] * sc; }
            { const Src src{ACT + b0 * ACTW + A_KS, ACTW, nullptr, 0, ACT + b0 * ACTW + A_VS, ACTW};
              const unsigned long long tm = ((unsigned long long)__builtin_amdgcn_readfirstlane(misc[3]) << 32) | __builtin_amdgcn_readfirstlane(misc[2]);
              attn_pass<4, true, 1>(c.lds, c, src, qf, tm, wor, t, nsl, 0.125f * LOG2E, 0x7fffffffu, rm, 0, o, m, ls); }
            { const float sc = g1 / ls; const float* oc = WSP(float, WS_OCMP) + tok * 256 + h * 64;
#pragma unroll
              for (int dt = 0; dt < 2; ++dt)
#pragma unroll
                  for (int g = 0; g < 4; ++g) { const f32x4 cv = *(const f32x4*)(oc + 32 * dt + 8 * g + 4 * hi);
#pragma unroll
                      for (int e = 0; e < 4; ++e) res[dt][4 * g + e] += o[dt][4 * g + e] * sc + g0 * cv[e]; } }
            store_o(BR + tok * 1024 + h * 64, res, 1.f, hi);
        } else {
            const int v = u - 768, b = v >> 6, g = (v >> 5) & 1, cc = v & 31, hr = w >> 2, h = 2 * g + hr;
            const int t = cc * 128 + (w & 3) * 32 + r32; const size_t tok = (size_t)b * SEQ + t; const size_t b0 = (size_t)b * SEQ;
            bf16x8 qf[4]; load_qf<4>(qf, ACT + tok * ACTW + A_QB + h * 64, hi);
            const Src src{ACT + b0 * ACTW + A_KB + g * 64, ACTW, nullptr, 0, ACT + b0 * ACTW + A_VB + g * 64, ACTW};
            const int lo = cc >= 1 ? 2 * cc - 2 : 0; const int hiT = 2 * cc + 1; const unsigned long long upto = hiT >= 63 ? ~0ull : ((1ull << (hiT + 1)) - 1ull);
            const unsigned long long tm = upto & ~((1ull << lo) - 1ull);
            const unsigned long long wm = ((w & 3) < 2) ? (tm & ~(1ull << hiT)) : tm;
            __syncthreads();
            attn_pass<4, true, 0>(c.lds, c, src, qf, tm, wm, t, -SLOPES[1][h] * LOG2E, 0.125f * LOG2E, 128u, 0ull, 0, o, m, ls);
            const float sk2 = p.in[10][l * 4 + h] * LOG2E; const float mf = fmaxf(m, sk2); const float a = __builtin_amdgcn_exp2f(m - mf); const float den = ls * a + __builtin_amdgcn_exp2f(sk2 - mf);
            store_o(BR + tok * 1024 + 256 + h * 64, o, a / den, hi);
        }
        __syncthreads();
    }
}
DEV void moba_gate(const Params& p, const Ctx& c) {
    const bf16_t* ACT = WSP(bf16_t, WS_ACT); unsigned* MS = WSP(unsigned, WS_OWIN);
    for (int it = c.gw; it < 1024; it += c.NGW) {
        int b, g, h; item_bgh(it, b, g, h); const int t = g * 64 + c.lane; const size_t tok = (size_t)b * SEQ + t; const int nb = g >> 2;
        float q[64]; load_q<64>(q, ACT + tok * ACTW + A_QC + h * 64);
        const float* KM = WSP(float, WS_MISC + MISC_KMEAN) + (size_t)b * 16 * 256 + h * 64;
        float v1 = -INFINITY, v2 = -INFINITY, v3 = -INFINITY; int i1 = -1, i2 = -1, i3 = -1;
        for (int n = 0; n < nb; ++n) { const float* km = KM + n * 256; float dsum = 0.f;
#pragma unroll
            for (int d = 0; d < 64; ++d) dsum += q[d] * km[d];
            if (dsum > v1) { v3 = v2; i3 = i2; v2 = v1; i2 = i1; v1 = dsum; i1 = n; }
            else if (dsum > v2) { v3 = v2; i3 = i2; v2 = dsum; i2 = n; }
            else if (dsum > v3) { v3 = dsum; i3 = n; } }
        unsigned mk = 0u; if (i1 >= 0) mk |= 1u << i1; if (i2 >= 0) mk |= 1u << i2; if (i3 >= 0) mk |= 1u << i3;
        MS[tok * 4 + h] = mk;
    }
}
DEV void phase_cmpw2(const Params& p, const Ctx& c, int l) {
    const int lane = c.lane;
    const float* HIDP = WSP(float, WS_PB);
    bf16_t* KCB = WSP(bf16_t, WS_MISC + MISC_KCB); bf16_t* VCB = WSP(bf16_t, WS_MISC + MISC_VCB);
    const float* gq = p.in[6] + (size_t)l * 10 * 64;
    LAS float* hs = (LAS float*)(c.lds + c.wave * 1024);
    for (int it = c.gw; it < 2 * 1020; it += c.NGW) { const int kv = it / 1020, r = it % 1020; const size_t row = (size_t)kv * 1024 + r;
#pragma unroll
        for (int j = 0; j < 4; ++j) { const int k = lane + 64 * j;
            const float hsum = (HIDP[(0 * 2048 + row) * 256 + k] + HIDP[(1 * 2048 + row) * 256 + k]) + (HIDP[(2 * 2048 + row) * 256 + k] + HIDP[(3 * 2048 + row) * 256 + k]);
            hs[k] = silu_(hsum); }
        LDS_WAIT(); asm volatile("" ::: "memory");
        const float* w2 = p.in[9] + (size_t)(l * 2 + kv) * 256 * 64;
        float a0 = 0.f, a1 = 0.f, a2 = 0.f, a3 = 0.f;
#pragma unroll 8
        for (int k = 0; k < 256; k += 4) { a0 += hs[k] * w2[k * 64 + lane]; a1 += hs[k + 1] * w2[(k + 1) * 64 + lane]; a2 += hs[k + 2] * w2[(k + 2) * 64 + lane]; a3 += hs[k + 3] * w2[(k + 3) * 64 + lane]; }
        const float a = (a0 + a1) + (a2 + a3);
        LDS_WAIT(); asm volatile("" ::: "memory");
        const int b = r / 255, i = r % 255;
        if (kv == 0) KCB[(b * 256 + i) * 64 + lane] = (bf16_t)f2bf(head_norm(a, gq + 1 * 64, lane)); else VCB[(b * 256 + i) * 64 + lane] = (bf16_t)f2bf(a);
        if (i == 0) { if (kv == 0) KCB[(b * 256 + 255) * 64 + lane] = 0; else VCB[(b * 256 + 255) * 64 + lane] = 0; } }
}

struct FMergeAll { const bf16_t* GATES; bf16_t* MIXB;
    DEV void operator()(int row, int vcol, const f32x4& v0, const f32x4& v1) const {
        const int n = vcol >> 10, col = vcol & 1023;
        const u32x4 gw = *(const u32x4*)(GATES + (size_t)row * NGATE + n * 1024 + col);
        f32x4 a = (f32x4){bflo(gw.x), bfhi(gw.x), bflo(gw.y), bfhi(gw.y)} * v0, b = (f32x4){bflo(gw.z), bfhi(gw.z), bflo(gw.w), bfhi(gw.w)} * v1;
        bf16_t* mx = MIXB + (size_t)row * 1024 + col;
        if (n > 0) { const u32x4 pv = *(const u32x4*)mx; a += (f32x4){bflo(pv.x), bfhi(pv.x), bflo(pv.y), bfhi(pv.y)}; b += (f32x4){bflo(pv.z), bfhi(pv.z), bflo(pv.w), bfhi(pv.w)}; }
        u32x4 w; w.x = pk2(a[0], a[1]); w.y = pk2(a[2], a[3]); w.z = pk2(b[0], b[1]); w.w = pk2(b[2], b[3]); *(u32x4*)mx = w; } };
struct MergeOrder { pg8::StaticOrder so;
    DEV bool next(int i, pg8::Unit& u) const { if (!so.next(i >> 2, u)) return false; const int n = i & 3; u.pn += 4 * n; u.ao = n * 512; return true; } };
template <int NB> DEV void phase_merge(const Params& p, const Ctx& c, int l) {
    pg8::Gemm g{WSP(bf16_t, WS_BR), WSP(bf16_t, WS_WBR) + (size_t)l * 4 * 1024 * 256, 1024, 256};
    MergeOrder S; S.so.init(NTOK, 1024, c.G, c.bid);
    pg8::Epi8<FMergeAll> E{{WSP(bf16_t, WS_GATES), (bf16_t*)(p.ws + WS_BIG + BIG_MIXB)}};
    pg8::gemm_phase<pg8::Epi8<FMergeAll>, MergeOrder, true>(c.lds, g, S, E);
}
struct FOut { float* X; const float* g1; float* XO;
    DEV void operator()(int row, int col, const f32x4& v0, const f32x4& v1) const { const float* gg = g1 + (row / SEQ) * 6144 + col; float* x = X + (size_t)row * DM + col;
        float* xo = XO + (size_t)row * DM + col; *(f32x4*)xo = *(const f32x4*)x + *(const f32x4*)gg * v0; *(f32x4*)(xo + 4) = *(const f32x4*)(x + 4) + *(const f32x4*)(gg + 4) * v1; } };
template <bool REAL> DEV void phase_out(const Params& p, const Ctx& c, int l) {
    pg8::Gemm g{(const bf16_t*)(p.ws + WS_BIG + BIG_MIXB), WSP(bf16_t, WS_WOUT) + (size_t)l * 1024 * 1024, 1024, 1024};
    pg8::StaticOrder S; S.init(NTOK, 1024, c.G, c.bid);
    pg8::Epi8<FOut> E{{p.out, WSP(float, WS_MOD) + (size_t)l * 4 * 6144 + 2048, REAL ? p.out : WSP(float, WS_MUR)}};
    pg8::gemm_phase<pg8::Epi8<FOut>, pg8::StaticOrder, true>(c.lds, g, S, E);
}

template <bool COUNT> DEV void phase_router(const Params& p, const Ctx& c, int l) {
    const float* MOD = WSP(float, WS_MOD); bf16_t* H2B = WSP(bf16_t, WS_HBF);
    int* EID = WSP(int, WS_MISC + MISC_EID); float* WTS = WSP(float, WS_MISC + MISC_WTS);
    const float* WRT = WSP(float, WS_MISC + MISC_WRT) + (size_t)l * 36 * 1024;
    const int lane = c.lane;
    LAS int* hist = (LAS int*)(c.lds + 8192);
    if (c.tid < 32) hist[c.tid] = 0;
    __syncthreads();
    const int rpb = NTOK / c.G, rpw = rpb / 8;
    LAS float* lgs = (LAS float*)(c.lds + c.wave * 1024);
    for (int ri = 0; ri < rpw; ri += 4) { const int row0 = c.bid * rpb + c.wave * rpw + ri; const int b = row0 / SEQ;
        f32x4 v[4][4];
        const float* gn = p.in[4] + (size_t)(l * 2 + 1) * DM; const float* sh = MOD + (l * 4 + b) * 6144 + 3072; const float* sc = sh + 1024;
#pragma unroll
        for (int q = 0; q < 4; ++q) { float ss = 0.f;
#pragma unroll
            for (int j = 0; j < 4; ++j) { v[q][j] = *(const f32x4*)(p.out + (size_t)(row0 + q) * DM + j * 256 + lane * 4); ss += (v[q][j][0] * v[q][j][0] + v[q][j][1] * v[q][j][1]) + (v[q][j][2] * v[q][j][2] + v[q][j][3] * v[q][j][3]); }
            const float r = rsqrtf(wave_sum(ss) * (1.f / DM) + EPS);
#pragma unroll
            for (int j = 0; j < 4; ++j) { const int col = j * 256 + lane * 4;
                const f32x4 g = *(const f32x4*)(gn + col), s1 = *(const f32x4*)(sc + col), s0 = *(const f32x4*)(sh + col);
                v[q][j] = v[q][j] * r * g * (s1 + 1.f) + s0;
                u32x2 o; o.x = pk2(v[q][j][0], v[q][j][1]); o.y = pk2(v[q][j][2], v[q][j][3]); *(u32x2*)(H2B + (size_t)(row0 + q) * DM + col) = o; } }
#pragma unroll 1
        for (int eg = 0; eg < 18; ++eg) { float a[2][4];
#pragma unroll
            for (int u = 0; u < 2; ++u) { const float* wr = WRT + (eg * 2 + u) * 1024 + lane * 4; f32x4 wv[4];
#pragma unroll
                for (int j = 0; j < 4; ++j) wv[j] = *(const f32x4*)(wr + j * 256);
#pragma unroll
                for (int q = 0; q < 4; ++q) { float t = 0.f;
#pragma unroll
                    for (int j = 0; j < 4; ++j) t += (v[q][j][0] * wv[j][0] + v[q][j][1] * wv[j][1]) + (v[q][j][2] * wv[j][2] + v[q][j][3] * wv[j][3]);
                    a[u][q] = t; } }
#pragma unroll
            for (int u = 0; u < 2; ++u)
#pragma unroll
                for (int q = 0; q < 4; ++q) a[u][q] = wave_sum(a[u][q]);
            if (lane == 0) {
#pragma unroll
                for (int q = 0; q < 4; ++q) { lgs[q * 64 + eg * 2] = a[0][q]; lgs[q * 64 + eg * 2 + 1] = a[1][q]; } } }
        LDS_WAIT(); asm volatile("" ::: "memory");
        if (lane < 4) { const LAS float* lg = lgs + lane * 64; const int row = row0 + lane;
            float lc[4];
#pragma unroll
            for (int i = 0; i < 4; ++i) lc[i] = lg[i] + p.in[19][l * 4 + i];
            int grp = 0; float mx = lc[0];
#pragma unroll
            for (int i = 1; i < 4; ++i) if (lc[i] > mx) { mx = lc[i]; grp = i; }
            float z = 0.f;
#pragma unroll
            for (int i = 0; i < 4; ++i) z += __expf(lc[i] - mx);
            const float pg = 1.f / z;
            float f1 = -INFINITY, f2 = -INFINITY; int e1 = 0, e2 = 0;
#pragma unroll
            for (int i = 0; i < 8; ++i) { const float x = lg[4 + grp * 8 + i] + p.in[21][l * 32 + grp * 8 + i];
                if (x > f1) { f2 = f1; e2 = e1; f1 = x; e1 = i; } else if (x > f2) { f2 = x; e2 = i; } }
            const float q2 = __expf(f2 - f1); const float w1 = pg / (1.f + q2), w2 = pg * q2 / (1.f + q2);
            const int x1 = grp * 8 + e1, x2 = grp * 8 + e2;
            EID[row * 2] = x1; EID[row * 2 + 1] = x2; WTS[row * 2] = w1; WTS[row * 2 + 1] = w2;
            __hip_atomic_fetch_add(hist + x1, 1, __ATOMIC_RELAXED, __HIP_MEMORY_SCOPE_WORKGROUP); __hip_atomic_fetch_add(hist + x2, 1, __ATOMIC_RELAXED, __HIP_MEMORY_SCOPE_WORKGROUP); }
        LDS_WAIT(); asm volatile("" ::: "memory");
    }
    __syncthreads();
    if (c.tid < 32) WSP(int, WS_MISC + MISC_HIST)[c.bid * 32 + c.tid] = hist[c.tid];
}

struct MoeTab { LAS int* start; LAS int* tile_e; LAS int* ntiles; };
DEV MoeTab build_moe_tab(const Params& p, const Ctx& c, int l) {
    MoeTab T; T.start = (LAS int*)(c.lds + LDS_AUX + 1024); T.tile_e = T.start + 32; T.ntiles = T.tile_e + 192;
    __syncthreads();
    if (c.tid == 0) { const unsigned* cnt = WSP(unsigned, WS_CTL) + CW_CNT + l * 32; int row = 0, nt = 0;
        for (int e = 0; e < 32; ++e) { const int n = (int)__hip_atomic_load(cnt + e, __ATOMIC_RELAXED, __HIP_MEMORY_SCOPE_AGENT); T.start[e] = row; const int tiles = (n + 255) >> 8;
            for (int i = 0; i < tiles; ++i) T.tile_e[nt + i] = e;
            nt += tiles; row += tiles * 256; }
        T.ntiles[0] = nt; }
    __syncthreads();
    return T;
}
DEV void phase_moesort(const Params& p, const Ctx& c, int l, int rep) {
    const int* HIST = WSP(int, WS_MISC + MISC_HIST);
    LAS int* part = (LAS int*)(c.lds + 4096);
    LAS int* base = part + 1024;
    LAS int* curs = base + 32;
    LAS int* tot = curs + 32;
    { const int e = c.tid & 31, seg = c.tid >> 5; int sa = 0, sp = 0;
      for (int i = 0; i < 16; ++i) { const int bb = seg * 16 + i; if (bb < c.G) { const int hv = HIST[bb * 32 + e]; sa += hv; sp += bb < c.bid ? hv : 0; } }
      part[seg * 32 + e] = sa; part[512 + seg * 32 + e] = sp; }
    __syncthreads();
    if (c.tid < 32) { int sa = 0, sp = 0;
        for (int i = 0; i < 16; ++i) { sa += part[i * 32 + c.tid]; sp += part[512 + i * 32 + c.tid]; }
        tot[c.tid] = sa; base[c.tid] = sp; curs[c.tid] = 0;
        if (c.bid == 0) WSP(unsigned, WS_CTL)[CW_CNT + l * 32 + c.tid] = (unsigned)sa; }
    __syncthreads();
    if (c.tid == 0) { int row = 0; for (int e = 0; e < 32; ++e) { base[e] += row; row += ((tot[e] + 255) >> 8) << 8; } }
    __syncthreads();
    const int* EID = WSP(int, WS_MISC + MISC_EID); int* PSLOT = WSP(int, WS_MISC + MISC_PSLOT);
    const bf16_t* H2B = WSP(bf16_t, WS_HBF); bf16_t* XS = (bf16_t*)(p.ws + WS_BIG + BIG_XS);
    const int lane = c.lane; const int rpb = NTOK / c.G, rpw = rpb / 8;
    for (int ri = 0; ri < rpw; ++ri) { const int tok = c.bid * rpb + c.wave * rpw + ri;
        const u32x4 a = *(const u32x4*)(H2B + (size_t)tok * DM + lane * 16), b2 = *(const u32x4*)(H2B + (size_t)tok * DM + lane * 16 + 8);
#pragma unroll
        for (int k = 0; k < 2; ++k) { const int e = EID[tok * 2 + k]; int slot = 0;
            if (lane == 0) slot = base[e] + __hip_atomic_fetch_add(curs + e, 1, __ATOMIC_RELAXED, __HIP_MEMORY_SCOPE_WORKGROUP);
            slot = __builtin_amdgcn_readfirstlane(slot);
            if (lane == 0) PSLOT[tok * 2 + k] = slot;
            *(u32x4*)(XS + (size_t)slot * DM + lane * 16) = a; *(u32x4*)(XS + (size_t)slot * DM + lane * 16 + 8) = b2; }
    }
}
template <int NCOL> struct MoeOrder { int G, c; LAS const int* tile_e; int ntiles;
    DEV bool next(int i, pg8::Unit& u) const { const int L = i * G + c; if (L >= ntiles * NCOL) return false; const int pm = L / NCOL; u.pm = pm; u.pn = tile_e[pm] * NCOL + (L % NCOL); u.ao = 0; return true; } };
struct FMoe1 { bf16_t* ACTB;
    DEV void operator()(int row, int col, const f32x4& v0, const f32x4& v1) const { const int ce = col & 511;
        u32x2 w; w.x = pk2(silu_(v0[0]) * v0[1], silu_(v0[2]) * v0[3]); w.y = pk2(silu_(v1[0]) * v1[1], silu_(v1[2]) * v1[3]);
        *(u32x2*)(ACTB + (size_t)row * 256 + (ce >> 1)) = w; } };
struct FMoe2 { bf16_t* YP;
    DEV void operator()(int row, int col, const f32x4& v0, const f32x4& v1) const { const int ce = col & 1023;
        u32x4 w; w.x = pk2(v0[0], v0[1]); w.y = pk2(v0[2], v0[3]); w.z = pk2(v1[0], v1[1]); w.w = pk2(v1[2], v1[3]); *(u32x4*)(YP + (size_t)row * DM + ce) = w; } };
DEV void phase_moe1(const Params& p, const Ctx& c, int l) {
    const MoeTab T = build_moe_tab(p, c, l);
    pg8::Gemm g{(const bf16_t*)(p.ws + WS_BIG + BIG_XS), WSP(bf16_t, WS_W13) + (size_t)l * 32 * 512 * 1024, 1024, 1024};
    MoeOrder<2> S{c.G, c.bid, T.tile_e, T.ntiles[0]}; pg8::Epi8<FMoe1> E{{WSP(bf16_t, WS_MUR)}};
    pg8::gemm_phase<pg8::Epi8<FMoe1>, MoeOrder<2>, true>(c.lds, g, S, E);
}
DEV void phase_moe2(const Params& p, const Ctx& c, int l) {
    const MoeTab T = build_moe_tab(p, c, l);
    pg8::Gemm g{WSP(bf16_t, WS_MUR), WSP(bf16_t, WS_W2) + (size_t)l * 32 * 1024 * 256, 256, 256};
    MoeOrder<4> S{c.G, c.bid, T.tile_e, T.ntiles[0]}; pg8::Epi8<FMoe2> E{{(bf16_t*)(p.ws + WS_BIG + BIG_YP)}};
    pg8::gemm_phase<pg8::Epi8<FMoe2>, MoeOrder<4>, true>(c.lds, g, S, E);
}

constexpr int PH_PRO = 0, PH_NORM1 = 1, PH_INPROJ = 2, PH_POST = 3, PH_MLAUP = 4, PH_POST2 = 5, PH_ATTN = 6, PH_CMPATTN = 7, PH_TOPK = 8, PH_SLC = 9,
              PH_MERGE0 = 10, PH_MERGE1 = 11, PH_MERGE2 = 12, PH_MERGE3 = 13, PH_OUT = 14, PH_ROUTER = 15, PH_SORT = 16, PH_MOE1 = 17, PH_MOE2 = 18, PH_FINAL = 19, PH_COUNT = 20;
constexpr int LDS_PTAB = LDS_AUX + 64;
DEV unsigned long long uni64(unsigned long long v) { const unsigned lo = __builtin_amdgcn_readfirstlane((unsigned)v), hi = __builtin_amdgcn_readfirstlane((unsigned)(v >> 32)); return ((unsigned long long)hi << 32) | lo; }
DEV void store_params(const Params& p, LAS unsigned char* lds) {
    LAS unsigned long long* L = (LAS unsigned long long*)(lds + LDS_PTAB);
    if (threadIdx.x == 0) {
#pragma unroll
        for (int i = 0; i < 24; ++i) L[i] = (unsigned long long)p.in[i];
        L[24] = (unsigned long long)p.out; L[25] = (unsigned long long)p.ws; }
}
DEV Params load_params(LAS unsigned char* lds) {
    const LAS unsigned long long* L = (const LAS unsigned long long*)(lds + LDS_PTAB); Params p;
#pragma unroll
    for (int i = 0; i < 24; ++i) p.in[i] = (const float*)uni64(L[i]);
    p.out = (float*)uni64(L[24]); p.ws = (unsigned char*)uni64(L[25]); return p;
}
template <int PH, int REP = 0> DEV void run_phase(const Params& p, const Ctx& c, int l) {
    if constexpr (PH == PH_PRO) phase_prologue(p, c);
    else if constexpr (PH == PH_NORM1) phase_norm1<true, REP == 0>(p, c, l);
    else if constexpr (PH == PH_INPROJ) phase_inproj(p, c, l);
    else if constexpr (PH == PH_POST) phase_post(p, c, l);
    else if constexpr (PH == PH_MLAUP) phase_mlaup(p, c, l);
    else if constexpr (PH == PH_POST2) phase_post2(p, c, l);
    else if constexpr (PH == PH_ATTN) phase_cmpw2(p, c, l);
    else if constexpr (PH == PH_CMPATTN) phase_cmpsel(p, c, l);
    else if constexpr (PH == PH_TOPK) { }
    else if constexpr (PH == PH_SLC) phase_attn2(p, c, l + 8 * REP);
    else if constexpr (PH == PH_MERGE0) phase_merge<0>(p, c, l);
    else if constexpr (PH == PH_OUT) phase_out<REP == 0>(p, c, l);
    else if constexpr (PH == PH_ROUTER) phase_router<REP == 0>(p, c, l);
    else if constexpr (PH == PH_SORT) phase_moesort(p, c, l, REP);
    else if constexpr (PH == PH_MOE1) phase_moe1(p, c, l);
    else if constexpr (PH == PH_MOE2) phase_moe2(p, c, l);
    else if constexpr (PH == PH_FINAL) phase_norm1<false, true>(p, c, NLAYER);
}

#if !MK_ONE_LAUNCH
template <int PH> __global__ void __launch_bounds__(512, 2) k_phase(Params p, int l) {
    extern __shared__ __attribute__((aligned(16))) unsigned char lds_raw[];
    const Ctx c = make_ctx((LAS unsigned char*)lds_raw);
    run_phase<PH>(p, c, l);
}
template <int PH> static void launch_phase(const Params& p, int l, int grid, hipStream_t stream) {
    static bool attr_set = false;
    if (!attr_set) { (void)hipFuncSetAttribute((const void*)k_phase<PH>, hipFuncAttributeMaxDynamicSharedMemorySize, LDS_BYTES); attr_set = true; }
    hipLaunchKernelGGL(k_phase<PH>, dim3(grid), dim3(512), LDS_BYTES, stream, p, l);
}
#else
#define BAR() xcd_barrier_fn(bar.bar, bar.x, bar.st)
template <int l> DEV void mega_layer(LAS unsigned char* lds, const XcdBarrier& bar) {
        { const Ctx c = make_ctx(lds); const Params q = load_params(lds); run_phase<PH_NORM1>(q, c, l); } BAR(); if constexpr ((PROBE_MASK >> PH_NORM1) & 1u) { { const Ctx c = make_ctx(lds); const Params q = load_params(lds); run_phase<PH_NORM1, 1>(q, c, l); } BAR(); }
        { const Ctx c = make_ctx(lds); const Params q = load_params(lds); run_phase<PH_INPROJ>(q, c, l); } BAR(); if constexpr ((PROBE_MASK >> PH_INPROJ) & 1u) { { const Ctx c = make_ctx(lds); const Params q = load_params(lds); run_phase<PH_INPROJ, 1>(q, c, l); } BAR(); }
        { const Ctx c = make_ctx(lds); const Params q = load_params(lds); run_phase<PH_POST>(q, c, l); } BAR(); if constexpr ((PROBE_MASK >> PH_POST) & 1u) { { const Ctx c = make_ctx(lds); const Params q = load_params(lds); run_phase<PH_POST, 1>(q, c, l); } BAR(); }
        { const Ctx c = make_ctx(lds); const Params q = load_params(lds); run_phase<PH_MLAUP>(q, c, l); } BAR(); if constexpr ((PROBE_MASK >> PH_MLAUP) & 1u) { { const Ctx c = make_ctx(lds); const Params q = load_params(lds); run_phase<PH_MLAUP, 1>(q, c, l); } BAR(); }
        { const Ctx c = make_ctx(lds); const Params q = load_params(lds); run_phase<PH_POST2>(q, c, l); } BAR(); if constexpr ((PROBE_MASK >> PH_POST2) & 1u) { { const Ctx c = make_ctx(lds); const Params q = load_params(lds); run_phase<PH_POST2, 1>(q, c, l); } BAR(); }
        { const Ctx c = make_ctx(lds); const Params q = load_params(lds); run_phase<PH_ATTN>(q, c, l); } BAR(); if constexpr ((PROBE_MASK >> PH_ATTN) & 1u) { { const Ctx c = make_ctx(lds); const Params q = load_params(lds); run_phase<PH_ATTN, 1>(q, c, l); } BAR(); }
        { const Ctx c = make_ctx(lds); const Params q = load_params(lds); run_phase<PH_CMPATTN>(q, c, l); } BAR(); if constexpr ((PROBE_MASK >> PH_CMPATTN) & 1u) { { const Ctx c = make_ctx(lds); const Params q = load_params(lds); run_phase<PH_CMPATTN, 1>(q, c, l); } BAR(); }
        { const Ctx c = make_ctx(lds); const Params q = load_params(lds); run_phase<PH_SLC>(q, c, l); } BAR(); if constexpr ((PROBE_MASK >> PH_SLC) & 1u) { { const Ctx c = make_ctx(lds); const Params q = load_params(lds); run_phase<PH_SLC, 1>(q, c, l); } BAR(); }
        { const Ctx c = make_ctx(lds); const Params q = load_params(lds); run_phase<PH_MERGE0>(q, c, l); } BAR(); if constexpr ((PROBE_MASK >> PH_MERGE0) & 1u) { { const Ctx c = make_ctx(lds); const Params q = load_params(lds); run_phase<PH_MERGE0, 1>(q, c, l); } BAR(); }
        { const Ctx c = make_ctx(lds); const Params q = load_params(lds); run_phase<PH_OUT>(q, c, l); } BAR(); if constexpr ((PROBE_MASK >> PH_OUT) & 1u) { { const Ctx c = make_ctx(lds); const Params q = load_params(lds); run_phase<PH_OUT, 1>(q, c, l); } BAR(); }
        { const Ctx c = make_ctx(lds); const Params q = load_params(lds); run_phase<PH_ROUTER>(q, c, l); } BAR(); if constexpr ((PROBE_MASK >> PH_ROUTER) & 1u) { { const Ctx c = make_ctx(lds); const Params q = load_params(lds); run_phase<PH_ROUTER, 1>(q, c, l); } BAR(); }
        { const Ctx c = make_ctx(lds); const Params q = load_params(lds); run_phase<PH_SORT>(q, c, l); } BAR(); if constexpr ((PROBE_MASK >> PH_SORT) & 1u) { { const Ctx c = make_ctx(lds); const Params q = load_params(lds); run_phase<PH_SORT, 1>(q, c, l); } BAR(); }
        { const Ctx c = make_ctx(lds); const Params q = load_params(lds); run_phase<PH_MOE1>(q, c, l); } BAR(); if constexpr ((PROBE_MASK >> PH_MOE1) & 1u) { { const Ctx c = make_ctx(lds); const Params q = load_params(lds); run_phase<PH_MOE1, 1>(q, c, l); } BAR(); }
        { const Ctx c = make_ctx(lds); const Params q = load_params(lds); run_phase<PH_MOE2>(q, c, l); } BAR(); if constexpr ((PROBE_MASK >> PH_MOE2) & 1u) { { const Ctx c = make_ctx(lds); const Params q = load_params(lds); run_phase<PH_MOE2, 1>(q, c, l); } BAR(); }
}
__global__ void __launch_bounds__(512, 2) k_mega(Params p) {
    extern __shared__ __attribute__((aligned(16))) unsigned char lds_raw[];
    LAS unsigned char* lds = (LAS unsigned char*)lds_raw;
    volatile LAS unsigned* bst = (volatile LAS unsigned*)(lds + LDS_AUX);
    if (threadIdx.x < 4) bst[threadIdx.x] = 0u;
    store_params(p, lds);
    __syncthreads();
    const XcdBarrier bar = xcd_barrier_post(WSP(unsigned, WS_CTL) + CW_BAR, bst);
    { const Ctx c = make_ctx(lds); const Params q = load_params(lds); run_phase<PH_PRO>(q, c, 0); } BAR(); if constexpr ((PROBE_MASK >> PH_PRO) & 1u) { { const Ctx c = make_ctx(lds); const Params q = load_params(lds); run_phase<PH_PRO, 1>(q, c, 0); } BAR(); }
    mega_layer<0>(lds, bar); mega_layer<1>(lds, bar); mega_layer<2>(lds, bar); mega_layer<3>(lds, bar);
    { const Ctx c = make_ctx(lds); const Params q = load_params(lds); run_phase<PH_FINAL>(q, c, NLAYER); }
#undef BAR
}
#endif

extern "C" void kernel_launch(void* const* d_in, const int* in_sizes, int n_in, void* d_out, int out_size, void* d_ws, size_t ws_size, hipStream_t stream) {
    if (n_in != 24 || out_size != NTOK * DM || ws_size < WS_END) { fprintf(stderr, "kernel_launch: unexpected shapes (n_in %d out %d ws %zu, need %zu)\n", n_in, out_size, ws_size, (size_t)WS_END); return; }
    Params p{};
    for (int i = 0; i < 24; ++i) p.in[i] = (const float*)d_in[i];
    p.out = (float*)d_out; p.ws = (unsigned char*)d_ws;
    (void)hipMemsetAsync((char*)d_ws + WS_CTL, 0, 1 * MiB, stream);
    const int grid = 256;
#if !MK_ONE_LAUNCH
    launch_phase<PH_PRO>(p, 0, grid, stream);
    for (int l = 0; l < NLAYER; ++l) {
        launch_phase<PH_NORM1>(p, l, grid, stream);
        launch_phase<PH_INPROJ>(p, l, grid, stream);
        launch_phase<PH_POST>(p, l, grid, stream);
        launch_phase<PH_MLAUP>(p, l, grid, stream);
        launch_phase<PH_POST2>(p, l, grid, stream);
        launch_phase<PH_ATTN>(p, l, grid, stream);
        launch_phase<PH_CMPATTN>(p, l, grid, stream);
        launch_phase<PH_SLC>(p, l, grid, stream);
        launch_phase<PH_MERGE0>(p, l, grid, stream);
        launch_phase<PH_OUT>(p, l, grid, stream);
        launch_phase<PH_ROUTER>(p, l, grid, stream);
        launch_phase<PH_SORT>(p, l, grid, stream);
        launch_phase<PH_MOE1>(p, l, grid, stream);
        launch_phase<PH_MOE2>(p, l, grid, stream);
    }
    launch_phase<PH_FINAL>(p, NLAYER, grid, stream);
#else
    static bool attr_set = false;
    if (!attr_set) { (void)hipFuncSetAttribute((const void*)k_mega, hipFuncAttributeMaxDynamicSharedMemorySize, LDS_BYTES); attr_set = true; }
    hipLaunchKernelGGL(k_mega, dim3(grid), dim3(512), LDS_BYTES, stream, p);
#endif
}
```

```cpp
#include <hip/hip_runtime.h>
#include <cstdio>
#include <cstdint>
#include <cmath>

#ifndef MK_ONE_LAUNCH
#define MK_ONE_LAUNCH 1
#endif
#ifndef PROBE_MASK
#define PROBE_MASK 0u
#endif

#define DEV __device__ __forceinline__
#define LAS __attribute__((address_space(3)))
typedef unsigned short bf16_t;
typedef short bf16x8 __attribute__((ext_vector_type(8)));
typedef float f32x4 __attribute__((ext_vector_type(4)));
typedef unsigned u32x4 __attribute__((ext_vector_type(4)));
typedef unsigned u32x2 __attribute__((ext_vector_type(2)));

constexpr int NBATCH = 4, SEQ = 4096, DM = 1024, NTOK = NBATCH * SEQ, NLAYER = 4;
constexpr int DIN = 6572, NSMALL = 2476, PSW = 2560, NPROJ = 6656, NGATE = 4096;
constexpr int I_QA = 0, I_KC = 256, I_VC = 320, I_KS = 384, I_VS = 448, I_KW = 512, I_VW = 576, I_GL = 640, I_QB = 652, I_KB = 908, I_VB = 1036,
              I_QC = 1164, I_KCC = 1420, I_VCC = 1676, I_CQ = 1932, I_CKV = 2316, I_KR = 2444;
constexpr int ACTW = 2560;
constexpr int A_QA = 0, A_KCR = 256, A_VCR = 320, A_KS = 384, A_VS = 448, A_KW = 512, A_VW = 576, A_QB = 640, A_KB = 896, A_VB = 1024,
              A_QC = 1152, A_KC = 1408, A_VC = 1664, A_CQ = 1920, A_CKV = 2304, A_KR = 2432;
constexpr int ACT2W = 896, A2_QF = 0, A2_KN = 384, A2_VD = 640;
constexpr int NCMP = 255, NEXP = 32, XS_ROWS = 40960;
constexpr float EPS = 1e-6f;
__device__ const float SLOPES[3][4] = {{0.70710678118654752f, 0.25f, 0.08838834764831845f, 0.015625f},
                                       {0.5f, 0.17677669529663689f, 0.0625f, 0.0078125f},
                                       {0.35355339059327379f, 0.125f, 0.03125f, 0.00390625f}};

constexpr size_t MiB = 1u << 20;
constexpr size_t WS_CTL = 0;
constexpr size_t WS_MOD = 1 * MiB;
constexpr size_t WS_ROPE = 2 * MiB;
constexpr size_t WS_MISC = 3 * MiB;
constexpr size_t WS_WIN = 8 * MiB;
constexpr size_t WS_W13 = WS_WIN + 56 * MiB;
constexpr size_t WS_W2 = WS_W13 + 128 * MiB;
constexpr size_t WS_WOUT = WS_W2 + 64 * MiB;
constexpr size_t WS_WBR = WS_WOUT + 8 * MiB;
constexpr size_t WS_CW1 = WS_WBR + 8 * MiB;
constexpr size_t WS_WU = WS_CW1 + 8 * MiB;
constexpr size_t WS_HBF = WS_WU + 4 * MiB;
constexpr size_t WS_BIG = WS_HBF + 32 * MiB;
constexpr size_t WS_GATES = WS_BIG + 160 * MiB;
constexpr size_t WS_ACT = WS_GATES + 128 * MiB;
constexpr size_t WS_ACT2 = WS_ACT + 80 * MiB;
constexpr size_t WS_MUR = WS_ACT2 + 28 * MiB;
constexpr size_t WS_CMPA = WS_MUR + 64 * MiB;
constexpr size_t WS_HID = WS_CMPA + 8 * MiB;
constexpr size_t WS_PB = WS_HID + 1 * MiB;
constexpr size_t WS_OCMP = WS_PB + 16 * MiB;
constexpr size_t WS_OWIN = WS_OCMP + 16 * MiB;
constexpr size_t WS_SMALL = WS_OWIN + 16 * MiB;
constexpr size_t WS_BR = WS_SMALL + 2 * MiB;
constexpr size_t WS_END = WS_BR + 32 * MiB;
static_assert(WS_END <= 1000 * MiB, "workspace map");
constexpr size_t BIG_PSM = 0, BIG_MIX = 0, BIG_MIXB = 64 * MiB, BIG_XS = 0, BIG_YP = 80 * MiB;
constexpr size_t MISC_HIST = 3 * MiB;
constexpr size_t MISC_KCB = 1024 * 1024, MISC_VCB = 1024 * 1024 + 128 * 1024, MISC_WRT = 2 * MiB;
constexpr size_t MISC_KCMP = 0, MISC_VCMP = 256 * 1024, MISC_KMEAN = 512 * 1024, MISC_EID = 640 * 1024, MISC_WTS = 768 * 1024, MISC_PSLOT = 896 * 1024;
constexpr size_t SM_PL = 0, SM_SEL = 256 * 1024, SM_GA = 512 * 1024;
constexpr int CW_BAR = 4096;
constexpr int CW_CNT = 16384;
constexpr int CW_CUR = 16384 + 256;

constexpr int RING_BYTES = 131072, LDS_AUX = RING_BYTES, LDS_BYTES = 147456;

struct Params { const float* in[24]; float* out; unsigned char* ws; };

DEV float bf2f(unsigned v) { return __uint_as_float(v << 16); }
DEV float bflo(unsigned w) { return __uint_as_float(w << 16); }
DEV float bfhi(unsigned w) { return __uint_as_float(w & 0xffff0000u); }
DEV unsigned f2bf(float f) { unsigned u = __float_as_uint(f); return (u + 0x7fffu + ((u >> 16) & 1u)) >> 16; }
DEV unsigned pk2(float lo, float hi) { return f2bf(lo) | (f2bf(hi) << 16); }
template <int M> DEV float swz_xor(float v) { return __int_as_float(__builtin_amdgcn_ds_swizzle(__float_as_int(v), (M << 10) | 0x1f)); }
template <int M> DEV int swz_xor_i(int v) { return __builtin_amdgcn_ds_swizzle(v, (M << 10) | 0x1f); }
DEV float xhalf(float v, float& other) { auto rr = __builtin_amdgcn_permlane32_swap(__float_as_uint(v), __float_as_uint(v), false, false); other = __uint_as_float(rr[1]); return __uint_as_float(rr[0]); }
DEV float wave_sum(float v) {
    v += swz_xor<1>(v); v += swz_xor<2>(v); v += swz_xor<4>(v); v += swz_xor<8>(v); v += swz_xor<16>(v);
    float hi; const float lo = xhalf(v, hi); return lo + hi;
}
DEV float sigm(float x) { return 1.f / (1.f + __expf(-x)); }
DEV float silu_(float x) { return x / (1.f + __expf(-x)); }
#define LDS_WAIT() asm volatile("s_waitcnt lgkmcnt(0)" ::: "memory")

namespace pg8 {
constexpr int BM = 256, BK = 64, HALF = 128, HTB = HALF * BK * 2, STAGE_BYTES = 8 * HTB, NXCD = 8, WGM = 8;
__host__ __device__ __forceinline__ int lds_byte(int r, int c) { const int st = (r >> 4) * 2 + (c >> 5), rr = r & 15, cc = c & 31, ob = rr * 64 + cc * 2; return st * 1024 + (ob ^ (((ob >> 9) & 1) << 5)); }
__host__ __device__ __forceinline__ void stage_rc(int b, int& R, int& C) { const int st = b / 1024, sb = b % 1024, swz = sb ^ (((sb >> 9) & 1) << 5); R = (st >> 1) * 16 + swz / 64; C = (st & 1) * 32 + (swz % 64) / 2; }
__host__ __device__ __forceinline__ int perm32(int rho) { const int n = rho >> 4, i = rho & 15; return 8 * (i >> 2) + 4 * n + (i & 3); }
struct Unit { int pm, pn, ao; };
struct Gemm { const bf16_t* A; const bf16_t* Bt; int lda, K; };
struct StaticOrder {
    int nM, nN, nwg, G, c;
    __device__ void init(int M, int N, int G_, int c_) { nM = M / BM; nN = N / BM; nwg = nM * nN; G = G_; c = c_; }
    __device__ bool next(int i, Unit& u) const {
        const long L = (long)i * G + c; if (L >= nwg) return false;
        int wgid = (int)L; { const int q = nwg / NXCD, r = nwg % NXCD, xcd = wgid % NXCD, off = wgid / NXCD; wgid = (xcd < r ? xcd * (q + 1) : r * (q + 1) + (xcd - r) * q) + off; }
        const int nig = WGM * nN, gid = wgid / nig, fm = gid * WGM, gsz = (nM - fm) < WGM ? (nM - fm) : WGM;
        u.pm = fm + ((wgid % nig) % gsz); u.pn = (wgid % nig) / gsz; u.ao = 0; return true;
    }
};
template <class F> struct Epi8 {
    F f;
    __device__ __forceinline__ void operator()(const f32x4 (&acc)[2][2][4][2], const Unit& u, int wr, int wc, int fr, int fq) const {
        const int row0 = u.pm * BM + wr * 64 + fr, col0 = u.pn * BM + wc * 32 + 8 * fq;
#pragma unroll
        for (int ai = 0; ai < 2; ++ai)
#pragma unroll
            for (int m = 0; m < 4; ++m)
#pragma unroll
                for (int bj = 0; bj < 2; ++bj) f(row0 + ai * HALF + m * 16, col0 + bj * HALF, acc[ai][bj][m][0], acc[ai][bj][m][1]);
    }
};
template <class Epi, class Sched, bool ALIGN_EPI>
__device__ __forceinline__ void gemm_phase(LAS unsigned char* lds, const Gemm g, const Sched& S, const Epi& E) {
    int tid_ = threadIdx.x; asm volatile("" : "+v"(tid_));
    const int tid = tid_, wid = __builtin_amdgcn_readfirstlane(tid >> 6), lane = tid & 63, wr = wid >> 2, wc = wid & 3, fr = lane & 15, fq = lane >> 4;
    const int K = g.K, nt = K / BK, lda = g.lda;
    unsigned voffA[2], voffB[2];
#pragma unroll
    for (int i = 0; i < 2; ++i) { int R, C; stage_rc(tid * 16 + i * 8192, R, C); const int Rb = (R & ~31) + perm32(R & 31);
        voffA[i] = (unsigned)(R * lda + C) * 2u; voffB[i] = (unsigned)(Rb * K + C) * 2u; }
    const size_t kstep = (size_t)(BK * 2);
    const size_t hstepA = (size_t)HALF * lda * 2, tstepA = 2 * hstepA;
    const size_t hstepB = (size_t)HALF * K * 2, tstepB = 2 * hstepB;
    const unsigned ldsw = (unsigned)wid * 1024u;
    const int aoff = lds_byte(wr * 64 + fr, fq * 8), boff = lds_byte(wc * 32 + fr, fq * 8);
#define PG8_SA(b, h) (((b) * 2 + (h)) * HTB)
#define PG8_SB(b, h) ((4 + (b) * 2 + (h)) * HTB)
#define PG8_STAGE(bufoff, gbase, voff) do { _Pragma("unroll") for (int _i = 0; _i < 2; ++_i) \
        __builtin_amdgcn_global_load_lds((const unsigned*)((const char*)(gbase) + (voff)[_i]), (LAS unsigned*)(lds + (bufoff) + ldsw + _i * 8192), 16, 0, 0); } while (0)
#define PG8_LDA(dst, b, h) do { _Pragma("unroll") for (int m = 0; m < 4; ++m) _Pragma("unroll") for (int k = 0; k < 2; ++k) dst[m][k] = *(const LAS bf16x8*)(lds + PG8_SA(b, h) + aoff + m * 2048 + k * 1024); } while (0)
#define PG8_LDB(dst, b, h) do { _Pragma("unroll") for (int n = 0; n < 2; ++n) _Pragma("unroll") for (int k = 0; k < 2; ++k) dst[n][k] = *(const LAS bf16x8*)(lds + PG8_SB(b, h) + boff + n * 2048 + k * 1024); } while (0)
#define PG8_MMA(ai, bj, At, Bt) do { __builtin_amdgcn_s_setprio(1); _Pragma("unroll") for (int m = 0; m < 4; ++m) _Pragma("unroll") for (int n = 0; n < 2; ++n) _Pragma("unroll") for (int k = 0; k < 2; ++k) \
        acc[ai][bj][m][n] = __builtin_amdgcn_mfma_f32_16x16x32_bf16(Bt[n][k], At[m][k], acc[ai][bj][m][n], 0, 0, 0); __builtin_amdgcn_s_setprio(0); } while (0)
#define PG8_WAIT_V(n) asm volatile("s_waitcnt vmcnt(" #n ")" ::: "memory")
#define PG8_WAIT_L(n) asm volatile("s_waitcnt lgkmcnt(" #n ")" ::: "memory")
#define PG8_BAR __builtin_amdgcn_s_barrier()
#define PG8_SCHED __builtin_amdgcn_sched_barrier(0)
    Unit cur, nxt; int ui = 0;
    if (!S.next(0, cur)) return;
    f32x4 acc[2][2][4][2];
#pragma unroll
    for (int a = 0; a < 2; ++a)
#pragma unroll
        for (int b = 0; b < 2; ++b)
#pragma unroll
            for (int m = 0; m < 4; ++m)
#pragma unroll
                for (int n = 0; n < 2; ++n) acc[a][b][m][n] = (f32x4){0.f, 0.f, 0.f, 0.f};
    bf16x8 At[4][2], B0[2][2], B1[2][2];
    const char* cA = (const char*)g.A + (size_t)cur.pm * tstepA + cur.ao; const char* cB = (const char*)g.Bt + (size_t)cur.pn * tstepB;
    PG8_STAGE(PG8_SB(0, 0), cB, voffB); PG8_STAGE(PG8_SB(0, 1), cB + hstepB, voffB); PG8_STAGE(PG8_SA(0, 0), cA, voffA); PG8_STAGE(PG8_SA(0, 1), cA + hstepA, voffA);
    if (wr == 1) PG8_BAR;
    PG8_WAIT_V(2); PG8_BAR;
    PG8_STAGE(PG8_SB(1, 0), cB + kstep, voffB); PG8_STAGE(PG8_SA(1, 0), cA + kstep, voffA); PG8_STAGE(PG8_SB(1, 1), cB + hstepB + kstep, voffB);
    PG8_WAIT_V(6); PG8_BAR;
    for (;;) {
        const bool has_next = S.next(ui + 1, nxt);
        const char* nA = has_next ? (const char*)g.A + (size_t)nxt.pm * tstepA + nxt.ao : cA; const char* nB = has_next ? (const char*)g.Bt + (size_t)nxt.pn * tstepB : cB;
        for (int t = 0; t < nt; t += 2) {
            const bool last = (t == nt - 2);
            const char* a1 = cA + (size_t)(t + 1) * kstep;
            const char* a2 = last ? nA : cA + (size_t)(t + 2) * kstep; const char* b2 = last ? nB : cB + (size_t)(t + 2) * kstep;
            const char* a3 = a2 + kstep; const char* b3 = b2 + kstep;
            PG8_LDB(B0, 0, 0); PG8_LDB(B1, 0, 1); PG8_SCHED; PG8_LDA(At, 0, 0); PG8_STAGE(PG8_SA(1, 1), a1 + hstepA, voffA);
            PG8_WAIT_V(8); PG8_WAIT_L(0); PG8_BAR; PG8_MMA(0, 0, At, B0); PG8_MMA(0, 1, At, B1); PG8_BAR; PG8_SCHED;
            PG8_LDA(At, 0, 1); PG8_STAGE(PG8_SB(0, 0), b2, voffB); PG8_STAGE(PG8_SB(0, 1), b2 + hstepB, voffB); PG8_STAGE(PG8_SA(0, 0), a2, voffA);
            PG8_WAIT_V(8); PG8_WAIT_L(0); PG8_BAR; PG8_MMA(1, 0, At, B0); PG8_MMA(1, 1, At, B1); PG8_BAR; PG8_SCHED;
            PG8_LDB(B0, 1, 0); PG8_LDB(B1, 1, 1); PG8_SCHED; PG8_LDA(At, 1, 0); PG8_STAGE(PG8_SA(0, 1), a2 + hstepA, voffA);
            PG8_WAIT_V(8); PG8_WAIT_L(0); PG8_BAR; PG8_MMA(0, 0, At, B0); PG8_MMA(0, 1, At, B1); PG8_BAR; PG8_SCHED;
            PG8_LDA(At, 1, 1); PG8_STAGE(PG8_SB(1, 0), b3, voffB); PG8_STAGE(PG8_SB(1, 1), b3 + hstepB, voffB); PG8_STAGE(PG8_SA(1, 0), a3, voffA);
            PG8_WAIT_V(8); PG8_WAIT_L(0); PG8_BAR; PG8_MMA(1, 0, At, B0); PG8_MMA(1, 1, At, B1); PG8_BAR; PG8_SCHED;
        }
        if constexpr (ALIGN_EPI) { if (wr == 0) PG8_BAR; }
        E(acc, cur, wr, wc, fr, fq);
        if (!has_next) break;
#pragma unroll
        for (int a = 0; a < 2; ++a)
#pragma unroll
            for (int b = 0; b < 2; ++b)
#pragma unroll
                for (int m = 0; m < 4; ++m)
#pragma unroll
                    for (int n = 0; n < 2; ++n) acc[a][b][m][n] = (f32x4){0.f, 0.f, 0.f, 0.f};
        cur = nxt; cA = nA; cB = nB; ++ui;
        if constexpr (ALIGN_EPI) { if (wr == 1) PG8_BAR; }
    }
    PG8_WAIT_V(0);
    if constexpr (!ALIGN_EPI) { if (wr == 0) PG8_BAR; }
    PG8_BAR;
#undef PG8_SA
#undef PG8_SB
#undef PG8_STAGE
#undef PG8_LDA
#undef PG8_LDB
#undef PG8_MMA
#undef PG8_WAIT_V
#undef PG8_WAIT_L
#undef PG8_BAR
#undef PG8_SCHED
}
}

#define XB_TMO      128
#define XB_XCNT(j)  (256  + 64 * (j))
#define XB_XSUB(j)  (1280 + 64 * (j))
#define XB_XGEN(j)  (2304 + 64 * (j))
#define XB_TOP      3328
#define XB_TOPGEN   3392
#define XCD_BAR_WORDS 3456
#define XB_SPIN_CAP (1u << 22)
__device__ __forceinline__ unsigned xb_ld(unsigned* p)              { return __hip_atomic_load(p, __ATOMIC_RELAXED, __HIP_MEMORY_SCOPE_AGENT); }
__device__ __forceinline__ unsigned xb_add(unsigned* p, unsigned v) { return __hip_atomic_fetch_add(p, v, __ATOMIC_RELAXED, __HIP_MEMORY_SCOPE_AGENT); }
__device__ __forceinline__ unsigned xb_xcc_id() { return (unsigned)__builtin_amdgcn_s_getreg((3 << 11) | 20) & 0xFu; }
#define XB_SPIN(cond, bar) do { unsigned _sp = 0; while (cond) { __builtin_amdgcn_s_sleep(1); \
    if ((++_sp & 255u) == 0u) { if (xb_ld(&(bar)[XB_TMO])) break; if (_sp > XB_SPIN_CAP) { atomicAdd(&(bar)[XB_TMO], 1u); break; } } } } while (0)
struct XcdBarrier { unsigned* bar; unsigned x; volatile LAS unsigned* st; };
__device__ __forceinline__ XcdBarrier xcd_barrier_post(unsigned* bar, volatile LAS unsigned* st) {
    XcdBarrier b; b.bar = bar; b.x = xb_xcc_id(); b.st = st;
    if (threadIdx.x == 0) (void)xb_add(&bar[XB_XCNT(b.x)], 1u);
    return b;
}
__device__ __forceinline__ void xcd_barrier_complete(unsigned* bar, unsigned x, unsigned& nloc, unsigned& nx) {
    const unsigned G = gridDim.x * gridDim.y * gridDim.z;
    unsigned sum, cnt, mine, sp = 0u;
    for (;;) {
        sum = 0u; cnt = 0u; mine = 0u;
#pragma unroll
        for (unsigned j = 0; j < 16; ++j) { const unsigned c = xb_ld(&bar[XB_XCNT(j)]); sum += c; cnt += (c > 0u) ? 1u : 0u; mine = (j == x) ? c : mine; }
        if (sum == G) break;
        __builtin_amdgcn_s_sleep(1);
        if ((++sp & 255u) == 0u) { if (xb_ld(&bar[XB_TMO])) break; if (sp > XB_SPIN_CAP) { atomicAdd(&bar[XB_TMO], 1u); break; } }
    }
    nloc = mine > 0u ? mine : 1u; nx = cnt > 0u ? cnt : 1u;
}
__device__ __noinline__ void xcd_barrier_fn(unsigned* bar_, unsigned x_, volatile LAS unsigned* st_) {
    XcdBarrier b; b.bar = bar_; b.x = x_; b.st = st_;
    asm volatile("s_waitcnt vmcnt(0)" ::: "memory");
    __syncthreads();
    if (threadIdx.x == 0) {
        unsigned* bar = b.bar;
        __builtin_amdgcn_s_waitcnt(0);
        unsigned nloc = b.st[0], nx = b.st[1];
        if (nloc == 0u) { xcd_barrier_complete(bar, b.x, nloc, nx); b.st[0] = nloc; b.st[1] = nx; }
        const unsigned old = xb_add(&bar[XB_XSUB(b.x)], 1u);
        const unsigned gen = old / nloc;
        if (old + 1u == (gen + 1u) * nloc) {
            __builtin_amdgcn_fence(__ATOMIC_RELEASE, "agent");
            asm volatile("s_waitcnt vmcnt(0)" ::: "memory");
            const unsigned og = xb_add(&bar[XB_TOP], 1u);
            const unsigned tg = og / nx;
            if (og + 1u == (tg + 1u) * nx) xb_add(&bar[XB_TOPGEN], 1u);
            else XB_SPIN(xb_ld(&bar[XB_TOPGEN]) == tg, bar);
            __builtin_amdgcn_fence(__ATOMIC_ACQUIRE, "agent");
            xb_add(&bar[XB_XGEN(b.x)], 1u);
            asm volatile("s_waitcnt vmcnt(0)" ::: "memory");
        } else {
            XB_SPIN(xb_ld(&bar[XB_XGEN(b.x)]) == gen, bar);
            __builtin_amdgcn_fence(__ATOMIC_ACQUIRE, "agent");
            asm volatile("s_waitcnt vmcnt(0)" ::: "memory");
        }
    }
    __syncthreads();
}

struct Ctx {
    int tid, lane, wave, gw, NGW, bid, G;
    LAS unsigned char* lds;
};
DEV Ctx make_ctx(LAS unsigned char* lds) {
    Ctx c; int tid_ = threadIdx.x; asm volatile("" : "+v"(tid_));
    c.tid = tid_; c.lane = c.tid & 63; c.wave = __builtin_amdgcn_readfirstlane(c.tid >> 6); { int b_ = blockIdx.x, g_ = gridDim.x; asm volatile("" : "+s"(b_), "+s"(g_)); c.bid = b_; c.G = g_; }
    c.gw = c.bid * 8 + c.wave; c.NGW = c.G * 8; c.lds = lds; return c;
}
#define WSP(T, off) ((T*)(p.ws + (off)))

DEV void transpose_item(const float* W, const float* W2, int ldw, int K, bf16_t* WT, int nblk, int mode, int nvalid, int item, LAS float* scr, int lane) {
    const int kb = item / nblk, nb = item % nblk, k0 = 64 * kb, n0 = 32 * nb;
    const int n = n0 + (lane & 31);
    const float* src = W; int c = -1; int ld = ldw; int kofs = 0;
    if (mode == 0) { c = n < nvalid ? n : -1; }
    else if (mode == 1) { c = n < NSMALL ? n : (n < PSW ? -1 : n - (PSW - NSMALL)); }
    else if (mode == 2) { c = (n & 1) ? 256 + (n >> 1) : (n >> 1); }
    else { if (n < 384 && k0 < 384) { c = n; ld = 384; } else if (n >= 512 && k0 >= 384) { src = W2; c = n - 512; ld = 512; kofs = 384; } }
#pragma unroll
    for (int i = 0; i < 32; ++i) { const int kk = 2 * i + (lane >> 5); scr[kk * 33 + (lane & 31)] = (c >= 0) ? src[(size_t)(k0 - kofs + kk) * ld + c] : 0.f; }
    LDS_WAIT(); asm volatile("" ::: "memory");
    const int c8 = lane & 7;
#pragma unroll
    for (int j = 0; j < 4; ++j) { const int nn = (lane >> 3) + 8 * j; const LAS float* s = scr + (8 * c8) * 33 + nn;
        u32x4 o; o.x = pk2(s[0 * 33], s[1 * 33]); o.y = pk2(s[2 * 33], s[3 * 33]); o.z = pk2(s[4 * 33], s[5 * 33]); o.w = pk2(s[6 * 33], s[7 * 33]);
        *(u32x4*)(WT + (size_t)(n0 + nn) * K + k0 + 8 * c8) = o; }
    LDS_WAIT(); asm volatile("" ::: "memory");
}
constexpr int IT_WIN = 16 * 208, IT_W13 = 256 * 32, IT_W2 = 128 * 32, IT_CW1 = 256 * 2, IT_WBR = 128 * 4, IT_WOUT = 512, IT_WU = 8 * 32;
constexpr int IT_LAYER = IT_WIN + IT_W13 + IT_W2 + IT_CW1 + IT_WBR + IT_WOUT + IT_WU;
DEV void phase_prologue(const Params& p, const Ctx& c) {
    { float* MOD = WSP(float, WS_MOD);
      LAS float* sc = (LAS float*)(c.lds + 73728);
      LAS float* ps = (LAS float*)(c.lds + 90112);
      for (int i = c.tid; i < 4096; i += 512) sc[i] = silu_(p.in[1][i]);
      __syncthreads();
      for (int it = c.bid; it < NLAYER * 96; it += c.G) { const int l = it / 96, j = (it % 96) * 64 + c.lane;
          const float* wa = p.in[2] + ((size_t)l * 1024 + c.wave * 128) * 6144 + j; const LAS float* s0 = sc + c.wave * 128;
          float a0 = 0.f, a1 = 0.f, a2 = 0.f, a3 = 0.f;
#pragma unroll 16
          for (int k = 0; k < 128; ++k) { const float w = wa[(size_t)k * 6144]; a0 += s0[k] * w; a1 += s0[1024 + k] * w; a2 += s0[2048 + k] * w; a3 += s0[3072 + k] * w; }
          ps[(c.wave * 4 + 0) * 64 + c.lane] = a0; ps[(c.wave * 4 + 1) * 64 + c.lane] = a1; ps[(c.wave * 4 + 2) * 64 + c.lane] = a2; ps[(c.wave * 4 + 3) * 64 + c.lane] = a3;
          __syncthreads();
          if (c.tid < 256) { const int bb = c.tid >> 6, jj = (it % 96) * 64 + (c.tid & 63); float a = p.in[3][l * 6144 + jj];
#pragma unroll
              for (int w8 = 0; w8 < 8; ++w8) a += ps[(w8 * 4 + bb) * 64 + (c.tid & 63)];
              MOD[(l * 4 + bb) * 6144 + jj] = a; }
          __syncthreads(); } }
    { float* RC = WSP(float, WS_ROPE); float* RS = RC + 4096 * 16;
      for (int i = c.bid * 512 + c.tid; i < 4096 * 16; i += c.G * 512) { const int pos = i >> 4, k = i & 15;
          const float inv = (float)pow(10000.0, -(double)k / 16.0); const float ang = (float)pos * inv;
          RC[i] = (float)cos((double)ang); RS[i] = (float)sin((double)ang); } }
    { float* WRT = WSP(float, WS_MISC + MISC_WRT);
      for (int i = c.bid * 512 + c.tid; i < NLAYER * 36 * 1024; i += c.G * 512) { const int k = i & 1023, e = (i >> 10) % 36, l = i / (36 * 1024);
          WRT[i] = e < 4 ? p.in[18][((size_t)l * 1024 + k) * 4 + e] : p.in[20][((size_t)l * 1024 + k) * 32 + (e - 4)]; } }
    LAS float* scr = (LAS float*)(c.lds + c.wave * 8448);
    for (int it = c.gw; it < IT_LAYER * NLAYER; it += c.NGW) {
        const int l = it / IT_LAYER; int r = it % IT_LAYER;
        if (r < IT_WIN) { transpose_item(p.in[5] + (size_t)l * 1024 * DIN, nullptr, DIN, 1024, WSP(bf16_t, WS_WIN) + (size_t)l * NPROJ * 1024, NPROJ / 32, 1, 0, r, scr, c.lane); continue; } r -= IT_WIN;
        if (r < IT_W13) { const int e = r / 256; transpose_item(p.in[22] + (size_t)(l * 32 + e) * 1024 * 512, nullptr, 512, 1024, WSP(bf16_t, WS_W13) + (size_t)(l * 32 + e) * 512 * 1024, 16, 2, 0, r % 256, scr, c.lane); continue; } r -= IT_W13;
        if (r < IT_W2) { const int e = r / 128; transpose_item(p.in[23] + (size_t)(l * 32 + e) * 256 * 1024, nullptr, 1024, 256, WSP(bf16_t, WS_W2) + (size_t)(l * 32 + e) * 1024 * 256, 32, 0, 1024, r % 128, scr, c.lane); continue; } r -= IT_W2;
        if (r < IT_CW1) { const int blk = r / 64, kv = blk >> 2, ks = blk & 3; transpose_item(p.in[8] + ((size_t)(l * 2 + kv) * 2048 + ks * 512) * 256, nullptr, 256, 512, WSP(bf16_t, WS_CW1) + (size_t)(l * 8 + blk) * 256 * 512, 8, 0, 256, r % 64, scr, c.lane); continue; } r -= IT_CW1;
        if (r < IT_WBR) { const int n = r / 128; transpose_item(p.in[16] + (size_t)(l * 4 + n) * 256 * 1024, nullptr, 1024, 256, WSP(bf16_t, WS_WBR) + (size_t)(l * 4 + n) * 1024 * 256, 32, 0, 1024, r % 128, scr, c.lane); continue; } r -= IT_WBR;
        if (r < IT_WOUT) { transpose_item(p.in[17] + (size_t)l * 1024 * 1024, nullptr, 1024, 1024, WSP(bf16_t, WS_WOUT) + (size_t)l * 1024 * 1024, 32, 0, 1024, r, scr, c.lane); continue; } r -= IT_WOUT;
        transpose_item(p.in[14] + (size_t)l * 384 * 384, p.in[15] + (size_t)l * 128 * 512, 0, 512, WSP(bf16_t, WS_WU) + (size_t)l * 1024 * 512, 32, 3, 0, r, scr, c.lane);
    }
}

template <bool NORM, bool WRITEX> DEV void phase_norm1(const Params& p, const Ctx& c, int l) {
    const float* MOD = WSP(float, WS_MOD);
    const bf16_t* YP = (const bf16_t*)(p.ws + WS_BIG + BIG_YP);
    const int* PSLOT = WSP(int, WS_MISC + MISC_PSLOT); const float* WTS = WSP(float, WS_MISC + MISC_WTS);
    bf16_t* HBF = WSP(bf16_t, WS_HBF);
    for (int row = c.gw; row < NTOK; row += c.NGW) {
        const int b = row / SEQ;
        f32x4 v[4];
        if (l == 0 || !WRITEX) {
            const float* xs = l == 0 ? p.in[0] : p.out;
#pragma unroll
            for (int j = 0; j < 4; ++j) v[j] = *(const f32x4*)(xs + (size_t)row * DM + j * 256 + c.lane * 4);
        } else {
            const float* g2 = MOD + ((l - 1) * 4 + b) * 6144 + 5120;
            const int s0 = PSLOT[row * 2], s1 = PSLOT[row * 2 + 1]; const float w0 = WTS[row * 2], w1 = WTS[row * 2 + 1];
#pragma unroll
            for (int j = 0; j < 4; ++j) { const int col = j * 256 + c.lane * 4;
                const f32x4 x = *(const f32x4*)(p.out + (size_t)row * DM + col); const f32x4 g = *(const f32x4*)(g2 + col);
                const u32x2 y0 = *(const u32x2*)(YP + (size_t)s0 * DM + col), y1 = *(const u32x2*)(YP + (size_t)s1 * DM + col);
                f32x4 y; y[0] = w0 * bflo(y0.x) + w1 * bflo(y1.x); y[1] = w0 * bfhi(y0.x) + w1 * bfhi(y1.x); y[2] = w0 * bflo(y0.y) + w1 * bflo(y1.y); y[3] = w0 * bfhi(y0.y) + w1 * bfhi(y1.y);
                v[j] = x + g * y; }
        }
        if (WRITEX) {
#pragma unroll
            for (int j = 0; j < 4; ++j) *(f32x4*)(p.out + (size_t)row * DM + j * 256 + c.lane * 4) = v[j]; }
        if (NORM) {
            float ss = 0.f;
#pragma unroll
            for (int j = 0; j < 4; ++j) ss += (v[j][0] * v[j][0] + v[j][1] * v[j][1]) + (v[j][2] * v[j][2] + v[j][3] * v[j][3]);
            const float r = rsqrtf(wave_sum(ss) * (1.f / DM) + EPS);
            const float* gn = p.in[4] + (size_t)(l * 2 + 0) * DM; const float* sh = MOD + (l * 4 + b) * 6144; const float* sc = sh + 1024;
#pragma unroll
            for (int j = 0; j < 4; ++j) { const int col = j * 256 + c.lane * 4;
                const f32x4 g = *(const f32x4*)(gn + col), s1 = *(const f32x4*)(sc + col), s0 = *(const f32x4*)(sh + col);
                const f32x4 h = v[j] * r * g * (s1 + 1.f) + s0;
                u32x2 o; o.x = pk2(h[0], h[1]); o.y = pk2(h[2], h[3]); *(u32x2*)(HBF + (size_t)row * DM + col) = o; }
        }
    }
}

struct FInproj { float* PSM; bf16_t* GATES;
    DEV void operator()(int row, int col, const f32x4& v0, const f32x4& v1) const {
        if (col < PSW) { float* o = PSM + (size_t)row * PSW + col; *(f32x4*)o = v0; *(f32x4*)(o + 4) = v1; }
        else { u32x4 w; w.x = pk2(sigm(v0[0]), sigm(v0[1])); w.y = pk2(sigm(v0[2]), sigm(v0[3])); w.z = pk2(sigm(v1[0]), sigm(v1[1])); w.w = pk2(sigm(v1[2]), sigm(v1[3]));
               *(u32x4*)(GATES + (size_t)row * NGATE + (col - PSW)) = w; } } };
DEV void phase_inproj(const Params& p, const Ctx& c, int l) {
    pg8::Gemm g{WSP(bf16_t, WS_HBF), WSP(bf16_t, WS_WIN) + (size_t)l * NPROJ * 1024, 1024, 1024};
    pg8::StaticOrder S; S.init(NTOK, NPROJ, c.G, c.bid);
    pg8::Epi8<FInproj> E{{(float*)(p.ws + WS_BIG + BIG_PSM), WSP(bf16_t, WS_GATES)}};
    pg8::gemm_phase<pg8::Epi8<FInproj>, pg8::StaticOrder, true>(c.lds, g, S, E);
}

DEV float head_norm(float v, const float* gain, int lane) { const float ss = wave_sum(v * v); return v * rsqrtf(ss * (1.f / 64.f) + EPS) * gain[lane]; }
DEV void phase_post(const Params& p, const Ctx& c, int l) {
    const float* PSM = (const float*)(p.ws + WS_BIG + BIG_PSM); bf16_t* ACT = WSP(bf16_t, WS_ACT);
    float* GA = WSP(float, WS_SMALL + SM_GA);
    const float* gq = p.in[6] + (size_t)l * 10 * 64;
    const float* RC = WSP(float, WS_ROPE); const float* RS = RC + 4096 * 16;
    const int lane = c.lane;
    for (int row = c.gw; row < NTOK; row += c.NGW) {
        const float* P = PSM + (size_t)row * PSW; bf16_t* A = ACT + (size_t)row * ACTW; const int t = row % SEQ;
#pragma unroll
        for (int h = 0; h < 4; ++h) A[A_QA + h * 64 + lane] = (bf16_t)f2bf(head_norm(P[I_QA + h * 64 + lane], gq + 0 * 64, lane));
        A[A_KCR + lane] = (bf16_t)f2bf(P[I_KC + lane]); A[A_VCR + lane] = (bf16_t)f2bf(P[I_VC + lane]);
        A[A_KS + lane] = (bf16_t)f2bf(head_norm(P[I_KS + lane], gq + 2 * 64, lane)); A[A_VS + lane] = (bf16_t)f2bf(P[I_VS + lane]);
        A[A_KW + lane] = (bf16_t)f2bf(head_norm(P[I_KW + lane], gq + 3 * 64, lane)); A[A_VW + lane] = (bf16_t)f2bf(P[I_VW + lane]);
        if (lane < 12) GA[row * 12 + lane] = sigm(P[I_GL + lane]);
#pragma unroll
        for (int h = 0; h < 4; ++h) A[A_QB + h * 64 + lane] = (bf16_t)f2bf(head_norm(P[I_QB + h * 64 + lane], gq + 4 * 64, lane));
#pragma unroll
        for (int h = 0; h < 2; ++h) { A[A_KB + h * 64 + lane] = (bf16_t)f2bf(head_norm(P[I_KB + h * 64 + lane], gq + 5 * 64, lane)); A[A_VB + h * 64 + lane] = (bf16_t)f2bf(P[I_VB + h * 64 + lane]); }
#pragma unroll
        for (int h = 0; h < 4; ++h) { A[A_QC + h * 64 + lane] = (bf16_t)f2bf(head_norm(P[I_QC + h * 64 + lane], gq + 6 * 64, lane));
            A[A_KC + h * 64 + lane] = (bf16_t)f2bf(head_norm(P[I_KCC + h * 64 + lane], gq + 7 * 64, lane)); A[A_VC + h * 64 + lane] = (bf16_t)f2bf(P[I_VCC + h * 64 + lane]); }
        { float x[6]; float ss = 0.f;
#pragma unroll
          for (int j = 0; j < 6; ++j) { x[j] = P[I_CQ + j * 64 + lane]; ss += x[j] * x[j]; }
          const float r = rsqrtf(wave_sum(ss) * (1.f / 384.f) + EPS); const float* g = p.in[11] + l * 384;
#pragma unroll
          for (int j = 0; j < 6; ++j) A[A_CQ + j * 64 + lane] = (bf16_t)f2bf(x[j] * r * g[j * 64 + lane]); }
        { float x0 = P[I_CKV + lane], x1 = P[I_CKV + 64 + lane]; const float r = rsqrtf(wave_sum(x0 * x0 + x1 * x1) * (1.f / 128.f) + EPS); const float* g = p.in[12] + l * 128;
          A[A_CKV + lane] = (bf16_t)f2bf(x0 * r * g[lane]); A[A_CKV + 64 + lane] = (bf16_t)f2bf(x1 * r * g[64 + lane]); }
        { const float x = lane < 32 ? P[I_KR + lane] : 0.f; const float r = rsqrtf(wave_sum(x * x) * (1.f / 32.f) + EPS);
          const float y = x * r * p.in[13][(l * 2 + 1) * 32 + (lane & 31)];
          const float yo = swz_xor<16>(y); const int k = lane & 15; const float cs = RC[t * 16 + k], sn = RS[t * 16 + k];
          const float o = (lane & 16) ? (yo * sn + y * cs) : (y * cs - yo * sn);
          if (lane < 32) A[A_KR + lane] = (bf16_t)f2bf(o); }
    }
}

struct FStoreF32 { float* O; int ld;
    DEV void operator()(int row, int col, const f32x4& v0, const f32x4& v1) const { float* o = O + (size_t)row * ld + col; *(f32x4*)o = v0; *(f32x4*)(o + 4) = v1; } };
DEV void phase_mlaup(const Params& p, const Ctx& c, int l) {
    { pg8::Gemm g{WSP(bf16_t, WS_ACT) + A_CQ, WSP(bf16_t, WS_WU) + (size_t)l * 1024 * 512, ACTW, 512};
      pg8::StaticOrder S; S.init(NTOK, 1024, c.G, c.bid);
      pg8::Epi8<FStoreF32> E{{WSP(float, WS_MUR), 1024}};
      pg8::gemm_phase<pg8::Epi8<FStoreF32>, pg8::StaticOrder, true>(c.lds, g, S, E); }
    { const bf16_t* ACT = WSP(bf16_t, WS_ACT); bf16_t* CMPA = WSP(bf16_t, WS_CMPA); const float* pe = p.in[7] + (size_t)l * 2 * 32 * 64;
      for (int idx = c.bid * 512 + c.tid; idx < 2 * 1024 * 256; idx += c.G * 512) {
          const int c8 = idx & 255, r = (idx >> 8) & 1023, kv = idx >> 18; const int j = c8 >> 3, d = (c8 & 7) * 8;
          u32x4 o = (u32x4){0u, 0u, 0u, 0u};
          if (r < 1020) { const int b = r / 255, i = r % 255; const size_t tok = (size_t)b * SEQ + 16 * i + j;
              const u32x4 s = *(const u32x4*)(ACT + tok * ACTW + (kv ? A_VCR : A_KCR) + d); const float* pp = pe + (kv * 32 + j) * 64 + d;
              o.x = pk2(bflo(s.x) + pp[0], bfhi(s.x) + pp[1]); o.y = pk2(bflo(s.y) + pp[2], bfhi(s.y) + pp[3]); o.z = pk2(bflo(s.z) + pp[4], bfhi(s.z) + pp[5]); o.w = pk2(bflo(s.w) + pp[6], bfhi(s.w) + pp[7]); }
          *(u32x4*)(CMPA + ((size_t)kv * 1024 + r) * 2048 + c8 * 8) = o; } }
    { const bf16_t* ACT = WSP(bf16_t, WS_ACT); float* KM = WSP(float, WS_MISC + MISC_KMEAN);
      for (int idx = c.bid * 512 + c.tid; idx < 4 * 16 * 256; idx += c.G * 512) { const int hd = idx & 255, n = (idx >> 8) & 15, b = idx >> 12;
          const bf16_t* src = ACT + ((size_t)b * SEQ + n * 256) * ACTW + A_KC + hd; float s = 0.f;
          for (int i = 0; i < 256; ++i) s += bf2f(src[(size_t)i * ACTW]);
          KM[idx] = s * (1.f / 256.f); } }
}

struct CmpOrder { int G, c; DEV bool next(int i, pg8::Unit& u) const { const int L = i * G + c; if (L >= 32) return false; const int ks = L & 3, pm = L >> 2; u.pm = pm; u.pn = (pm >> 2) * 4 + ks; u.ao = ks * 1024; return true; } };
struct FCmpPart { float* HIDP;
    DEV void operator()(int row, int vcol, const f32x4& v0, const f32x4& v1) const { const int cc = vcol & 255, ks = (vcol >> 8) & 3;
        float* o = HIDP + ((size_t)ks * 2048 + row) * 256 + cc; *(f32x4*)o = v0; *(f32x4*)(o + 4) = v1; } };
DEV void phase_post2(const Params& p, const Ctx& c, int l) {
    {
      pg8::Gemm g{WSP(bf16_t, WS_CMPA), WSP(bf16_t, WS_CW1) + (size_t)l * 2 * 256 * 2048, 2048, 512};
      CmpOrder S{c.G, c.bid}; pg8::Epi8<FCmpPart> E{{WSP(float, WS_PB)}};
      pg8::gemm_phase<pg8::Epi8<FCmpPart>, CmpOrder, true>(c.lds, g, S, E); }
    const float* MUR = WSP(float, WS_MUR); bf16_t* ACT2 = WSP(bf16_t, WS_ACT2);
    const float* gq = p.in[6] + (size_t)l * 10 * 64; const float* RC = WSP(float, WS_ROPE); const float* RS = RC + 4096 * 16;
    const int lane = c.lane;
    for (int row = c.gw; row < NTOK; row += c.NGW) {
        const float* R = MUR + (size_t)row * 1024; bf16_t* A = ACT2 + (size_t)row * ACT2W; const int t = row % SEQ;
#pragma unroll
        for (int h = 0; h < 4; ++h) {
            A[A2_QF + h * 96 + lane] = (bf16_t)f2bf(head_norm(R[h * 96 + lane], gq + 8 * 64, lane));
            { const float x = lane < 32 ? R[h * 96 + 64 + lane] : 0.f; const float r = rsqrtf(wave_sum(x * x) * (1.f / 32.f) + EPS);
              const float y = x * r * p.in[13][(l * 2 + 0) * 32 + (lane & 31)];
              const float yo = swz_xor<16>(y); const int k = lane & 15; const float cs = RC[t * 16 + k], sn = RS[t * 16 + k];
              const float o = (lane & 16) ? (yo * sn + y * cs) : (y * cs - yo * sn);
              if (lane < 32) A[A2_QF + h * 96 + 64 + lane] = (bf16_t)f2bf(o); }
            A[A2_KN + h * 64 + lane] = (bf16_t)f2bf(head_norm(R[512 + h * 128 + lane], gq + 9 * 64, lane));
            A[A2_VD + h * 64 + lane] = (bf16_t)f2bf(R[512 + h * 128 + 64 + lane]);
        }
    }
}

template <int D0, int D1, int DV>
DEV void att_step(const float (&q)[D0 + D1], float (&o)[DV], float& m, float& l, const bf16_t* k0, const bf16_t* k1, const bf16_t* v, float scale, float bias, bool valid) {
    float acc = 0.f;
#pragma unroll
    for (int i = 0; i < D0 / 8; ++i) { const u32x4 u = *(const u32x4*)(k0 + 8 * i);
        acc += q[8 * i] * bflo(u.x) + q[8 * i + 1] * bfhi(u.x) + q[8 * i + 2] * bflo(u.y) + q[8 * i + 3] * bfhi(u.y) + q[8 * i + 4] * bflo(u.z) + q[8 * i + 5] * bfhi(u.z) + q[8 * i + 6] * bflo(u.w) + q[8 * i + 7] * bfhi(u.w); }
    if (D1 > 0) {
#pragma unroll
        for (int i = 0; i < D1 / 8; ++i) { const u32x4 u = *(const u32x4*)(k1 + 8 * i); const int b = D0 + 8 * i;
            acc += q[b] * bflo(u.x) + q[b + 1] * bfhi(u.x) + q[b + 2] * bflo(u.y) + q[b + 3] * bfhi(u.y) + q[b + 4] * bflo(u.z) + q[b + 5] * bfhi(u.z) + q[b + 6] * bflo(u.w) + q[b + 7] * bfhi(u.w); }
    }
    const float s = acc * scale + bias;
    if (valid) {
        if (s > m) { const float a = __expf(m - s); l *= a;
#pragma unroll
            for (int d = 0; d < DV; ++d) o[d] *= a;
            m = s; }
        const float pr = __expf(s - m); l += pr;
#pragma unroll
        for (int i = 0; i < DV / 8; ++i) { const u32x4 u = *(const u32x4*)(v + 8 * i);
            o[8 * i] += pr * bflo(u.x); o[8 * i + 1] += pr * bfhi(u.x); o[8 * i + 2] += pr * bflo(u.y); o[8 * i + 3] += pr * bfhi(u.y);
            o[8 * i + 4] += pr * bflo(u.z); o[8 * i + 5] += pr * bfhi(u.z); o[8 * i + 6] += pr * bflo(u.w); o[8 * i + 7] += pr * bfhi(u.w); }
    }
}
template <int D> DEV void load_q(float (&q)[D], const bf16_t* src) {
#pragma unroll
    for (int i = 0; i < D / 8; ++i) { const u32x4 u = *(const u32x4*)(src + 8 * i);
        q[8 * i] = bflo(u.x); q[8 * i + 1] = bfhi(u.x); q[8 * i + 2] = bflo(u.y); q[8 * i + 3] = bfhi(u.y); q[8 * i + 4] = bflo(u.z); q[8 * i + 5] = bfhi(u.z); q[8 * i + 6] = bflo(u.w); q[8 * i + 7] = bfhi(u.w); }
}
template <int DV> DEV void store_o_bf16(bf16_t* dst, const float (&o)[DV], float inv) {
#pragma unroll
    for (int i = 0; i < DV / 8; ++i) { u32x4 w; w.x = pk2(o[8 * i] * inv, o[8 * i + 1] * inv); w.y = pk2(o[8 * i + 2] * inv, o[8 * i + 3] * inv); w.z = pk2(o[8 * i + 4] * inv, o[8 * i + 5] * inv); w.w = pk2(o[8 * i + 6] * inv, o[8 * i + 7] * inv);
        *(u32x4*)(dst + 8 * i) = w; }
}
DEV void item_bgh(int it, int& b, int& g, int& h) { const int r = it & 63, bh = it >> 6; g = (r & 1) ? 63 - (r >> 1) : (r >> 1); b = bh >> 2; h = bh & 3; }

DEV void phase_attn(const Params& p, const Ctx& c, int l) {
    const int lane = c.lane;
    { const bf16_t* HID = WSP(bf16_t, WS_HID); float* KC = WSP(float, WS_MISC + MISC_KCMP); float* VC = WSP(float, WS_MISC + MISC_VCMP);
      const float* gq = p.in[6] + (size_t)l * 10 * 64;
      for (int it = c.gw; it < 2 * 1020; it += c.NGW) { const int kv = it / 1020, r = it % 1020;
          const float* w2 = p.in[9] + (size_t)(l * 2 + kv) * 256 * 64; const bf16_t* hrow = HID + ((size_t)kv * 1024 + r) * 256;
          float a = 0.f;
          for (int k = 0; k < 256; ++k) a += bf2f(hrow[k]) * w2[k * 64 + lane];
          const int b = r / 255, i = r % 255;
          if (kv == 0) KC[(b * 256 + i) * 64 + lane] = head_norm(a, gq + 1 * 64, lane); else VC[(b * 256 + i) * 64 + lane] = a; } }
    const bf16_t* ACT = WSP(bf16_t, WS_ACT); const bf16_t* ACT2 = WSP(bf16_t, WS_ACT2); bf16_t* BR = WSP(bf16_t, WS_BR);
    for (int it0 = c.gw; it0 < 2048; it0 += c.NGW) {
        if (it0 < 1024) {
            int b, g, h; item_bgh(it0, b, g, h); const int t = g * 64 + lane; const size_t tok = (size_t)b * SEQ + t;
            float q[96], o[64]; float m = -INFINITY, ls = 0.f;
            load_q<96>(q, ACT2 + tok * ACT2W + A2_QF + h * 96);
#pragma unroll
            for (int d = 0; d < 64; ++d) o[d] = 0.f;
            const float scale = 0.10206207261596575f;
            for (int s = g * 64 + 63; s >= 0; --s) { const size_t kt = (size_t)b * SEQ + s;
                att_step<64, 32, 64>(q, o, m, ls, ACT2 + kt * ACT2W + A2_KN + h * 64, ACT + kt * ACTW + A_KR, ACT2 + kt * ACT2W + A2_VD + h * 64, scale, 0.f, s <= t); }
            store_o_bf16<64>(BR + tok * 1024 + 768 + h * 64, o, 1.f / ls);
        } else {
            int b, g, h; item_bgh(it0 - 1024, b, g, h); const int t = g * 64 + lane; const size_t tok = (size_t)b * SEQ + t;
            const int nb = g >> 2; const float slope = SLOPES[2][h];
            float q[64], o[64]; float m = -INFINITY, ls = 0.f;
            load_q<64>(q, ACT + tok * ACTW + A_QC + h * 64);
#pragma unroll
            for (int d = 0; d < 64; ++d) o[d] = 0.f;
            const float* KM = WSP(float, WS_MISC + MISC_KMEAN) + (size_t)b * 16 * 256 + h * 64;
            float v1 = -INFINITY, v2 = -INFINITY, v3 = -INFINITY; int i1 = -1, i2 = -1, i3 = -1;
            for (int n = 0; n < nb; ++n) { const float* km = KM + n * 256; float dsum = 0.f;
#pragma unroll
                for (int d = 0; d < 64; ++d) dsum += q[d] * km[d];
                if (dsum > v1) { v3 = v2; i3 = i2; v2 = v1; i2 = i1; v1 = dsum; i1 = n; }
                else if (dsum > v2) { v3 = v2; i3 = i2; v2 = dsum; i2 = n; }
                else if (dsum > v3) { v3 = dsum; i3 = n; } }
            const int start = nb * 256;
            for (int s = g * 64 + 63; s >= start; --s) { const size_t kt = (size_t)b * SEQ + s;
                att_step<64, 0, 64>(q, o, m, ls, ACT + kt * ACTW + A_KC + h * 64, nullptr, ACT + kt * ACTW + A_VC + h * 64, 0.125f, -slope * (float)(t - s), s <= t); }
            for (int n = nb - 1; n >= 0; --n) { const bool sel = (n == i1) || (n == i2) || (n == i3);
                if (!__any(sel)) continue;
                for (int s = n * 256 + 255; s >= n * 256; --s) { const size_t kt = (size_t)b * SEQ + s;
                    att_step<64, 0, 64>(q, o, m, ls, ACT + kt * ACTW + A_KC + h * 64, nullptr, ACT + kt * ACTW + A_VC + h * 64, 0.125f, -slope * (float)(t - s), sel); } }
            store_o_bf16<64>(BR + tok * 1024 + 512 + h * 64, o, 1.f / ls);
        }
    }
    for (int it0 = c.gw; it0 < 2048; it0 += c.NGW) {
        const bool swa = it0 >= 1024;
        int b, g, h; item_bgh(swa ? it0 - 1024 : it0, b, g, h); const int t = g * 64 + lane; const size_t tok = (size_t)b * SEQ + t;
        const int W = swa ? 128 : 512; const float slope = SLOPES[swa ? 1 : 0][h];
        const int qoff = swa ? A_QB + h * 64 : A_QA + h * 64, koff = swa ? A_KB + (h >> 1) * 64 : A_KW, voff = swa ? A_VB + (h >> 1) * 64 : A_VW;
        float q[64], o[64]; float m = -INFINITY, ls = 0.f;
        load_q<64>(q, ACT + tok * ACTW + qoff);
#pragma unroll
        for (int d = 0; d < 64; ++d) o[d] = 0.f;
        int lo = g * 64 - (W - 1); if (lo < 0) lo = 0;
        for (int s = g * 64 + 63; s >= lo; --s) { const size_t kt = (size_t)b * SEQ + s; const int dist = t - s;
            att_step<64, 0, 64>(q, o, m, ls, ACT + kt * ACTW + koff, nullptr, ACT + kt * ACTW + voff, 0.125f, -slope * (float)dist, dist >= 0 && dist < W); }
        if (swa) { const float sk = p.in[10][l * 4 + h]; const float mf = fmaxf(m, sk); const float a = __expf(m - mf); const float den = ls * a + __expf(sk - mf);
            store_o_bf16<64>(BR + tok * 1024 + 256 + h * 64, o, a / den); }
        else { float* OW = WSP(float, WS_OWIN) + tok * 256 + h * 64; const float inv = 1.f / ls;
#pragma unroll
            for (int d = 0; d < 64; d += 4) *(f32x4*)(OW + d) = (f32x4){o[d] * inv, o[d + 1] * inv, o[d + 2] * inv, o[d + 3] * inv}; }
    }
}

DEV void phase_cmpattn(const Params& p, const Ctx& c, int l) {
    const bf16_t* ACT = WSP(bf16_t, WS_ACT); const float* KC = WSP(float, WS_MISC + MISC_KCMP); const float* VC = WSP(float, WS_MISC + MISC_VCMP);
    float* PB = WSP(float, WS_PB); float* PL = WSP(float, WS_SMALL + SM_PL); float* OC = WSP(float, WS_OCMP);
    const int lane = c.lane;
    for (int it = c.gw; it < 1024; it += c.NGW) {
        int b, g, h; item_bgh(it, b, g, h); const int t = g * 64 + lane; const size_t tok = (size_t)b * SEQ + t; const float slope = SLOPES[0][h];
        float q[64], o[64];
        load_q<64>(q, ACT + tok * ACTW + A_QA + h * 64);
#pragma unroll
        for (int d = 0; d < 64; ++d) o[d] = 0.f;
        const int nvis = t >= 31 ? ((t - 31) >> 4) + 1 : 0;
        const int tmaxw = g * 64 + 63; const int nmax = tmaxw >= 31 ? ((tmaxw - 31) >> 4) + 1 : 0;
        const float* kcb = KC + (size_t)b * 256 * 64; const float* vcb = VC + (size_t)b * 256 * 64;
        float m = -INFINITY;
        for (int n = 0; n < nmax; ++n) { const float* k = kcb + n * 64; float a = 0.f;
#pragma unroll
            for (int d = 0; d < 64; ++d) a += q[d] * k[d];
            const float s = a * 0.125f - slope * (float)(t - (16 * n + 31));
            if (n < nvis) m = fmaxf(m, s); }
        float ls = 0.f, carry = 0.f; float* pb = PB + (tok * 4 + h) * 64;
        for (int j = 0; j < 64; ++j) { float e4[4];
#pragma unroll
            for (int u = 0; u < 4; ++u) { const int n = 4 * j + u; float e = 0.f;
                if (n < nmax) { const float* k = kcb + n * 64; float a = 0.f;
#pragma unroll
                    for (int d = 0; d < 64; ++d) a += q[d] * k[d];
                    const float s = a * 0.125f - slope * (float)(t - (16 * n + 31));
                    if (n < nvis) { e = __expf(s - m); const float* v = vcb + n * 64;
#pragma unroll
                        for (int d = 0; d < 64; ++d) o[d] += e * v[d]; } }
                e4[u] = e; }
            pb[j] = carry + e4[0] + e4[1] + e4[2] + e4[3]; carry = e4[3]; ls += e4[0] + e4[1] + e4[2] + e4[3];
            if (4 * j + 4 >= nmax) { for (int jj = j + 1; jj < 64; ++jj) pb[jj] = (jj == j + 1) ? carry : 0.f; break; } }
        const float inv = 1.f / fmaxf(ls, 1e-30f);
        PL[tok * 4 + h] = inv;
        float* oc = OC + tok * 256 + h * 64;
#pragma unroll
        for (int d = 0; d < 64; d += 4) *(f32x4*)(oc + d) = (f32x4){o[d] * inv, o[d + 1] * inv, o[d + 2] * inv, o[d + 3] * inv};
    }
}

DEV void phase_topk(const Params& p, const Ctx& c) {
    const float* PB = WSP(float, WS_PB); const float* PL = WSP(float, WS_SMALL + SM_PL); unsigned long long* SEL = WSP(unsigned long long, WS_SMALL + SM_SEL);
    const int lane = c.lane;
    for (int tok = c.gw; tok < NTOK; tok += c.NGW) {
        const int t = tok % SEQ, cur = t >> 6;
        float ps = 0.f;
#pragma unroll
        for (int h = 0; h < 4; ++h) ps += PB[((size_t)tok * 4 + h) * 64 + lane] * PL[tok * 4 + h];
        const bool forced = (lane == 0) || (lane == cur) || (lane == cur - 1);
        float score = lane <= cur ? ps + (forced ? 1e4f : 0.f) : -1e30f;
        unsigned long long mask = 0ull;
        for (int r = 0; r < 8; ++r) {
            float bv = score; int bi = lane;
#define TK_STEP(M) { const float ov = swz_xor<M>(bv); const int oi = swz_xor_i<M>(bi); if (ov > bv || (ov == bv && oi < bi)) { bv = ov; bi = oi; } }
            TK_STEP(1) TK_STEP(2) TK_STEP(4) TK_STEP(8) TK_STEP(16)
#undef TK_STEP
            { auto rv = __builtin_amdgcn_permlane32_swap(__float_as_uint(bv), __float_as_uint(bv), false, false); auto ri = __builtin_amdgcn_permlane32_swap((unsigned)bi, (unsigned)bi, false, false);
              const float v0 = __uint_as_float(rv[0]), v1 = __uint_as_float(rv[1]); const int i0 = (int)ri[0], i1 = (int)ri[1];
              if (v1 > v0 || (v1 == v0 && i1 < i0)) { bv = v1; bi = i1; } else { bv = v0; bi = i0; } }
            if (bv > -5e29f) mask |= 1ull << bi;
            if (lane == bi) score = -INFINITY;
        }
        if (lane == 0) SEL[tok] = mask;
    }
}

DEV void phase_slc(const Params& p, const Ctx& c, int l) {
    const bf16_t* ACT = WSP(bf16_t, WS_ACT); bf16_t* BR = WSP(bf16_t, WS_BR); const unsigned long long* SEL = WSP(unsigned long long, WS_SMALL + SM_SEL);
    const float* OC = WSP(float, WS_OCMP); const float* OW = WSP(float, WS_OWIN); const float* GA = WSP(float, WS_SMALL + SM_GA);
    const int lane = c.lane;
    for (int it = c.gw; it < 1024; it += c.NGW) {
        int b, g, h; item_bgh(it, b, g, h); const int t = g * 64 + lane; const size_t tok = (size_t)b * SEQ + t; const float slope = SLOPES[0][h];
        float q[64], o[64]; float m = -INFINITY, ls = 0.f;
        load_q<64>(q, ACT + tok * ACTW + A_QA + h * 64);
#pragma unroll
        for (int d = 0; d < 64; ++d) o[d] = 0.f;
        const unsigned long long mask = SEL[tok];
        for (int j = g; j >= 0; --j) { const bool sel = (mask >> j) & 1ull;
            if (!__any(sel)) continue;
            for (int s = j * 64 + 63; s >= j * 64; --s) { const size_t kt = (size_t)b * SEQ + s;
                att_step<64, 0, 64>(q, o, m, ls, ACT + kt * ACTW + A_KS, nullptr, ACT + kt * ACTW + A_VS, 0.125f, -slope * (float)(t - s), sel && s <= t); } }
        const float inv = 1.f / ls; const float g0 = GA[tok * 12 + h * 3], g1 = GA[tok * 12 + h * 3 + 1], g2 = GA[tok * 12 + h * 3 + 2];
        const float* oc = OC + tok * 256 + h * 64; const float* ow = OW + tok * 256 + h * 64;
#pragma unroll
        for (int d = 0; d < 64; ++d) o[d] = g0 * oc[d] + g1 * o[d] * inv + g2 * ow[d];
        store_o_bf16<64>(BR + tok * 1024 + h * 64, o, 1.f);
    }
}


namespace fa {
typedef float f32x16 __attribute__((ext_vector_type(16)));
typedef short v4i16_t __attribute__((ext_vector_type(4)));
typedef float f32x2_t __attribute__((ext_vector_type(2))); typedef __bf16 bf16x2_t __attribute__((ext_vector_type(2)));
constexpr int KROWB = 208, VROWB = 192, KBYTES = 64 * KROWB, VBYTES = 64 * VROWB, STG = KBYTES + VBYTES;
constexpr int LDS_MISC = 2 * STG;
constexpr float LOG2E = 1.4426950408889634f;
constexpr float MFLOOR = -1e20f;
DEV unsigned cvtpk(float lo, float hi) { f32x2_t v = {lo, hi}; bf16x2_t b = __builtin_convertvector(v, bf16x2_t); return __builtin_bit_cast(unsigned, b); }
DEV unsigned long long uni64(unsigned long long v) { const unsigned lo = __builtin_amdgcn_readfirstlane((unsigned)v), hi = __builtin_amdgcn_readfirstlane((unsigned)(v >> 32)); return ((unsigned long long)hi << 32) | lo; }
DEV unsigned long long wave_or64(unsigned long long v) {
    unsigned lo = (unsigned)v, hi = (unsigned)(v >> 32);
#define FA_OR(M) lo |= (unsigned)__builtin_amdgcn_ds_swizzle((int)lo, (M << 10) | 0x1f); hi |= (unsigned)__builtin_amdgcn_ds_swizzle((int)hi, (M << 10) | 0x1f);
    FA_OR(1) FA_OR(2) FA_OR(4) FA_OR(8) FA_OR(16)
#undef FA_OR
    { auto a = __builtin_amdgcn_permlane32_swap(lo, lo, false, false); lo = a[0] | a[1]; auto b = __builtin_amdgcn_permlane32_swap(hi, hi, false, false); hi = b[0] | b[1]; }
    return uni64(((unsigned long long)hi << 32) | lo);
}
struct Src { const bf16_t* k; int kp; const bf16_t* k2; int k2p; const bf16_t* v; int vp; };
template <int NQ, bool ALIBI, int SELMODE>
DEV void attn_tile(const LAS unsigned char* kb, const LAS unsigned char* vb, const bf16x8 (&qf)[NQ], const f32x16& ci0, const f32x16& ci1, int kt, int lane,
                   int t, float nslope2, float c1, unsigned W, unsigned long long rowmask, int own_blk, f32x16 (&o)[2], float& m, float& l) {
    const int r32 = lane & 31, hi = lane >> 5, i16 = lane & 15, tq = i16 >> 2, tp = i16 & 3, blk = (lane >> 4) & 1;
    f32x16 s0, s1;
#pragma unroll
    for (int d0 = 0; d0 < NQ; ++d0) {
        const bf16x8 k0 = *(const LAS bf16x8*)(kb + r32 * KROWB + (16 * d0 + 8 * hi) * 2);
        const bf16x8 k1 = *(const LAS bf16x8*)(kb + (32 + r32) * KROWB + (16 * d0 + 8 * hi) * 2);
        s0 = __builtin_amdgcn_mfma_f32_32x32x16_bf16(k0, qf[d0], d0 == 0 ? ci0 : s0, 0, 0, 0);
        s1 = __builtin_amdgcn_mfma_f32_32x32x16_bf16(k1, qf[d0], d0 == 0 ? ci1 : s1, 0, 0, 0);
    }
    bool rowsel = true;
    if (SELMODE == 1) rowsel = (rowmask >> kt) & 1ull;
    if (SELMODE == 2) rowsel = ((kt >> 2) == own_blk) || ((rowmask >> (kt >> 2)) & 1ull);
    const int db0 = t - (kt * 64 + 4 * hi);
    const bool allok = rowsel && ((unsigned)(db0 - 59) < (W - 59u));
    if (!__all(allok)) {
        const unsigned Weff = rowsel ? W : 0u;
#pragma unroll
        for (int i = 0; i < 16; ++i) { const int cr = (i & 3) + 8 * (i >> 2);
            s0[i] = ((unsigned)(db0 - cr) < Weff) ? s0[i] : -INFINITY; s1[i] = ((unsigned)(db0 - 32 - cr) < Weff) ? s1[i] : -INFINITY; }
    }
    float smax = fmaxf(s0[0], s1[0]);
#pragma unroll
    for (int i = 1; i < 16; ++i) smax = fmaxf(smax, fmaxf(s0[i], s1[i]));
    const float Bt = ALIBI ? nslope2 * (float)db0 : 0.f;
    float mx = fmaf(smax, c1, Bt);
    { auto rr = __builtin_amdgcn_permlane32_swap(__float_as_uint(mx), __float_as_uint(mx), false, false); mx = fmaxf(__uint_as_float(rr[0]), __uint_as_float(rr[1])); }
    const float mn = fmaxf(m, mx);
    if (__any(mn > m)) { const float alpha = __builtin_amdgcn_exp2f(m - mn); l *= alpha;
#pragma unroll
        for (int dt = 0; dt < 2; ++dt)
#pragma unroll
            for (int i = 0; i < 16; ++i) o[dt][i] *= alpha; }
    m = mn;
    const float boff = Bt - mn;
    float ls = 0.f;
#pragma unroll
    for (int i = 0; i < 16; ++i) { s0[i] = __builtin_amdgcn_exp2f(fmaf(s0[i], c1, boff)); s1[i] = __builtin_amdgcn_exp2f(fmaf(s1[i], c1, boff)); ls += s0[i] + s1[i]; }
    l += ls;
#pragma unroll
    for (int hf = 0; hf < 2; ++hf)
#pragma unroll
        for (int ks = 0; ks < 2; ++ks) {
            u32x4 pw;
            if (hf == 0) { pw.x = cvtpk(s0[8 * ks], s0[8 * ks + 1]); pw.y = cvtpk(s0[8 * ks + 2], s0[8 * ks + 3]); pw.z = cvtpk(s0[8 * ks + 4], s0[8 * ks + 5]); pw.w = cvtpk(s0[8 * ks + 6], s0[8 * ks + 7]); }
            else         { pw.x = cvtpk(s1[8 * ks], s1[8 * ks + 1]); pw.y = cvtpk(s1[8 * ks + 2], s1[8 * ks + 3]); pw.z = cvtpk(s1[8 * ks + 4], s1[8 * ks + 5]); pw.w = cvtpk(s1[8 * ks + 6], s1[8 * ks + 7]); }
            const bf16x8 pb = __builtin_bit_cast(bf16x8, pw);
#pragma unroll
            for (int dt = 0; dt < 2; ++dt) {
                const LAS unsigned char* vp = vb + (32 * hf + 16 * ks + 4 * hi + tq) * VROWB + (32 * dt + 16 * blk + 4 * tp) * 2;
                const v4i16_t lo = __builtin_amdgcn_ds_read_tr16_b64_v4i16((LAS v4i16_t*)vp);
                const v4i16_t hv = __builtin_amdgcn_ds_read_tr16_b64_v4i16((LAS v4i16_t*)(vp + 8 * VROWB));
                const bf16x8 va = (bf16x8){lo[0], lo[1], lo[2], lo[3], hv[0], hv[1], hv[2], hv[3]};
                o[dt] = __builtin_amdgcn_mfma_f32_32x32x16_bf16(va, pb, o[dt], 0, 0, 0);
            }
        }
}
template <int NQ, bool ALIBI, int SELMODE>
DEV void attn_pass(LAS unsigned char* lds, const Ctx& c, const Src& src, const bf16x8 (&qf)[NQ], unsigned long long tmask, unsigned long long wmask,
                   int t, float nslope2, float c1, unsigned W, unsigned long long rowmask, int own_blk, f32x16 (&o)[2], float& m, float& l) {
    const int tid = c.tid, lane = c.lane;
    const int skey = tid >> 3, sch = tid & 7, skey2 = tid >> 2, sch2 = tid & 3;
    u32x4 kA, vA, k2A = (u32x4){0u, 0u, 0u, 0u}, kB, vB, k2B = (u32x4){0u, 0u, 0u, 0u};
#define FA_GLOAD(kt_, KR, VR, K2R) do { const size_t r_ = (size_t)((kt_) * 64 + skey); KR = *(const u32x4*)(src.k + r_ * src.kp + sch * 8); VR = *(const u32x4*)(src.v + r_ * src.vp + sch * 8); \
        if (NQ == 6) { if (tid < 256) K2R = *(const u32x4*)(src.k2 + (size_t)((kt_) * 64 + skey2) * src.k2p + sch2 * 8); } } while (0)
#define FA_LSTORE(buf_, KR, VR, K2R) do { LAS unsigned char* st_ = lds + (buf_) * STG; *(LAS u32x4*)(st_ + skey * KROWB + sch * 16) = KR; *(LAS u32x4*)(st_ + KBYTES + skey * VROWB + sch * 16) = VR; \
        if (NQ == 6) { if (tid < 256) *(LAS u32x4*)(st_ + skey2 * KROWB + 128 + sch2 * 16) = K2R; } } while (0)
#define FA_NEXT(kt_, ok_) do { ok_ = tmask != 0ull; kt_ = 0; if (ok_) { kt_ = 63 - __builtin_clzll(tmask); tmask &= ~(1ull << kt_); } } while (0)
#define FA_TILE(kt_, buf_) do { if ((wmask >> (kt_)) & 1ull) attn_tile<NQ, ALIBI, SELMODE>(lds + (buf_) * STG, lds + (buf_) * STG + KBYTES, qf, ci0, ci1, kt_, lane, t, nslope2, c1, W, rowmask, own_blk, o, m, l); } while (0)
#pragma unroll
    for (int dt = 0; dt < 2; ++dt)
#pragma unroll
        for (int i = 0; i < 16; ++i) o[dt][i] = 0.f;
    m = MFLOOR; l = 0.f;
    f32x16 ci0, ci1;
#pragma unroll
    for (int i = 0; i < 16; ++i) { const int cr = (i & 3) + 8 * (i >> 2); ci0[i] = ALIBI ? -nslope2 * (float)cr / c1 : 0.f; ci1[i] = ALIBI ? -nslope2 * (float)(32 + cr) / c1 : 0.f; }
    int ktA, ktB; bool okA, okB;
    FA_NEXT(ktA, okA);
    if (!okA) return;
    FA_GLOAD(ktA, kA, vA, k2A);
    FA_NEXT(ktB, okB);
    if (okB) FA_GLOAD(ktB, kB, vB, k2B);
    for (;;) {
        { FA_LSTORE(0, kA, vA, k2A); __syncthreads(); const int cur = ktA; FA_NEXT(ktA, okA); if (okA) FA_GLOAD(ktA, kA, vA, k2A); FA_TILE(cur, 0); }
        if (!okB) break;
        { FA_LSTORE(1, kB, vB, k2B); __syncthreads(); const int cur = ktB; FA_NEXT(ktB, okB); if (okB) FA_GLOAD(ktB, kB, vB, k2B); FA_TILE(cur, 1); }
        if (!okA) break;
    }
    __syncthreads();
    { auto rr = __builtin_amdgcn_permlane32_swap(__float_as_uint(l), __float_as_uint(l), false, false); l = __uint_as_float(rr[0]) + __uint_as_float(rr[1]); }
#undef FA_GLOAD
#undef FA_LSTORE
#undef FA_NEXT
#undef FA_TILE
}
template <int NQ> DEV void load_qf(bf16x8 (&qf)[NQ], const bf16_t* qrow, int hi) {
#pragma unroll
    for (int d0 = 0; d0 < NQ; ++d0) qf[d0] = *(const bf16x8*)(qrow + 16 * d0 + 8 * hi);
}
DEV void store_o(bf16_t* orow, const f32x16 (&o)[2], float sc, int hi) {
#pragma unroll
    for (int dt = 0; dt < 2; ++dt)
#pragma unroll
        for (int g = 0; g < 4; ++g) { u32x2 w; w.x = cvtpk(o[dt][4 * g] * sc, o[dt][4 * g + 1] * sc); w.y = cvtpk(o[dt][4 * g + 2] * sc, o[dt][4 * g + 3] * sc);
            *(u32x2*)(orow + 32 * dt + 8 * g + 4 * hi) = w; }
}
DEV unsigned long long expand4(unsigned m16) { unsigned long long r = 0ull;
#pragma unroll
    for (int j = 0; j < 16; ++j) if ((m16 >> j) & 1u) r |= 0xFull << (4 * j);
    return r; }
}


DEV void moba_gate(const Params& p, const Ctx& c);
namespace fc {
using namespace fa;
constexpr int CKROWB = 144, CVROWB = 320, CKB = 64 * CKROWB, CVB = 64 * CVROWB, CSTG = CKB + CVB, BINS_OFF = 2 * CSTG, BINW = 65;
static_assert(BINS_OFF + 4 * 64 * BINW * 4 <= RING_BYTES, "cmp unit LDS");
DEV void cmp_unit(const Params& p, const Ctx& c, int b, int cb) {
    LAS unsigned char* lds = c.lds;
    const int tid = c.tid, lane = c.lane, r32 = lane & 31, hi = lane >> 5, w = c.wave, h = w >> 1;
    const int t = cb * 64 + (w & 1) * 32 + r32; const size_t tok = (size_t)b * SEQ + t;
    const bf16_t* ACT = WSP(bf16_t, WS_ACT);
    const bf16_t* KCB = WSP(bf16_t, WS_MISC + MISC_KCB) + (size_t)b * 256 * 64; const bf16_t* VCB = WSP(bf16_t, WS_MISC + MISC_VCB) + (size_t)b * 256 * 64;
    bf16x8 qf[4]; load_qf<4>(qf, ACT + tok * ACTW + A_QA + h * 64, hi);
    const float nslope2 = -SLOPES[0][h] * LOG2E, c1 = 0.125f * LOG2E;
    const int tmaxu = cb * 64 + 63; const int nvmax = tmaxu >= 31 ? ((tmaxu - 31) >> 4) + 1 : 0;
    const int ntile = (nvmax + 63) >> 6;
    const int skey = tid >> 3, sch = tid & 7;
    const int i16 = lane & 15, tq = i16 >> 2, tp = i16 & 3, blk = (lane >> 4) & 1;
    f32x16 o[4]; float m = MFLOOR, l = 0.f;
#pragma unroll
    for (int dt = 0; dt < 4; ++dt)
#pragma unroll
        for (int i = 0; i < 16; ++i) o[dt][i] = 0.f;
    for (int kt = ntile - 1; kt >= 0; --kt) {
        const int buf = kt & 1;
        LAS unsigned char* st = lds + buf * CSTG;
        { const int n = kt * 64 + skey;
          *(LAS u32x4*)(st + skey * CKROWB + sch * 16) = *(const u32x4*)(KCB + (size_t)n * 64 + sch * 8);
          *(LAS u32x4*)(st + CKB + skey * CVROWB + sch * 16) = *(const u32x4*)(VCB + (size_t)n * 64 + sch * 8);
          unsigned cw[4];
#pragma unroll
          for (int e = 0; e < 4; ++e) { const int j0 = sch * 8 + 2 * e, j1 = j0 + 1; const int ja = n >> 2; const bool ex = (n & 3) == 3;
              const unsigned lo16 = (j0 == ja || (ex && j0 == ja + 1)) ? 0x3F80u : 0u, hi16 = (j1 == ja || (ex && j1 == ja + 1)) ? 0x3F80u : 0u; cw[e] = lo16 | (hi16 << 16); }
          *(LAS u32x4*)(st + CKB + skey * CVROWB + 128 + sch * 16) = (u32x4){cw[0], cw[1], cw[2], cw[3]}; }
        __syncthreads();
        const LAS unsigned char* kb = st; const LAS unsigned char* vb = st + CKB;
        f32x16 s0, s1;
#pragma unroll
        for (int i = 0; i < 16; ++i) { s0[i] = 0.f; s1[i] = 0.f; }
#pragma unroll
        for (int d0 = 0; d0 < 4; ++d0) {
            const bf16x8 k0 = *(const LAS bf16x8*)(kb + r32 * CKROWB + (16 * d0 + 8 * hi) * 2);
            const bf16x8 k1 = *(const LAS bf16x8*)(kb + (32 + r32) * CKROWB + (16 * d0 + 8 * hi) * 2);
            s0 = __builtin_amdgcn_mfma_f32_32x32x16_bf16(k0, qf[d0], s0, 0, 0, 0);
            s1 = __builtin_amdgcn_mfma_f32_32x32x16_bf16(k1, qf[d0], s1, 0, 0, 0);
        }
        const int db0 = (t - 31) - 16 * (kt * 64 + 4 * hi);
        float mx = -INFINITY;
#pragma unroll
        for (int i = 0; i < 16; ++i) { const int cr = (i & 3) + 8 * (i >> 2);
            { const int d = db0 - 16 * cr; float x = fmaf((float)d, nslope2, s0[i] * c1); x = (d >= 0) ? x : -INFINITY; s0[i] = x; mx = fmaxf(mx, x); }
            { const int d = db0 - 16 * (32 + cr); float x = fmaf((float)d, nslope2, s1[i] * c1); x = (d >= 0) ? x : -INFINITY; s1[i] = x; mx = fmaxf(mx, x); } }
        { auto rr = __builtin_amdgcn_permlane32_swap(__float_as_uint(mx), __float_as_uint(mx), false, false); mx = fmaxf(__uint_as_float(rr[0]), __uint_as_float(rr[1])); }
        const float mn = fmaxf(m, mx); const float alpha = __builtin_amdgcn_exp2f(m - mn); m = mn;
        float ls = 0.f;
#pragma unroll
        for (int i = 0; i < 16; ++i) { s0[i] = __builtin_amdgcn_exp2f(s0[i] - mn); s1[i] = __builtin_amdgcn_exp2f(s1[i] - mn); ls += s0[i] + s1[i]; }
        l = l * alpha + ls;
#pragma unroll
        for (int dt = 0; dt < 4; ++dt)
#pragma unroll
            for (int i = 0; i < 16; ++i) o[dt][i] *= alpha;
#pragma unroll
        for (int hf = 0; hf < 2; ++hf)
#pragma unroll
            for (int ks = 0; ks < 2; ++ks) {
                u32x4 pw;
                if (hf == 0) { pw.x = cvtpk(s0[8 * ks], s0[8 * ks + 1]); pw.y = cvtpk(s0[8 * ks + 2], s0[8 * ks + 3]); pw.z = cvtpk(s0[8 * ks + 4], s0[8 * ks + 5]); pw.w = cvtpk(s0[8 * ks + 6], s0[8 * ks + 7]); }
                else         { pw.x = cvtpk(s1[8 * ks], s1[8 * ks + 1]); pw.y = cvtpk(s1[8 * ks + 2], s1[8 * ks + 3]); pw.z = cvtpk(s1[8 * ks + 4], s1[8 * ks + 5]); pw.w = cvtpk(s1[8 * ks + 6], s1[8 * ks + 7]); }
                const bf16x8 pb = __builtin_bit_cast(bf16x8, pw);
#pragma unroll
                for (int dt = 0; dt < 4; ++dt) {
                    const LAS unsigned char* vp = vb + (32 * hf + 16 * ks + 4 * hi + tq) * CVROWB + (32 * dt + 16 * blk + 4 * tp) * 2;
                    const v4i16_t lo = __builtin_amdgcn_ds_read_tr16_b64_v4i16((LAS v4i16_t*)vp);
                    const v4i16_t hv = __builtin_amdgcn_ds_read_tr16_b64_v4i16((LAS v4i16_t*)(vp + 8 * CVROWB));
                    const bf16x8 va = (bf16x8){lo[0], lo[1], lo[2], lo[3], hv[0], hv[1], hv[2], hv[3]};
                    o[dt] = __builtin_amdgcn_mfma_f32_32x32x16_bf16(va, pb, o[dt], 0, 0, 0);
                }
            }
    }
    { auto rr = __builtin_amdgcn_permlane32_swap(__float_as_uint(l), __float_as_uint(l), false, false); l = __uint_as_float(rr[0]) + __uint_as_float(rr[1]); }
    const float inv = 1.f / fmaxf(l, 1e-30f);
    { float* oc = WSP(float, WS_OCMP) + tok * 256 + h * 64;
#pragma unroll
      for (int dt = 0; dt < 2; ++dt)
#pragma unroll
          for (int g = 0; g < 4; ++g) *(f32x4*)(oc + 32 * dt + 8 * g + 4 * hi) = (f32x4){o[dt][4 * g] * inv, o[dt][4 * g + 1] * inv, o[dt][4 * g + 2] * inv, o[dt][4 * g + 3] * inv}; }
    LAS float* bins = (LAS float*)(lds + BINS_OFF);
    { const int rowl = h * 64 + (w & 1) * 32 + r32;
#pragma unroll
      for (int dd = 0; dd < 2; ++dd)
#pragma unroll
          for (int i = 0; i < 16; ++i) bins[rowl * BINW + 32 * dd + (i & 3) + 8 * (i >> 2) + 4 * hi] = o[2 + dd][i] * inv; }
    __syncthreads();
    unsigned long long* SEL = WSP(unsigned long long, WS_SMALL + SM_SEL);
    for (int i = 0; i < 8; ++i) { const int tl = w * 8 + i; const int tt = cb * 64 + tl; const int cur = cb;
        const float ps = ((bins[(0 * 64 + tl) * BINW + lane] + bins[(1 * 64 + tl) * BINW + lane]) + bins[(2 * 64 + tl) * BINW + lane]) + bins[(3 * 64 + tl) * BINW + lane];
        const bool forced = (lane == 0) || (lane == cur) || (lane == cur - 1);
        float score = lane <= cur ? ps + (forced ? 1e4f : 0.f) : -1e30f;
        unsigned long long mask = 0ull;
        for (int r = 0; r < 8; ++r) {
            float bv = score; int bi = lane;
#define TK_STEP(M) { const float ov = swz_xor<M>(bv); const int oi = swz_xor_i<M>(bi); if (ov > bv || (ov == bv && oi < bi)) { bv = ov; bi = oi; } }
            TK_STEP(1) TK_STEP(2) TK_STEP(4) TK_STEP(8) TK_STEP(16)
#undef TK_STEP
            { auto rv = __builtin_amdgcn_permlane32_swap(__float_as_uint(bv), __float_as_uint(bv), false, false); auto ri = __builtin_amdgcn_permlane32_swap((unsigned)bi, (unsigned)bi, false, false);
              const float v0 = __uint_as_float(rv[0]), v1 = __uint_as_float(rv[1]); const int i0 = (int)ri[0], i1 = (int)ri[1];
              if (v1 > v0 || (v1 == v0 && i1 < i0)) { bv = v1; bi = i1; } else { bv = v0; bi = i0; } }
            if (bv > -5e29f) mask |= 1ull << bi;
            if (lane == bi) score = -INFINITY;
        }
        if (lane == 0) SEL[(size_t)b * SEQ + tt] = mask;
    }
    __syncthreads();
}
}
DEV void phase_cmpsel(const Params& p, const Ctx& c, int l) {
    for (int u = c.bid; u < 256; u += c.G) { const int v = (u * 37) & 255;
        fc::cmp_unit(p, c, v & 3, 63 - (v >> 2)); }
    moba_gate(p, c);
}

constexpr int CW_QUEUE = 16384 + 512;
constexpr int N_ATT_UNITS = 1024;
DEV void phase_attn2(const Params& p, const Ctx& c, int l) {
    using namespace fa;
    const bf16_t* ACT = WSP(bf16_t, WS_ACT); const bf16_t* ACT2 = WSP(bf16_t, WS_ACT2); bf16_t* BR = WSP(bf16_t, WS_BR);
    unsigned* qhead = WSP(unsigned, WS_CTL) + CW_QUEUE + l; l &= 7;
    volatile LAS unsigned* misc = (volatile LAS unsigned*)(c.lds + LDS_MISC);
    const int lane = c.lane, r32 = lane & 31, hi = lane >> 5, w = c.wave;
    for (;;) {
        if (c.tid == 0) { misc[0] = atomicAdd(qhead, 1u); misc[2] = 0u; misc[3] = 0u; }
        __syncthreads();
        const int u = (int)__builtin_amdgcn_readfirstlane(misc[0]);
        if (u >= N_ATT_UNITS) break;
        f32x16 o[2]; float m, ls;
        if (u < 512) {
            const int k = 15 - (u >> 5), r = u & 31, bh = r & 15, b = bh >> 2, h = bh & 3; const bool moba = (r >> 4) != 0;
            const int t = k * 256 + w * 32 + r32; const size_t tok = (size_t)b * SEQ + t; const size_t b0 = (size_t)b * SEQ;
            if (!moba) {
                bf16x8 qf[6]; load_qf<6>(qf, ACT2 + tok * ACT2W + A2_QF + h * 96, hi);
                const Src src{ACT2 + b0 * ACT2W + A2_KN + h * 64, ACT2W, ACT + b0 * ACTW + A_KR, ACTW, ACT2 + b0 * ACT2W + A2_VD + h * 64, ACT2W};
                const int nt = 4 * k + 4; const unsigned long long tm = nt >= 64 ? ~0ull : ((1ull << nt) - 1ull);
                const int nw = 4 * k + (w >> 1) + 1; const unsigned long long wm = nw >= 64 ? ~0ull : ((1ull << nw) - 1ull);
                __syncthreads();
                attn_pass<6, false, 0>(c.lds, c, src, qf, tm, wm, t, 0.f, 0.10206207261596575f * LOG2E, 0x7fffffffu, 0ull, 0, o, m, ls);
                store_o(BR + tok * 1024 + 768 + h * 64, o, 1.f / ls, hi);
            } else {
                bf16x8 qf[4]; load_qf<4>(qf, ACT + tok * ACTW + A_QC + h * 64, hi);
                const Src src{ACT + b0 * ACTW + A_KC + h * 64, ACTW, nullptr, 0, ACT + b0 * ACTW + A_VC + h * 64, ACTW};
                const unsigned rm = WSP(unsigned, WS_OWIN)[tok * 4 + h];
                const unsigned long long wor = wave_or64((unsigned long long)rm);
                if (lane == 0) atomicOr((unsigned*)&misc[2], (unsigned)wor);
                __syncthreads();
                const unsigned bor = __builtin_amdgcn_readfirstlane(misc[2]);
                const unsigned long long own_all = 0xFull << (4 * k);
                const int nw = (w >> 1) + 1; const unsigned long long own_w = ((1ull << nw) - 1ull) << (4 * k);
                const unsigned long long tm = uni64(expand4(bor) | own_all), wm = uni64(expand4((unsigned)wor) | own_w);
                attn_pass<4, true, 2>(c.lds, c, src, qf, tm, wm, t, -SLOPES[2][h] * LOG2E, 0.125f * LOG2E, 0x7fffffffu, (unsigned long long)rm, k, o, m, ls);
                store_o(BR + tok * 1024 + 512 + h * 64, o, 1.f / ls, hi);
            }
        } else if (u < 768) {
            const int v = u - 512, cb = 63 - (v >> 2), b = v & 3, h = w >> 1;
            const int t = cb * 64 + (w & 1) * 32 + r32; const size_t tok = (size_t)b * SEQ + t; const size_t b0 = (size_t)b * SEQ;
            bf16x8 qf[4]; load_qf<4>(qf, ACT + tok * ACTW + A_QA + h * 64, hi);
            const float nsl = -SLOPES[0][h] * LOG2E;
            const float* GA = WSP(float, WS_SMALL + SM_GA) + tok * 12 + h * 3; const float g0 = GA[0], g1 = GA[1], g2 = GA[2];
            const unsigned long long rm = WSP(unsigned long long, WS_SMALL + SM_SEL)[tok];
            const unsigned long long wor = wave_or64(rm);
            if (lane == 0) { atomicOr((unsigned*)&misc[2], (unsigned)wor); atomicOr((unsigned*)&misc[3], (unsigned)(wor >> 32)); }
            { const Src src{ACT + b0 * ACTW + A_KW, ACTW, nullptr, 0, ACT + b0 * ACTW + A_VW, ACTW};
              const int lo = cb >= 8 ? cb - 8 : 0; const unsigned long long upto = cb >= 63 ? ~0ull : ((1ull << (cb + 1)) - 1ull); const unsigned long long tm = upto & ~((1ull << lo) - 1ull);
              __syncthreads();
              attn_pass<4, true, 0>(c.lds, c, src, qf, tm, tm, t, nsl, 0.125f * LOG2E, 512u, 0ull, 0, o, m, ls); }
            f32x16 res[2]; { const float sc = g2 / ls;
#pragma unroll
              for (int dt = 0; dt < 2; ++dt)
#pragma unroll
                  for (int i = 0; i < 16; ++i) res[dt][i] = o[dt][i] * sc; }
            { const Src src{ACT + b0 * ACTW + A_KS, ACTW, nullptr, 0, ACT + b0 * ACTW + A_VS, ACTW};
              const unsigned long long tm = ((unsigned long long)__builtin_amdgcn_readfirstlane(misc[3]) << 32) | __builtin_amdgcn_readfirstlane(misc[2]);
              attn_pass<4, true, 1>(c.lds, c, src, qf, tm, wor, t, nsl, 0.125f * LOG2E, 0x7fffffffu, rm, 0, o, m, ls); }
            { const float sc = g1 / ls; const float* oc = WSP(float, WS_OCMP) + tok * 256 + h * 64;
#pragma unroll
              for (int dt = 0; dt < 2; ++dt)
#pragma unroll
                  for (int g = 0; g < 4; ++g) { const f32x4 cv = *(const f32x4*)(oc + 32 * dt + 8 * g + 4 * hi);
#pragma unroll
                      for (int e = 0; e < 4; ++e) res[dt][4 * g + e] += o[dt][4 * g + e] * sc + g0 * cv[e]; } }
            store_o(BR + tok * 1024 + h * 64, res, 1.f, hi);
        } else {
            const int v = u - 768, b = v >> 6, g = (v >> 5) & 1, cc = v & 31, hr = w >> 2, h = 2 * g + hr;
            const int t = cc * 128 + (w & 3) * 32 + r32; const size_t tok = (size_t)b * SEQ + t; const size_t b0 = (size_t)b * SEQ;
            bf16x8 qf[4]; load_qf<4>(qf, ACT + tok * ACTW + A_QB + h * 64, hi);
            const Src src{ACT + b0 * ACTW + A_KB + g * 64, ACTW, nullptr, 0, ACT + b0 * ACTW + A_VB + g * 64, ACTW};
            const int lo = cc >= 1 ? 2 * cc - 2 : 0; const int hiT = 2 * cc + 1; const unsigned long long upto = hiT >= 63 ? ~0ull : ((1ull << (hiT + 1)) - 1ull);
            const unsigned long long tm = upto & ~((1ull << lo) - 1ull);
            const unsigned long long wm = ((w & 3) < 2) ? (tm & ~(1ull << hiT)) : tm;
            __syncthreads();
            attn_pass<4, true, 0>(c.lds, c, src, qf, tm, wm, t, -SLOPES[1][h] * LOG2E, 0.125f * LOG2E, 128u, 0ull, 0, o, m, ls);
            const float sk2 = p.in[10][l * 4 + h] * LOG2E; const float mf = fmaxf(m, sk2); const float a = __builtin_amdgcn_exp2f(m - mf); const float den = ls * a + __builtin_amdgcn_exp2f(sk2 - mf);
            store_o(BR + tok * 1024 + 256 + h * 64, o, a / den, hi);
        }
        __syncthreads();
    }
}
DEV void moba_gate(const Params& p, const Ctx& c) {
    const bf16_t* ACT = WSP(bf16_t, WS_ACT); unsigned* MS = WSP(unsigned, WS_OWIN);
    for (int it = c.gw; it < 1024; it += c.NGW) {
        int b, g, h; item_bgh(it, b, g, h); const int t = g * 64 + c.lane; const size_t tok = (size_t)b * SEQ + t; const int nb = g >> 2;
        float q[64]; load_q<64>(q, ACT + tok * ACTW + A_QC + h * 64);
        const float* KM = WSP(float, WS_MISC + MISC_KMEAN) + (size_t)b * 16 * 256 + h * 64;
        float v1 = -INFINITY, v2 = -INFINITY, v3 = -INFINITY; int i1 = -1, i2 = -1, i3 = -1;
        for (int n = 0; n < nb; ++n) { const float* km = KM + n * 256; float dsum = 0.f;
#pragma unroll
            for (int d = 0; d < 64; ++d) dsum += q[d] * km[d];
            if (dsum > v1) { v3 = v2; i3 = i2; v2 = v1; i2 = i1; v1 = dsum; i1 = n; }
            else if (dsum > v2) { v3 = v2; i3 = i2; v2 = dsum; i2 = n; }
            else if (dsum > v3) { v3 = dsum; i3 = n; } }
        unsigned mk = 0u; if (i1 >= 0) mk |= 1u << i1; if (i2 >= 0) mk |= 1u << i2; if (i3 >= 0) mk |= 1u << i3;
        MS[tok * 4 + h] = mk;
    }
}
DEV void phase_cmpw2(const Params& p, const Ctx& c, int l) {
    const int lane = c.lane;
    const float* HIDP = WSP(float, WS_PB);
    bf16_t* KCB = WSP(bf16_t, WS_MISC + MISC_KCB); bf16_t* VCB = WSP(bf16_t, WS_MISC + MISC_VCB);
    const float* gq = p.in[6] + (size_t)l * 10 * 64;
    LAS float* hs = (LAS float*)(c.lds + c.wave * 1024);
    for (int it = c.gw; it < 2 * 1020; it += c.NGW) { const int kv = it / 1020, r = it % 1020; const size_t row = (size_t)kv * 1024 + r;
#pragma unroll
        for (int j = 0; j < 4; ++j) { const int k = lane + 64 * j;
            const float hsum = (HIDP[(0 * 2048 + row) * 256 + k] + HIDP[(1 * 2048 + row) * 256 + k]) + (HIDP[(2 * 2048 + row) * 256 + k] + HIDP[(3 * 2048 + row) * 256 + k]);
            hs[k] = silu_(hsum); }
        LDS_WAIT(); asm volatile("" ::: "memory");
        const float* w2 = p.in[9] + (size_t)(l * 2 + kv) * 256 * 64;
        float a0 = 0.f, a1 = 0.f, a2 = 0.f, a3 = 0.f;
#pragma unroll 8
        for (int k = 0; k < 256; k += 4) { a0 += hs[k] * w2[k * 64 + lane]; a1 += hs[k + 1] * w2[(k + 1) * 64 + lane]; a2 += hs[k + 2] * w2[(k + 2) * 64 + lane]; a3 += hs[k + 3] * w2[(k + 3) * 64 + lane]; }
        const float a = (a0 + a1) + (a2 + a3);
        LDS_WAIT(); asm volatile("" ::: "memory");
        const int b = r / 255, i = r % 255;
        if (kv == 0) KCB[(b * 256 + i) * 64 + lane] = (bf16_t)f2bf(head_norm(a, gq + 1 * 64, lane)); else VCB[(b * 256 + i) * 64 + lane] = (bf16_t)f2bf(a);
        if (i == 0) { if (kv == 0) KCB[(b * 256 + 255) * 64 + lane] = 0; else VCB[(b * 256 + 255) * 64 + lane] = 0; } }
}

struct FMergeAll { const bf16_t* GATES; bf16_t* MIXB;
    DEV void operator()(int row, int vcol, const f32x4& v0, const f32x4& v1) const {
        const int n = vcol >> 10, col = vcol & 1023;
        const u32x4 gw = *(const u32x4*)(GATES + (size_t)row * NGATE + n * 1024 + col);
        f32x4 a = (f32x4){bflo(gw.x), bfhi(gw.x), bflo(gw.y), bfhi(gw.y)} * v0, b = (f32x4){bflo(gw.z), bfhi(gw.z), bflo(gw.w), bfhi(gw.w)} * v1;
        bf16_t* mx = MIXB + (size_t)row * 1024 + col;
        if (n > 0) { const u32x4 pv = *(const u32x4*)mx; a += (f32x4){bflo(pv.x), bfhi(pv.x), bflo(pv.y), bfhi(pv.y)}; b += (f32x4){bflo(pv.z), bfhi(pv.z), bflo(pv.w), bfhi(pv.w)}; }
        u32x4 w; w.x = pk2(a[0], a[1]); w.y = pk2(a[2], a[3]); w.z = pk2(b[0], b[1]); w.w = pk2(b[2], b[3]); *(u32x4*)mx = w; } };
struct MergeOrder { pg8::StaticOrder so;
    DEV bool next(int i, pg8::Unit& u) const { if (!so.next(i >> 2, u)) return false; const int n = i & 3; u.pn += 4 * n; u.ao = n * 512; return true; } };
template <int NB> DEV void phase_merge(const Params& p, const Ctx& c, int l) {
    pg8::Gemm g{WSP(bf16_t, WS_BR), WSP(bf16_t, WS_WBR) + (size_t)l * 4 * 1024 * 256, 1024, 256};
    MergeOrder S; S.so.init(NTOK, 1024, c.G, c.bid);
    pg8::Epi8<FMergeAll> E{{WSP(bf16_t, WS_GATES), (bf16_t*)(p.ws + WS_BIG + BIG_MIXB)}};
    pg8::gemm_phase<pg8::Epi8<FMergeAll>, MergeOrder, true>(c.lds, g, S, E);
}
struct FOut { float* X; const float* g1; float* XO;
    DEV void operator()(int row, int col, const f32x4& v0, const f32x4& v1) const { const float* gg = g1 + (row / SEQ) * 6144 + col; float* x = X + (size_t)row * DM + col;
        float* xo = XO + (size_t)row * DM + col; *(f32x4*)xo = *(const f32x4*)x + *(const f32x4*)gg * v0; *(f32x4*)(xo + 4) = *(const f32x4*)(x + 4) + *(const f32x4*)(gg + 4) * v1; } };
template <bool REAL> DEV void phase_out(const Params& p, const Ctx& c, int l) {
    pg8::Gemm g{(const bf16_t*)(p.ws + WS_BIG + BIG_MIXB), WSP(bf16_t, WS_WOUT) + (size_t)l * 1024 * 1024, 1024, 1024};
    pg8::StaticOrder S; S.init(NTOK, 1024, c.G, c.bid);
    pg8::Epi8<FOut> E{{p.out, WSP(float, WS_MOD) + (size_t)l * 4 * 6144 + 2048, REAL ? p.out : WSP(float, WS_MUR)}};
    pg8::gemm_phase<pg8::Epi8<FOut>, pg8::StaticOrder, true>(c.lds, g, S, E);
}

template <bool COUNT> DEV void phase_router(const Params& p, const Ctx& c, int l) {
    const float* MOD = WSP(float, WS_MOD); bf16_t* H2B = WSP(bf16_t, WS_HBF);
    int* EID = WSP(int, WS_MISC + MISC_EID); float* WTS = WSP(float, WS_MISC + MISC_WTS);
    const float* WRT = WSP(float, WS_MISC + MISC_WRT) + (size_t)l * 36 * 1024;
    const int lane = c.lane;
    LAS int* hist = (LAS int*)(c.lds + 8192);
    if (c.tid < 32) hist[c.tid] = 0;
    __syncthreads();
    const int rpb = NTOK / c.G, rpw = rpb / 8;
    LAS float* lgs = (LAS float*)(c.lds + c.wave * 1024);
    for (int ri = 0; ri < rpw; ri += 4) { const int row0 = c.bid * rpb + c.wave * rpw + ri; const int b = row0 / SEQ;
        f32x4 v[4][4];
        const float* gn = p.in[4] + (size_t)(l * 2 + 1) * DM; const float* sh = MOD + (l * 4 + b) * 6144 + 3072; const float* sc = sh + 1024;
#pragma unroll
        for (int q = 0; q < 4; ++q) { float ss = 0.f;
#pragma unroll
            for (int j = 0; j < 4; ++j) { v[q][j] = *(const f32x4*)(p.out + (size_t)(row0 + q) * DM + j * 256 + lane * 4); ss += (v[q][j][0] * v[q][j][0] + v[q][j][1] * v[q][j][1]) + (v[q][j][2] * v[q][j][2] + v[q][j][3] * v[q][j][3]); }
            const float r = rsqrtf(wave_sum(ss) * (1.f / DM) + EPS);
#pragma unroll
            for (int j = 0; j < 4; ++j) { const int col = j * 256 + lane * 4;
                const f32x4 g = *(const f32x4*)(gn + col), s1 = *(const f32x4*)(sc + col), s0 = *(const f32x4*)(sh + col);
                v[q][j] = v[q][j] * r * g * (s1 + 1.f) + s0;
                u32x2 o; o.x = pk2(v[q][j][0], v[q][j][1]); o.y = pk2(v[q][j][2], v[q][j][3]); *(u32x2*)(H2B + (size_t)(row0 + q) * DM + col) = o; } }
#pragma unroll 1
        for (int eg = 0; eg < 18; ++eg) { float a[2][4];
#pragma unroll
            for (int u = 0; u < 2; ++u) { const float* wr = WRT + (eg * 2 + u) * 1024 + lane * 4; f32x4 wv[4];
#pragma unroll
                for (int j = 0; j < 4; ++j) wv[j] = *(const f32x4*)(wr + j * 256);
#pragma unroll
                for (int q = 0; q < 4; ++q) { float t = 0.f;
#pragma unroll
                    for (int j = 0; j < 4; ++j) t += (v[q][j][0] * wv[j][0] + v[q][j][1] * wv[j][1]) + (v[q][j][2] * wv[j][2] + v[q][j][3] * wv[j][3]);
                    a[u][q] = t; } }
#pragma unroll
            for (int u = 0; u < 2; ++u)
#pragma unroll
                for (int q = 0; q < 4; ++q) a[u][q] = wave_sum(a[u][q]);
            if (lane == 0) {
#pragma unroll
                for (int q = 0; q < 4; ++q) { lgs[q * 64 + eg * 2] = a[0][q]; lgs[q * 64 + eg * 2 + 1] = a[1][q]; } } }
        LDS_WAIT(); asm volatile("" ::: "memory");
        if (lane < 4) { const LAS float* lg = lgs + lane * 64; const int row = row0 + lane;
            float lc[4];
#pragma unroll
            for (int i = 0; i < 4; ++i) lc[i] = lg[i] + p.in[19][l * 4 + i];
            int grp = 0; float mx = lc[0];
#pragma unroll
            for (int i = 1; i < 4; ++i) if (lc[i] > mx) { mx = lc[i]; grp = i; }
            float z = 0.f;
#pragma unroll
            for (int i = 0; i < 4; ++i) z += __expf(lc[i] - mx);
            const float pg = 1.f / z;
            float f1 = -INFINITY, f2 = -INFINITY; int e1 = 0, e2 = 0;
#pragma unroll
            for (int i = 0; i < 8; ++i) { const float x = lg[4 + grp * 8 + i] + p.in[21][l * 32 + grp * 8 + i];
                if (x > f1) { f2 = f1; e2 = e1; f1 = x; e1 = i; } else if (x > f2) { f2 = x; e2 = i; } }
            const float q2 = __expf(f2 - f1); const float w1 = pg / (1.f + q2), w2 = pg * q2 / (1.f + q2);
            const int x1 = grp * 8 + e1, x2 = grp * 8 + e2;
            EID[row * 2] = x1; EID[row * 2 + 1] = x2; WTS[row * 2] = w1; WTS[row * 2 + 1] = w2;
            __hip_atomic_fetch_add(hist + x1, 1, __ATOMIC_RELAXED, __HIP_MEMORY_SCOPE_WORKGROUP); __hip_atomic_fetch_add(hist + x2, 1, __ATOMIC_RELAXED, __HIP_MEMORY_SCOPE_WORKGROUP); }
        LDS_WAIT(); asm volatile("" ::: "memory");
    }
    __syncthreads();
    if (c.tid < 32) WSP(int, WS_MISC + MISC_HIST)[c.bid * 32 + c.tid] = hist[c.tid];
}

struct MoeTab { LAS int* start; LAS int* tile_e; LAS int* ntiles; };
DEV MoeTab build_moe_tab(const Params& p, const Ctx& c, int l) {
    MoeTab T; T.start = (LAS int*)(c.lds + LDS_AUX + 1024); T.tile_e = T.start + 32; T.ntiles = T.tile_e + 192;
    __syncthreads();
    if (c.tid == 0) { const unsigned* cnt = WSP(unsigned, WS_CTL) + CW_CNT + l * 32; int row = 0, nt = 0;
        for (int e = 0; e < 32; ++e) { const int n = (int)__hip_atomic_load(cnt + e, __ATOMIC_RELAXED, __HIP_MEMORY_SCOPE_AGENT); T.start[e] = row; const int tiles = (n + 255) >> 8;
            for (int i = 0; i < tiles; ++i) T.tile_e[nt + i] = e;
            nt += tiles; row += tiles * 256; }
        T.ntiles[0] = nt; }
    __syncthreads();
    return T;
}
DEV void phase_moesort(const Params& p, const Ctx& c, int l, int rep) {
    const int* HIST = WSP(int, WS_MISC + MISC_HIST);
    LAS int* part = (LAS int*)(c.lds + 4096);
    LAS int* base = part + 1024;
    LAS int* curs = base + 32;
    LAS int* tot = curs + 32;
    { const int e = c.tid & 31, seg = c.tid >> 5; int sa = 0, sp = 0;
      for (int i = 0; i < 16; ++i) { const int bb = seg * 16 + i; if (bb < c.G) { const int hv = HIST[bb * 32 + e]; sa += hv; sp += bb < c.bid ? hv : 0; } }
      part[seg * 32 + e] = sa; part[512 + seg * 32 + e] = sp; }
    __syncthreads();
    if (c.tid < 32) { int sa = 0, sp = 0;
        for (int i = 0; i < 16; ++i) { sa += part[i * 32 + c.tid]; sp += part[512 + i * 32 + c.tid]; }
        tot[c.tid] = sa; base[c.tid] = sp; curs[c.tid] = 0;
        if (c.bid == 0) WSP(unsigned, WS_CTL)[CW_CNT + l * 32 + c.tid] = (unsigned)sa; }
    __syncthreads();
    if (c.tid == 0) { int row = 0; for (int e = 0; e < 32; ++e) { base[e] += row; row += ((tot[e] + 255) >> 8) << 8; } }
    __syncthreads();
    const int* EID = WSP(int, WS_MISC + MISC_EID); int* PSLOT = WSP(int, WS_MISC + MISC_PSLOT);
    const bf16_t* H2B = WSP(bf16_t, WS_HBF); bf16_t* XS = (bf16_t*)(p.ws + WS_BIG + BIG_XS);
    const int lane = c.lane; const int rpb = NTOK / c.G, rpw = rpb / 8;
    for (int ri = 0; ri < rpw; ++ri) { const int tok = c.bid * rpb + c.wave * rpw + ri;
        const u32x4 a = *(const u32x4*)(H2B + (size_t)tok * DM + lane * 16), b2 = *(const u32x4*)(H2B + (size_t)tok * DM + lane * 16 + 8);
#pragma unroll
        for (int k = 0; k < 2; ++k) { const int e = EID[tok * 2 + k]; int slot = 0;
            if (lane == 0) slot = base[e] + __hip_atomic_fetch_add(curs + e, 1, __ATOMIC_RELAXED, __HIP_MEMORY_SCOPE_WORKGROUP);
            slot = __builtin_amdgcn_readfirstlane(slot);
            if (lane == 0) PSLOT[tok * 2 + k] = slot;
            *(u32x4*)(XS + (size_t)slot * DM + lane * 16) = a; *(u32x4*)(XS + (size_t)slot * DM + lane * 16 + 8) = b2; }
    }
}
template <int NCOL> struct MoeOrder { int G, c; LAS const int* tile_e; int ntiles;
    DEV bool next(int i, pg8::Unit& u) const { const int L = i * G + c; if (L >= ntiles * NCOL) return false; const int pm = L / NCOL; u.pm = pm; u.pn = tile_e[pm] * NCOL + (L % NCOL); u.ao = 0; return true; } };
struct FMoe1 { bf16_t* ACTB;
    DEV void operator()(int row, int col, const f32x4& v0, const f32x4& v1) const { const int ce = col & 511;
        u32x2 w; w.x = pk2(silu_(v0[0]) * v0[1], silu_(v0[2]) * v0[3]); w.y = pk2(silu_(v1[0]) * v1[1], silu_(v1[2]) * v1[3]);
        *(u32x2*)(ACTB + (size_t)row * 256 + (ce >> 1)) = w; } };
struct FMoe2 { bf16_t* YP;
    DEV void operator()(int row, int col, const f32x4& v0, const f32x4& v1) const { const int ce = col & 1023;
        u32x4 w; w.x = pk2(v0[0], v0[1]); w.y = pk2(v0[2], v0[3]); w.z = pk2(v1[0], v1[1]); w.w = pk2(v1[2], v1[3]); *(u32x4*)(YP + (size_t)row * DM + ce) = w; } };
DEV void phase_moe1(const Params& p, const Ctx& c, int l) {
    const MoeTab T = build_moe_tab(p, c, l);
    pg8::Gemm g{(const bf16_t*)(p.ws + WS_BIG + BIG_XS), WSP(bf16_t, WS_W13) + (size_t)l * 32 * 512 * 1024, 1024, 1024};
    MoeOrder<2> S{c.G, c.bid, T.tile_e, T.ntiles[0]}; pg8::Epi8<FMoe1> E{{WSP(bf16_t, WS_MUR)}};
    pg8::gemm_phase<pg8::Epi8<FMoe1>, MoeOrder<2>, true>(c.lds, g, S, E);
}
DEV void phase_moe2(const Params& p, const Ctx& c, int l) {
    const MoeTab T = build_moe_tab(p, c, l);
    pg8::Gemm g{WSP(bf16_t, WS_MUR), WSP(bf16_t, WS_W2) + (size_t)l * 32 * 1024 * 256, 256, 256};
    MoeOrder<4> S{c.G, c.bid, T.tile_e, T.ntiles[0]}; pg8::Epi8<FMoe2> E{{(bf16_t*)(p.ws + WS_BIG + BIG_YP)}};
    pg8::gemm_phase<pg8::Epi8<FMoe2>, MoeOrder<4>, true>(c.lds, g, S, E);
}

constexpr int PH_PRO = 0, PH_NORM1 = 1, PH_INPROJ = 2, PH_POST = 3, PH_MLAUP = 4, PH_POST2 = 5, PH_ATTN = 6, PH_CMPATTN = 7, PH_TOPK = 8, PH_SLC = 9,
              PH_MERGE0 = 10, PH_MERGE1 = 11, PH_MERGE2 = 12, PH_MERGE3 = 13, PH_OUT = 14, PH_ROUTER = 15, PH_SORT = 16, PH_MOE1 = 17, PH_MOE2 = 18, PH_FINAL = 19, PH_COUNT = 20;
constexpr int LDS_PTAB = LDS_AUX + 64;
DEV unsigned long long uni64(unsigned long long v) { const unsigned lo = __builtin_amdgcn_readfirstlane((unsigned)v), hi = __builtin_amdgcn_readfirstlane((unsigned)(v >> 32)); return ((unsigned long long)hi << 32) | lo; }
DEV void store_params(const Params& p, LAS unsigned char* lds) {
    LAS unsigned long long* L = (LAS unsigned long long*)(lds + LDS_PTAB);
    if (threadIdx.x == 0) {
#pragma unroll
        for (int i = 0; i < 24; ++i) L[i] = (unsigned long long)p.in[i];
        L[24] = (unsigned long long)p.out; L[25] = (unsigned long long)p.ws; }
}
DEV Params load_params(LAS unsigned char* lds) {
    const LAS unsigned long long* L = (const LAS unsigned long long*)(lds + LDS_PTAB); Params p;
#pragma unroll
    for (int i = 0; i < 24; ++i) p.in[i] = (const float*)uni64(L[i]);
    p.out = (float*)uni64(L[24]); p.ws = (unsigned char*)uni64(L[25]); return p;
}
template <int PH, int REP = 0> DEV void run_phase(const Params& p, const Ctx& c, int l) {
    if constexpr (PH == PH_PRO) phase_prologue(p, c);
    else if constexpr (PH == PH_NORM1) phase_norm1<true, REP == 0>(p, c, l);
    else if constexpr (PH == PH_INPROJ) phase_inproj(p, c, l);
    else if constexpr (PH == PH_POST) phase_post(p, c, l);
    else if constexpr (PH == PH_MLAUP) phase_mlaup(p, c, l);
    else if constexpr (PH == PH_POST2) phase_post2(p, c, l);
    else if constexpr (PH == PH_ATTN) phase_cmpw2(p, c, l);
    else if constexpr (PH == PH_CMPATTN) phase_cmpsel(p, c, l);
    else if constexpr (PH == PH_TOPK) { }
    else if constexpr (PH == PH_SLC) phase_attn2(p, c, l + 8 * REP);
    else if constexpr (PH == PH_MERGE0) phase_merge<0>(p, c, l);
    else if constexpr (PH == PH_OUT) phase_out<REP == 0>(p, c, l);
    else if constexpr (PH == PH_ROUTER) phase_router<REP == 0>(p, c, l);
    else if constexpr (PH == PH_SORT) phase_moesort(p, c, l, REP);
    else if constexpr (PH == PH_MOE1) phase_moe1(p, c, l);
    else if constexpr (PH == PH_MOE2) phase_moe2(p, c, l);
    else if constexpr (PH == PH_FINAL) phase_norm1<false, true>(p, c, NLAYER);
}

#if !MK_ONE_LAUNCH
template <int PH> __global__ void __launch_bounds__(512, 2) k_phase(Params p, int l) {
    extern __shared__ __attribute__((aligned(16))) unsigned char lds_raw[];
    const Ctx c = make_ctx((LAS unsigned char*)lds_raw);
    run_phase<PH>(p, c, l);
}
template <int PH> static void launch_phase(const Params& p, int l, int grid, hipStream_t stream) {
    static bool attr_set = false;
    if (!attr_set) { (void)hipFuncSetAttribute((const void*)k_phase<PH>, hipFuncAttributeMaxDynamicSharedMemorySize, LDS_BYTES); attr_set = true; }
    hipLaunchKernelGGL(k_phase<PH>, dim3(grid), dim3(512), LDS_BYTES, stream, p, l);
}
#else
#define BAR() xcd_barrier_fn(bar.bar, bar.x, bar.st)
template <int l> DEV void mega_layer(LAS unsigned char* lds, const XcdBarrier& bar) {
        { const Ctx c = make_ctx(lds); const Params q = load_params(lds); run_phase<PH_NORM1>(q, c, l); } BAR(); if constexpr ((PROBE_MASK >> PH_NORM1) & 1u) { { const Ctx c = make_ctx(lds); const Params q = load_params(lds); run_phase<PH_NORM1, 1>(q, c, l); } BAR(); }
        { const Ctx c = make_ctx(lds); const Params q = load_params(lds); run_phase<PH_INPROJ>(q, c, l); } BAR(); if constexpr ((PROBE_MASK >> PH_INPROJ) & 1u) { { const Ctx c = make_ctx(lds); const Params q = load_params(lds); run_phase<PH_INPROJ, 1>(q, c, l); } BAR(); }
        { const Ctx c = make_ctx(lds); const Params q = load_params(lds); run_phase<PH_POST>(q, c, l); } BAR(); if constexpr ((PROBE_MASK >> PH_POST) & 1u) { { const Ctx c = make_ctx(lds); const Params q = load_params(lds); run_phase<PH_POST, 1>(q, c, l); } BAR(); }
        { const Ctx c = make_ctx(lds); const Params q = load_params(lds); run_phase<PH_MLAUP>(q, c, l); } BAR(); if constexpr ((PROBE_MASK >> PH_MLAUP) & 1u) { { const Ctx c = make_ctx(lds); const Params q = load_params(lds); run_phase<PH_MLAUP, 1>(q, c, l); } BAR(); }
        { const Ctx c = make_ctx(lds); const Params q = load_params(lds); run_phase<PH_POST2>(q, c, l); } BAR(); if constexpr ((PROBE_MASK >> PH_POST2) & 1u) { { const Ctx c = make_ctx(lds); const Params q = load_params(lds); run_phase<PH_POST2, 1>(q, c, l); } BAR(); }
        { const Ctx c = make_ctx(lds); const Params q = load_params(lds); run_phase<PH_ATTN>(q, c, l); } BAR(); if constexpr ((PROBE_MASK >> PH_ATTN) & 1u) { { const Ctx c = make_ctx(lds); const Params q = load_params(lds); run_phase<PH_ATTN, 1>(q, c, l); } BAR(); }
        { const Ctx c = make_ctx(lds); const Params q = load_params(lds); run_phase<PH_CMPATTN>(q, c, l); } BAR(); if constexpr ((PROBE_MASK >> PH_CMPATTN) & 1u) { { const Ctx c = make_ctx(lds); const Params q = load_params(lds); run_phase<PH_CMPATTN, 1>(q, c, l); } BAR(); }
        { const Ctx c = make_ctx(lds); const Params q = load_params(lds); run_phase<PH_SLC>(q, c, l); } BAR(); if constexpr ((PROBE_MASK >> PH_SLC) & 1u) { { const Ctx c = make_ctx(lds); const Params q = load_params(lds); run_phase<PH_SLC, 1>(q, c, l); } BAR(); }
        { const Ctx c = make_ctx(lds); const Params q = load_params(lds); run_phase<PH_MERGE0>(q, c, l); } BAR(); if constexpr ((PROBE_MASK >> PH_MERGE0) & 1u) { { const Ctx c = make_ctx(lds); const Params q = load_params(lds); run_phase<PH_MERGE0, 1>(q, c, l); } BAR(); }
        { const Ctx c = make_ctx(lds); const Params q = load_params(lds); run_phase<PH_OUT>(q, c, l); } BAR(); if constexpr ((PROBE_MASK >> PH_OUT) & 1u) { { const Ctx c = make_ctx(lds); const Params q = load_params(lds); run_phase<PH_OUT, 1>(q, c, l); } BAR(); }
        { const Ctx c = make_ctx(lds); const Params q = load_params(lds); run_phase<PH_ROUTER>(q, c, l); } BAR(); if constexpr ((PROBE_MASK >> PH_ROUTER) & 1u) { { const Ctx c = make_ctx(lds); const Params q = load_params(lds); run_phase<PH_ROUTER, 1>(q, c, l); } BAR(); }
        { const Ctx c = make_ctx(lds); const Params q = load_params(lds); run_phase<PH_SORT>(q, c, l); } BAR(); if constexpr ((PROBE_MASK >> PH_SORT) & 1u) { { const Ctx c = make_ctx(lds); const Params q = load_params(lds); run_phase<PH_SORT, 1>(q, c, l); } BAR(); }
        { const Ctx c = make_ctx(lds); const Params q = load_params(lds); run_phase<PH_MOE1>(q, c, l); } BAR(); if constexpr ((PROBE_MASK >> PH_MOE1) & 1u) { { const Ctx c = make_ctx(lds); const Params q = load_params(lds); run_phase<PH_MOE1, 1>(q, c, l); } BAR(); }
        { const Ctx c = make_ctx(lds); const Params q = load_params(lds); run_phase<PH_MOE2>(q, c, l); } BAR(); if constexpr ((PROBE_MASK >> PH_MOE2) & 1u) { { const Ctx c = make_ctx(lds); const Params q = load_params(lds); run_phase<PH_MOE2, 1>(q, c, l); } BAR(); }
}
__global__ void __launch_bounds__(512, 2) k_mega(Params p) {
    extern __shared__ __attribute__((aligned(16))) unsigned char lds_raw[];
    LAS unsigned char* lds = (LAS unsigned char*)lds_raw;
    volatile LAS unsigned* bst = (volatile LAS unsigned*)(lds + LDS_AUX);
    if (threadIdx.x < 4) bst[threadIdx.x] = 0u;
    store_params(p, lds);
    __syncthreads();
    const XcdBarrier bar = xcd_barrier_post(WSP(unsigned, WS_CTL) + CW_BAR, bst);
    { const Ctx c = make_ctx(lds); const Params q = load_params(lds); run_phase<PH_PRO>(q, c, 0); } BAR(); if constexpr ((PROBE_MASK >> PH_PRO) & 1u) { { const Ctx c = make_ctx(lds); const Params q = load_params(lds); run_phase<PH_PRO, 1>(q, c, 0); } BAR(); }
    mega_layer<0>(lds, bar); mega_layer<1>(lds, bar); mega_layer<2>(lds, bar); mega_layer<3>(lds, bar);
    { const Ctx c = make_ctx(lds); const Params q = load_params(lds); run_phase<PH_FINAL>(q, c, NLAYER); }
#undef BAR
}
#endif

extern "C" void kernel_launch(void* const* d_in, const int* in_sizes, int n_in, void* d_out, int out_size, void* d_ws, size_t ws_size, hipStream_t stream) {
    if (n_in != 24 || out_size != NTOK * DM || ws_size < WS_END) { fprintf(stderr, "kernel_launch: unexpected shapes (n_in %d out %d ws %zu, need %zu)\n", n_in, out_size, ws_size, (size_t)WS_END); return; }
    Params p{};
    for (int i = 0; i < 24; ++i) p.in[i] = (const float*)d_in[i];
    p.out = (float*)d_out; p.ws = (unsigned char*)d_ws;
    (void)hipMemsetAsync((char*)d_ws + WS_CTL, 0, 1 * MiB, stream);
    const int grid = 256;
#if !MK_ONE_LAUNCH
    launch_phase<PH_PRO>(p, 0, grid, stream);
    for (int l = 0; l < NLAYER; ++l) {
        launch_phase<PH_NORM1>(p, l, grid, stream);
        launch_phase<PH_INPROJ>(p, l, grid, stream);
        launch_phase<PH_POST>(p, l, grid, stream);
        launch_phase<PH_MLAUP>(p, l, grid, stream);
        launch_phase<PH_POST2>(p, l, grid, stream);
        launch_phase<PH_ATTN>(p, l, grid, stream);
        launch_phase<PH_CMPATTN>(p, l, grid, stream);
        launch_phase<PH_SLC>(p, l, grid, stream);
        launch_phase<PH_MERGE0>(p, l, grid, stream);
        launch_phase<PH_OUT>(p, l, grid, stream);
        launch_phase<PH_ROUTER>(p, l, grid, stream);
        launch_phase<PH_SORT>(p, l, grid, stream);
        launch_phase<PH_MOE1>(p, l, grid, stream);
        launch_phase<PH_MOE2>(p, l, grid, stream);
    }
    launch_phase<PH_FINAL>(p, NLAYER, grid, stream);
#else
    static bool attr_set = false;
    if (!attr_set) { (void)hipFuncSetAttribute((const void*)k_mega, hipFuncAttributeMaxDynamicSharedMemorySize, LDS_BYTES); attr_set = true; }
    hipLaunchKernelGGL(k_mega, dim3(grid), dim3(512), LDS_BYTES, stream, p);
#endif
}
```

```cpp
#include <hip/hip_runtime.h>
#include <cstdio>
#include <cstdint>
#include <cmath>

#ifndef MK_ONE_LAUNCH
#define MK_ONE_LAUNCH 1
#endif
#ifndef PROBE_MASK
#define PROBE_MASK 0u
#endif

#define DEV __device__ __forceinline__
#define LAS __attribute__((address_space(3)))
typedef unsigned short bf16_t;
typedef short bf16x8 __attribute__((ext_vector_type(8)));
typedef float f32x4 __attribute__((ext_vector_type(4)));
typedef unsigned u32x4 __attribute__((ext_vector_type(4)));
typedef unsigned u32x2 __attribute__((ext_vector_type(2)));

constexpr int NBATCH = 4, SEQ = 4096, DM = 1024, NTOK = NBATCH * SEQ, NLAYER = 4;
constexpr int DIN = 6572, NSMALL = 2476, PSW = 2560, NPROJ = 6656, NGATE = 4096;
constexpr int I_QA = 0, I_KC = 256, I_VC = 320, I_KS = 384, I_VS = 448, I_KW = 512, I_VW = 576, I_GL = 640, I_QB = 652, I_KB = 908, I_VB = 1036,
              I_QC = 1164, I_KCC = 1420, I_VCC = 1676, I_CQ = 1932, I_CKV = 2316, I_KR = 2444;
constexpr int ACTW = 2560;
constexpr int A_QA = 0, A_KCR = 256, A_VCR = 320, A_KS = 384, A_VS = 448, A_KW = 512, A_VW = 576, A_QB = 640, A_KB = 896, A_VB = 1024,
              A_QC = 1152, A_KC = 1408, A_VC = 1664, A_CQ = 1920, A_CKV = 2304, A_KR = 2432;
constexpr int ACT2W = 896, A2_QF = 0, A2_KN = 384, A2_VD = 640;
constexpr int NCMP = 255, NEXP = 32, XS_ROWS = 40960;
constexpr float EPS = 1e-6f;
__device__ const float SLOPES[3][4] = {{0.70710678118654752f, 0.25f, 0.08838834764831845f, 0.015625f},
                                       {0.5f, 0.17677669529663689f, 0.0625f, 0.0078125f},
                                       {0.35355339059327379f, 0.125f, 0.03125f, 0.00390625f}};

constexpr size_t MiB = 1u << 20;
constexpr size_t WS_CTL = 0;
constexpr size_t WS_MOD = 1 * MiB;
constexpr size_t WS_ROPE = 2 * MiB;
constexpr size_t WS_MISC = 3 * MiB;
constexpr size_t WS_WIN = 8 * MiB;
constexpr size_t WS_W13 = WS_WIN + 56 * MiB;
constexpr size_t WS_W2 = WS_W13 + 128 * MiB;
constexpr size_t WS_WOUT = WS_W2 + 64 * MiB;
constexpr size_t WS_WBR = WS_WOUT + 8 * MiB;
constexpr size_t WS_CW1 = WS_WBR + 8 * MiB;
constexpr size_t WS_WU = WS_CW1 + 8 * MiB;
constexpr size_t WS_HBF = WS_WU + 4 * MiB;
constexpr size_t WS_BIG = WS_HBF + 32 * MiB;
constexpr size_t WS_GATES = WS_BIG + 160 * MiB;
constexpr size_t WS_ACT = WS_GATES + 128 * MiB;
constexpr size_t WS_ACT2 = WS_ACT + 80 * MiB;
constexpr size_t WS_MUR = WS_ACT2 + 28 * MiB;
constexpr size_t WS_CMPA = WS_MUR + 64 * MiB;
constexpr size_t WS_HID = WS_CMPA + 8 * MiB;
constexpr size_t WS_PB = WS_HID + 1 * MiB;
constexpr size_t WS_OCMP = WS_PB + 16 * MiB;
constexpr size_t WS_OWIN = WS_OCMP + 16 * MiB;
constexpr size_t WS_SMALL = WS_OWIN + 16 * MiB;
constexpr size_t WS_BR = WS_SMALL + 2 * MiB;
constexpr size_t WS_END = WS_BR + 32 * MiB;
static_assert(WS_END <= 1000 * MiB, "workspace map");
constexpr size_t BIG_PSM = 0, BIG_MIX = 0, BIG_MIXB = 64 * MiB, BIG_XS = 0, BIG_YP = 80 * MiB;
constexpr size_t MISC_HIST = 3 * MiB;
constexpr size_t MISC_KCB = 1024 * 1024, MISC_VCB = 1024 * 1024 + 128 * 1024, MISC_WRT = 2 * MiB;
constexpr size_t MISC_KCMP = 0, MISC_VCMP = 256 * 1024, MISC_KMEAN = 512 * 1024, MISC_EID = 640 * 1024, MISC_WTS = 768 * 1024, MISC_PSLOT = 896 * 1024;
constexpr size_t SM_PL = 0, SM_SEL = 256 * 1024, SM_GA = 512 * 1024;
constexpr int CW_BAR = 4096;
constexpr int CW_CNT = 16384;
constexpr int CW_CUR = 16384 + 256;

constexpr int RING_BYTES = 131072, LDS_AUX = RING_BYTES, LDS_BYTES = 147456;

struct Params { const float* in[24]; float* out; unsigned char* ws; };

DEV float bf2f(unsigned v) { return __uint_as_float(v << 16); }
DEV float bflo(unsigned w) { return __uint_as_float(w << 16); }
DEV float bfhi(unsigned w) { return __uint_as_float(w & 0xffff0000u); }
DEV unsigned f2bf(float f) { unsigned u = __float_as_uint(f); return (u + 0x7fffu + ((u >> 16) & 1u)) >> 16; }
DEV unsigned pk2(float lo, float hi) { return f2bf(lo) | (f2bf(hi) << 16); }
template <int M> DEV float swz_xor(float v) { return __int_as_float(__builtin_amdgcn_ds_swizzle(__float_as_int(v), (M << 10) | 0x1f)); }
template <int M> DEV int swz_xor_i(int v) { return __builtin_amdgcn_ds_swizzle(v, (M << 10) | 0x1f); }
DEV float xhalf(float v, float& other) { auto rr = __builtin_amdgcn_permlane32_swap(__float_as_uint(v), __float_as_uint(v), false, false); other = __uint_as_float(rr[1]); return __uint_as_float(rr[0]); }
DEV float wave_sum(float v) {
    v += swz_xor<1>(v); v += swz_xor<2>(v); v += swz_xor<4>(v); v += swz_xor<8>(v); v += swz_xor<16>(v);
    float hi; const float lo = xhalf(v, hi); return lo + hi;
}
DEV float sigm(float x) { return 1.f / (1.f + __expf(-x)); }
DEV float silu_(float x) { return x / (1.f + __expf(-x)); }
#define LDS_WAIT() asm volatile("s_waitcnt lgkmcnt(0)" ::: "memory")

namespace pg8 {
constexpr int BM = 256, BK = 64, HALF = 128, HTB = HALF * BK * 2, STAGE_BYTES = 8 * HTB, NXCD = 8, WGM = 8;
__host__ __device__ __forceinline__ int lds_byte(int r, int c) { const int st = (r >> 4) * 2 + (c >> 5), rr = r & 15, cc = c & 31, ob = rr * 64 + cc * 2; return st * 1024 + (ob ^ (((ob >> 9) & 1) << 5)); }
__host__ __device__ __forceinline__ void stage_rc(int b, int& R, int& C) { const int st = b / 1024, sb = b % 1024, swz = sb ^ (((sb >> 9) & 1) << 5); R = (st >> 1) * 16 + swz / 64; C = (st & 1) * 32 + (swz % 64) / 2; }
__host__ __device__ __forceinline__ int perm32(int rho) { const int n = rho >> 4, i = rho & 15; return 8 * (i >> 2) + 4 * n + (i & 3); }
struct Unit { int pm, pn, ao; };
struct Gemm { const bf16_t* A; const bf16_t* Bt; int lda, K; };
struct StaticOrder {
    int nM, nN, nwg, G, c;
    __device__ void init(int M, int N, int G_, int c_) { nM = M / BM; nN = N / BM; nwg = nM * nN; G = G_; c = c_; }
    __device__ bool next(int i, Unit& u) const {
        const long L = (long)i * G + c; if (L >= nwg) return false;
        int wgid = (int)L; { const int q = nwg / NXCD, r = nwg % NXCD, xcd = wgid % NXCD, off = wgid / NXCD; wgid = (xcd < r ? xcd * (q + 1) : r * (q + 1) + (xcd - r) * q) + off; }
        const int nig = WGM * nN, gid = wgid / nig, fm = gid * WGM, gsz = (nM - fm) < WGM ? (nM - fm) : WGM;
        u.pm = fm + ((wgid % nig) % gsz); u.pn = (wgid % nig) / gsz; u.ao = 0; return true;
    }
};
template <class F> struct Epi8 {
    F f;
    __device__ __forceinline__ void operator()(const f32x4 (&acc)[2][2][4][2], const Unit& u, int wr, int wc, int fr, int fq) const {
        const int row0 = u.pm * BM + wr * 64 + fr, col0 = u.pn * BM + wc * 32 + 8 * fq;
#pragma unroll
        for (int ai = 0; ai < 2; ++ai)
#pragma unroll
            for (int m = 0; m < 4; ++m)
#pragma unroll
                for (int bj = 0; bj < 2; ++bj) f(row0 + ai * HALF + m * 16, col0 + bj * HALF, acc[ai][bj][m][0], acc[ai][bj][m][1]);
    }
};
template <class Epi, class Sched, bool ALIGN_EPI>
__device__ __forceinline__ void gemm_phase(LAS unsigned char* lds, const Gemm g, const Sched& S, const Epi& E) {
    int tid_ = threadIdx.x; asm volatile("" : "+v"(tid_));
    const int tid = tid_, wid = __builtin_amdgcn_readfirstlane(tid >> 6), lane = tid & 63, wr = wid >> 2, wc = wid & 3, fr = lane & 15, fq = lane >> 4;
    const int K = g.K, nt = K / BK, lda = g.lda;
    unsigned voffA[2], voffB[2];
#pragma unroll
    for (int i = 0; i < 2; ++i) { int R, C; stage_rc(tid * 16 + i * 8192, R, C); const int Rb = (R & ~31) + perm32(R & 31);
        voffA[i] = (unsigned)(R * lda + C) * 2u; voffB[i] = (unsigned)(Rb * K + C) * 2u; }
    const size_t kstep = (size_t)(BK * 2);
    const size_t hstepA = (size_t)HALF * lda * 2, tstepA = 2 * hstepA;
    const size_t hstepB = (size_t)HALF * K * 2, tstepB = 2 * hstepB;
    const unsigned ldsw = (unsigned)wid * 1024u;
    const int aoff = lds_byte(wr * 64 + fr, fq * 8), boff = lds_byte(wc * 32 + fr, fq * 8);
#define PG8_SA(b, h) (((b) * 2 + (h)) * HTB)
#define PG8_SB(b, h) ((4 + (b) * 2 + (h)) * HTB)
#define PG8_STAGE(bufoff, gbase, voff) do { _Pragma("unroll") for (int _i = 0; _i < 2; ++_i) \
        __builtin_amdgcn_global_load_lds((const unsigned*)((const char*)(gbase) + (voff)[_i]), (LAS unsigned*)(lds + (bufoff) + ldsw + _i * 8192), 16, 0, 0); } while (0)
#define PG8_LDA(dst, b, h) do { _Pragma("unroll") for (int m = 0; m < 4; ++m) _Pragma("unroll") for (int k = 0; k < 2; ++k) dst[m][k] = *(const LAS bf16x8*)(lds + PG8_SA(b, h) + aoff + m * 2048 + k * 1024); } while (0)
#define PG8_LDB(dst, b, h) do { _Pragma("unroll") for (int n = 0; n < 2; ++n) _Pragma("unroll") for (int k = 0; k < 2; ++k) dst[n][k] = *(const LAS bf16x8*)(lds + PG8_SB(b, h) + boff + n * 2048 + k * 1024); } while (0)
#define PG8_MMA(ai, bj, At, Bt) do { __builtin_amdgcn_s_setprio(1); _Pragma("unroll") for (int m = 0; m < 4; ++m) _Pragma("unroll") for (int n = 0; n < 2; ++n) _Pragma("unroll") for (int k = 0; k < 2; ++k) \
        acc[ai][bj][m][n] = __builtin_amdgcn_mfma_f32_16x16x32_bf16(Bt[n][k], At[m][k], acc[ai][bj][m][n], 0, 0, 0); __builtin_amdgcn_s_setprio(0); } while (0)
#define PG8_WAIT_V(n) asm volatile("s_waitcnt vmcnt(" #n ")" ::: "memory")
#define PG8_WAIT_L(n) asm volatile("s_waitcnt lgkmcnt(" #n ")" ::: "memory")
#define PG8_BAR __builtin_amdgcn_s_barrier()
#define PG8_SCHED __builtin_amdgcn_sched_barrier(0)
    Unit cur, nxt; int ui = 0;
    if (!S.next(0, cur)) return;
    f32x4 acc[2][2][4][2];
#pragma unroll
    for (int a = 0; a < 2; ++a)
#pragma unroll
        for (int b = 0; b < 2; ++b)
#pragma unroll
            for (int m = 0; m < 4; ++m)
#pragma unroll
                for (int n = 0; n < 2; ++n) acc[a][b][m][n] = (f32x4){0.f, 0.f, 0.f, 0.f};
    bf16x8 At[4][2], B0[2][2], B1[2][2];
    const char* cA = (const char*)g.A + (size_t)cur.pm * tstepA + cur.ao; const char* cB = (const char*)g.Bt + (size_t)cur.pn * tstepB;
    PG8_STAGE(PG8_SB(0, 0), cB, voffB); PG8_STAGE(PG8_SB(0, 1), cB + hstepB, voffB); PG8_STAGE(PG8_SA(0, 0), cA, voffA); PG8_STAGE(PG8_SA(0, 1), cA + hstepA, voffA);
    if (wr == 1) PG8_BAR;
    PG8_WAIT_V(2); PG8_BAR;
    PG8_STAGE(PG8_SB(1, 0), cB + kstep, voffB); PG8_STAGE(PG8_SA(1, 0), cA + kstep, voffA); PG8_STAGE(PG8_SB(1, 1), cB + hstepB + kstep, voffB);
    PG8_WAIT_V(6); PG8_BAR;
    for (;;) {
        const bool has_next = S.next(ui + 1, nxt);
        const char* nA = has_next ? (const char*)g.A + (size_t)nxt.pm * tstepA + nxt.ao : cA; const char* nB = has_next ? (const char*)g.Bt + (size_t)nxt.pn * tstepB : cB;
        for (int t = 0; t < nt; t += 2) {
            const bool last = (t == nt - 2);
            const char* a1 = cA + (size_t)(t + 1) * kstep;
            const char* a2 = last ? nA : cA + (size_t)(t + 2) * kstep; const char* b2 = last ? nB : cB + (size_t)(t + 2) * kstep;
            const char* a3 = a2 + kstep; const char* b3 = b2 + kstep;
            PG8_LDB(B0, 0, 0); PG8_LDB(B1, 0, 1); PG8_SCHED; PG8_LDA(At, 0, 0); PG8_STAGE(PG8_SA(1, 1), a1 + hstepA, voffA);
            PG8_WAIT_V(8); PG8_WAIT_L(0); PG8_BAR; PG8_MMA(0, 0, At, B0); PG8_MMA(0, 1, At, B1); PG8_BAR; PG8_SCHED;
            PG8_LDA(At, 0, 1); PG8_STAGE(PG8_SB(0, 0), b2, voffB); PG8_STAGE(PG8_SB(0, 1), b2 + hstepB, voffB); PG8_STAGE(PG8_SA(0, 0), a2, voffA);
            PG8_WAIT_V(8); PG8_WAIT_L(0); PG8_BAR; PG8_MMA(1, 0, At, B0); PG8_MMA(1, 1, At, B1); PG8_BAR; PG8_SCHED;
            PG8_LDB(B0, 1, 0); PG8_LDB(B1, 1, 1); PG8_SCHED; PG8_LDA(At, 1, 0); PG8_STAGE(PG8_SA(0, 1), a2 + hstepA, voffA);
            PG8_WAIT_V(8); PG8_WAIT_L(0); PG8_BAR; PG8_MMA(0, 0, At, B0); PG8_MMA(0, 1, At, B1); PG8_BAR; PG8_SCHED;
            PG8_LDA(At, 1, 1); PG8_STAGE(PG8_SB(1, 0), b3, voffB); PG8_STAGE(PG8_SB(1, 1), b3 + hstepB, voffB); PG8_STAGE(PG8_SA(1, 0), a3, voffA);
            PG8_WAIT_V(8); PG8_WAIT_L(0); PG8_BAR; PG8_MMA(1, 0, At, B0); PG8_MMA(1, 1, At, B1); PG8_BAR; PG8_SCHED;
        }
        if constexpr (ALIGN_EPI) { if (wr == 0) PG8_BAR; }
        E(acc, cur, wr, wc, fr, fq);
        if (!has_next) break;
#pragma unroll
        for (int a = 0; a < 2; ++a)
#pragma unroll
            for (int b = 0; b < 2; ++b)
#pragma unroll
                for (int m = 0; m < 4; ++m)
#pragma unroll
                    for (int n = 0; n < 2; ++n) acc[a][b][m][n] = (f32x4){0.f, 0.f, 0.f, 0.f};
        cur = nxt; cA = nA; cB = nB; ++ui;
        if constexpr (ALIGN_EPI) { if (wr == 1) PG8_BAR; }
    }
    PG8_WAIT_V(0);
    if constexpr (!ALIGN_EPI) { if (wr == 0) PG8_BAR; }
    PG8_BAR;
#undef PG8_SA
#undef PG8_SB
#undef PG8_STAGE
#undef PG8_LDA
#undef PG8_LDB
#undef PG8_MMA
#undef PG8_WAIT_V
#undef PG8_WAIT_L
#undef PG8_BAR
#undef PG8_SCHED
}
}

#define XB_TMO      128
#define XB_XCNT(j)  (256  + 64 * (j))
#define XB_XSUB(j)  (1280 + 64 * (j))
#define XB_XGEN(j)  (2304 + 64 * (j))
#define XB_TOP      3328
#define XB_TOPGEN   3392
#define XCD_BAR_WORDS 3456
#define XB_SPIN_CAP (1u << 22)
__device__ __forceinline__ unsigned xb_ld(unsigned* p)              { return __hip_atomic_load(p, __ATOMIC_RELAXED, __HIP_MEMORY_SCOPE_AGENT); }
__device__ __forceinline__ unsigned xb_add(unsigned* p, unsigned v) { return __hip_atomic_fetch_add(p, v, __ATOMIC_RELAXED, __HIP_MEMORY_SCOPE_AGENT); }
__device__ __forceinline__ unsigned xb_xcc_id() { return (unsigned)__builtin_amdgcn_s_getreg((3 << 11) | 20) & 0xFu; }
#define XB_SPIN(cond, bar) do { unsigned _sp = 0; while (cond) { __builtin_amdgcn_s_sleep(1); \
    if ((++_sp & 255u) == 0u) { if (xb_ld(&(bar)[XB_TMO])) break; if (_sp > XB_SPIN_CAP) { atomicAdd(&(bar)[XB_TMO], 1u); break; } } } } while (0)
struct XcdBarrier { unsigned* bar; unsigned x; volatile LAS unsigned* st; };
__device__ __forceinline__ XcdBarrier xcd_barrier_post(unsigned* bar, volatile LAS unsigned* st) {
    XcdBarrier b; b.bar = bar; b.x = xb_xcc_id(); b.st = st;
    if (threadIdx.x == 0) (void)xb_add(&bar[XB_XCNT(b.x)], 1u);
    return b;
}
__device__ __forceinline__ void xcd_barrier_complete(unsigned* bar, unsigned x, unsigned& nloc, unsigned& nx) {
    const unsigned G = gridDim.x * gridDim.y * gridDim.z;
    unsigned sum, cnt, mine, sp = 0u;
    for (;;) {
        sum = 0u; cnt = 0u; mine = 0u;
#pragma unroll
        for (unsigned j = 0; j < 16; ++j) { const unsigned c = xb_ld(&bar[XB_XCNT(j)]); sum += c; cnt += (c > 0u) ? 1u : 0u; mine = (j == x) ? c : mine; }
        if (sum == G) break;
        __builtin_amdgcn_s_sleep(1);
        if ((++sp & 255u) == 0u) { if (xb_ld(&bar[XB_TMO])) break; if (sp > XB_SPIN_CAP) { atomicAdd(&bar[XB_TMO], 1u); break; } }
    }
    nloc = mine > 0u ? mine : 1u; nx = cnt > 0u ? cnt : 1u;
}
__device__ __noinline__ void xcd_barrier_fn(unsigned* bar_, unsigned x_, volatile LAS unsigned* st_) {
    XcdBarrier b; b.bar = bar_; b.x = x_; b.st = st_;
    asm volatile("s_waitcnt vmcnt(0)" ::: "memory");
    __syncthreads();
    if (threadIdx.x == 0) {
        unsigned* bar = b.bar;
        __builtin_amdgcn_s_waitcnt(0);
        unsigned nloc = b.st[0], nx = b.st[1];
        if (nloc == 0u) { xcd_barrier_complete(bar, b.x, nloc, nx); b.st[0] = nloc; b.st[1] = nx; }
        const unsigned old = xb_add(&bar[XB_XSUB(b.x)], 1u);
        const unsigned gen = old / nloc;
        if (old + 1u == (gen + 1u) * nloc) {
            __builtin_amdgcn_fence(__ATOMIC_RELEASE, "agent");
            asm volatile("s_waitcnt vmcnt(0)" ::: "memory");
            const unsigned og = xb_add(&bar[XB_TOP], 1u);
            const unsigned tg = og / nx;
            if (og + 1u == (tg + 1u) * nx) xb_add(&bar[XB_TOPGEN], 1u);
            else XB_SPIN(xb_ld(&bar[XB_TOPGEN]) == tg, bar);
            __builtin_amdgcn_fence(__ATOMIC_ACQUIRE, "agent");
            xb_add(&bar[XB_XGEN(b.x)], 1u);
            asm volatile("s_waitcnt vmcnt(0)" ::: "memory");
        } else {
            XB_SPIN(xb_ld(&bar[XB_XGEN(b.x)]) == gen, bar);
            __builtin_amdgcn_fence(__ATOMIC_ACQUIRE, "agent");
            asm volatile("s_waitcnt vmcnt(0)" ::: "memory");
        }
    }
    __syncthreads();
}

struct Ctx {
    int tid, lane, wave, gw, NGW, bid, G;
    LAS unsigned char* lds;
};
DEV Ctx make_ctx(LAS unsigned char* lds) {
    Ctx c; int tid_ = threadIdx.x; asm volatile("" : "+v"(tid_));
    c.tid = tid_; c.lane = c.tid & 63; c.wave = __builtin_amdgcn_readfirstlane(c.tid >> 6); { int b_ = blockIdx.x, g_ = gridDim.x; asm volatile("" : "+s"(b_), "+s"(g_)); c.bid = b_; c.G = g_; }
    c.gw = c.bid * 8 + c.wave; c.NGW = c.G * 8; c.lds = lds; return c;
}
#define WSP(T, off) ((T*)(p.ws + (off)))

DEV void transpose_item(const float* W, const float* W2, int ldw, int K, bf16_t* WT, int nblk, int mode, int nvalid, int item, LAS float* scr, int lane) {
    const int kb = item / nblk, nb = item % nblk, k0 = 64 * kb, n0 = 32 * nb;
    const int n = n0 + (lane & 31);
    const float* src = W; int c = -1; int ld = ldw; int kofs = 0;
    if (mode == 0) { c = n < nvalid ? n : -1; }
    else if (mode == 1) { c = n < NSMALL ? n : (n < PSW ? -1 : n - (PSW - NSMALL)); }
    else if (mode == 2) { c = (n & 1) ? 256 + (n >> 1) : (n >> 1); }
    else { if (n < 384 && k0 < 384) { c = n; ld = 384; } else if (n >= 512 && k0 >= 384) { src = W2; c = n - 512; ld = 512; kofs = 384; } }
#pragma unroll
    for (int i = 0; i < 32; ++i) { const int kk = 2 * i + (lane >> 5); scr[kk * 33 + (lane & 31)] = (c >= 0) ? src[(size_t)(k0 - kofs + kk) * ld + c] : 0.f; }
    LDS_WAIT(); asm volatile("" ::: "memory");
    const int c8 = lane & 7;
#pragma unroll
    for (int j = 0; j < 4; ++j) { const int nn = (lane >> 3) + 8 * j; const LAS float* s = scr + (8 * c8) * 33 + nn;
        u32x4 o; o.x = pk2(s[0 * 33], s[1 * 33]); o.y = pk2(s[2 * 33], s[3 * 33]); o.z = pk2(s[4 * 33], s[5 * 33]); o.w = pk2(s[6 * 33], s[7 * 33]);
        *(u32x4*)(WT + (size_t)(n0 + nn) * K + k0 + 8 * c8) = o; }
    LDS_WAIT(); asm volatile("" ::: "memory");
}
constexpr int IT_WIN = 16 * 208, IT_W13 = 256 * 32, IT_W2 = 128 * 32, IT_CW1 = 256 * 2, IT_WBR = 128 * 4, IT_WOUT = 512, IT_WU = 8 * 32;
constexpr int IT_LAYER = IT_WIN + IT_W13 + IT_W2 + IT_CW1 + IT_WBR + IT_WOUT + IT_WU;
DEV void phase_prologue(const Params& p, const Ctx& c) {
    { float* MOD = WSP(float, WS_MOD);
      LAS float* sc = (LAS float*)(c.lds + 73728);
      LAS float* ps = (LAS float*)(c.lds + 90112);
      for (int i = c.tid; i < 4096; i += 512) sc[i] = silu_(p.in[1][i]);
      __syncthreads();
      for (int it = c.bid; it < NLAYER * 96; it += c.G) { const int l = it / 96, j = (it % 96) * 64 + c.lane;
          const float* wa = p.in[2] + ((size_t)l * 1024 + c.wave * 128) * 6144 + j; const LAS float* s0 = sc + c.wave * 128;
          float a0 = 0.f, a1 = 0.f, a2 = 0.f, a3 = 0.f;
#pragma unroll 16
          for (int k = 0; k < 128; ++k) { const float w = wa[(size_t)k * 6144]; a0 += s0[k] * w; a1 += s0[1024 + k] * w; a2 += s0[2048 + k] * w; a3 += s0[3072 + k] * w; }
          ps[(c.wave * 4 + 0) * 64 + c.lane] = a0; ps[(c.wave * 4 + 1) * 64 + c.lane] = a1; ps[(c.wave * 4 + 2) * 64 + c.lane] = a2; ps[(c.wave * 4 + 3) * 64 + c.lane] = a3;
          __syncthreads();
          if (c.tid < 256) { const int bb = c.tid >> 6, jj = (it % 96) * 64 + (c.tid & 63); float a = p.in[3][l * 6144 + jj];
#pragma unroll
              for (int w8 = 0; w8 < 8; ++w8) a += ps[(w8 * 4 + bb) * 64 + (c.tid & 63)];
              MOD[(l * 4 + bb) * 6144 + jj] = a; }
          __syncthreads(); } }
    { float* RC = WSP(float, WS_ROPE); float* RS = RC + 4096 * 16;
      for (int i = c.bid * 512 + c.tid; i < 4096 * 16; i += c.G * 512) { const int pos = i >> 4, k = i & 15;
          const float inv = (float)pow(10000.0, -(double)k / 16.0); const float ang = (float)pos * inv;
          RC[i] = (float)cos((double)ang); RS[i] = (float)sin((double)ang); } }
    { float* WRT = WSP(float, WS_MISC + MISC_WRT);
      for (int i = c.bid * 512 + c.tid; i < NLAYER * 36 * 1024; i += c.G * 512) { const int k = i & 1023, e = (i >> 10) % 36, l = i / (36 * 1024);
          WRT[i] = e < 4 ? p.in[18][((size_t)l * 1024 + k) * 4 + e] : p.in[20][((size_t)l * 1024 + k) * 32 + (e - 4)]; } }
    LAS float* scr = (LAS float*)(c.lds + c.wave * 8448);
    for (int it = c.gw; it < IT_LAYER * NLAYER; it += c.NGW) {
        const int l = it / IT_LAYER; int r = it % IT_LAYER;
        if (r < IT_WIN) { transpose_item(p.in[5] + (size_t)l * 1024 * DIN, nullptr, DIN, 1024, WSP(bf16_t, WS_WIN) + (size_t)l * NPROJ * 1024, NPROJ / 32, 1, 0, r, scr, c.lane); continue; } r -= IT_WIN;
        if (r < IT_W13) { const int e = r / 256; transpose_item(p.in[22] + (size_t)(l * 32 + e) * 1024 * 512, nullptr, 512, 1024, WSP(bf16_t, WS_W13) + (size_t)(l * 32 + e) * 512 * 1024, 16, 2, 0, r % 256, scr, c.lane); continue; } r -= IT_W13;
        if (r < IT_W2) { const int e = r / 128; transpose_item(p.in[23] + (size_t)(l * 32 + e) * 256 * 1024, nullptr, 1024, 256, WSP(bf16_t, WS_W2) + (size_t)(l * 32 + e) * 1024 * 256, 32, 0, 1024, r % 128, scr, c.lane); continue; } r -= IT_W2;
        if (r < IT_CW1) { const int blk = r / 64, kv = blk >> 2, ks = blk & 3; transpose_item(p.in[8] + ((size_t)(l * 2 + kv) * 2048 + ks * 512) * 256, nullptr, 256, 512, WSP(bf16_t, WS_CW1) + (size_t)(l * 8 + blk) * 256 * 512, 8, 0, 256, r % 64, scr, c.lane); continue; } r -= IT_CW1;
        if (r < IT_WBR) { const int n = r / 128; transpose_item(p.in[16] + (size_t)(l * 4 + n) * 256 * 1024, nullptr, 1024, 256, WSP(bf16_t, WS_WBR) + (size_t)(l * 4 + n) * 1024 * 256, 32, 0, 1024, r % 128, scr, c.lane); continue; } r -= IT_WBR;
        if (r < IT_WOUT) { transpose_item(p.in[17] + (size_t)l * 1024 * 1024, nullptr, 1024, 1024, WSP(bf16_t, WS_WOUT) + (size_t)l * 1024 * 1024, 32, 0, 1024, r, scr, c.lane); continue; } r -= IT_WOUT;
        transpose_item(p.in[14] + (size_t)l * 384 * 384, p.in[15] + (size_t)l * 128 * 512, 0, 512, WSP(bf16_t, WS_WU) + (size_t)l * 1024 * 512, 32, 3, 0, r, scr, c.lane);
    }
}

template <bool NORM, bool WRITEX> DEV void phase_norm1(const Params& p, const Ctx& c, int l) {
    const float* MOD = WSP(float, WS_MOD);
    const bf16_t* YP = (const bf16_t*)(p.ws + WS_BIG + BIG_YP);
    const int* PSLOT = WSP(int, WS_MISC + MISC_PSLOT); const float* WTS = WSP(float, WS_MISC + MISC_WTS);
    bf16_t* HBF = WSP(bf16_t, WS_HBF);
    for (int row = c.gw; row < NTOK; row += c.NGW) {
        const int b = row / SEQ;
        f32x4 v[4];
        if (l == 0 || !WRITEX) {
            const float* xs = l == 0 ? p.in[0] : p.out;
#pragma unroll
            for (int j = 0; j < 4; ++j) v[j] = *(const f32x4*)(xs + (size_t)row * DM + j * 256 + c.lane * 4);
        } else {
            const float* g2 = MOD + ((l - 1) * 4 + b) * 6144 + 5120;
            const int s0 = PSLOT[row * 2], s1 = PSLOT[row * 2 + 1]; const float w0 = WTS[row * 2], w1 = WTS[row * 2 + 1];
#pragma unroll
            for (int j = 0; j < 4; ++j) { const int col = j * 256 + c.lane * 4;
                const f32x4 x = *(const f32x4*)(p.out + (size_t)row * DM + col); const f32x4 g = *(const f32x4*)(g2 + col);
                const u32x2 y0 = *(const u32x2*)(YP + (size_t)s0 * DM + col), y1 = *(const u32x2*)(YP + (size_t)s1 * DM + col);
                f32x4 y; y[0] = w0 * bflo(y0.x) + w1 * bflo(y1.x); y[1] = w0 * bfhi(y0.x) + w1 * bfhi(y1.x); y[2] = w0 * bflo(y0.y) + w1 * bflo(y1.y); y[3] = w0 * bfhi(y0.y) + w1 * bfhi(y1.y);
                v[j] = x + g * y; }
        }
        if (WRITEX) {
#pragma unroll
            for (int j = 0; j < 4; ++j) *(f32x4*)(p.out + (size_t)row * DM + j * 256 + c.lane * 4) = v[j]; }
        if (NORM) {
            float ss = 0.f;
#pragma unroll
            for (int j = 0; j < 4; ++j) ss += (v[j][0] * v[j][0] + v[j][1] * v[j][1]) + (v[j][2] * v[j][2] + v[j][3] * v[j][3]);
            const float r = rsqrtf(wave_sum(ss) * (1.f / DM) + EPS);
            const float* gn = p.in[4] + (size_t)(l * 2 + 0) * DM; const float* sh = MOD + (l * 4 + b) * 6144; const float* sc = sh + 1024;
#pragma unroll
            for (int j = 0; j < 4; ++j) { const int col = j * 256 + c.lane * 4;
                const f32x4 g = *(const f32x4*)(gn + col), s1 = *(const f32x4*)(sc + col), s0 = *(const f32x4*)(sh + col);
                const f32x4 h = v[j] * r * g * (s1 + 1.f) + s0;
                u32x2 o; o.x = pk2(h[0], h[1]); o.y = pk2(h[2], h[3]); *(u32x2*)(HBF + (size_t)row * DM + col) = o; }
        }
    }
}

struct FInproj { bf16_t* PSB; bf16_t* GATES;
    DEV void operator()(int row, int col, const f32x4& v0, const f32x4& v1) const {
        u32x4 w; w.x = pk2(v0[0], v0[1]); w.y = pk2(v0[2], v0[3]); w.z = pk2(v1[0], v1[1]); w.w = pk2(v1[2], v1[3]);
        if (col < PSW) *(u32x4*)(PSB + (size_t)row * PSW + col) = w; else *(u32x4*)(GATES + (size_t)row * NGATE + (col - PSW)) = w; } };
DEV void phase_inproj(const Params& p, const Ctx& c, int l) {
    pg8::Gemm g{WSP(bf16_t, WS_HBF), WSP(bf16_t, WS_WIN) + (size_t)l * NPROJ * 1024, 1024, 1024};
    pg8::StaticOrder S; S.init(NTOK, NPROJ, c.G, c.bid);
    pg8::Epi8<FInproj> E{{(bf16_t*)(p.ws + WS_BIG + BIG_PSM), WSP(bf16_t, WS_GATES)}};
    pg8::gemm_phase<pg8::Epi8<FInproj>, pg8::StaticOrder, true>(c.lds, g, S, E);
}

DEV float head_norm(float v, const float* gain, int lane) { const float ss = wave_sum(v * v); return v * rsqrtf(ss * (1.f / 64.f) + EPS) * gain[lane]; }
#define P_(i_) bf2f(PB_[i_])
DEV void phase_post(const Params& p, const Ctx& c, int l) {
    const bf16_t* PSM = (const bf16_t*)(p.ws + WS_BIG + BIG_PSM); bf16_t* ACT = WSP(bf16_t, WS_ACT);
    float* GA = WSP(float, WS_SMALL + SM_GA);
    const float* gq = p.in[6] + (size_t)l * 10 * 64;
    const float* RC = WSP(float, WS_ROPE); const float* RS = RC + 4096 * 16;
    const int lane = c.lane;
    for (int row = c.gw; row < NTOK; row += c.NGW) {
        const bf16_t* PB_ = PSM + (size_t)row * PSW; bf16_t* A = ACT + (size_t)row * ACTW; const int t = row % SEQ;
#pragma unroll
        for (int h = 0; h < 4; ++h) A[A_QA + h * 64 + lane] = (bf16_t)f2bf(head_norm(P_(I_QA + h * 64 + lane), gq + 0 * 64, lane));
        A[A_KCR + lane] = (bf16_t)f2bf(P_(I_KC + lane)); A[A_VCR + lane] = (bf16_t)f2bf(P_(I_VC + lane));
        A[A_KS + lane] = (bf16_t)f2bf(head_norm(P_(I_KS + lane), gq + 2 * 64, lane)); A[A_VS + lane] = (bf16_t)f2bf(P_(I_VS + lane));
        A[A_KW + lane] = (bf16_t)f2bf(head_norm(P_(I_KW + lane), gq + 3 * 64, lane)); A[A_VW + lane] = (bf16_t)f2bf(P_(I_VW + lane));
        if (lane < 12) GA[row * 12 + lane] = sigm(P_(I_GL + lane));
#pragma unroll
        for (int h = 0; h < 4; ++h) A[A_QB + h * 64 + lane] = (bf16_t)f2bf(head_norm(P_(I_QB + h * 64 + lane), gq + 4 * 64, lane));
#pragma unroll
        for (int h = 0; h < 2; ++h) { A[A_KB + h * 64 + lane] = (bf16_t)f2bf(head_norm(P_(I_KB + h * 64 + lane), gq + 5 * 64, lane)); A[A_VB + h * 64 + lane] = (bf16_t)f2bf(P_(I_VB + h * 64 + lane)); }
#pragma unroll
        for (int h = 0; h < 4; ++h) { A[A_QC + h * 64 + lane] = (bf16_t)f2bf(head_norm(P_(I_QC + h * 64 + lane), gq + 6 * 64, lane));
            A[A_KC + h * 64 + lane] = (bf16_t)f2bf(head_norm(P_(I_KCC + h * 64 + lane), gq + 7 * 64, lane)); A[A_VC + h * 64 + lane] = (bf16_t)f2bf(P_(I_VCC + h * 64 + lane)); }
        { float x[6]; float ss = 0.f;
#pragma unroll
          for (int j = 0; j < 6; ++j) { x[j] = P_(I_CQ + j * 64 + lane); ss += x[j] * x[j]; }
          const float r = rsqrtf(wave_sum(ss) * (1.f / 384.f) + EPS); const float* g = p.in[11] + l * 384;
#pragma unroll
          for (int j = 0; j < 6; ++j) A[A_CQ + j * 64 + lane] = (bf16_t)f2bf(x[j] * r * g[j * 64 + lane]); }
        { float x0 = P_(I_CKV + lane), x1 = P_(I_CKV + 64 + lane); const float r = rsqrtf(wave_sum(x0 * x0 + x1 * x1) * (1.f / 128.f) + EPS); const float* g = p.in[12] + l * 128;
          A[A_CKV + lane] = (bf16_t)f2bf(x0 * r * g[lane]); A[A_CKV + 64 + lane] = (bf16_t)f2bf(x1 * r * g[64 + lane]); }
        { const float x = lane < 32 ? P_(I_KR + lane) : 0.f; const float r = rsqrtf(wave_sum(x * x) * (1.f / 32.f) + EPS);
          const float y = x * r * p.in[13][(l * 2 + 1) * 32 + (lane & 31)];
          const float yo = swz_xor<16>(y); const int k = lane & 15; const float cs = RC[t * 16 + k], sn = RS[t * 16 + k];
          const float o = (lane & 16) ? (yo * sn + y * cs) : (y * cs - yo * sn);
          if (lane < 32) A[A_KR + lane] = (bf16_t)f2bf(o); }
    }
}
#undef P_

struct FStoreF32 { float* O; int ld;
    DEV void operator()(int row, int col, const f32x4& v0, const f32x4& v1) const { float* o = O + (size_t)row * ld + col; *(f32x4*)o = v0; *(f32x4*)(o + 4) = v1; } };
DEV void phase_mlaup(const Params& p, const Ctx& c, int l) {
    { pg8::Gemm g{WSP(bf16_t, WS_ACT) + A_CQ, WSP(bf16_t, WS_WU) + (size_t)l * 1024 * 512, ACTW, 512};
      pg8::StaticOrder S; S.init(NTOK, 1024, c.G, c.bid);
      pg8::Epi8<FStoreF32> E{{WSP(float, WS_MUR), 1024}};
      pg8::gemm_phase<pg8::Epi8<FStoreF32>, pg8::StaticOrder, true>(c.lds, g, S, E); }
    { const bf16_t* ACT = WSP(bf16_t, WS_ACT); bf16_t* CMPA = WSP(bf16_t, WS_CMPA); const float* pe = p.in[7] + (size_t)l * 2 * 32 * 64;
      for (int idx = c.bid * 512 + c.tid; idx < 2 * 1024 * 256; idx += c.G * 512) {
          const int c8 = idx & 255, r = (idx >> 8) & 1023, kv = idx >> 18; const int j = c8 >> 3, d = (c8 & 7) * 8;
          u32x4 o = (u32x4){0u, 0u, 0u, 0u};
          if (r < 1020) { const int b = r / 255, i = r % 255; const size_t tok = (size_t)b * SEQ + 16 * i + j;
              const u32x4 s = *(const u32x4*)(ACT + tok * ACTW + (kv ? A_VCR : A_KCR) + d); const float* pp = pe + (kv * 32 + j) * 64 + d;
              o.x = pk2(bflo(s.x) + pp[0], bfhi(s.x) + pp[1]); o.y = pk2(bflo(s.y) + pp[2], bfhi(s.y) + pp[3]); o.z = pk2(bflo(s.z) + pp[4], bfhi(s.z) + pp[5]); o.w = pk2(bflo(s.w) + pp[6], bfhi(s.w) + pp[7]); }
          *(u32x4*)(CMPA + ((size_t)kv * 1024 + r) * 2048 + c8 * 8) = o; } }
    { const bf16_t* ACT = WSP(bf16_t, WS_ACT); float* KM = WSP(float, WS_MISC + MISC_KMEAN);
      for (int idx = c.bid * 512 + c.tid; idx < 4 * 16 * 256; idx += c.G * 512) { const int hd = idx & 255, n = (idx >> 8) & 15, b = idx >> 12;
          const bf16_t* src = ACT + ((size_t)b * SEQ + n * 256) * ACTW + A_KC + hd; float s = 0.f;
          for (int i = 0; i < 256; ++i) s += bf2f(src[(size_t)i * ACTW]);
          KM[idx] = s * (1.f / 256.f); } }
}

struct CmpOrder { int G, c; DEV bool next(int i, pg8::Unit& u) const { const int L = i * G + c; if (L >= 32) return false; const int ks = L & 3, pm = L >> 2; u.pm = pm; u.pn = (pm >> 2) * 4 + ks; u.ao = ks * 1024; return true; } };
struct FCmpPart { float* HIDP;
    DEV void operator()(int row, int vcol, const f32x4& v0, const f32x4& v1) const { const int cc = vcol & 255, ks = (vcol >> 8) & 3;
        float* o = HIDP + ((size_t)ks * 2048 + row) * 256 + cc; *(f32x4*)o = v0; *(f32x4*)(o + 4) = v1; } };
DEV void phase_post2(const Params& p, const Ctx& c, int l) {
    {
      pg8::Gemm g{WSP(bf16_t, WS_CMPA), WSP(bf16_t, WS_CW1) + (size_t)l * 2 * 256 * 2048, 2048, 512};
      CmpOrder S{c.G, c.bid}; pg8::Epi8<FCmpPart> E{{WSP(float, WS_PB)}};
      pg8::gemm_phase<pg8::Epi8<FCmpPart>, CmpOrder, true>(c.lds, g, S, E); }
    const float* MUR = WSP(float, WS_MUR); bf16_t* ACT2 = WSP(bf16_t, WS_ACT2);
    const float* gq = p.in[6] + (size_t)l * 10 * 64; const float* RC = WSP(float, WS_ROPE); const float* RS = RC + 4096 * 16;
    const int lane = c.lane;
    for (int row = c.gw; row < NTOK; row += c.NGW) {
        const float* R = MUR + (size_t)row * 1024; bf16_t* A = ACT2 + (size_t)row * ACT2W; const int t = row % SEQ;
#pragma unroll
        for (int h = 0; h < 4; ++h) {
            A[A2_QF + h * 96 + lane] = (bf16_t)f2bf(head_norm(R[h * 96 + lane], gq + 8 * 64, lane));
            { const float x = lane < 32 ? R[h * 96 + 64 + lane] : 0.f; const float r = rsqrtf(wave_sum(x * x) * (1.f / 32.f) + EPS);
              const float y = x * r * p.in[13][(l * 2 + 0) * 32 + (lane & 31)];
              const float yo = swz_xor<16>(y); const int k = lane & 15; const float cs = RC[t * 16 + k], sn = RS[t * 16 + k];
              const float o = (lane & 16) ? (yo * sn + y * cs) : (y * cs - yo * sn);
              if (lane < 32) A[A2_QF + h * 96 + 64 + lane] = (bf16_t)f2bf(o); }
            A[A2_KN + h * 64 + lane] = (bf16_t)f2bf(head_norm(R[512 + h * 128 + lane], gq + 9 * 64, lane));
            A[A2_VD + h * 64 + lane] = (bf16_t)f2bf(R[512 + h * 128 + 64 + lane]);
        }
    }
}

template <int D0, int D1, int DV>
DEV void att_step(const float (&q)[D0 + D1], float (&o)[DV], float& m, float& l, const bf16_t* k0, const bf16_t* k1, const bf16_t* v, float scale, float bias, bool valid) {
    float acc = 0.f;
#pragma unroll
    for (int i = 0; i < D0 / 8; ++i) { const u32x4 u = *(const u32x4*)(k0 + 8 * i);
        acc += q[8 * i] * bflo(u.x) + q[8 * i + 1] * bfhi(u.x) + q[8 * i + 2] * bflo(u.y) + q[8 * i + 3] * bfhi(u.y) + q[8 * i + 4] * bflo(u.z) + q[8 * i + 5] * bfhi(u.z) + q[8 * i + 6] * bflo(u.w) + q[8 * i + 7] * bfhi(u.w); }
    if (D1 > 0) {
#pragma unroll
        for (int i = 0; i < D1 / 8; ++i) { const u32x4 u = *(const u32x4*)(k1 + 8 * i); const int b = D0 + 8 * i;
            acc += q[b] * bflo(u.x) + q[b + 1] * bfhi(u.x) + q[b + 2] * bflo(u.y) + q[b + 3] * bfhi(u.y) + q[b + 4] * bflo(u.z) + q[b + 5] * bfhi(u.z) + q[b + 6] * bflo(u.w) + q[b + 7] * bfhi(u.w); }
    }
    const float s = acc * scale + bias;
    if (valid) {
        if (s > m) { const float a = __expf(m - s); l *= a;
#pragma unroll
            for (int d = 0; d < DV; ++d) o[d] *= a;
            m = s; }
        const float pr = __expf(s - m); l += pr;
#pragma unroll
        for (int i = 0; i < DV / 8; ++i) { const u32x4 u = *(const u32x4*)(v + 8 * i);
            o[8 * i] += pr * bflo(u.x); o[8 * i + 1] += pr * bfhi(u.x); o[8 * i + 2] += pr * bflo(u.y); o[8 * i + 3] += pr * bfhi(u.y);
            o[8 * i + 4] += pr * bflo(u.z); o[8 * i + 5] += pr * bfhi(u.z); o[8 * i + 6] += pr * bflo(u.w); o[8 * i + 7] += pr * bfhi(u.w); }
    }
}
template <int D> DEV void load_q(float (&q)[D], const bf16_t* src) {
#pragma unroll
    for (int i = 0; i < D / 8; ++i) { const u32x4 u = *(const u32x4*)(src + 8 * i);
        q[8 * i] = bflo(u.x); q[8 * i + 1] = bfhi(u.x); q[8 * i + 2] = bflo(u.y); q[8 * i + 3] = bfhi(u.y); q[8 * i + 4] = bflo(u.z); q[8 * i + 5] = bfhi(u.z); q[8 * i + 6] = bflo(u.w); q[8 * i + 7] = bfhi(u.w); }
}
template <int DV> DEV void store_o_bf16(bf16_t* dst, const float (&o)[DV], float inv) {
#pragma unroll
    for (int i = 0; i < DV / 8; ++i) { u32x4 w; w.x = pk2(o[8 * i] * inv, o[8 * i + 1] * inv); w.y = pk2(o[8 * i + 2] * inv, o[8 * i + 3] * inv); w.z = pk2(o[8 * i + 4] * inv, o[8 * i + 5] * inv); w.w = pk2(o[8 * i + 6] * inv, o[8 * i + 7] * inv);
        *(u32x4*)(dst + 8 * i) = w; }
}
DEV void item_bgh(int it, int& b, int& g, int& h) { const int r = it & 63, bh = it >> 6; g = (r & 1) ? 63 - (r >> 1) : (r >> 1); b = bh >> 2; h = bh & 3; }

DEV void phase_attn(const Params& p, const Ctx& c, int l) {
    const int lane = c.lane;
    { const bf16_t* HID = WSP(bf16_t, WS_HID); float* KC = WSP(float, WS_MISC + MISC_KCMP); float* VC = WSP(float, WS_MISC + MISC_VCMP);
      const float* gq = p.in[6] + (size_t)l * 10 * 64;
      for (int it = c.gw; it < 2 * 1020; it += c.NGW) { const int kv = it / 1020, r = it % 1020;
          const float* w2 = p.in[9] + (size_t)(l * 2 + kv) * 256 * 64; const bf16_t* hrow = HID + ((size_t)kv * 1024 + r) * 256;
          float a = 0.f;
          for (int k = 0; k < 256; ++k) a += bf2f(hrow[k]) * w2[k * 64 + lane];
          const int b = r / 255, i = r % 255;
          if (kv == 0) KC[(b * 256 + i) * 64 + lane] = head_norm(a, gq + 1 * 64, lane); else VC[(b * 256 + i) * 64 + lane] = a; } }
    const bf16_t* ACT = WSP(bf16_t, WS_ACT); const bf16_t* ACT2 = WSP(bf16_t, WS_ACT2); bf16_t* BR = WSP(bf16_t, WS_BR);
    for (int it0 = c.gw; it0 < 2048; it0 += c.NGW) {
        if (it0 < 1024) {
            int b, g, h; item_bgh(it0, b, g, h); const int t = g * 64 + lane; const size_t tok = (size_t)b * SEQ + t;
            float q[96], o[64]; float m = -INFINITY, ls = 0.f;
            load_q<96>(q, ACT2 + tok * ACT2W + A2_QF + h * 96);
#pragma unroll
            for (int d = 0; d < 64; ++d) o[d] = 0.f;
            const float scale = 0.10206207261596575f;
            for (int s = g * 64 + 63; s >= 0; --s) { const size_t kt = (size_t)b * SEQ + s;
                att_step<64, 32, 64>(q, o, m, ls, ACT2 + kt * ACT2W + A2_KN + h * 64, ACT + kt * ACTW + A_KR, ACT2 + kt * ACT2W + A2_VD + h * 64, scale, 0.f, s <= t); }
            store_o_bf16<64>(BR + tok * 1024 + 768 + h * 64, o, 1.f / ls);
        } else {
            int b, g, h; item_bgh(it0 - 1024, b, g, h); const int t = g * 64 + lane; const size_t tok = (size_t)b * SEQ + t;
            const int nb = g >> 2; const float slope = SLOPES[2][h];
            float q[64], o[64]; float m = -INFINITY, ls = 0.f;
            load_q<64>(q, ACT + tok * ACTW + A_QC + h * 64);
#pragma unroll
            for (int d = 0; d < 64; ++d) o[d] = 0.f;
            const float* KM = WSP(float, WS_MISC + MISC_KMEAN) + (size_t)b * 16 * 256 + h * 64;
            float v1 = -INFINITY, v2 = -INFINITY, v3 = -INFINITY; int i1 = -1, i2 = -1, i3 = -1;
            for (int n = 0; n < nb; ++n) { const float* km = KM + n * 256; float dsum = 0.f;
#pragma unroll
                for (int d = 0; d < 64; ++d) dsum += q[d] * km[d];
                if (dsum > v1) { v3 = v2; i3 = i2; v2 = v1; i2 = i1; v1 = dsum; i1 = n; }
                else if (dsum > v2) { v3 = v2; i3 = i2; v2 = dsum; i2 = n; }
                else if (dsum > v3) { v3 = dsum; i3 = n; } }
            const int start = nb * 256;
            for (int s = g * 64 + 63; s >= start; --s) { const size_t kt = (size_t)b * SEQ + s;
                att_step<64, 0, 64>(q, o, m, ls, ACT + kt * ACTW + A_KC + h * 64, nullptr, ACT + kt * ACTW + A_VC + h * 64, 0.125f, -slope * (float)(t - s), s <= t); }
            for (int n = nb - 1; n >= 0; --n) { const bool sel = (n == i1) || (n == i2) || (n == i3);
                if (!__any(sel)) continue;
                for (int s = n * 256 + 255; s >= n * 256; --s) { const size_t kt = (size_t)b * SEQ + s;
                    att_step<64, 0, 64>(q, o, m, ls, ACT + kt * ACTW + A_KC + h * 64, nullptr, ACT + kt * ACTW + A_VC + h * 64, 0.125f, -slope * (float)(t - s), sel); } }
            store_o_bf16<64>(BR + tok * 1024 + 512 + h * 64, o, 1.f / ls);
        }
    }
    for (int it0 = c.gw; it0 < 2048; it0 += c.NGW) {
        const bool swa = it0 >= 1024;
        int b, g, h; item_bgh(swa ? it0 - 1024 : it0, b, g, h); const int t = g * 64 + lane; const size_t tok = (size_t)b * SEQ + t;
        const int W = swa ? 128 : 512; const float slope = SLOPES[swa ? 1 : 0][h];
        const int qoff = swa ? A_QB + h * 64 : A_QA + h * 64, koff = swa ? A_KB + (h >> 1) * 64 : A_KW, voff = swa ? A_VB + (h >> 1) * 64 : A_VW;
        float q[64], o[64]; float m = -INFINITY, ls = 0.f;
        load_q<64>(q, ACT + tok * ACTW + qoff);
#pragma unroll
        for (int d = 0; d < 64; ++d) o[d] = 0.f;
        int lo = g * 64 - (W - 1); if (lo < 0) lo = 0;
        for (int s = g * 64 + 63; s >= lo; --s) { const size_t kt = (size_t)b * SEQ + s; const int dist = t - s;
            att_step<64, 0, 64>(q, o, m, ls, ACT + kt * ACTW + koff, nullptr, ACT + kt * ACTW + voff, 0.125f, -slope * (float)dist, dist >= 0 && dist < W); }
        if (swa) { const float sk = p.in[10][l * 4 + h]; const float mf = fmaxf(m, sk); const float a = __expf(m - mf); const float den = ls * a + __expf(sk - mf);
            store_o_bf16<64>(BR + tok * 1024 + 256 + h * 64, o, a / den); }
        else { float* OW = WSP(float, WS_OWIN) + tok * 256 + h * 64; const float inv = 1.f / ls;
#pragma unroll
            for (int d = 0; d < 64; d += 4) *(f32x4*)(OW + d) = (f32x4){o[d] * inv, o[d + 1] * inv, o[d + 2] * inv, o[d + 3] * inv}; }
    }
}

DEV void phase_cmpattn(const Params& p, const Ctx& c, int l) {
    const bf16_t* ACT = WSP(bf16_t, WS_ACT); const float* KC = WSP(float, WS_MISC + MISC_KCMP); const float* VC = WSP(float, WS_MISC + MISC_VCMP);
    float* PB = WSP(float, WS_PB); float* PL = WSP(float, WS_SMALL + SM_PL); float* OC = WSP(float, WS_OCMP);
    const int lane = c.lane;
    for (int it = c.gw; it < 1024; it += c.NGW) {
        int b, g, h; item_bgh(it, b, g, h); const int t = g * 64 + lane; const size_t tok = (size_t)b * SEQ + t; const float slope = SLOPES[0][h];
        float q[64], o[64];
        load_q<64>(q, ACT + tok * ACTW + A_QA + h * 64);
#pragma unroll
        for (int d = 0; d < 64; ++d) o[d] = 0.f;
        const int nvis = t >= 31 ? ((t - 31) >> 4) + 1 : 0;
        const int tmaxw = g * 64 + 63; const int nmax = tmaxw >= 31 ? ((tmaxw - 31) >> 4) + 1 : 0;
        const float* kcb = KC + (size_t)b * 256 * 64; const float* vcb = VC + (size_t)b * 256 * 64;
        float m = -INFINITY;
        for (int n = 0; n < nmax; ++n) { const float* k = kcb + n * 64; float a = 0.f;
#pragma unroll
            for (int d = 0; d < 64; ++d) a += q[d] * k[d];
            const float s = a * 0.125f - slope * (float)(t - (16 * n + 31));
            if (n < nvis) m = fmaxf(m, s); }
        float ls = 0.f, carry = 0.f; float* pb = PB + (tok * 4 + h) * 64;
        for (int j = 0; j < 64; ++j) { float e4[4];
#pragma unroll
            for (int u = 0; u < 4; ++u) { const int n = 4 * j + u; float e = 0.f;
                if (n < nmax) { const float* k = kcb + n * 64; float a = 0.f;
#pragma unroll
                    for (int d = 0; d < 64; ++d) a += q[d] * k[d];
                    const float s = a * 0.125f - slope * (float)(t - (16 * n + 31));
                    if (n < nvis) { e = __expf(s - m); const float* v = vcb + n * 64;
#pragma unroll
                        for (int d = 0; d < 64; ++d) o[d] += e * v[d]; } }
                e4[u] = e; }
            pb[j] = carry + e4[0] + e4[1] + e4[2] + e4[3]; carry = e4[3]; ls += e4[0] + e4[1] + e4[2] + e4[3];
            if (4 * j + 4 >= nmax) { for (int jj = j + 1; jj < 64; ++jj) pb[jj] = (jj == j + 1) ? carry : 0.f; break; } }
        const float inv = 1.f / fmaxf(ls, 1e-30f);
        PL[tok * 4 + h] = inv;
        float* oc = OC + tok * 256 + h * 64;
#pragma unroll
        for (int d = 0; d < 64; d += 4) *(f32x4*)(oc + d) = (f32x4){o[d] * inv, o[d + 1] * inv, o[d + 2] * inv, o[d + 3] * inv};
    }
}

DEV void phase_topk(const Params& p, const Ctx& c) {
    const float* PB = WSP(float, WS_PB); const float* PL = WSP(float, WS_SMALL + SM_PL); unsigned long long* SEL = WSP(unsigned long long, WS_SMALL + SM_SEL);
    const int lane = c.lane;
    for (int tok = c.gw; tok < NTOK; tok += c.NGW) {
        const int t = tok % SEQ, cur = t >> 6;
        float ps = 0.f;
#pragma unroll
        for (int h = 0; h < 4; ++h) ps += PB[((size_t)tok * 4 + h) * 64 + lane] * PL[tok * 4 + h];
        const bool forced = (lane == 0) || (lane == cur) || (lane == cur - 1);
        float score = lane <= cur ? ps + (forced ? 1e4f : 0.f) : -1e30f;
        unsigned long long mask = 0ull;
        for (int r = 0; r < 8; ++r) {
            float bv = score; int bi = lane;
#define TK_STEP(M) { const float ov = swz_xor<M>(bv); const int oi = swz_xor_i<M>(bi); if (ov > bv || (ov == bv && oi < bi)) { bv = ov; bi = oi; } }
            TK_STEP(1) TK_STEP(2) TK_STEP(4) TK_STEP(8) TK_STEP(16)
#undef TK_STEP
            { auto rv = __builtin_amdgcn_permlane32_swap(__float_as_uint(bv), __float_as_uint(bv), false, false); auto ri = __builtin_amdgcn_permlane32_swap((unsigned)bi, (unsigned)bi, false, false);
              const float v0 = __uint_as_float(rv[0]), v1 = __uint_as_float(rv[1]); const int i0 = (int)ri[0], i1 = (int)ri[1];
              if (v1 > v0 || (v1 == v0 && i1 < i0)) { bv = v1; bi = i1; } else { bv = v0; bi = i0; } }
            if (bv > -5e29f) mask |= 1ull << bi;
            if (lane == bi) score = -INFINITY;
        }
        if (lane == 0) SEL[tok] = mask;
    }
}

DEV void phase_slc(const Params& p, const Ctx& c, int l) {
    const bf16_t* ACT = WSP(bf16_t, WS_ACT); bf16_t* BR = WSP(bf16_t, WS_BR); const unsigned long long* SEL = WSP(unsigned long long, WS_SMALL + SM_SEL);
    const float* OC = WSP(float, WS_OCMP); const float* OW = WSP(float, WS_OWIN); const float* GA = WSP(float, WS_SMALL + SM_GA);
    const int lane = c.lane;
    for (int it = c.gw; it < 1024; it += c.NGW) {
        int b, g, h; item_bgh(it, b, g, h); const int t = g * 64 + lane; const size_t tok = (size_t)b * SEQ + t; const float slope = SLOPES[0][h];
        float q[64], o[64]; float m = -INFINITY, ls = 0.f;
        load_q<64>(q, ACT + tok * ACTW + A_QA + h * 64);
#pragma unroll
        for (int d = 0; d < 64; ++d) o[d] = 0.f;
        const unsigned long long mask = SEL[tok];
        for (int j = g; j >= 0; --j) { const bool sel = (mask >> j) & 1ull;
            if (!__any(sel)) continue;
            for (int s = j * 64 + 63; s >= j * 64; --s) { const size_t kt = (size_t)b * SEQ + s;
                att_step<64, 0, 64>(q, o, m, ls, ACT + kt * ACTW + A_KS, nullptr, ACT + kt * ACTW + A_VS, 0.125f, -slope * (float)(t - s), sel && s <= t); } }
        const float inv = 1.f / ls; const float g0 = GA[tok * 12 + h * 3], g1 = GA[tok * 12 + h * 3 + 1], g2 = GA[tok * 12 + h * 3 + 2];
        const float* oc = OC + tok * 256 + h * 64; const float* ow = OW + tok * 256 + h * 64;
#pragma unroll
        for (int d = 0; d < 64; ++d) o[d] = g0 * oc[d] + g1 * o[d] * inv + g2 * ow[d];
        store_o_bf16<64>(BR + tok * 1024 + h * 64, o, 1.f);
    }
}


namespace fa {
typedef float f32x16 __attribute__((ext_vector_type(16)));
typedef short v4i16_t __attribute__((ext_vector_type(4)));
typedef float f32x2_t __attribute__((ext_vector_type(2))); typedef __bf16 bf16x2_t __attribute__((ext_vector_type(2)));
constexpr int KROWB = 208, VROWB = 192, KBYTES = 64 * KROWB, VBYTES = 64 * VROWB, STG = KBYTES + VBYTES;
constexpr int LDS_MISC = 2 * STG;
constexpr float LOG2E = 1.4426950408889634f;
constexpr float MFLOOR = -1e20f;
DEV unsigned cvtpk(float lo, float hi) { f32x2_t v = {lo, hi}; bf16x2_t b = __builtin_convertvector(v, bf16x2_t); return __builtin_bit_cast(unsigned, b); }
DEV unsigned long long uni64(unsigned long long v) { const unsigned lo = __builtin_amdgcn_readfirstlane((unsigned)v), hi = __builtin_amdgcn_readfirstlane((unsigned)(v >> 32)); return ((unsigned long long)hi << 32) | lo; }
DEV unsigned long long wave_or64(unsigned long long v) {
    unsigned lo = (unsigned)v, hi = (unsigned)(v >> 32);
#define FA_OR(M) lo |= (unsigned)__builtin_amdgcn_ds_swizzle((int)lo, (M << 10) | 0x1f); hi |= (unsigned)__builtin_amdgcn_ds_swizzle((int)hi, (M << 10) | 0x1f);
    FA_OR(1) FA_OR(2) FA_OR(4) FA_OR(8) FA_OR(16)
#undef FA_OR
    { auto a = __builtin_amdgcn_permlane32_swap(lo, lo, false, false); lo = a[0] | a[1]; auto b = __builtin_amdgcn_permlane32_swap(hi, hi, false, false); hi = b[0] | b[1]; }
    return uni64(((unsigned long long)hi << 32) | lo);
}
struct Src { const bf16_t* k; int kp; const bf16_t* k2; int k2p; const bf16_t* v; int vp; };
template <int NQ, bool ALIBI, int SELMODE>
DEV void attn_tile(const LAS unsigned char* kb, const LAS unsigned char* vb, const bf16x8 (&qf)[NQ], const f32x16& ci0, const f32x16& ci1, int kt, int lane,
                   int t, float nslope2, float c1, unsigned W, unsigned long long rowmask, int own_blk, f32x16 (&o)[2], float& m, float& l) {
    const int r32 = lane & 31, hi = lane >> 5, i16 = lane & 15, tq = i16 >> 2, tp = i16 & 3, blk = (lane >> 4) & 1;
    f32x16 s0, s1;
#pragma unroll
    for (int d0 = 0; d0 < NQ; ++d0) {
        const bf16x8 k0 = *(const LAS bf16x8*)(kb + r32 * KROWB + (16 * d0 + 8 * hi) * 2);
        const bf16x8 k1 = *(const LAS bf16x8*)(kb + (32 + r32) * KROWB + (16 * d0 + 8 * hi) * 2);
        s0 = __builtin_amdgcn_mfma_f32_32x32x16_bf16(k0, qf[d0], d0 == 0 ? ci0 : s0, 0, 0, 0);
        s1 = __builtin_amdgcn_mfma_f32_32x32x16_bf16(k1, qf[d0], d0 == 0 ? ci1 : s1, 0, 0, 0);
    }
    bool rowsel = true;
    if (SELMODE == 1) rowsel = (rowmask >> kt) & 1ull;
    if (SELMODE == 2) rowsel = ((kt >> 2) == own_blk) || ((rowmask >> (kt >> 2)) & 1ull);
    const int db0 = t - (kt * 64 + 4 * hi);
    const bool allok = rowsel && ((unsigned)(db0 - 59) < (W - 59u));
    if (!__all(allok)) {
        const unsigned Weff = rowsel ? W : 0u;
#pragma unroll
        for (int i = 0; i < 16; ++i) { const int cr = (i & 3) + 8 * (i >> 2);
            s0[i] = ((unsigned)(db0 - cr) < Weff) ? s0[i] : -INFINITY; s1[i] = ((unsigned)(db0 - 32 - cr) < Weff) ? s1[i] : -INFINITY; }
    }
    float smax = fmaxf(s0[0], s1[0]);
#pragma unroll
    for (int i = 1; i < 16; ++i) smax = fmaxf(smax, fmaxf(s0[i], s1[i]));
    const float Bt = ALIBI ? nslope2 * (float)db0 : 0.f;
    float mx = fmaf(smax, c1, Bt);
    { auto rr = __builtin_amdgcn_permlane32_swap(__float_as_uint(mx), __float_as_uint(mx), false, false); mx = fmaxf(__uint_as_float(rr[0]), __uint_as_float(rr[1])); }
    const float mn = fmaxf(m, mx);
    if (__any(mn > m)) { const float alpha = __builtin_amdgcn_exp2f(m - mn); l *= alpha;
#pragma unroll
        for (int dt = 0; dt < 2; ++dt)
#pragma unroll
            for (int i = 0; i < 16; ++i) o[dt][i] *= alpha; }
    m = mn;
    const float boff = Bt - mn;
    float ls = 0.f;
#pragma unroll
    for (int i = 0; i < 16; ++i) { s0[i] = __builtin_amdgcn_exp2f(fmaf(s0[i], c1, boff)); s1[i] = __builtin_amdgcn_exp2f(fmaf(s1[i], c1, boff)); ls += s0[i] + s1[i]; }
    l += ls;
#pragma unroll
    for (int hf = 0; hf < 2; ++hf)
#pragma unroll
        for (int ks = 0; ks < 2; ++ks) {
            u32x4 pw;
            if (hf == 0) { pw.x = cvtpk(s0[8 * ks], s0[8 * ks + 1]); pw.y = cvtpk(s0[8 * ks + 2], s0[8 * ks + 3]); pw.z = cvtpk(s0[8 * ks + 4], s0[8 * ks + 5]); pw.w = cvtpk(s0[8 * ks + 6], s0[8 * ks + 7]); }
            else         { pw.x = cvtpk(s1[8 * ks], s1[8 * ks + 1]); pw.y = cvtpk(s1[8 * ks + 2], s1[8 * ks + 3]); pw.z = cvtpk(s1[8 * ks + 4], s1[8 * ks + 5]); pw.w = cvtpk(s1[8 * ks + 6], s1[8 * ks + 7]); }
            const bf16x8 pb = __builtin_bit_cast(bf16x8, pw);
#pragma unroll
            for (int dt = 0; dt < 2; ++dt) {
                const LAS unsigned char* vp = vb + (32 * hf + 16 * ks + 4 * hi + tq) * VROWB + (32 * dt + 16 * blk + 4 * tp) * 2;
                const v4i16_t lo = __builtin_amdgcn_ds_read_tr16_b64_v4i16((LAS v4i16_t*)vp);
                const v4i16_t hv = __builtin_amdgcn_ds_read_tr16_b64_v4i16((LAS v4i16_t*)(vp + 8 * VROWB));
                const bf16x8 va = (bf16x8){lo[0], lo[1], lo[2], lo[3], hv[0], hv[1], hv[2], hv[3]};
                o[dt] = __builtin_amdgcn_mfma_f32_32x32x16_bf16(va, pb, o[dt], 0, 0, 0);
            }
        }
}
template <int NQ, bool ALIBI, int SELMODE>
DEV void attn_pass(LAS unsigned char* lds, const Ctx& c, const Src& src, const bf16x8 (&qf)[NQ], unsigned long long tmask, unsigned long long wmask,
                   int t, float nslope2, float c1, unsigned W, unsigned long long rowmask, int own_blk, f32x16 (&o)[2], float& m, float& l) {
    const int tid = c.tid, lane = c.lane;
    const int skey = tid >> 3, sch = tid & 7, skey2 = tid >> 2, sch2 = tid & 3;
    u32x4 kA, vA, k2A = (u32x4){0u, 0u, 0u, 0u}, kB, vB, k2B = (u32x4){0u, 0u, 0u, 0u};
#define FA_GLOAD(kt_, KR, VR, K2R) do { const size_t r_ = (size_t)((kt_) * 64 + skey); KR = *(const u32x4*)(src.k + r_ * src.kp + sch * 8); VR = *(const u32x4*)(src.v + r_ * src.vp + sch * 8); \
        if (NQ == 6) { if (tid < 256) K2R = *(const u32x4*)(src.k2 + (size_t)((kt_) * 64 + skey2) * src.k2p + sch2 * 8); } } while (0)
#define FA_LSTORE(buf_, KR, VR, K2R) do { LAS unsigned char* st_ = lds + (buf_) * STG; *(LAS u32x4*)(st_ + skey * KROWB + sch * 16) = KR; *(LAS u32x4*)(st_ + KBYTES + skey * VROWB + sch * 16) = VR; \
        if (NQ == 6) { if (tid < 256) *(LAS u32x4*)(st_ + skey2 * KROWB + 128 + sch2 * 16) = K2R; } } while (0)
#define FA_NEXT(kt_, ok_) do { ok_ = tmask != 0ull; kt_ = 0; if (ok_) { kt_ = 63 - __builtin_clzll(tmask); tmask &= ~(1ull << kt_); } } while (0)
#define FA_TILE(kt_, buf_) do { if ((wmask >> (kt_)) & 1ull) attn_tile<NQ, ALIBI, SELMODE>(lds + (buf_) * STG, lds + (buf_) * STG + KBYTES, qf, ci0, ci1, kt_, lane, t, nslope2, c1, W, rowmask, own_blk, o, m, l); } while (0)
#pragma unroll
    for (int dt = 0; dt < 2; ++dt)
#pragma unroll
        for (int i = 0; i < 16; ++i) o[dt][i] = 0.f;
    m = MFLOOR; l = 0.f;
    f32x16 ci0, ci1;
#pragma unroll
    for (int i = 0; i < 16; ++i) { const int cr = (i & 3) + 8 * (i >> 2); ci0[i] = ALIBI ? -nslope2 * (float)cr / c1 : 0.f; ci1[i] = ALIBI ? -nslope2 * (float)(32 + cr) / c1 : 0.f; }
    int ktA, ktB; bool okA, okB;
    FA_NEXT(ktA, okA);
    if (!okA) return;
    FA_GLOAD(ktA, kA, vA, k2A);
    FA_NEXT(ktB, okB);
    if (okB) FA_GLOAD(ktB, kB, vB, k2B);
    for (;;) {
        { FA_LSTORE(0, kA, vA, k2A); __syncthreads(); const int cur = ktA; FA_NEXT(ktA, okA); if (okA) FA_GLOAD(ktA, kA, vA, k2A); FA_TILE(cur, 0); }
        if (!okB) break;
        { FA_LSTORE(1, kB, vB, k2B); __syncthreads(); const int cur = ktB; FA_NEXT(ktB, okB); if (okB) FA_GLOAD(ktB, kB, vB, k2B); FA_TILE(cur, 1); }
        if (!okA) break;
    }
    __syncthreads();
    { auto rr = __builtin_amdgcn_permlane32_swap(__float_as_uint(l), __float_as_uint(l), false, false); l = __uint_as_float(rr[0]) + __uint_as_float(rr[1]); }
#undef FA_GLOAD
#undef FA_LSTORE
#undef FA_NEXT
#undef FA_TILE
}
template <int NQ> DEV void load_qf(bf16x8 (&qf)[NQ], const bf16_t* qrow, int hi) {
#pragma unroll
    for (int d0 = 0; d0 < NQ; ++d0) qf[d0] = *(const bf16x8*)(qrow + 16 * d0 + 8 * hi);
}
DEV void store_o(bf16_t* orow, const f32x16 (&o)[2], float sc, int hi) {
#pragma unroll
    for (int dt = 0; dt < 2; ++dt)
#pragma unroll
        for (int g = 0; g < 4; ++g) { u32x2 w; w.x = cvtpk(o[dt][4 * g] * sc, o[dt][4 * g + 1] * sc); w.y = cvtpk(o[dt][4 * g + 2] * sc, o[dt][4 * g + 3] * sc);
            *(u32x2*)(orow + 32 * dt + 8 * g + 4 * hi) = w; }
}
DEV unsigned long long expand4(unsigned m16) { unsigned long long r = 0ull;
#pragma unroll
    for (int j = 0; j < 16; ++j) if ((m16 >> j) & 1u) r |= 0xFull << (4 * j);
    return r; }
}


DEV void moba_gate(const Params& p, const Ctx& c);
namespace fc {
using namespace fa;
constexpr int CKROWB = 144, CVROWB = 320, CKB = 64 * CKROWB, CVB = 64 * CVROWB, CSTG = CKB + CVB, BINS_OFF = 2 * CSTG, BINW = 65;
static_assert(BINS_OFF + 4 * 64 * BINW * 4 <= RING_BYTES, "cmp unit LDS");
DEV void cmp_unit(const Params& p, const Ctx& c, int b, int cb) {
    LAS unsigned char* lds = c.lds;
    const int tid = c.tid, lane = c.lane, r32 = lane & 31, hi = lane >> 5, w = c.wave, h = w >> 1;
    const int t = cb * 64 + (w & 1) * 32 + r32; const size_t tok = (size_t)b * SEQ + t;
    const bf16_t* ACT = WSP(bf16_t, WS_ACT);
    const bf16_t* KCB = WSP(bf16_t, WS_MISC + MISC_KCB) + (size_t)b * 256 * 64; const bf16_t* VCB = WSP(bf16_t, WS_MISC + MISC_VCB) + (size_t)b * 256 * 64;
    bf16x8 qf[4]; load_qf<4>(qf, ACT + tok * ACTW + A_QA + h * 64, hi);
    const float nslope2 = -SLOPES[0][h] * LOG2E, c1 = 0.125f * LOG2E;
    const int tmaxu = cb * 64 + 63; const int nvmax = tmaxu >= 31 ? ((tmaxu - 31) >> 4) + 1 : 0;
    const int ntile = (nvmax + 63) >> 6;
    const int skey = tid >> 3, sch = tid & 7;
    const int i16 = lane & 15, tq = i16 >> 2, tp = i16 & 3, blk = (lane >> 4) & 1;
    f32x16 o[4]; float m = MFLOOR, l = 0.f;
#pragma unroll
    for (int dt = 0; dt < 4; ++dt)
#pragma unroll
        for (int i = 0; i < 16; ++i) o[dt][i] = 0.f;
    for (int kt = ntile - 1; kt >= 0; --kt) {
        const int buf = kt & 1;
        LAS unsigned char* st = lds + buf * CSTG;
        { const int n = kt * 64 + skey;
          *(LAS u32x4*)(st + skey * CKROWB + sch * 16) = *(const u32x4*)(KCB + (size_t)n * 64 + sch * 8);
          *(LAS u32x4*)(st + CKB + skey * CVROWB + sch * 16) = *(const u32x4*)(VCB + (size_t)n * 64 + sch * 8);
          unsigned cw[4];
#pragma unroll
          for (int e = 0; e < 4; ++e) { const int j0 = sch * 8 + 2 * e, j1 = j0 + 1; const int ja = n >> 2; const bool ex = (n & 3) == 3;
              const unsigned lo16 = (j0 == ja || (ex && j0 == ja + 1)) ? 0x3F80u : 0u, hi16 = (j1 == ja || (ex && j1 == ja + 1)) ? 0x3F80u : 0u; cw[e] = lo16 | (hi16 << 16); }
          *(LAS u32x4*)(st + CKB + skey * CVROWB + 128 + sch * 16) = (u32x4){cw[0], cw[1], cw[2], cw[3]}; }
        __syncthreads();
        const LAS unsigned char* kb = st; const LAS unsigned char* vb = st + CKB;
        f32x16 s0, s1;
#pragma unroll
        for (int i = 0; i < 16; ++i) { s0[i] = 0.f; s1[i] = 0.f; }
#pragma unroll
        for (int d0 = 0; d0 < 4; ++d0) {
            const bf16x8 k0 = *(const LAS bf16x8*)(kb + r32 * CKROWB + (16 * d0 + 8 * hi) * 2);
            const bf16x8 k1 = *(const LAS bf16x8*)(kb + (32 + r32) * CKROWB + (16 * d0 + 8 * hi) * 2);
            s0 = __builtin_amdgcn_mfma_f32_32x32x16_bf16(k0, qf[d0], s0, 0, 0, 0);
            s1 = __builtin_amdgcn_mfma_f32_32x32x16_bf16(k1, qf[d0], s1, 0, 0, 0);
        }
        const int db0 = (t - 31) - 16 * (kt * 64 + 4 * hi);
        float mx = -INFINITY;
#pragma unroll
        for (int i = 0; i < 16; ++i) { const int cr = (i & 3) + 8 * (i >> 2);
            { const int d = db0 - 16 * cr; float x = fmaf((float)d, nslope2, s0[i] * c1); x = (d >= 0) ? x : -INFINITY; s0[i] = x; mx = fmaxf(mx, x); }
            { const int d = db0 - 16 * (32 + cr); float x = fmaf((float)d, nslope2, s1[i] * c1); x = (d >= 0) ? x : -INFINITY; s1[i] = x; mx = fmaxf(mx, x); } }
        { auto rr = __builtin_amdgcn_permlane32_swap(__float_as_uint(mx), __float_as_uint(mx), false, false); mx = fmaxf(__uint_as_float(rr[0]), __uint_as_float(rr[1])); }
        const float mn = fmaxf(m, mx); const float alpha = __builtin_amdgcn_exp2f(m - mn); m = mn;
        float ls = 0.f;
#pragma unroll
        for (int i = 0; i < 16; ++i) { s0[i] = __builtin_amdgcn_exp2f(s0[i] - mn); s1[i] = __builtin_amdgcn_exp2f(s1[i] - mn); ls += s0[i] + s1[i]; }
        l = l * alpha + ls;
#pragma unroll
        for (int dt = 0; dt < 4; ++dt)
#pragma unroll
            for (int i = 0; i < 16; ++i) o[dt][i] *= alpha;
#pragma unroll
        for (int hf = 0; hf < 2; ++hf)
#pragma unroll
            for (int ks = 0; ks < 2; ++ks) {
                u32x4 pw;
                if (hf == 0) { pw.x = cvtpk(s0[8 * ks], s0[8 * ks + 1]); pw.y = cvtpk(s0[8 * ks + 2], s0[8 * ks + 3]); pw.z = cvtpk(s0[8 * ks + 4], s0[8 * ks + 5]); pw.w = cvtpk(s0[8 * ks + 6], s0[8 * ks + 7]); }
                else         { pw.x = cvtpk(s1[8 * ks], s1[8 * ks + 1]); pw.y = cvtpk(s1[8 * ks + 2], s1[8 * ks + 3]); pw.z = cvtpk(s1[8 * ks + 4], s1[8 * ks + 5]); pw.w = cvtpk(s1[8 * ks + 6], s1[8 * ks + 7]); }
                const bf16x8 pb = __builtin_bit_cast(bf16x8, pw);
#pragma unroll
                for (int dt = 0; dt < 4; ++dt) {
                    const LAS unsigned char* vp = vb + (32 * hf + 16 * ks + 4 * hi + tq) * CVROWB + (32 * dt + 16 * blk + 4 * tp) * 2;
                    const v4i16_t lo = __builtin_amdgcn_ds_read_tr16_b64_v4i16((LAS v4i16_t*)vp);
                    const v4i16_t hv = __builtin_amdgcn_ds_read_tr16_b64_v4i16((LAS v4i16_t*)(vp + 8 * CVROWB));
                    const bf16x8 va = (bf16x8){lo[0], lo[1], lo[2], lo[3], hv[0], hv[1], hv[2], hv[3]};
                    o[dt] = __builtin_amdgcn_mfma_f32_32x32x16_bf16(va, pb, o[dt], 0, 0, 0);
                }
            }
    }
    { auto rr = __builtin_amdgcn_permlane32_swap(__float_as_uint(l), __float_as_uint(l), false, false); l = __uint_as_float(rr[0]) + __uint_as_float(rr[1]); }
    const float inv = 1.f / fmaxf(l, 1e-30f);
    { float* oc = WSP(float, WS_OCMP) + tok * 256 + h * 64;
#pragma unroll
      for (int dt = 0; dt < 2; ++dt)
#pragma unroll
          for (int g = 0; g < 4; ++g) *(f32x4*)(oc + 32 * dt + 8 * g + 4 * hi) = (f32x4){o[dt][4 * g] * inv, o[dt][4 * g + 1] * inv, o[dt][4 * g + 2] * inv, o[dt][4 * g + 3] * inv}; }
    LAS float* bins = (LAS float*)(lds + BINS_OFF);
    { const int rowl = h * 64 + (w & 1) * 32 + r32;
#pragma unroll
      for (int dd = 0; dd < 2; ++dd)
#pragma unroll
          for (int i = 0; i < 16; ++i) bins[rowl * BINW + 32 * dd + (i & 3) + 8 * (i >> 2) + 4 * hi] = o[2 + dd][i] * inv; }
    __syncthreads();
    unsigned long long* SEL = WSP(unsigned long long, WS_SMALL + SM_SEL);
    for (int i = 0; i < 8; ++i) { const int tl = w * 8 + i; const int tt = cb * 64 + tl; const int cur = cb;
        const float ps = ((bins[(0 * 64 + tl) * BINW + lane] + bins[(1 * 64 + tl) * BINW + lane]) + bins[(2 * 64 + tl) * BINW + lane]) + bins[(3 * 64 + tl) * BINW + lane];
        const bool forced = (lane == 0) || (lane == cur) || (lane == cur - 1);
        float score = lane <= cur ? ps + (forced ? 1e4f : 0.f) : -1e30f;
        unsigned long long mask = 0ull;
        for (int r = 0; r < 8; ++r) {
            float bv = score; int bi = lane;
#define TK_STEP(M) { const float ov = swz_xor<M>(bv); const int oi = swz_xor_i<M>(bi); if (ov > bv || (ov == bv && oi < bi)) { bv = ov; bi = oi; } }
            TK_STEP(1) TK_STEP(2) TK_STEP(4) TK_STEP(8) TK_STEP(16)
#undef TK_STEP
            { auto rv = __builtin_amdgcn_permlane32_swap(__float_as_uint(bv), __float_as_uint(bv), false, false); auto ri = __builtin_amdgcn_permlane32_swap((unsigned)bi, (unsigned)bi, false, false);
              const float v0 = __uint_as_float(rv[0]), v1 = __uint_as_float(rv[1]); const int i0 = (int)ri[0], i1 = (int)ri[1];
              if (v1 > v0 || (v1 == v0 && i1 < i0)) { bv = v1; bi = i1; } else { bv = v0; bi = i0; } }
            if (bv > -5e29f) mask |= 1ull << bi;
            if (lane == bi) score = -INFINITY;
        }
        if (lane == 0) SEL[(size_t)b * SEQ + tt] = mask;
    }
    __syncthreads();
}
}
DEV void phase_cmpsel(const Params& p, const Ctx& c, int l) {
    for (int u = c.bid; u < 256; u += c.G) { const int v = (u * 37) & 255;
        fc::cmp_unit(p, c, v & 3, 63 - (v >> 2)); }
    moba_gate(p, c);
}

constexpr int CW_QUEUE = 16384 + 512;
constexpr int N_ATT_UNITS = 1024;
DEV void phase_attn2(const Params& p, const Ctx& c, int l) {
    using namespace fa;
    const bf16_t* ACT = WSP(bf16_t, WS_ACT); const bf16_t* ACT2 = WSP(bf16_t, WS_ACT2); bf16_t* BR = WSP(bf16_t, WS_BR);
    unsigned* qhead = WSP(unsigned, WS_CTL) + CW_QUEUE + l; l &= 7;
    volatile LAS unsigned* misc = (volatile LAS unsigned*)(c.lds + LDS_MISC);
    const int lane = c.lane, r32 = lane & 31, hi = lane >> 5, w = c.wave;
    for (;;) {
        if (c.tid == 0) { misc[0] = atomicAdd(qhead, 1u); misc[2] = 0u; misc[3] = 0u; }
        __syncthreads();
        const int u = (int)__builtin_amdgcn_readfirstlane(misc[0]);
        if (u >= N_ATT_UNITS) break;
        f32x16 o[2]; float m, ls;
        if (u < 512) {
            const int k = 15 - (u >> 5), r = u & 31, bh = r & 15, b = bh >> 2, h = bh & 3; const bool moba = (r >> 4) != 0;
            const int t = k * 256 + w * 32 + r32; const size_t tok = (size_t)b * SEQ + t; const size_t b0 = (size_t)b * SEQ;
            if (!moba) {
                bf16x8 qf[6]; load_qf<6>(qf, ACT2 + tok * ACT2W + A2_QF + h * 96, hi);
                const Src src{ACT2 + b0 * ACT2W + A2_KN + h * 64, ACT2W, ACT + b0 * ACTW + A_KR, ACTW, ACT2 + b0 * ACT2W + A2_VD + h * 64, ACT2W};
                const int nt = 4 * k + 4; const unsigned long long tm = nt >= 64 ? ~0ull : ((1ull << nt) - 1ull);
                const int nw = 4 * k + (w >> 1) + 1; const unsigned long long wm = nw >= 64 ? ~0ull : ((1ull << nw) - 1ull);
                __syncthreads();
                attn_pass<6, false, 0>(c.lds, c, src, qf, tm, wm, t, 0.f, 0.10206207261596575f * LOG2E, 0x7fffffffu, 0ull, 0, o, m, ls);
                store_o(BR + tok * 1024 + 768 + h * 64, o, 1.f / ls, hi);
            } else {
                bf16x8 qf[4]; load_qf<4>(qf, ACT + tok * ACTW + A_QC + h * 64, hi);
                const Src src{ACT + b0 * ACTW + A_KC + h * 64, ACTW, nullptr, 0, ACT + b0 * ACTW + A_VC + h * 64, ACTW};
                const unsigned rm = WSP(unsigned, WS_OWIN)[tok * 4 + h];
                const unsigned long long wor = wave_or64((unsigned long long)rm);
                if (lane == 0) atomicOr((unsigned*)&misc[2], (unsigned)wor);
                __syncthreads();
                const unsigned bor = __builtin_amdgcn_readfirstlane(misc[2]);
                const unsigned long long own_all = 0xFull << (4 * k);
                const int nw = (w >> 1) + 1; const unsigned long long own_w = ((1ull << nw) - 1ull) << (4 * k);
                const unsigned long long tm = uni64(expand4(bor) | own_all), wm = uni64(expand4((unsigned)wor) | own_w);
                attn_pass<4, true, 2>(c.lds, c, src, qf, tm, wm, t, -SLOPES[2][h] * LOG2E, 0.125f * LOG2E, 0x7fffffffu, (unsigned long long)rm, k, o, m, ls);
                store_o(BR + tok * 1024 + 512 + h * 64, o, 1.f / ls, hi);
            }
        } else if (u < 768) {
            const int v = u - 512, cb = 63 - (v >> 2), b = v & 3, h = w >> 1;
            const int t = cb * 64 + (w & 1) * 32 + r32; const size_t tok = (size_t)b * SEQ + t; const size_t b0 = (size_t)b * SEQ;
            bf16x8 qf[4]; load_qf<4>(qf, ACT + tok * ACTW + A_QA + h * 64, hi);
            const float nsl = -SLOPES[0][h] * LOG2E;
            const float* GA = WSP(float, WS_SMALL + SM_GA) + tok * 12 + h * 3; const float g0 = GA[0], g1 = GA[1], g2 = GA[2];
            const unsigned long long rm = WSP(unsigned long long, WS_SMALL + SM_SEL)[tok];
            const unsigned long long wor = wave_or64(rm);
            if (lane == 0) { atomicOr((unsigned*)&misc[2], (unsigned)wor); atomicOr((unsigned*)&misc[3], (unsigned)(wor >> 32)); }
            { const Src src{ACT + b0 * ACTW + A_KW, ACTW, nullptr, 0, ACT + b0 * ACTW + A_VW, ACTW};
              const int lo = cb >= 8 ? cb - 8 : 0; const unsigned long long upto = cb >= 63 ? ~0ull : ((1ull << (cb + 1)) - 1ull); const unsigned long long tm = upto & ~((1ull << lo) - 1ull);
              __syncthreads();
              attn_pass<4, true, 0>(c.lds, c, src, qf, tm, tm, t, nsl, 0.125f * LOG2E, 512u, 0ull, 0, o, m, ls); }
            f32x16 res[2]; { const float sc = g2 / ls;
#pragma unroll
              for (int dt = 0; dt < 2; ++dt)
#pragma unroll
                  for (int i = 0; i < 16; ++i) res[dt][i] = o[dt][i] * sc; }
            { const Src src{ACT + b0 * ACTW + A_KS, ACTW, nullptr, 0, ACT + b0 * ACTW + A_VS, ACTW};
              const unsigned long long tm = ((unsigned long long)__builtin_amdgcn_readfirstlane(misc[3]) << 32) | __builtin_amdgcn_readfirstlane(misc[2]);
              attn_pass<4, true, 1>(c.lds, c, src, qf, tm, wor, t, nsl, 0.125f * LOG2E, 0x7fffffffu, rm, 0, o, m, ls); }
            { const float sc = g1 / ls; const float* oc = WSP(float, WS_OCMP) + tok * 256 + h * 64;
#pragma unroll
              for (int dt = 0; dt < 2; ++dt)
#pragma unroll
                  for (int g = 0; g < 4; ++g) { const f32x4 cv = *(const f32x4*)(oc + 32 * dt + 8 * g + 4 * hi);
#pragma unroll
                      for (int e = 0; e < 4; ++e) res[dt][4 * g + e] += o[dt][4 * g + e] * sc + g0 * cv[e]; } }
            store_o(BR + tok * 1024 + h * 64, res, 1.f, hi);
        } else {
            const int v = u - 768, b = v >> 6, g = (v >> 5) & 1, cc = v & 31, hr = w >> 2, h = 2 * g + hr;
            const int t = cc * 128 + (w & 3) * 32 + r32; const size_t tok = (size_t)b * SEQ + t; const size_t b0 = (size_t)b * SEQ;
            bf16x8 qf[4]; load_qf<4>(qf, ACT + tok * ACTW + A_QB + h * 64, hi);
            const Src src{ACT + b0 * ACTW + A_KB + g * 64, ACTW, nullptr, 0, ACT + b0 * ACTW + A_VB + g * 64, ACTW};
            const int lo = cc >= 1 ? 2 * cc - 2 : 0; const int hiT = 2 * cc + 1; const unsigned long long upto = hiT >= 63 ? ~0ull : ((1ull << (hiT + 1)) - 1ull);
            const unsigned long long tm = upto & ~((1ull << lo) - 1ull);
            const unsigned long long wm = ((w & 3) < 2) ? (tm & ~(1ull << hiT)) : tm;
            __syncthreads();
            attn_pass<4, true, 0>(c.lds, c, src, qf, tm, wm, t, -SLOPES[1][h] * LOG2E, 0.125f * LOG2E, 128u, 0ull, 0, o, m, ls);
            const float sk2 = p.in[10][l * 4 + h] * LOG2E; const float mf = fmaxf(m, sk2); const float a = __builtin_amdgcn_exp2f(m - mf); const float den = ls * a + __builtin_amdgcn_exp2f(sk2 - mf);
            store_o(BR + tok * 1024 + 256 + h * 64, o, a / den, hi);
        }
        __syncthreads();
    }
}
DEV void moba_gate(const Params& p, const Ctx& c) {
    const bf16_t* ACT = WSP(bf16_t, WS_ACT); unsigned* MS = WSP(unsigned, WS_OWIN);
    for (int it = c.gw; it < 1024; it += c.NGW) {
        int b, g, h; item_bgh(it, b, g, h); const int t = g * 64 + c.lane; const size_t tok = (size_t)b * SEQ + t; const int nb = g >> 2;
        float q[64]; load_q<64>(q, ACT + tok * ACTW + A_QC + h * 64);
        const float* KM = WSP(float, WS_MISC + MISC_KMEAN) + (size_t)b * 16 * 256 + h * 64;
        float v1 = -INFINITY, v2 = -INFINITY, v3 = -INFINITY; int i1 = -1, i2 = -1, i3 = -1;
        for (int n = 0; n < nb; ++n) { const float* km = KM + n * 256; float dsum = 0.f;
#pragma unroll
            for (int d = 0; d < 64; ++d) dsum += q[d] * km[d];
            if (dsum > v1) { v3 = v2; i3 = i2; v2 = v1; i2 = i1; v1 = dsum; i1 = n; }
            else if (dsum > v2) { v3 = v2; i3 = i2; v2 = dsum; i2 = n; }
            else if (dsum > v3) { v3 = dsum; i3 = n; } }
        unsigned mk = 0u; if (i1 >= 0) mk |= 1u << i1; if (i2 >= 0) mk |= 1u << i2; if (i3 >= 0) mk |= 1u << i3;
        MS[tok * 4 + h] = mk;
    }
}
DEV void phase_cmpw2(const Params& p, const Ctx& c, int l) {
    const int lane = c.lane;
    const float* HIDP = WSP(float, WS_PB);
    bf16_t* KCB = WSP(bf16_t, WS_MISC + MISC_KCB); bf16_t* VCB = WSP(bf16_t, WS_MISC + MISC_VCB);
    const float* gq = p.in[6] + (size_t)l * 10 * 64;
    LAS float* hs = (LAS float*)(c.lds + c.wave * 1024);
    for (int it = c.gw; it < 2 * 1020; it += c.NGW) { const int kv = it / 1020, r = it % 1020; const size_t row = (size_t)kv * 1024 + r;
#pragma unroll
        for (int j = 0; j < 4; ++j) { const int k = lane + 64 * j;
            const float hsum = (HIDP[(0 * 2048 + row) * 256 + k] + HIDP[(1 * 2048 + row) * 256 + k]) + (HIDP[(2 * 2048 + row) * 256 + k] + HIDP[(3 * 2048 + row) * 256 + k]);
            hs[k] = silu_(hsum); }
        LDS_WAIT(); asm volatile("" ::: "memory");
        const float* w2 = p.in[9] + (size_t)(l * 2 + kv) * 256 * 64;
        float a0 = 0.f, a1 = 0.f, a2 = 0.f, a3 = 0.f;
#pragma unroll 8
        for (int k = 0; k < 256; k += 4) { a0 += hs[k] * w2[k * 64 + lane]; a1 += hs[k + 1] * w2[(k + 1) * 64 + lane]; a2 += hs[k + 2] * w2[(k + 2) * 64 + lane]; a3 += hs[k + 3] * w2[(k + 3) * 64 + lane]; }
        const float a = (a0 + a1) + (a2 + a3);
        LDS_WAIT(); asm volatile("" ::: "memory");
        const int b = r / 255, i = r % 255;
        if (kv == 0) KCB[(b * 256 + i) * 64 + lane] = (bf16_t)f2bf(head_norm(a, gq + 1 * 64, lane)); else VCB[(b * 256 + i) * 64 + lane] = (bf16_t)f2bf(a);
        if (i == 0) { if (kv == 0) KCB[(b * 256 + 255) * 64 + lane] = 0; else VCB[(b * 256 + 255) * 64 + lane] = 0; } }
}

struct FMergeAll { const bf16_t* GATES; bf16_t* MIXB;
    DEV void operator()(int row, int vcol, const f32x4& v0, const f32x4& v1) const {
        const int n = vcol >> 10, col = vcol & 1023;
        const u32x4 gw = *(const u32x4*)(GATES + (size_t)row * NGATE + n * 1024 + col);
        f32x4 a = (f32x4){sigm(bflo(gw.x)), sigm(bfhi(gw.x)), sigm(bflo(gw.y)), sigm(bfhi(gw.y))} * v0, b = (f32x4){sigm(bflo(gw.z)), sigm(bfhi(gw.z)), sigm(bflo(gw.w)), sigm(bfhi(gw.w))} * v1;
        bf16_t* mx = MIXB + (size_t)row * 1024 + col;
        if (n > 0) { const u32x4 pv = *(const u32x4*)mx; a += (f32x4){bflo(pv.x), bfhi(pv.x), bflo(pv.y), bfhi(pv.y)}; b += (f32x4){bflo(pv.z), bfhi(pv.z), bflo(pv.w), bfhi(pv.w)}; }
        u32x4 w; w.x = pk2(a[0], a[1]); w.y = pk2(a[2], a[3]); w.z = pk2(b[0], b[1]); w.w = pk2(b[2], b[3]); *(u32x4*)mx = w; } };
struct MergeOrder { pg8::StaticOrder so;
    DEV bool next(int i, pg8::Unit& u) const { if (!so.next(i >> 2, u)) return false; const int n = i & 3; u.pn += 4 * n; u.ao = n * 512; return true; } };
template <int NB> DEV void phase_merge(const Params& p, const Ctx& c, int l) {
    pg8::Gemm g{WSP(bf16_t, WS_BR), WSP(bf16_t, WS_WBR) + (size_t)l * 4 * 1024 * 256, 1024, 256};
    MergeOrder S; S.so.init(NTOK, 1024, c.G, c.bid);
    pg8::Epi8<FMergeAll> E{{WSP(bf16_t, WS_GATES), (bf16_t*)(p.ws + WS_BIG + BIG_MIXB)}};
    pg8::gemm_phase<pg8::Epi8<FMergeAll>, MergeOrder, true>(c.lds, g, S, E);
}
struct FOut { float* X; const float* g1; float* XO;
    DEV void operator()(int row, int col, const f32x4& v0, const f32x4& v1) const { const float* gg = g1 + (row / SEQ) * 6144 + col; float* x = X + (size_t)row * DM + col;
        float* xo = XO + (size_t)row * DM + col; *(f32x4*)xo = *(const f32x4*)x + *(const f32x4*)gg * v0; *(f32x4*)(xo + 4) = *(const f32x4*)(x + 4) + *(const f32x4*)(gg + 4) * v1; } };
template <bool REAL> DEV void phase_out(const Params& p, const Ctx& c, int l) {
    pg8::Gemm g{(const bf16_t*)(p.ws + WS_BIG + BIG_MIXB), WSP(bf16_t, WS_WOUT) + (size_t)l * 1024 * 1024, 1024, 1024};
    pg8::StaticOrder S; S.init(NTOK, 1024, c.G, c.bid);
    pg8::Epi8<FOut> E{{p.out, WSP(float, WS_MOD) + (size_t)l * 4 * 6144 + 2048, REAL ? p.out : WSP(float, WS_MUR)}};
    pg8::gemm_phase<pg8::Epi8<FOut>, pg8::StaticOrder, true>(c.lds, g, S, E);
}

template <bool COUNT> DEV void phase_router(const Params& p, const Ctx& c, int l) {
    const float* MOD = WSP(float, WS_MOD); bf16_t* H2B = WSP(bf16_t, WS_HBF);
    int* EID = WSP(int, WS_MISC + MISC_EID); float* WTS = WSP(float, WS_MISC + MISC_WTS);
    const float* WRT = WSP(float, WS_MISC + MISC_WRT) + (size_t)l * 36 * 1024;
    const int lane = c.lane;
    LAS int* hist = (LAS int*)(c.lds + 8192);
    if (c.tid < 32) hist[c.tid] = 0;
    __syncthreads();
    const int rpb = NTOK / c.G, rpw = rpb / 8;
    LAS float* lgs = (LAS float*)(c.lds + c.wave * 1024);
    for (int ri = 0; ri < rpw; ri += 4) { const int row0 = c.bid * rpb + c.wave * rpw + ri; const int b = row0 / SEQ;
        f32x4 v[4][4];
        const float* gn = p.in[4] + (size_t)(l * 2 + 1) * DM; const float* sh = MOD + (l * 4 + b) * 6144 + 3072; const float* sc = sh + 1024;
#pragma unroll
        for (int q = 0; q < 4; ++q) { float ss = 0.f;
#pragma unroll
            for (int j = 0; j < 4; ++j) { v[q][j] = *(const f32x4*)(p.out + (size_t)(row0 + q) * DM + j * 256 + lane * 4); ss += (v[q][j][0] * v[q][j][0] + v[q][j][1] * v[q][j][1]) + (v[q][j][2] * v[q][j][2] + v[q][j][3] * v[q][j][3]); }
            const float r = rsqrtf(wave_sum(ss) * (1.f / DM) + EPS);
#pragma unroll
            for (int j = 0; j < 4; ++j) { const int col = j * 256 + lane * 4;
                const f32x4 g = *(const f32x4*)(gn + col), s1 = *(const f32x4*)(sc + col), s0 = *(const f32x4*)(sh + col);
                v[q][j] = v[q][j] * r * g * (s1 + 1.f) + s0;
                u32x2 o; o.x = pk2(v[q][j][0], v[q][j][1]); o.y = pk2(v[q][j][2], v[q][j][3]); *(u32x2*)(H2B + (size_t)(row0 + q) * DM + col) = o; } }
#pragma unroll 1
        for (int eg = 0; eg < 18; ++eg) { float a[2][4];
#pragma unroll
            for (int u = 0; u < 2; ++u) { const float* wr = WRT + (eg * 2 + u) * 1024 + lane * 4; f32x4 wv[4];
#pragma unroll
                for (int j = 0; j < 4; ++j) wv[j] = *(const f32x4*)(wr + j * 256);
#pragma unroll
                for (int q = 0; q < 4; ++q) { float t = 0.f;
#pragma unroll
                    for (int j = 0; j < 4; ++j) t += (v[q][j][0] * wv[j][0] + v[q][j][1] * wv[j][1]) + (v[q][j][2] * wv[j][2] + v[q][j][3] * wv[j][3]);
                    a[u][q] = t; } }
#pragma unroll
            for (int u = 0; u < 2; ++u)
#pragma unroll
                for (int q = 0; q < 4; ++q) a[u][q] = wave_sum(a[u][q]);
            if (lane == 0) {
#pragma unroll
                for (int q = 0; q < 4; ++q) { lgs[q * 64 + eg * 2] = a[0][q]; lgs[q * 64 + eg * 2 + 1] = a[1][q]; } } }
        LDS_WAIT(); asm volatile("" ::: "memory");
        if (lane < 4) { const LAS float* lg = lgs + lane * 64; const int row = row0 + lane;
            float lc[4];
#pragma unroll
            for (int i = 0; i < 4; ++i) lc[i] = lg[i] + p.in[19][l * 4 + i];
            int grp = 0; float mx = lc[0];
#pragma unroll
            for (int i = 1; i < 4; ++i) if (lc[i] > mx) { mx = lc[i]; grp = i; }
            float z = 0.f;
#pragma unroll
            for (int i = 0; i < 4; ++i) z += __expf(lc[i] - mx);
            const float pg = 1.f / z;
            float f1 = -INFINITY, f2 = -INFINITY; int e1 = 0, e2 = 0;
#pragma unroll
            for (int i = 0; i < 8; ++i) { const float x = lg[4 + grp * 8 + i] + p.in[21][l * 32 + grp * 8 + i];
                if (x > f1) { f2 = f1; e2 = e1; f1 = x; e1 = i; } else if (x > f2) { f2 = x; e2 = i; } }
            const float q2 = __expf(f2 - f1); const float w1 = pg / (1.f + q2), w2 = pg * q2 / (1.f + q2);
            const int x1 = grp * 8 + e1, x2 = grp * 8 + e2;
            EID[row * 2] = x1; EID[row * 2 + 1] = x2; WTS[row * 2] = w1; WTS[row * 2 + 1] = w2;
            __hip_atomic_fetch_add(hist + x1, 1, __ATOMIC_RELAXED, __HIP_MEMORY_SCOPE_WORKGROUP); __hip_atomic_fetch_add(hist + x2, 1, __ATOMIC_RELAXED, __HIP_MEMORY_SCOPE_WORKGROUP); }
        LDS_WAIT(); asm volatile("" ::: "memory");
    }
    __syncthreads();
    if (c.tid < 32) WSP(int, WS_MISC + MISC_HIST)[c.bid * 32 + c.tid] = hist[c.tid];
}

struct MoeTab { LAS int* start; LAS int* tile_e; LAS int* ntiles; };
DEV MoeTab build_moe_tab(const Params& p, const Ctx& c, int l) {
    MoeTab T; T.start = (LAS int*)(c.lds + LDS_AUX + 1024); T.tile_e = T.start + 32; T.ntiles = T.tile_e + 192;
    __syncthreads();
    if (c.tid == 0) { const unsigned* cnt = WSP(unsigned, WS_CTL) + CW_CNT + l * 32; int row = 0, nt = 0;
        for (int e = 0; e < 32; ++e) { const int n = (int)__hip_atomic_load(cnt + e, __ATOMIC_RELAXED, __HIP_MEMORY_SCOPE_AGENT); T.start[e] = row; const int tiles = (n + 255) >> 8;
            for (int i = 0; i < tiles; ++i) T.tile_e[nt + i] = e;
            nt += tiles; row += tiles * 256; }
        T.ntiles[0] = nt; }
    __syncthreads();
    return T;
}
DEV void phase_moesort(const Params& p, const Ctx& c, int l, int rep) {
    const int* HIST = WSP(int, WS_MISC + MISC_HIST);
    LAS int* part = (LAS int*)(c.lds + 4096);
    LAS int* base = part + 1024;
    LAS int* curs = base + 32;
    LAS int* tot = curs + 32;
    { const int e = c.tid & 31, seg = c.tid >> 5; int sa = 0, sp = 0;
      for (int i = 0; i < 16; ++i) { const int bb = seg * 16 + i; if (bb < c.G) { const int hv = HIST[bb * 32 + e]; sa += hv; sp += bb < c.bid ? hv : 0; } }
      part[seg * 32 + e] = sa; part[512 + seg * 32 + e] = sp; }
    __syncthreads();
    if (c.tid < 32) { int sa = 0, sp = 0;
        for (int i = 0; i < 16; ++i) { sa += part[i * 32 + c.tid]; sp += part[512 + i * 32 + c.tid]; }
        tot[c.tid] = sa; base[c.tid] = sp; curs[c.tid] = 0;
        if (c.bid == 0) WSP(unsigned, WS_CTL)[CW_CNT + l * 32 + c.tid] = (unsigned)sa; }
    __syncthreads();
    if (c.tid == 0) { int row = 0; for (int e = 0; e < 32; ++e) { base[e] += row; row += ((tot[e] + 255) >> 8) << 8; } }
    __syncthreads();
    const int* EID = WSP(int, WS_MISC + MISC_EID); int* PSLOT = WSP(int, WS_MISC + MISC_PSLOT);
    const bf16_t* H2B = WSP(bf16_t, WS_HBF); bf16_t* XS = (bf16_t*)(p.ws + WS_BIG + BIG_XS);
    const int lane = c.lane; const int rpb = NTOK / c.G, rpw = rpb / 8;
    for (int ri = 0; ri < rpw; ++ri) { const int tok = c.bid * rpb + c.wave * rpw + ri;
        const u32x4 a = *(const u32x4*)(H2B + (size_t)tok * DM + lane * 16), b2 = *(const u32x4*)(H2B + (size_t)tok * DM + lane * 16 + 8);
#pragma unroll
        for (int k = 0; k < 2; ++k) { const int e = EID[tok * 2 + k]; int slot = 0;
            if (lane == 0) slot = base[e] + __hip_atomic_fetch_add(curs + e, 1, __ATOMIC_RELAXED, __HIP_MEMORY_SCOPE_WORKGROUP);
            slot = __builtin_amdgcn_readfirstlane(slot);
            if (lane == 0) PSLOT[tok * 2 + k] = slot;
            *(u32x4*)(XS + (size_t)slot * DM + lane * 16) = a; *(u32x4*)(XS + (size_t)slot * DM + lane * 16 + 8) = b2; }
    }
}
template <int NCOL> struct MoeOrder { int G, c; LAS const int* tile_e; int ntiles;
    DEV bool next(int i, pg8::Unit& u) const { const int L = i * G + c; if (L >= ntiles * NCOL) return false; const int pm = L / NCOL; u.pm = pm; u.pn = tile_e[pm] * NCOL + (L % NCOL); u.ao = 0; return true; } };
struct FMoe1 { bf16_t* ACTB;
    DEV void operator()(int row, int col, const f32x4& v0, const f32x4& v1) const { const int ce = col & 511;
        u32x2 w; w.x = pk2(silu_(v0[0]) * v0[1], silu_(v0[2]) * v0[3]); w.y = pk2(silu_(v1[0]) * v1[1], silu_(v1[2]) * v1[3]);
        *(u32x2*)(ACTB + (size_t)row * 256 + (ce >> 1)) = w; } };
struct FMoe2 { bf16_t* YP;
    DEV void operator()(int row, int col, const f32x4& v0, const f32x4& v1) const { const int ce = col & 1023;
        u32x4 w; w.x = pk2(v0[0], v0[1]); w.y = pk2(v0[2], v0[3]); w.z = pk2(v1[0], v1[1]); w.w = pk2(v1[2], v1[3]); *(u32x4*)(YP + (size_t)row * DM + ce) = w; } };
DEV void phase_moe1(const Params& p, const Ctx& c, int l) {
    const MoeTab T = build_moe_tab(p, c, l);
    pg8::Gemm g{(const bf16_t*)(p.ws + WS_BIG + BIG_XS), WSP(bf16_t, WS_W13) + (size_t)l * 32 * 512 * 1024, 1024, 1024};
    MoeOrder<2> S{c.G, c.bid, T.tile_e, T.ntiles[0]}; pg8::Epi8<FMoe1> E{{WSP(bf16_t, WS_MUR)}};
    pg8::gemm_phase<pg8::Epi8<FMoe1>, MoeOrder<2>, true>(c.lds, g, S, E);
}
DEV void phase_moe2(const Params& p, const Ctx& c, int l) {
    const MoeTab T = build_moe_tab(p, c, l);
    pg8::Gemm g{WSP(bf16_t, WS_MUR), WSP(bf16_t, WS_W2) + (size_t)l * 32 * 1024 * 256, 256, 256};
    MoeOrder<4> S{c.G, c.bid, T.tile_e, T.ntiles[0]}; pg8::Epi8<FMoe2> E{{(bf16_t*)(p.ws + WS_BIG + BIG_YP)}};
    pg8::gemm_phase<pg8::Epi8<FMoe2>, MoeOrder<4>, true>(c.lds, g, S, E);
}

constexpr int PH_PRO = 0, PH_NORM1 = 1, PH_INPROJ = 2, PH_POST = 3, PH_MLAUP = 4, PH_POST2 = 5, PH_ATTN = 6, PH_CMPATTN = 7, PH_TOPK = 8, PH_SLC = 9,
              PH_MERGE0 = 10, PH_MERGE1 = 11, PH_MERGE2 = 12, PH_MERGE3 = 13, PH_OUT = 14, PH_ROUTER = 15, PH_SORT = 16, PH_MOE1 = 17, PH_MOE2 = 18, PH_FINAL = 19, PH_COUNT = 20;
constexpr int LDS_PTAB = LDS_AUX + 64;
DEV unsigned long long uni64(unsigned long long v) { const unsigned lo = __builtin_amdgcn_readfirstlane((unsigned)v), hi = __builtin_amdgcn_readfirstlane((unsigned)(v >> 32)); return ((unsigned long long)hi << 32) | lo; }
DEV void store_params(const Params& p, LAS unsigned char* lds) {
    LAS unsigned long long* L = (LAS unsigned long long*)(lds + LDS_PTAB);
    if (threadIdx.x == 0) {
#pragma unroll
        for (int i = 0; i < 24; ++i) L[i] = (unsigned long long)p.in[i];
        L[24] = (unsigned long long)p.out; L[25] = (unsigned long long)p.ws; }
}
DEV Params load_params(LAS unsigned char* lds) {
    const LAS unsigned long long* L = (const LAS unsigned long long*)(lds + LDS_PTAB); Params p;
#pragma unroll
    for (int i = 0; i < 24; ++i) p.in[i] = (const float*)uni64(L[i]);
    p.out = (float*)uni64(L[24]); p.ws = (unsigned char*)uni64(L[25]); return p;
}
template <int PH, int REP = 0> DEV void run_phase(const Params& p, const Ctx& c, int l) {
    if constexpr (PH == PH_PRO) phase_prologue(p, c);
    else if constexpr (PH == PH_NORM1) phase_norm1<true, REP == 0>(p, c, l);
    else if constexpr (PH == PH_INPROJ) phase_inproj(p, c, l);
    else if constexpr (PH == PH_POST) phase_post(p, c, l);
    else if constexpr (PH == PH_MLAUP) phase_mlaup(p, c, l);
    else if constexpr (PH == PH_POST2) phase_post2(p, c, l);
    else if constexpr (PH == PH_ATTN) phase_cmpw2(p, c, l);
    else if constexpr (PH == PH_CMPATTN) phase_cmpsel(p, c, l);
    else if constexpr (PH == PH_TOPK) { }
    else if constexpr (PH == PH_SLC) phase_attn2(p, c, l + 8 * REP);
    else if constexpr (PH == PH_MERGE0) phase_merge<0>(p, c, l);
    else if constexpr (PH == PH_OUT) phase_out<REP == 0>(p, c, l);
    else if constexpr (PH == PH_ROUTER) phase_router<REP == 0>(p, c, l);
    else if constexpr (PH == PH_SORT) phase_moesort(p, c, l, REP);
    else if constexpr (PH == PH_MOE1) phase_moe1(p, c, l);
    else if constexpr (PH == PH_MOE2) phase_moe2(p, c, l);
    else if constexpr (PH == PH_FINAL) phase_norm1<false, true>(p, c, NLAYER);
}

#if !MK_ONE_LAUNCH
template <int PH> __global__ void __launch_bounds__(512, 2) k_phase(Params p, int l) {
    extern __shared__ __attribute__((aligned(16))) unsigned char lds_raw[];
    const Ctx c = make_ctx((LAS unsigned char*)lds_raw);
    run_phase<PH>(p, c, l);
}
template <int PH> static void launch_phase(const Params& p, int l, int grid, hipStream_t stream) {
    static bool attr_set = false;
    if (!attr_set) { (void)hipFuncSetAttribute((const void*)k_phase<PH>, hipFuncAttributeMaxDynamicSharedMemorySize, LDS_BYTES); attr_set = true; }
    hipLaunchKernelGGL(k_phase<PH>, dim3(grid), dim3(512), LDS_BYTES, stream, p, l);
}
#else
#define BAR() xcd_barrier_fn(bar.bar, bar.x, bar.st)
template <int l> DEV void mega_layer(LAS unsigned char* lds, const XcdBarrier& bar) {
        { const Ctx c = make_ctx(lds); const Params q = load_params(lds); run_phase<PH_NORM1>(q, c, l); } BAR(); if constexpr ((PROBE_MASK >> PH_NORM1) & 1u) { { const Ctx c = make_ctx(lds); const Params q = load_params(lds); run_phase<PH_NORM1, 1>(q, c, l); } BAR(); }
        { const Ctx c = make_ctx(lds); const Params q = load_params(lds); run_phase<PH_INPROJ>(q, c, l); } BAR(); if constexpr ((PROBE_MASK >> PH_INPROJ) & 1u) { { const Ctx c = make_ctx(lds); const Params q = load_params(lds); run_phase<PH_INPROJ, 1>(q, c, l); } BAR(); }
        { const Ctx c = make_ctx(lds); const Params q = load_params(lds); run_phase<PH_POST>(q, c, l); } BAR(); if constexpr ((PROBE_MASK >> PH_POST) & 1u) { { const Ctx c = make_ctx(lds); const Params q = load_params(lds); run_phase<PH_POST, 1>(q, c, l); } BAR(); }
        { const Ctx c = make_ctx(lds); const Params q = load_params(lds); run_phase<PH_MLAUP>(q, c, l); } BAR(); if constexpr ((PROBE_MASK >> PH_MLAUP) & 1u) { { const Ctx c = make_ctx(lds); const Params q = load_params(lds); run_phase<PH_MLAUP, 1>(q, c, l); } BAR(); }
        { const Ctx c = make_ctx(lds); const Params q = load_params(lds); run_phase<PH_POST2>(q, c, l); } BAR(); if constexpr ((PROBE_MASK >> PH_POST2) & 1u) { { const Ctx c = make_ctx(lds); const Params q = load_params(lds); run_phase<PH_POST2, 1>(q, c, l); } BAR(); }
        { const Ctx c = make_ctx(lds); const Params q = load_params(lds); run_phase<PH_ATTN>(q, c, l); } BAR(); if constexpr ((PROBE_MASK >> PH_ATTN) & 1u) { { const Ctx c = make_ctx(lds); const Params q = load_params(lds); run_phase<PH_ATTN, 1>(q, c, l); } BAR(); }
        { const Ctx c = make_ctx(lds); const Params q = load_params(lds); run_phase<PH_CMPATTN>(q, c, l); } BAR(); if constexpr ((PROBE_MASK >> PH_CMPATTN) & 1u) { { const Ctx c = make_ctx(lds); const Params q = load_params(lds); run_phase<PH_CMPATTN, 1>(q, c, l); } BAR(); }
        { const Ctx c = make_ctx(lds); const Params q = load_params(lds); run_phase<PH_SLC>(q, c, l); } BAR(); if constexpr ((PROBE_MASK >> PH_SLC) & 1u) { { const Ctx c = make_ctx(lds); const Params q = load_params(lds); run_phase<PH_SLC, 1>(q, c, l); } BAR(); }
        { const Ctx c = make_ctx(lds); const Params q = load_params(lds); run_phase<PH_MERGE0>(q, c, l); } BAR(); if constexpr ((PROBE_MASK >> PH_MERGE0) & 1u) { { const Ctx c = make_ctx(lds); const Params q = load_params(lds); run_phase<PH_MERGE0, 1>(q, c, l); } BAR(); }
        { const Ctx c = make_ctx(lds); const Params q = load_params(lds); run_phase<PH_OUT>(q, c, l); } BAR(); if constexpr ((PROBE_MASK >> PH_OUT) & 1u) { { const Ctx c = make_ctx(lds); const Params q = load_params(lds); run_phase<PH_OUT, 1>(q, c, l); } BAR(); }
        { const Ctx c = make_ctx(lds); const Params q = load_params(lds); run_phase<PH_ROUTER>(q, c, l); } BAR(); if constexpr ((PROBE_MASK >> PH_ROUTER) & 1u) { { const Ctx c = make_ctx(lds); const Params q = load_params(lds); run_phase<PH_ROUTER, 1>(q, c, l); } BAR(); }
        { const Ctx c = make_ctx(lds); const Params q = load_params(lds); run_phase<PH_SORT>(q, c, l); } BAR(); if constexpr ((PROBE_MASK >> PH_SORT) & 1u) { { const Ctx c = make_ctx(lds); const Params q = load_params(lds); run_phase<PH_SORT, 1>(q, c, l); } BAR(); }
        { const Ctx c = make_ctx(lds); const Params q = load_params(lds); run_phase<PH_MOE1>(q, c, l); } BAR(); if constexpr ((PROBE_MASK >> PH_MOE1) & 1u) { { const Ctx c = make_ctx(lds); const Params q = load_params(lds); run_phase<PH_MOE1, 1>(q, c, l); } BAR(); }
        { const Ctx c = make_ctx(lds); const Params q = load_params(lds); run_phase<PH_MOE2>(q, c, l); } BAR(); if constexpr ((PROBE_MASK >> PH_MOE2) & 1u) { { const Ctx c = make_ctx(lds); const Params q = load_params(lds); run_phase<PH_MOE2, 1>(q, c, l); } BAR(); }
}
__global__ void __launch_bounds__(512, 2) k_mega(Params p) {
    extern __shared__ __attribute__((aligned(16))) unsigned char lds_raw[];
    LAS unsigned char* lds = (LAS unsigned char*)lds_raw;
    volatile LAS unsigned* bst = (volatile LAS unsigned*)(lds + LDS_AUX);
    if (threadIdx.x < 4) bst[threadIdx.x] = 0u;
    store_params(p, lds);
    __syncthreads();
    const XcdBarrier bar = xcd_barrier_post(WSP(unsigned, WS_CTL) + CW_BAR, bst);
    { const Ctx c = make_ctx(lds); const Params q = load_params(lds); run_phase<PH_PRO>(q, c, 0); } BAR(); if constexpr ((PROBE_MASK >> PH_PRO) & 1u) { { const Ctx c = make_ctx(lds); const Params q = load_params(lds); run_phase<PH_PRO, 1>(q, c, 0); } BAR(); }
    mega_layer<0>(lds, bar); mega_layer<1>(lds, bar); mega_layer<2>(lds, bar); mega_layer<3>(lds, bar);
    { const Ctx c = make_ctx(lds); const Params q = load_params(lds); run_phase<PH_FINAL>(q, c, NLAYER); }
#undef BAR
}
#endif

extern "C" void kernel_launch(void* const* d_in, const int* in_sizes, int n_in, void* d_out, int out_size, void* d_ws, size_t ws_size, hipStream_t stream) {
    if (n_in != 24 || out_size != NTOK * DM || ws_size < WS_END) { fprintf(stderr, "kernel_launch: unexpected shapes (n_in %d out %d ws %zu, need %zu)\n", n_in, out_size, ws_size, (size_t)WS_END); return; }
    Params p{};
    for (int i = 0; i < 24; ++i) p.in[i] = (const float*)d_in[i];
    p.out = (float*)d_out; p.ws = (unsigned char*)d_ws;
    (void)hipMemsetAsync((char*)d_ws + WS_CTL, 0, 1 * MiB, stream);
    const int grid = 256;
#if !MK_ONE_LAUNCH
    launch_phase<PH_PRO>(p, 0, grid, stream);
    for (int l = 0; l < NLAYER; ++l) {
        launch_phase<PH_NORM1>(p, l, grid, stream);
        launch_phase<PH_INPROJ>(p, l, grid, stream);
        launch_phase<PH_POST>(p, l, grid, stream);
        launch_phase<PH_MLAUP>(p, l, grid, stream);
        launch_phase<PH_POST2>(p, l, grid, stream);
        launch_phase<PH_ATTN>(p, l, grid, stream);
        launch_phase<PH_CMPATTN>(p, l, grid, stream);
        launch_phase<PH_SLC>(p, l, grid, stream);
        launch_phase<PH_MERGE0>(p, l, grid, stream);
        launch_phase<PH_OUT>(p, l, grid, stream);
        launch_phase<PH_ROUTER>(p, l, grid, stream);
        launch_phase<PH_SORT>(p, l, grid, stream);
        launch_phase<PH_MOE1>(p, l, grid, stream);
        launch_phase<PH_MOE2>(p, l, grid, stream);
    }
    launch_phase<PH_FINAL>(p, NLAYER, grid, stream);
#else
    static bool attr_set = false;
    if (!attr_set) { (void)hipFuncSetAttribute((const void*)k_mega, hipFuncAttributeMaxDynamicSharedMemorySize, LDS_BYTES); attr_set = true; }
    hipLaunchKernelGGL(k_mega, dim3(grid), dim3(512), LDS_BYTES, stream, p);
#endif
}
```
